# Optimizing an MI355X kernel written in HIP

```python
import jax, jax.numpy as jnp
from jax import lax
import numpy as np

D_MODEL = 1024
BATCH = 8
SEQ = 4096
DEPTH = 1

N_HEADS = 8
HEAD_DIM = 64
N_KV = 2
GROUP = N_HEADS // N_KV
ROT_DIM = HEAD_DIM // 4
ROPE_THETA = 500000.0
CMP_BLOCK = 32
CMP_STRIDE = 16
CMP_HIDDEN = 4 * HEAD_DIM
SEL_BLOCK = 64
SEL_TOPK = 16
WINDOW = 512
Q_BLOCK = 128
N_NSA_BRANCHES = 3
ATTN_WIDTH = N_HEADS * HEAD_DIM
KV_WIDTH = N_KV * HEAD_DIM
POOL_WIDTH = 512
POOL_WINDOWS = (2, 4, 8, 16)
POOL_GROUP = POOL_WIDTH // len(POOL_WINDOWS)
D_FF = 4 * D_MODEL
IN_SIZES = (ATTN_WIDTH, 6 * KV_WIDTH, N_NSA_BRANCHES * N_HEADS, POOL_WIDTH, 2 * D_MODEL)
IN_WIDTH = sum(IN_SIZES)
EPS = 1e-6
NEG_INF = -1e30
FORCE_SCORE = 1e4

kernel_name = "nsa_pool_gated_hybrid_block"


def rms_norm(x, g):
    xf = x.astype(jnp.float32)
    y = xf * lax.rsqrt(jnp.mean(xf * xf, axis=-1, keepdims=True) + EPS)
    return (y * g.astype(jnp.float32)).astype(x.dtype)


def rope(x, pos):
    inv = ROPE_THETA ** (-jnp.arange(0, ROT_DIM, 2, dtype=jnp.float32) / ROT_DIM)
    ang = pos.astype(jnp.float32)[:, None] * inv
    cos, sin = jnp.cos(ang), jnp.sin(ang)
    xr = x[..., :ROT_DIM].astype(jnp.float32)
    x1, x2 = xr[..., :ROT_DIM // 2], xr[..., ROT_DIM // 2:]
    rot = jnp.concatenate([x1 * cos - x2 * sin, x2 * cos + x1 * sin], axis=-1)
    return jnp.concatenate([rot.astype(x.dtype), x[..., ROT_DIM:]], axis=-1)


def masked_softmax(s, mask):
    s = jnp.where(mask, s.astype(jnp.float32), NEG_INF)
    e = jnp.exp(s - jnp.max(s, axis=-1, keepdims=True)) * mask
    return e / jnp.maximum(jnp.sum(e, axis=-1, keepdims=True), 1e-30)


def cmp_to_sel_matrix(S):
    n_cmp = (S - CMP_BLOCK) // CMP_STRIDE + 1
    n_sel = S // SEL_BLOCK
    cs = np.arange(n_cmp)[:, None] * CMP_STRIDE
    js = np.arange(n_sel)[None, :] * SEL_BLOCK
    ov = np.clip(np.minimum(cs + CMP_BLOCK, js + SEL_BLOCK) - np.maximum(cs, js), 0, None)
    return jnp.asarray((ov / CMP_STRIDE).astype(np.float32))


def compress_blocks(k, pe, w1, w2):
    B, G, S, dh = k.shape
    ratio = CMP_BLOCK // CMP_STRIDE
    chunks = k.reshape(B, G, S // CMP_STRIDE, CMP_STRIDE, dh)
    n_cmp = S // CMP_STRIDE - ratio + 1
    blocks = jnp.concatenate([chunks[:, :, j:j + n_cmp] for j in range(ratio)], axis=3)
    flat = (blocks + pe).reshape(B, G, n_cmp, CMP_BLOCK * dh)
    return jax.nn.gelu(flat @ w1) @ w2


def nsa_attention(q_flat, kv_flat, gate_logits, pe_k, pe_v, ck_w1, ck_w2, cv_w1, cv_w2):
    B, S, _ = q_flat.shape
    dt = q_flat.dtype
    scale = HEAD_DIM ** -0.5
    t = jnp.arange(S)
    q = rope(q_flat.reshape(B, S, N_KV, GROUP, HEAD_DIM).transpose(0, 2, 3, 1, 4), t)

    def kv_heads(a):
        return a.reshape(B, S, N_KV, HEAD_DIM).transpose(0, 2, 1, 3)

    kc, vc, ks, vs, kw, vw = [kv_heads(a) for a in jnp.split(kv_flat, 6, axis=-1)]
    ks = rope(ks, t)
    kw = rope(kw, t)

    n_cmp = (S - CMP_BLOCK) // CMP_STRIDE + 1
    pos_c = jnp.arange(n_cmp) * CMP_STRIDE + CMP_BLOCK - 1
    k_cmp = rope(compress_blocks(kc, pe_k, ck_w1, ck_w2), pos_c)
    v_cmp = compress_blocks(vc, pe_v, cv_w1, cv_w2)
    s = jnp.einsum('bgrsd,bgcd->bgrsc', q, k_cmp) * scale
    p_cmp = masked_softmax(s, pos_c[None, :] <= t[:, None])
    o_cmp = jnp.einsum('bgrsc,bgcd->bgrsd', p_cmp.astype(dt), v_cmp)

    n_sel = S // SEL_BLOCK
    top = min(SEL_TOPK, n_sel)
    imp = jnp.einsum('bgrsc,cj->bgsj', p_cmp, cmp_to_sel_matrix(S))
    blk = jnp.arange(n_sel)[None, :]
    cur = (t // SEL_BLOCK)[:, None]
    imp = jnp.where(blk > cur, -FORCE_SCORE, imp)
    imp = jnp.where((blk == 0) | (blk == cur) | (blk == cur - 1), FORCE_SCORE, imp)
    _, sel_idx = lax.top_k(imp, top)

    nq = S // Q_BLOCK
    q_blocks = q.reshape(B, N_KV, GROUP, nq, Q_BLOCK, HEAD_DIM).transpose(3, 0, 1, 2, 4, 5)
    idx_blocks = sel_idx.reshape(B, N_KV, nq, Q_BLOCK, top).transpose(2, 0, 1, 3, 4)
    ks_blk = ks.reshape(B, N_KV, n_sel, SEL_BLOCK, HEAD_DIM)
    vs_blk = vs.reshape(B, N_KV, n_sel, SEL_BLOCK, HEAD_DIM)
    pad = ((0, 0), (0, 0), (WINDOW, 0), (0, 0))
    kw_pad = jnp.pad(kw, pad)
    vw_pad = jnp.pad(vw, pad)
    bi = jnp.arange(B)[:, None, None, None]
    gi = jnp.arange(N_KV)[None, :, None, None]
    offs = jnp.arange(SEL_BLOCK)
    band = WINDOW + Q_BLOCK

    def step(args):
        i, qb, ib = args
        qpos = i * Q_BLOCK + jnp.arange(Q_BLOCK)
        k_sel = ks_blk[bi, gi, ib].reshape(B, N_KV, Q_BLOCK, top * SEL_BLOCK, HEAD_DIM)
        v_sel = vs_blk[bi, gi, ib].reshape(B, N_KV, Q_BLOCK, top * SEL_BLOCK, HEAD_DIM)
        kpos = (ib[..., None] * SEL_BLOCK + offs).reshape(B, N_KV, Q_BLOCK, top * SEL_BLOCK)
        s_sel = jnp.einsum('bgrqd,bgqkd->bgrqk', qb, k_sel) * scale
        p_sel = masked_softmax(s_sel, (kpos <= qpos[:, None])[:, :, None])
        o_sel = jnp.einsum('bgrqk,bgqkd->bgrqd', p_sel.astype(dt), v_sel)
        k_win = lax.dynamic_slice_in_dim(kw_pad, i * Q_BLOCK, band, axis=2)
        v_win = lax.dynamic_slice_in_dim(vw_pad, i * Q_BLOCK, band, axis=2)
        wpos = i * Q_BLOCK - WINDOW + jnp.arange(band)
        dist = qpos[:, None] - wpos[None, :]
        wmask = (dist >= 0) & (dist < WINDOW) & (wpos >= 0)[None, :]
        s_win = jnp.einsum('bgrqd,bgkd->bgrqk', qb, k_win) * scale
        p_win = masked_softmax(s_win, wmask)
        o_win = jnp.einsum('bgrqk,bgkd->bgrqd', p_win.astype(dt), v_win)
        return o_sel, o_win

    o_sel, o_win = lax.map(step, (jnp.arange(nq), q_blocks, idx_blocks))
    o_sel = o_sel.transpose(1, 2, 3, 0, 4, 5).reshape(B, N_KV, GROUP, S, HEAD_DIM)
    o_win = o_win.transpose(1, 2, 3, 0, 4, 5).reshape(B, N_KV, GROUP, S, HEAD_DIM)

    g = jax.nn.sigmoid(gate_logits).reshape(B, S, N_NSA_BRANCHES, N_KV, GROUP).transpose(2, 0, 3, 4, 1)[..., None]
    o = g[0] * o_cmp + g[1] * o_sel + g[2] * o_win
    return o.transpose(0, 3, 1, 2, 4).reshape(B, S, ATTN_WIDTH)


def pool_mixer(u, w_pool, pool_scale):
    B, S, _ = u.shape
    uf = u.astype(jnp.float32)
    csp = jnp.concatenate([jnp.zeros((B, 1, POOL_WIDTH), jnp.float32), jnp.cumsum(uf, axis=1)], axis=1)
    t = jnp.arange(S)
    outs = []
    for gidx, w in enumerate(POOL_WINDOWS):
        lo, hi = gidx * POOL_GROUP, (gidx + 1) * POOL_GROUP
        c = csp[..., lo:hi]
        lower = jnp.concatenate([jnp.zeros((B, w - 1, POOL_GROUP), jnp.float32), c[:, :S - w + 1]], axis=1)
        cnt = jnp.minimum(t + 1, w).astype(jnp.float32)[:, None]
        outs.append((c[:, 1:] - lower) / cnt - uf[..., lo:hi])
    pooled = jnp.stack(outs, axis=2).astype(u.dtype)
    mixed = jnp.einsum('bsgc,gcd->bsgd', pooled, w_pool).reshape(B, S, POOL_WIDTH)
    return mixed * pool_scale


def hybrid_layer(x, norm_mix, w_in, cmp_pe_k, cmp_pe_v, cmp_k_w1, cmp_k_w2, cmp_v_w1, cmp_v_w2,
                 w_branch_attn, pool_w, pool_scale, w_branch_pool, w_out, norm_mlp, w_ff1, w_ff2):
    h = rms_norm(x, norm_mix)
    proj = h @ w_in
    q_flat, kv_flat, g_attn, u_pool, g_merge = jnp.split(proj, np.cumsum(IN_SIZES)[:-1].tolist(), axis=-1)
    a = nsa_attention(q_flat, kv_flat, g_attn, cmp_pe_k, cmp_pe_v, cmp_k_w1, cmp_k_w2, cmp_v_w1, cmp_v_w2) @ w_branch_attn
    b = pool_mixer(u_pool, pool_w, pool_scale) @ w_branch_pool
    ga, gb = jnp.split(jax.nn.sigmoid(g_merge), 2, axis=-1)
    x = x + (ga * a + gb * b) @ w_out
    h = rms_norm(x, norm_mlp)
    return x + jnp.square(jax.nn.relu(h @ w_ff1)) @ w_ff2


def setup_inputs(seed: int = 0) -> dict:
    key = jax.random.key(seed)
    ks = jax.random.split(key, 20)
    f32 = jnp.float32

    def nrm(k, shape, fan_in):
        return jax.random.normal(k, shape, f32) * (fan_in ** -0.5)

    def gain(k, shape):
        return 1.0 + 0.05 * jax.random.normal(k, shape, f32)

    L = DEPTH
    return {
        "x": jax.random.normal(ks[0], (BATCH, SEQ, D_MODEL), f32),
        "norm_mix": gain(ks[1], (L, D_MODEL)),
        "w_in": nrm(ks[2], (L, D_MODEL, IN_WIDTH), D_MODEL),
        "cmp_pe_k": 0.02 * jax.random.normal(ks[3], (L, CMP_BLOCK, HEAD_DIM), f32),
        "cmp_pe_v": 0.02 * jax.random.normal(ks[4], (L, CMP_BLOCK, HEAD_DIM), f32),
        "cmp_k_w1": nrm(ks[5], (L, CMP_BLOCK * HEAD_DIM, CMP_HIDDEN), CMP_BLOCK * HEAD_DIM),
        "cmp_k_w2": nrm(ks[6], (L, CMP_HIDDEN, HEAD_DIM), CMP_HIDDEN),
        "cmp_v_w1": nrm(ks[7], (L, CMP_BLOCK * HEAD_DIM, CMP_HIDDEN), CMP_BLOCK * HEAD_DIM),
        "cmp_v_w2": nrm(ks[8], (L, CMP_HIDDEN, HEAD_DIM), CMP_HIDDEN),
        "w_branch_attn": nrm(ks[9], (L, ATTN_WIDTH, D_MODEL), ATTN_WIDTH),
        "pool_w": nrm(ks[10], (L, len(POOL_WINDOWS), POOL_GROUP, POOL_GROUP), POOL_GROUP),
        "pool_scale": 1.0 + 0.1 * jax.random.normal(ks[11], (L, POOL_WIDTH), f32),
        "w_branch_pool": nrm(ks[12], (L, POOL_WIDTH, D_MODEL), POOL_WIDTH),
        "w_out": nrm(ks[13], (L, D_MODEL, D_MODEL), D_MODEL),
        "norm_mlp": gain(ks[14], (L, D_MODEL)),
        "w_ff1": nrm(ks[15], (L, D_MODEL, D_FF), D_MODEL),
        "w_ff2": nrm(ks[16], (L, D_FF, D_MODEL), D_FF),
        "norm_final": gain(ks[17], (D_MODEL,)),
    }


def reference(x, norm_mix, w_in, cmp_pe_k, cmp_pe_v, cmp_k_w1, cmp_k_w2, cmp_v_w1, cmp_v_w2,
              w_branch_attn, pool_w, pool_scale, w_branch_pool, w_out, norm_mlp, w_ff1, w_ff2,
              norm_final):
    for l in range(DEPTH):
        x = hybrid_layer(x, norm_mix[l], w_in[l], cmp_pe_k[l], cmp_pe_v[l], cmp_k_w1[l], cmp_k_w2[l],
                         cmp_v_w1[l], cmp_v_w2[l], w_branch_attn[l], pool_w[l], pool_scale[l],
                         w_branch_pool[l], w_out[l], norm_mlp[l], w_ff1[l], w_ff2[l])
    return rms_norm(x, norm_final)
```

```cpp
#include <hip/hip_runtime.h>
#include <hip/hip_cooperative_groups.h>
#include <stdint.h>
#include <stdio.h>
namespace cg = cooperative_groups;

#define DI __device__ __forceinline__
#define LAS __attribute__((address_space(3)))
typedef unsigned short u16;
typedef __attribute__((ext_vector_type(8))) short bf16x8;
typedef __attribute__((ext_vector_type(4))) short s16x4;
typedef __attribute__((ext_vector_type(16))) float f32x16;
typedef __attribute__((ext_vector_type(4))) float f32x4;
typedef __attribute__((ext_vector_type(4))) unsigned u32x4;
typedef __attribute__((ext_vector_type(2))) unsigned u32x2;
typedef __attribute__((ext_vector_type(2))) float f32x2;
typedef __attribute__((ext_vector_type(2))) __bf16 bf16x2_t;
typedef LAS const char* lds_cptr;

constexpr int T_TOK = 32768, SEQ = 4096, DM = 1024;
constexpr int NPROJ = 4096;
constexpr int NTHR = 512;
constexpr int LDS_BYTES = 135168;
constexpr float NEGF = -1e30f;
constexpr float QSCALE = 0.125f * 1.4426950408889634f;
#ifndef REP_MASK
#define REP_MASK 0
#endif
#ifndef ATTN_PRIO
#define ATTN_PRIO 0
#endif
#ifndef FUSE_FINAL
#define FUSE_FINAL 1
#endif
#ifndef PH_MASK
#define PH_MASK 0xffff
#endif

struct Params {
  const float *x, *norm_mix, *w_in, *pe_k, *pe_v, *ck_w1, *ck_w2, *cv_w1, *cv_w2, *w_ba, *pool_w, *pool_scale, *w_bp,
      *w_out, *norm_mlp, *w_ff1, *w_ff2, *norm_final;
  float* out;
  u16 *xb, *w_in_t, *wa_t, *wbe_t, *wo_t, *w1_t, *w2_t, *cw1_t, *cw2_t;
  float *rstd0, *cbias;
  float2* rope;
  u16 *qb, *kvb;
  float* gate;
  u16 *ub, *gm, *hid, *kcmp, *vcmp, *pooled, *ob, *mb, *act;
  float *ssq, *ssq2;
  unsigned* bar;
};

DI unsigned pack_bf2(float a, float b) {
  f32x2 v = {a, b};
  bf16x2_t r = __builtin_convertvector(v, bf16x2_t);
  return __builtin_bit_cast(unsigned, r);
}
DI float bf_lo(unsigned u) { return __uint_as_float(u << 16); }
DI float bf_hi(unsigned u) { return __uint_as_float(u & 0xffff0000u); }
DI float sigmoidf_(float v) { return __builtin_amdgcn_rcpf(1.f + __builtin_amdgcn_exp2f(-1.4426950408889634f * v)); }
DI float gelu_tanh(float x) {
  float u = 0.7978845608028654f * (x + 0.044715f * x * x * x);
  float th = 1.f - 2.f / (__expf(2.f * u) + 1.f);
  return 0.5f * x * (1.f + th);
}
DI f32x16 mfma32(bf16x8 a, bf16x8 b, f32x16 c) { return __builtin_amdgcn_mfma_f32_32x32x16_bf16(a, b, c, 0, 0, 0); }
DI int opaque_tid() { int t; asm volatile("v_mov_b32 %0, %1" : "=v"(t) : "v"((int)threadIdx.x)); return t; }
DI f32x16 zero16() { f32x16 z; for (int i = 0; i < 16; ++i) z[i] = 0.f; return z; }
DI s16x4 vtr(lds_cptr p) { return __builtin_amdgcn_ds_read_tr16_b64_v4i16((LAS s16x4*)p); }
DI u32x4 pack8(const f32x4& a, const f32x4& b) {
  u32x4 w = {pack_bf2(a[0], a[1]), pack_bf2(a[2], a[3]), pack_bf2(b[0], b[1]), pack_bf2(b[2], b[3])};
  return w;
}

constexpr int BM = 256, BK = 64, HALF = 128, HTB = HALF * BK * 2;
DI int lds_byte(int r, int c) { const int st = (r >> 4) * 2 + (c >> 5), rr = r & 15, cc = c & 31, ob = rr * 64 + cc * 2; return st * 1024 + (ob ^ (((ob >> 9) & 1) << 5)); }
DI void stage_rc(int b, int& R, int& C) { const int st = b / 1024, sb = b % 1024, swz = sb ^ (((sb >> 9) & 1) << 5); R = (st >> 1) * 16 + swz / 64; C = (st & 1) * 32 + (swz % 64) / 2; }
DI int perm32(int rho) { const int n = rho >> 4, i = rho & 15; return 8 * (i >> 2) + 4 * n + (i & 3); }

struct Unit { int pm, pn, k0; };
struct Gemm { const u16* A; const u16* Bt; int lda, ldb, K; size_t kstepA, kstepB; };

struct Sched {
  int mode, G, bid;
  DI bool next(int i, Unit& u) const {
    u.k0 = 0;
    if (mode == 2) {
      int t;
      if (G >= 256) { if (i > 0 || (bid & 1) || (bid >> 1) >= 128) return false; t = bid >> 1; }
      else { t = i * G + bid; if (t >= 128) return false; }
      u.pm = t >> 2; u.pn = u.pm >> 4; u.k0 = (t & 3) * 8; return true;
    }
    if (mode == 3) {
      int t;
      if (G >= 256) { if (i > 0 || (bid & 7) || (bid >> 3) >= 32) return false; t = bid >> 3; }
      else { t = i * G + bid; if (t >= 32) return false; }
      u.pm = t; u.pn = t >> 4; return true;
    }
    const int nN = mode == 0 ? 16 : 4;
    if (G == 256) {
      const int x = bid & 7, j = bid >> 3;
      if (mode == 0) { if (i >= 8) return false; u.pn = (x & 3) * 4 + (j & 3); u.pm = (x >> 2) * 64 + i * 8 + (j >> 2); return true; }
      if (i >= 2) return false; u.pn = j & 3; u.pm = x * 16 + i * 8 + (j >> 2); return true;
    }
    const int t = i * G + bid;
    if (t >= nN * 128) return false;
    u.pn = t % nN; u.pm = t / nN; return true;
  }
};

template <class Epi>
DI void gemm_phase(LAS unsigned char* lds, const Gemm g, const Sched& S, const Epi& E) {
  const int tid = opaque_tid(), wid = __builtin_amdgcn_readfirstlane(tid >> 6), lane = tid & 63, wr = wid >> 2, wc = wid & 3, fr = lane & 15, fq = lane >> 4;
  const int nt = g.K / BK;
  unsigned voffA[2], voffB[2];
#pragma unroll
  for (int i = 0; i < 2; ++i) {
    int R, C; stage_rc(tid * 16 + i * 8192, R, C);
    const int Rb = (R & ~31) + perm32(R & 31);
    voffA[i] = (unsigned)(R * g.lda + C) * 2u; voffB[i] = (unsigned)(Rb * g.ldb + C) * 2u;
  }
  const size_t kstep = g.kstepB, kstepA = g.kstepA;
  const size_t hstepA = (size_t)HALF * g.lda * 2, hstepB = (size_t)HALF * g.ldb * 2;
  const size_t tstepA = 2 * hstepA, tstepB = 2 * hstepB;
  const unsigned ldsw = (unsigned)wid * 1024u;
  const int aoff = lds_byte(wr * 64 + fr, fq * 8), boff = lds_byte(wc * 32 + fr, fq * 8);
#define PG8_SA(b, h) (((b) * 2 + (h)) * HTB)
#define PG8_SB(b, h) ((4 + (b) * 2 + (h)) * HTB)
#define PG8_STAGE(bufoff, gbase, voff) do { _Pragma("unroll") for (int _i = 0; _i < 2; ++_i) \
    __builtin_amdgcn_global_load_lds((const unsigned*)((const char*)(gbase) + (voff)[_i]), (LAS unsigned*)(lds + (bufoff) + ldsw + _i * 8192), 16, 0, 0); } while (0)
#define PG8_LDA(dst, b, h) do { _Pragma("unroll") for (int m = 0; m < 4; ++m) _Pragma("unroll") for (int k = 0; k < 2; ++k) dst[m][k] = *(const LAS bf16x8*)(lds + PG8_SA(b, h) + aoff + m * 2048 + k * 1024); } while (0)
#define PG8_LDB(dst, b, h) do { _Pragma("unroll") for (int n = 0; n < 2; ++n) _Pragma("unroll") for (int k = 0; k < 2; ++k) dst[n][k] = *(const LAS bf16x8*)(lds + PG8_SB(b, h) + boff + n * 2048 + k * 1024); } while (0)
#define PG8_MMA(ai, bj, At, Bt) do { __builtin_amdgcn_s_setprio(1); _Pragma("unroll") for (int m = 0; m < 4; ++m) _Pragma("unroll") for (int n = 0; n < 2; ++n) _Pragma("unroll") for (int k = 0; k < 2; ++k) \
    acc[ai][bj][m][n] = __builtin_amdgcn_mfma_f32_16x16x32_bf16(Bt[n][k], At[m][k], acc[ai][bj][m][n], 0, 0, 0); __builtin_amdgcn_s_setprio(0); } while (0)
#define PG8_WAIT_V(n) asm volatile("s_waitcnt vmcnt(" #n ")" ::: "memory")
#define PG8_WAIT_L(n) asm volatile("s_waitcnt lgkmcnt(" #n ")" ::: "memory")
#define PG8_BAR __builtin_amdgcn_s_barrier()
#define PG8_SCHED __builtin_amdgcn_sched_barrier(0)
  Unit cur, nxt; int ui = 0;
  if (!S.next(0, cur)) return;
  f32x4 acc[2][2][4][2];
#pragma unroll
  for (int a = 0; a < 2; ++a)
#pragma unroll
    for (int b = 0; b < 2; ++b)
#pragma unroll
      for (int m = 0; m < 4; ++m)
#pragma unroll
        for (int n = 0; n < 2; ++n) acc[a][b][m][n] = (f32x4){0.f, 0.f, 0.f, 0.f};
  bf16x8 At[4][2], B0[2][2], B1[2][2];
  const char* cA = (const char*)g.A + (size_t)cur.pm * tstepA + (size_t)cur.k0 * kstepA; const char* cB = (const char*)g.Bt + (size_t)cur.pn * tstepB + (size_t)cur.k0 * kstep;
  PG8_STAGE(PG8_SB(0, 0), cB, voffB); PG8_STAGE(PG8_SA(0, 0), cA, voffA); PG8_STAGE(PG8_SB(0, 1), cB + hstepB, voffB); PG8_STAGE(PG8_SA(0, 1), cA + hstepA, voffA);
  if (wr == 1) PG8_BAR;
  PG8_WAIT_V(4); PG8_BAR;
  PG8_STAGE(PG8_SB(1, 0), cB + kstep, voffB); PG8_STAGE(PG8_SA(1, 0), cA + kstepA, voffA); PG8_STAGE(PG8_SB(1, 1), cB + hstepB + kstep, voffB);
  PG8_WAIT_V(6); PG8_BAR;
  for (;;) {
    const bool has_next = S.next(ui + 1, nxt);
    const char* nA = has_next ? (const char*)g.A + (size_t)nxt.pm * tstepA + (size_t)nxt.k0 * kstepA : cA; const char* nB = has_next ? (const char*)g.Bt + (size_t)nxt.pn * tstepB + (size_t)nxt.k0 * kstep : cB;
    for (int t = 0; t < nt; t += 2) {
      const bool last = (t == nt - 2);
      const char* a1 = cA + (size_t)(t + 1) * kstepA;
      const char* a2 = last ? nA : cA + (size_t)(t + 2) * kstepA; const char* b2 = last ? nB : cB + (size_t)(t + 2) * kstep;
      const char* a3 = a2 + kstepA; const char* b3 = b2 + kstep;
      PG8_LDB(B0, 0, 0); PG8_SCHED; PG8_LDA(At, 0, 0); PG8_STAGE(PG8_SA(1, 1), a1 + hstepA, voffA);
      PG8_WAIT_L(8); PG8_BAR; PG8_WAIT_L(0); PG8_MMA(0, 0, At, B0); PG8_BAR; PG8_SCHED;
      PG8_LDB(B1, 0, 1); PG8_STAGE(PG8_SB(0, 0), b2, voffB);
      PG8_BAR; PG8_WAIT_L(0); PG8_MMA(0, 1, At, B1); PG8_BAR;
      PG8_LDA(At, 0, 1); PG8_STAGE(PG8_SA(0, 0), a2, voffA);
      PG8_BAR; PG8_WAIT_L(0); PG8_MMA(1, 0, At, B0); PG8_BAR; PG8_SCHED;
      PG8_STAGE(PG8_SB(0, 1), b2 + hstepB, voffB);
      PG8_WAIT_V(6); PG8_BAR; PG8_MMA(1, 1, At, B1); PG8_BAR;
      PG8_LDB(B0, 1, 0); PG8_SCHED; PG8_LDA(At, 1, 0); PG8_STAGE(PG8_SA(0, 1), a2 + hstepA, voffA);
      PG8_WAIT_L(8); PG8_BAR; PG8_WAIT_L(0); PG8_MMA(0, 0, At, B0); PG8_BAR; PG8_SCHED;
      PG8_LDB(B1, 1, 1); PG8_STAGE(PG8_SB(1, 0), b3, voffB);
      PG8_BAR; PG8_WAIT_L(0); PG8_MMA(0, 1, At, B1); PG8_BAR;
      PG8_LDA(At, 1, 1); PG8_STAGE(PG8_SA(1, 0), a3, voffA);
      PG8_BAR; PG8_WAIT_L(0); PG8_MMA(1, 0, At, B0); PG8_BAR; PG8_SCHED;
      PG8_STAGE(PG8_SB(1, 1), b3 + hstepB, voffB);
      PG8_WAIT_V(6); PG8_BAR; PG8_MMA(1, 1, At, B1); PG8_BAR;
    }
    E(acc, cur, wr, wc, fr, fq);
    if (!has_next) break;
#pragma unroll
    for (int a = 0; a < 2; ++a)
#pragma unroll
      for (int b = 0; b < 2; ++b)
#pragma unroll
        for (int m = 0; m < 4; ++m)
#pragma unroll
          for (int n = 0; n < 2; ++n) acc[a][b][m][n] = (f32x4){0.f, 0.f, 0.f, 0.f};
    cur = nxt; cA = nA; cB = nB; ++ui;
  }
  PG8_WAIT_V(0);
  if (wr == 0) PG8_BAR;
  PG8_BAR;
#undef PG8_SA
#undef PG8_SB
#undef PG8_STAGE
#undef PG8_LDA
#undef PG8_LDB
#undef PG8_MMA
#undef PG8_WAIT_V
#undef PG8_WAIT_L
#undef PG8_BAR
#undef PG8_SCHED
}

typedef f32x4 (&AccRef)[2][2][4][2];
DI unsigned xb_ld(unsigned* p)              { return __hip_atomic_load(p, __ATOMIC_RELAXED, __HIP_MEMORY_SCOPE_AGENT); }
DI unsigned xb_add(unsigned* p, unsigned v) { return __hip_atomic_fetch_add(p, v, __ATOMIC_RELAXED, __HIP_MEMORY_SCOPE_AGENT); }
#define EPI_ROWS for (int ai = 0; ai < 2; ++ai) _Pragma("unroll") for (int m = 0; m < 4; ++m)
#define EPI_ROW(u) ((u).pm * BM + ai * HALF + wr * 64 + m * 16 + fr)
#define EPI_COL(bj) ((bj) * HALF + wc * 32 + fq * 8)

DI void rope8(f32x4& v0, f32x4& v1, const float2* __restrict__ tab, int pos, int fq) {
  const f32x4* t4 = (const f32x4*)(tab + (size_t)pos * 8);
  const f32x4 c0 = t4[0], c1 = t4[1], c2 = t4[2], c3 = t4[3];
  float pv[8];
#pragma unroll
  for (int j = 0; j < 4; ++j) { pv[j] = __shfl_xor(v0[j], 16); pv[4 + j] = __shfl_xor(v1[j], 16); }
  if (fq < 2) {
    const float sg = fq ? 1.f : -1.f;
    v0[0] = v0[0] * c0[0] + sg * pv[0] * c0[1]; v0[1] = v0[1] * c0[2] + sg * pv[1] * c0[3];
    v0[2] = v0[2] * c1[0] + sg * pv[2] * c1[1]; v0[3] = v0[3] * c1[2] + sg * pv[3] * c1[3];
    v1[0] = v1[0] * c2[0] + sg * pv[4] * c2[1]; v1[1] = v1[1] * c2[2] + sg * pv[5] * c2[3];
    v1[2] = v1[2] * c3[0] + sg * pv[6] * c3[1]; v1[3] = v1[3] * c3[2] + sg * pv[7] * c3[3];
  }
}

DI void rope8t(f32x4& v0, f32x4& v1, const f32x4 (&t)[4], int fq) {
  float pv[8];
#pragma unroll
  for (int j = 0; j < 4; ++j) { pv[j] = __shfl_xor(v0[j], 16); pv[4 + j] = __shfl_xor(v1[j], 16); }
  if (fq < 2) {
    const float sg = fq ? 1.f : -1.f;
    v0[0] = v0[0] * t[0][0] + sg * pv[0] * t[0][1]; v0[1] = v0[1] * t[0][2] + sg * pv[1] * t[0][3];
    v0[2] = v0[2] * t[1][0] + sg * pv[2] * t[1][1]; v0[3] = v0[3] * t[1][2] + sg * pv[3] * t[1][3];
    v1[0] = v1[0] * t[2][0] + sg * pv[4] * t[2][1]; v1[1] = v1[1] * t[2][2] + sg * pv[5] * t[2][3];
    v1[2] = v1[2] * t[3][0] + sg * pv[6] * t[3][1]; v1[3] = v1[3] * t[3][2] + sg * pv[7] * t[3][3];
  }
}

struct EpiProj {
  const Params& p;
  DI void operator()(AccRef acc, const Unit& u, int wr, int wc, int fr, int fq) const {
    const int pn = u.pn;
    const bool roped = ((wc & 1) == 0) && (pn < 2 || pn == 3 || pn == 4);
    float rs8[8];
#pragma unroll
    EPI_ROWS rs8[ai * 4 + m] = p.rstd0[EPI_ROW(u)];
#pragma unroll
    for (int ai = 0; ai < 2; ++ai)
#pragma unroll
    for (int mh = 0; mh < 2; ++mh) {
      f32x4 tabx[2][4];
      if (roped) {
#pragma unroll
        for (int mm = 0; mm < 2; ++mm) {
          const int m = mh * 2 + mm;
          const f32x4* t4 = (const f32x4*)(p.rope + (size_t)(EPI_ROW(u) & (SEQ - 1)) * 8);
          tabx[mm][0] = t4[0]; tabx[mm][1] = t4[1]; tabx[mm][2] = t4[2]; tabx[mm][3] = t4[3];
        }
      }
#pragma unroll
      for (int mm = 0; mm < 2; ++mm) {
        const int m = mh * 2 + mm;
        const f32x4 (&tabm)[4] = tabx[mm];
        const int row = EPI_ROW(u);
        const float rs = rs8[ai * 4 + m];
        const int s = row & (SEQ - 1), b = row >> 12;
#pragma unroll
        for (int bj = 0; bj < 2; ++bj) {
          f32x4 v0 = acc[ai][bj][m][0] * rs, v1 = acc[ai][bj][m][1] * rs;
          const int lc = EPI_COL(bj);
          if (pn < 2) {
            if (roped) rope8t(v0, v1, tabm, fq);
            *(u32x4*)(p.qb + (size_t)row * 512 + pn * 256 + lc) = pack8(v0 * QSCALE, v1 * QSCALE);
          } else if (pn < 5) {
            const int which = (pn - 2) * 2 + bj;
            if ((which == 2 || which == 4) && roped) rope8t(v0, v1, tabm, fq);
            const int g = wc >> 1, d = (wc & 1) * 32 + fq * 8;
            *(u32x4*)(p.kvb + ((size_t)((which * 16 + b * 2 + g) * SEQ + s)) * 64 + d) = pack8(v0, v1);
          } else if (pn < 7) {
            *(u32x4*)(p.ub + (size_t)row * 512 + (pn - 5) * 256 + lc) = pack8(v0, v1);
          } else if (pn < 15) {
#pragma unroll
            for (int j = 0; j < 4; ++j) { v0[j] = sigmoidf_(v0[j]); v1[j] = sigmoidf_(v1[j]); }
            *(u32x4*)(p.gm + (size_t)row * 2048 + (pn - 7) * 256 + lc) = pack8(v0, v1);
          } else {
            if (bj == 0 && wc == 0 && fq < 3) {
#pragma unroll
              for (int j = 0; j < 4; ++j) { v0[j] = sigmoidf_(v0[j]); v1[j] = sigmoidf_(v1[j]); }
              f32x4* gp = (f32x4*)(p.gate + (size_t)row * 24 + fq * 8);
              gp[0] = v0; gp[1] = v1;
            }
          }
        }
      }
    }
  }
};

struct EpiCmpHid {
  float* hid32;
  DI void operator()(AccRef acc, const Unit& u, int wr, int wc, int fr, int fq) const {
    float* base = hid32 + ((size_t)((u.k0 >> 3) * 32 + u.pm) * 256) * 256;
#pragma unroll
    EPI_ROWS {
      const int c = ai * HALF + wr * 64 + m * 16 + fr;
#pragma unroll
      for (int bj = 0; bj < 2; ++bj) {
        f32x4* dp = (f32x4*)(base + (size_t)c * 256 + EPI_COL(bj));
        dp[0] = acc[ai][bj][m][0]; dp[1] = acc[ai][bj][m][1];
      }
    }
  }
};

struct EpiCmpOut {
  const Params& p;
  DI void operator()(AccRef acc, const Unit& u, int wr, int wc, int fr, int fq) const {
    const int kv = u.pm >> 4, bg = u.pm & 15;
    const bool roped = (kv == 0) && (wc == 0);
    u16* dst = (kv ? p.vcmp : p.kcmp) + (size_t)bg * 256 * 64;
#pragma unroll
    for (int ai = 0; ai < 2; ++ai) {
      f32x4 tabx[4][4];
      {
#pragma unroll
        for (int m = 0; m < 4; ++m) {
          const int c = ai * HALF + wr * 64 + m * 16 + fr;
          const f32x4* t4 = (const f32x4*)(p.rope + (size_t)min(16 * c + 31, SEQ - 1) * 8);
          tabx[m][0] = t4[0]; tabx[m][1] = t4[1]; tabx[m][2] = t4[2]; tabx[m][3] = t4[3];
        }
      }
#pragma unroll
      for (int m = 0; m < 4; ++m) {
        const int c = ai * HALF + wr * 64 + m * 16 + fr;
        f32x4 v0 = acc[ai][0][m][0], v1 = acc[ai][0][m][1];
        if (roped) rope8t(v0, v1, tabx[m], fq);
        if (c == 255) { v0 = (f32x4){0.f, 0.f, 0.f, 0.f}; v1 = v0; }
        if (wc < 2) *(u32x4*)(dst + c * 64 + wc * 32 + fq * 8) = pack8(v0, v1);
      }
    }
  }
};

template <int PASS>
struct EpiMerge {
  const Params& p;
  DI void operator()(AccRef acc, const Unit& u, int wr, int wc, int fr, int fq) const {
#pragma unroll
    for (int ai = 0; ai < 2; ++ai) {
      u32x4 gq[4][2], ov[4][2];
#pragma unroll
      for (int m = 0; m < 4; ++m)
#pragma unroll
        for (int bj = 0; bj < 2; ++bj) {
          const int row = EPI_ROW(u), col = u.pn * BM + EPI_COL(bj);
          gq[m][bj] = *(const u32x4*)(p.gm + (size_t)row * 2048 + PASS * 1024 + col);
          if (PASS == 1) ov[m][bj] = *(const u32x4*)(p.mb + (size_t)row * 1024 + col);
        }
#pragma unroll
      for (int m = 0; m < 4; ++m) {
        const int row = EPI_ROW(u);
#pragma unroll
        for (int bj = 0; bj < 2; ++bj) {
          const int col = u.pn * BM + EPI_COL(bj);
          const u32x4 g = gq[m][bj];
          f32x4 v0 = acc[ai][bj][m][0], v1 = acc[ai][bj][m][1];
          v0[0] *= bf_lo(g[0]); v0[1] *= bf_hi(g[0]); v0[2] *= bf_lo(g[1]); v0[3] *= bf_hi(g[1]);
          v1[0] *= bf_lo(g[2]); v1[1] *= bf_hi(g[2]); v1[2] *= bf_lo(g[3]); v1[3] *= bf_hi(g[3]);
          if (PASS == 1) {
            const u32x4 o = ov[m][bj];
            v0[0] += bf_lo(o[0]); v0[1] += bf_hi(o[0]); v0[2] += bf_lo(o[1]); v0[3] += bf_hi(o[1]);
            v1[0] += bf_lo(o[2]); v1[1] += bf_hi(o[2]); v1[2] += bf_lo(o[3]); v1[3] += bf_hi(o[3]);
          }
          *(u32x4*)(p.mb + (size_t)row * 1024 + col) = pack8(v0, v1);
        }
      }
    }
  }
};

template <bool WITH_BF16>
struct EpiResid {
  const float* resid; float* out; u16* outb; float* ssq;
  DI void operator()(AccRef acc, const Unit& u, int wr, int wc, int fr, int fq) const {
#pragma unroll
    for (int ai = 0; ai < 2; ++ai) {
      f32x4 rv[4][2][2];
#pragma unroll
      for (int m = 0; m < 4; ++m)
#pragma unroll
        for (int bj = 0; bj < 2; ++bj) {
          const f32x4* rp = (const f32x4*)(resid + (size_t)EPI_ROW(u) * 1024 + u.pn * BM + EPI_COL(bj));
          rv[m][bj][0] = rp[0]; rv[m][bj][1] = rp[1];
        }
#pragma unroll
      for (int m = 0; m < 4; ++m) {
        const int row = EPI_ROW(u);
        float sq = 0.f;
#pragma unroll
        for (int bj = 0; bj < 2; ++bj) {
          const size_t a = (size_t)row * 1024 + u.pn * BM + EPI_COL(bj);
          const f32x4 v0 = rv[m][bj][0] + acc[ai][bj][m][0], v1 = rv[m][bj][1] + acc[ai][bj][m][1];
          f32x4* op = (f32x4*)(out + a);
          op[0] = v0; op[1] = v1;
          if (WITH_BF16) *(u32x4*)(outb + a) = pack8(v0, v1);
#pragma unroll
          for (int j = 0; j < 4; ++j) sq += v0[j] * v0[j] + v1[j] * v1[j];
        }
        sq += __shfl_xor(sq, 16);
        sq += __shfl_xor(sq, 32);
        if (fq == 0) ssq[(size_t)row * 16 + u.pn * 4 + wc] = sq;
      }
    }
  }
};

struct EpiFinal {
  float* out; const float* gfin; float* ssq2; unsigned* cnt;
  DI void operator()(AccRef acc, const Unit& u, int wr, int wc, int fr, int fq) const {
#pragma unroll
    for (int ai = 0; ai < 2; ++ai)
#pragma unroll
    for (int mh = 0; mh < 2; ++mh) {
      f32x4 rv[2][2][2];
#pragma unroll
      for (int mm = 0; mm < 2; ++mm)
#pragma unroll
        for (int bj = 0; bj < 2; ++bj) {
          const int m = mh * 2 + mm;
          const f32x4* rp = (const f32x4*)(out + (size_t)EPI_ROW(u) * 1024 + u.pn * BM + EPI_COL(bj));
          rv[mm][bj][0] = rp[0]; rv[mm][bj][1] = rp[1];
        }
#pragma unroll
      for (int mm = 0; mm < 2; ++mm) {
        const int m = mh * 2 + mm;
        const int row = EPI_ROW(u);
        float sq = 0.f;
#pragma unroll
        for (int bj = 0; bj < 2; ++bj) {
          acc[ai][bj][m][0] += rv[mm][bj][0]; acc[ai][bj][m][1] += rv[mm][bj][1];
#pragma unroll
          for (int j = 0; j < 4; ++j) sq += acc[ai][bj][m][0][j] * acc[ai][bj][m][0][j] + acc[ai][bj][m][1][j] * acc[ai][bj][m][1][j];
        }
        sq += __shfl_xor(sq, 16);
        sq += __shfl_xor(sq, 32);
        if (fq == 0) __hip_atomic_store(ssq2 + (size_t)row * 16 + u.pn * 4 + wc, sq, __ATOMIC_RELAXED, __HIP_MEMORY_SCOPE_AGENT);
      }
    }
    asm volatile("s_waitcnt vmcnt(0)" ::: "memory");
    unsigned* c = cnt + (u.pm * 2 + wr) * 16;
    if (fq == 0 && fr == 0) (void)xb_add(c, 1u);
    { unsigned sp = 0; while (xb_ld(c) < 16u) { __builtin_amdgcn_s_sleep(1); if (++sp > (1u << 20)) break; } }
#pragma unroll
    EPI_ROWS {
      const int row = EPI_ROW(u);
      unsigned long long* sp = (unsigned long long*)(ssq2 + (size_t)row * 16 + fq * 4);
      const unsigned long long q0 = __hip_atomic_load(sp, __ATOMIC_RELAXED, __HIP_MEMORY_SCOPE_AGENT);
      const unsigned long long q1 = __hip_atomic_load(sp + 1, __ATOMIC_RELAXED, __HIP_MEMORY_SCOPE_AGENT);
      float ss = (__uint_as_float((unsigned)q0) + __uint_as_float((unsigned)(q0 >> 32))) + (__uint_as_float((unsigned)q1) + __uint_as_float((unsigned)(q1 >> 32)));
      ss += __shfl_xor(ss, 16);
      ss += __shfl_xor(ss, 32);
      const float rs = rsqrtf(ss * (1.f / DM) + 1e-6f);
#pragma unroll
      for (int bj = 0; bj < 2; ++bj) {
        const int col = u.pn * BM + EPI_COL(bj);
        const f32x4* gp = (const f32x4*)(gfin + col);
        f32x4* op = (f32x4*)(out + (size_t)row * 1024 + col);
        op[0] = acc[ai][bj][m][0] * rs * gp[0]; op[1] = acc[ai][bj][m][1] * rs * gp[1];
      }
    }
  }
};

struct EpiFF1 {
  const Params& p;
  DI void operator()(AccRef acc, const Unit& u, int wr, int wc, int fr, int fq) const {
    f32x4 part[8];
#pragma unroll
    EPI_ROWS part[ai * 4 + m] = *(const f32x4*)(p.ssq + (size_t)EPI_ROW(u) * 16 + fq * 4);
    float rs8[8];
#pragma unroll
    for (int r = 0; r < 8; ++r) {
      float ss = (part[r][0] + part[r][1]) + (part[r][2] + part[r][3]);
      ss += __shfl_xor(ss, 16);
      ss += __shfl_xor(ss, 32);
      rs8[r] = rsqrtf(ss * (1.f / DM) + 1e-6f);
    }
#pragma unroll
    EPI_ROWS {
      const int row = EPI_ROW(u);
      const float rs = rs8[ai * 4 + m];
#pragma unroll
      for (int bj = 0; bj < 2; ++bj) {
        f32x4 v0 = acc[ai][bj][m][0] * rs, v1 = acc[ai][bj][m][1] * rs;
#pragma unroll
        for (int j = 0; j < 4; ++j) { const float r0 = fmaxf(v0[j], 0.f), r1 = fmaxf(v1[j], 0.f); v0[j] = r0 * r0; v1[j] = r1 * r1; }
        const int col = u.pn * BM + EPI_COL(bj);
        *(u32x4*)(p.act + ((size_t)(col >> 6) * T_TOK + row) * 64 + (col & 63)) = pack8(v0, v1);
      }
    }
  }
};

DI void p0_rows(const Params& p, int item) {
  const int w = threadIdx.x >> 6, lane = threadIdx.x & 63;
  const int row0 = item * 32 + w * 4;
  float4 v[4][4];
#pragma unroll
  for (int r = 0; r < 4; ++r) {
    const float4* src = (const float4*)(p.x + (size_t)(row0 + r) * DM);
#pragma unroll
    for (int i = 0; i < 4; ++i) v[r][i] = src[lane + 64 * i];
  }
#pragma unroll
  for (int r = 0; r < 4; ++r) {
    float ss = 0.f;
#pragma unroll
    for (int i = 0; i < 4; ++i) ss += v[r][i].x * v[r][i].x + v[r][i].y * v[r][i].y + v[r][i].z * v[r][i].z + v[r][i].w * v[r][i].w;
#pragma unroll
    for (int o = 32; o; o >>= 1) ss += __shfl_xor(ss, o);
    if (lane == 0) p.rstd0[row0 + r] = rsqrtf(ss * (1.f / DM) + 1e-6f);
    u32x2* dst = (u32x2*)(p.xb + (size_t)(row0 + r) * DM);
#pragma unroll
    for (int i = 0; i < 4; ++i) {
      u32x2 o = {pack_bf2(v[r][i].x, v[r][i].y), pack_bf2(v[r][i].z, v[r][i].w)};
      dst[lane + 64 * i] = o;
    }
  }
}

constexpr int TJ_WIN = 1024, TJ_WA = 128, TJ_WO = 256, TJ_W1 = 1024, TJ_W2 = 1024, TJ_C1 = 128, TJ_C2 = 16;
constexpr int TJ_TOTAL = TJ_WIN + TJ_WA + TJ_WO + TJ_W1 + TJ_W2 + 2 * TJ_C1 + 2 * TJ_C2;

DI void p0_transpose(const Params& p, int item, char* smem) {
  const int half = threadIdx.x >> 8, tid = threadIdx.x & 255;
  int idx = item * 2 + half;
  const float* src; u16* dst; const float* scale = nullptr; int K, N, kind = 0;
  if (idx < TJ_WIN) { src = p.w_in; dst = p.w_in_t; scale = p.norm_mix; K = 1024; N = 3864; kind = 1; }
  else if ((idx -= TJ_WIN) < TJ_WA) { src = p.w_ba; dst = p.wa_t; K = 512; N = 1024; }
  else if ((idx -= TJ_WA) < TJ_WO) { src = p.w_out; dst = p.wo_t; K = 1024; N = 1024; }
  else if ((idx -= TJ_WO) < TJ_W1) { src = p.w_ff1; dst = p.w1_t; scale = p.norm_mlp; K = 1024; N = 4096; }
  else if ((idx -= TJ_W1) < TJ_W2) { src = p.w_ff2; dst = p.w2_t; K = 4096; N = 1024; kind = 2; }
  else if ((idx -= TJ_W2) < TJ_C1) { src = p.ck_w1; dst = p.cw1_t; K = 2048; N = 256; }
  else if ((idx -= TJ_C1) < TJ_C1) { src = p.cv_w1; dst = p.cw1_t + 256 * 2048; K = 2048; N = 256; }
  else if ((idx -= TJ_C1) < TJ_C2) { src = p.ck_w2; dst = p.cw2_t; K = 256; N = 64; }
  else { idx -= TJ_C2; src = p.cv_w2; dst = p.cw2_t + 256 * 256; K = 256; N = 64; }
  const int nk = K >> 6;
  const int k0 = (idx % nk) * 64, n0 = (idx / nk) * 64;
  float* tile = (float*)(smem + half * 16640);
  __syncthreads();
#pragma unroll
  for (int i = 0; i < 4; ++i) {
    const int kk = (tid >> 4) + 16 * i, nn = (tid & 15) * 4;
    const int nd = n0 + nn;
    int sc;
    if (kind == 1) sc = nd < 1280 ? nd : (nd < 3840 ? nd + 24 : (nd < 3864 ? nd - 2560 : -1));
    else sc = nd < N ? nd : -1;
    float4 v = make_float4(0.f, 0.f, 0.f, 0.f);
    if (sc >= 0) v = *(const float4*)(src + (size_t)(k0 + kk) * N + sc);
    if (scale) { float s = scale[k0 + kk]; v.x *= s; v.y *= s; v.z *= s; v.w *= s; }
    tile[kk * 65 + nn + 0] = v.x; tile[kk * 65 + nn + 1] = v.y; tile[kk * 65 + nn + 2] = v.z; tile[kk * 65 + nn + 3] = v.w;
  }
  __syncthreads();
  {
    const int n = tid >> 2, kq = (tid & 3) * 16;
    unsigned o[8];
#pragma unroll
    for (int j = 0; j < 8; ++j) o[j] = pack_bf2(tile[(kq + 2 * j) * 65 + n], tile[(kq + 2 * j + 1) * 65 + n]);
    u32x4* d = (kind == 2) ? (u32x4*)(dst + ((size_t)(k0 >> 6) * 1024 + (n0 + n)) * 64 + kq)
                           : (u32x4*)(dst + (size_t)(n0 + n) * K + k0 + kq);
    u32x4 o0 = {o[0], o[1], o[2], o[3]}, o1 = {o[4], o[5], o[6], o[7]};
    d[0] = o0; d[1] = o1;
  }
}

DI void p0_weff(const Params& p, int item, char* smem) {
  const int g = item >> 4, n0 = (item & 15) * 64, tid = threadIdx.x;
  float* pw = (float*)smem;
  float* ws = (float*)(smem + 66048);
  __syncthreads();
  for (int e = tid; e < 128 * 128; e += NTHR) { const int c = e >> 7, d = e & 127; pw[c * 129 + d] = p.pool_w[(size_t)g * 16384 + e] * p.pool_scale[g * 128 + d]; }
  for (int e = tid; e < 128 * 64; e += NTHR) { const int d = e >> 6, n = e & 63; ws[e] = p.w_bp[(size_t)(g * 128 + d) * 1024 + n0 + n]; }
  __syncthreads();
  const int c = tid & 127, nq = (tid >> 7) * 16;
  float a[16];
#pragma unroll
  for (int j = 0; j < 16; ++j) a[j] = 0.f;
  for (int d = 0; d < 128; ++d) {
    const float w = pw[c * 129 + d];
#pragma unroll
    for (int j = 0; j < 16; ++j) a[j] += w * ws[d * 64 + nq + j];
  }
#pragma unroll
  for (int j = 0; j < 16; ++j) p.wbe_t[(size_t)(n0 + nq + j) * 512 + g * 128 + c] = (u16)(pack_bf2(a[j], 0.f) & 0xffffu);
}

DI void p0_cbias(const Params& p, int idx, char* smem) {
  const int kv = idx >> 3, nc = idx & 7, tid = threadIdx.x, n = tid & 31, part = tid >> 5;
  const float* pe = kv ? p.pe_v : p.pe_k;
  const float* w1 = kv ? p.cv_w1 : p.ck_w1;
  float s = 0.f;
  for (int k = part * 128; k < part * 128 + 128; ++k) s += pe[k] * w1[(size_t)k * 256 + nc * 32 + n];
  float* red = (float*)smem;
  __syncthreads();
  red[part * 32 + n] = s;
  __syncthreads();
  if (tid < 32) {
    float t = 0.f;
#pragma unroll
    for (int j = 0; j < 16; ++j) t += red[j * 32 + tid];
    p.cbias[kv * 256 + nc * 32 + tid] = t;
  }
}

DI void p0_rope(const Params& p, int idx) {
  const int e = idx * NTHR + threadIdx.x;
  const int pos = e >> 3, i = e & 7;
  const float inv = powf(500000.0f, -(float)(2 * i) / 16.0f);
  const float ang = (float)pos * inv;
  float sn, cs;
  sincosf(ang, &sn, &cs);
  p.rope[e] = make_float2(cs, sn);
}

DI void p2a_pool_item(const Params& p, int item) {
  const int idx = item * NTHR + threadIdx.x;
  const int t = idx >> 6, ch = (idx & 63) * 8;
  const int grp = ch >> 7, wlen = 2 << grp, s = t & (SEQ - 1);
  const int cnt = min(s + 1, wlen);
  float a[8];
#pragma unroll
  for (int j = 0; j < 8; ++j) a[j] = 0.f;
  const u16* base = p.ub + (size_t)t * 512 + ch;
  u32x4 v[16];
#pragma unroll
  for (int k = 0; k < 16; ++k) { v[k] = (u32x4){0u, 0u, 0u, 0u}; if (k < cnt) v[k] = *(const u32x4*)(base - (size_t)k * 512); }
  const u32x4 cur = v[0];
#pragma unroll
  for (int k = 0; k < 16; ++k) {
#pragma unroll
    for (int j = 0; j < 4; ++j) { a[2 * j] += bf_lo(v[k][j]); a[2 * j + 1] += bf_hi(v[k][j]); }
  }
  const float ic = 1.f / (float)cnt;
  u32x4 o;
#pragma unroll
  for (int j = 0; j < 4; ++j) o[j] = pack_bf2(a[2 * j] * ic - bf_lo(cur[j]), a[2 * j + 1] * ic - bf_hi(cur[j]));
  *(u32x4*)(p.pooled + (size_t)t * 512 + ch) = o;
}

constexpr int AT_P = 65536, AT_S = 98304, AT_M = 131072;
template <int MODE>
DI void attn_tiles(const u16* __restrict__ Kg, const u16* __restrict__ Vg, int j0, int j1, char* smem,
                   const bf16x8 (&qf)[4], float& m, float& l, f32x16 (&O)[2], int lo, int hi, int lo_max, int hi_min,
                   unsigned mlo, unsigned mhi, float inv_l, int tok_l, int tid) {
  const int lane = tid & 63, l31 = lane & 31, h = lane >> 5;
  const int lk = tid >> 3, lc = tid & 7;
  const int kwr = lk * 128 + ((lc ^ ((lk >> 1) & 7)) << 4);
  const int vwr = 16384 + (lc >> 2) * 4096 + lk * 64 + (lc & 3) * 16;
  const int f = (l31 >> 1) & 7;
  const int krd = l31 * 128;
  int kx[4];
#pragma unroll
  for (int ks = 0; ks < 4; ++ks) kx[ks] = ((2 * ks + h) ^ f) << 4;
  const lds_cptr vrd = (lds_cptr)smem + 16384 + ((lane >> 4) & 1) * 32 + (lane & 3) * 8 + (4 * h + ((lane & 15) >> 2)) * 64;
  const int goff = lk * 64 + lc * 8;
  u32x4 rk, rv;
  rk = *(const u32x4*)(Kg + (size_t)j0 * 4096 + goff);
  if (MODE != 0) rv = *(const u32x4*)(Vg + (size_t)j0 * 4096 + goff);
  for (int j = j0; j <= j1; ++j) {
    const int bo = ((j - j0) & 1) * 8192;
    *(u32x4*)(smem + bo + kwr) = rk;
    if (MODE != 0) *(u32x4*)(smem + bo + vwr) = rv;
    __syncthreads();
    if (j < j1) {
      rk = *(const u32x4*)(Kg + (size_t)(j + 1) * 4096 + goff);
      if (MODE != 0) rv = *(const u32x4*)(Vg + (size_t)(j + 1) * 4096 + goff);
    }
    bool bit = true;
    if (MODE == 2) {
      bit = ((j < 32 ? (mlo >> j) : (mhi >> (j - 32))) & 1u) != 0;
      if (__ballot(bit) == 0ull) continue;
    }
    f32x16 s0 = zero16(), s1 = zero16();
#pragma unroll
    for (int ks = 0; ks < 4; ++ks) {
      bf16x8 a0 = *(const bf16x8*)(smem + bo + krd + kx[ks]);
      bf16x8 a1 = *(const bf16x8*)(smem + bo + krd + 4096 + kx[ks]);
      s0 = mfma32(a0, qf[ks], s0);
      s1 = mfma32(a1, qf[ks], s1);
    }
    const bool need_mask = (64 * j < lo_max) || (64 * j + 63 > hi_min);
    const int rlo = lo - 64 * j - 4 * h, span = hi - lo;
    if (need_mask) {
#pragma unroll
      for (int i = 0; i < 16; ++i) {
        const int c0 = 8 * (i >> 2) + (i & 3);
        if ((unsigned)(c0 - rlo) > (unsigned)span || span < 0) s0[i] = NEGF;
        if ((unsigned)(c0 + 32 - rlo) > (unsigned)span || span < 0) s1[i] = NEGF;
      }
    }
    float msub;
    if (MODE == 1) {
      msub = m;
    } else {
      float mx = s0[0];
#pragma unroll
      for (int i = 1; i < 16; ++i) mx = fmaxf(mx, s0[i]);
#pragma unroll
      for (int i = 0; i < 16; ++i) mx = fmaxf(mx, s1[i]);
      mx = fmaxf(mx, __shfl_xor(mx, 32));
      if (MODE == 2) mx = bit ? mx : NEGF;
      const float mn = fmaxf(m, mx);
      const float alpha = __builtin_amdgcn_exp2f(m - mn);
      m = mn;
      l *= alpha;
      if (MODE != 0) {
        if (__ballot(alpha != 1.f) != 0ull) {
#pragma unroll
          for (int i = 0; i < 16; ++i) { O[0][i] *= alpha; O[1][i] *= alpha; }
        }
      }
      msub = (MODE == 2 && !bit) ? 1e30f : mn;
    }
    msub = fmaxf(msub, -1e29f);
    float rs = 0.f;
#pragma unroll
    for (int i = 0; i < 16; ++i) {
      float p0 = __builtin_amdgcn_exp2f(s0[i] - msub), p1 = __builtin_amdgcn_exp2f(s1[i] - msub);
      if (MODE == 1) { p0 *= inv_l; p1 *= inv_l; }
      s0[i] = p0; s1[i] = p1;
      rs += p0 + p1;
    }
    l += rs;
    if (MODE == 0) continue;
    if (MODE == 1) {
      float* ps = (float*)(smem + AT_P) + tok_l * 256 + 64 * j + 4 * h;
#pragma unroll
      for (int gq = 0; gq < 4; ++gq) {
        float4 a, b;
        float t;
        t = s0[4 * gq + 0]; t += __shfl_xor(t, 1); t += __shfl_xor(t, 2); a.x = t;
        t = s0[4 * gq + 1]; t += __shfl_xor(t, 1); t += __shfl_xor(t, 2); a.y = t;
        t = s0[4 * gq + 2]; t += __shfl_xor(t, 1); t += __shfl_xor(t, 2); a.z = t;
        t = s0[4 * gq + 3]; t += __shfl_xor(t, 1); t += __shfl_xor(t, 2); a.w = t;
        t = s1[4 * gq + 0]; t += __shfl_xor(t, 1); t += __shfl_xor(t, 2); b.x = t;
        t = s1[4 * gq + 1]; t += __shfl_xor(t, 1); t += __shfl_xor(t, 2); b.y = t;
        t = s1[4 * gq + 2]; t += __shfl_xor(t, 1); t += __shfl_xor(t, 2); b.z = t;
        t = s1[4 * gq + 3]; t += __shfl_xor(t, 1); t += __shfl_xor(t, 2); b.w = t;
        if ((l31 & 3) == 0) { *(float4*)(ps + 8 * gq) = a; *(float4*)(ps + 32 + 8 * gq) = b; }
      }
    }
#pragma unroll
    for (int s4 = 0; s4 < 4; ++s4) {
      u32x4 pk;
      if (s4 < 2) {
#pragma unroll
        for (int jj = 0; jj < 4; ++jj) pk[jj] = pack_bf2(s0[8 * (s4 & 1) + 2 * jj], s0[8 * (s4 & 1) + 2 * jj + 1]);
      } else {
#pragma unroll
        for (int jj = 0; jj < 4; ++jj) pk[jj] = pack_bf2(s1[8 * (s4 & 1) + 2 * jj], s1[8 * (s4 & 1) + 2 * jj + 1]);
      }
      const bf16x8 pb = __builtin_bit_cast(bf16x8, pk);
#pragma unroll
      for (int dt = 0; dt < 2; ++dt) {
        s16x4 vlo = vtr(vrd + bo + dt * 4096 + s4 * 1024);
        s16x4 vhi = vtr(vrd + bo + dt * 4096 + s4 * 1024 + 512);
        bf16x8 vf = __builtin_shufflevector(vlo, vhi, 0, 1, 2, 3, 4, 5, 6, 7);
        O[dt] = mfma32(vf, pb, O[dt]);
      }
    }
  }
  __syncthreads();
}

template <int MODE>
DI void attn_tiles_pipe(const u16* __restrict__ Kg, const u16* __restrict__ Vg, int j0, int j1, char* smem,
                        const bf16x8 (&qf)[4], float& m, float& l, f32x16 (&O)[2], int lo, int hi, int lo_max, int hi_min,
                        unsigned mlo, unsigned mhi, int tid) {
  const int lane = tid & 63, l31 = lane & 31, h = lane >> 5;
  const int lk = tid >> 3, lc = tid & 7;
  const int kwr = lk * 128 + ((lc ^ ((lk >> 1) & 7)) << 4);
  const int vwr = 16384 + (lc >> 2) * 4096 + lk * 64 + (lc & 3) * 16;
  const int f = (l31 >> 1) & 7;
  const int krd = l31 * 128;
  int kx[4];
#pragma unroll
  for (int ks = 0; ks < 4; ++ks) kx[ks] = ((2 * ks + h) ^ f) << 4;
  const lds_cptr vrd = (lds_cptr)smem + 16384 + ((lane >> 4) & 1) * 32 + (lane & 3) * 8 + (4 * h + ((lane & 15) >> 2)) * 64;
  const int goff = lk * 64 + lc * 8;
  u32x4 rk, rv;
  auto qk_tile = [&](int bufoff, f32x16& d0, f32x16& d1) __attribute__((always_inline)) {
    bf16x8 ka[4], kb[4];
#pragma unroll
    for (int ks = 0; ks < 4; ++ks) { ka[ks] = *(const bf16x8*)(smem + bufoff + krd + kx[ks]); kb[ks] = *(const bf16x8*)(smem + bufoff + krd + 4096 + kx[ks]); }
    d0 = mfma32(ka[0], qf[0], zero16()); d1 = mfma32(kb[0], qf[0], zero16());
#pragma unroll
    for (int ks = 1; ks < 4; ++ks) { d0 = mfma32(ka[ks], qf[ks], d0); d1 = mfma32(kb[ks], qf[ks], d1); }
  };
  auto active = [&](int j) __attribute__((always_inline)) -> bool {
    if (MODE != 2) return true;
    const bool b = ((j < 32 ? (mlo >> j) : (mhi >> (j - 32))) & 1u) != 0;
    return __ballot(b) != 0ull;
  };
  auto step = [&](int j, bool act_c, bool& act_n, f32x16& c0, f32x16& c1, f32x16& n0, f32x16& n1) __attribute__((always_inline)) {
    const int par = (j - j0) & 1;
    const int bo = par * 8192, bn = (par ^ 1) * 8192;
    if (j < j1) *(u32x4*)(smem + bn + kwr) = rk;
    *(u32x4*)(smem + bo + vwr) = rv;
    __syncthreads();
    if (j + 2 <= j1) rk = *(const u32x4*)(Kg + (size_t)(j + 2) * 4096 + goff);
    if (j + 1 <= j1) rv = *(const u32x4*)(Vg + (size_t)(j + 1) * 4096 + goff);
    act_n = false;
    if (j < j1) { act_n = active(j + 1); if (act_n) qk_tile(bn, n0, n1); }
    if (!act_c) return;
    bool bit = true;
    if (MODE == 2) bit = ((j < 32 ? (mlo >> j) : (mhi >> (j - 32))) & 1u) != 0;
    const bool need_mask = (64 * j < lo_max) || (64 * j + 63 > hi_min);
    if (need_mask) {
      const int rlo = lo - 64 * j - 4 * h, span = hi - lo;
#pragma unroll
      for (int i = 0; i < 16; ++i) {
        const int cc = 8 * (i >> 2) + (i & 3);
        if ((unsigned)(cc - rlo) > (unsigned)span || span < 0) c0[i] = NEGF;
        if ((unsigned)(cc + 32 - rlo) > (unsigned)span || span < 0) c1[i] = NEGF;
      }
    }
    float mx = c0[0];
#pragma unroll
    for (int i = 1; i < 16; ++i) mx = fmaxf(mx, c0[i]);
#pragma unroll
    for (int i = 0; i < 16; ++i) mx = fmaxf(mx, c1[i]);
    mx = fmaxf(mx, __shfl_xor(mx, 32));
    if (MODE == 2) mx = bit ? mx : NEGF;
    const float mn = fmaxf(m, mx);
    const float alpha = __builtin_amdgcn_exp2f(m - mn);
    m = mn;
    l *= alpha;
    if (__ballot(alpha != 1.f) != 0ull) {
#pragma unroll
      for (int i = 0; i < 16; ++i) { O[0][i] *= alpha; O[1][i] *= alpha; }
    }
    const float msub = (MODE == 2 && !bit) ? 1e30f : fmaxf(mn, -1e29f);
    bf16x8 vf[4][2];
#pragma unroll
    for (int s4 = 0; s4 < 4; ++s4)
#pragma unroll
      for (int dt = 0; dt < 2; ++dt) {
        s16x4 vlo = vtr(vrd + bo + dt * 4096 + s4 * 1024);
        s16x4 vhi = vtr(vrd + bo + dt * 4096 + s4 * 1024 + 512);
        vf[s4][dt] = __builtin_shufflevector(vlo, vhi, 0, 1, 2, 3, 4, 5, 6, 7);
      }
    float rs = 0.f;
#pragma unroll
    for (int i = 0; i < 16; ++i) {
      const float p0 = __builtin_amdgcn_exp2f(c0[i] - msub), p1 = __builtin_amdgcn_exp2f(c1[i] - msub);
      c0[i] = p0; c1[i] = p1;
      rs += p0 + p1;
    }
    l += rs;
#pragma unroll
    for (int s4 = 0; s4 < 4; ++s4) {
      u32x4 pk;
      if (s4 < 2) {
#pragma unroll
        for (int jj = 0; jj < 4; ++jj) pk[jj] = pack_bf2(c0[8 * (s4 & 1) + 2 * jj], c0[8 * (s4 & 1) + 2 * jj + 1]);
      } else {
#pragma unroll
        for (int jj = 0; jj < 4; ++jj) pk[jj] = pack_bf2(c1[8 * (s4 & 1) + 2 * jj], c1[8 * (s4 & 1) + 2 * jj + 1]);
      }
      const bf16x8 pb = __builtin_bit_cast(bf16x8, pk);
      O[0] = mfma32(vf[s4][0], pb, O[0]);
      O[1] = mfma32(vf[s4][1], pb, O[1]);
    }
  };
  rk = *(const u32x4*)(Kg + (size_t)j0 * 4096 + goff);
  rv = *(const u32x4*)(Vg + (size_t)j0 * 4096 + goff);
  *(u32x4*)(smem + kwr) = rk;
  if (j0 < j1) rk = *(const u32x4*)(Kg + (size_t)(j0 + 1) * 4096 + goff);
  __syncthreads();
  f32x16 a0, a1, b0, b1;
  bool actA = true, actB = false;
  qk_tile(0, a0, a1);
  for (int j = j0; j <= j1; j += 2) {
    step(j, actA, actB, a0, a1, b0, b1);
    if (j + 1 <= j1) step(j + 1, actB, actA, b0, b1, a0, a1);
  }
  __syncthreads();
}

constexpr int RING = 6;
DI void glds16(const u16* g, char* lds) {
  __builtin_amdgcn_global_load_lds((const unsigned*)g, (LAS unsigned*)lds, 16, 0, 0);
}
template <int MODE>
DI void attn_tiles_ring(const u16* __restrict__ Kg, const u16* __restrict__ Vg, int j0, int j1, char* smem,
                        const bf16x8 (&qf)[4], float& m, float& l, f32x16 (&O)[2], int lo, int hi, int lo_max, int hi_min,
                        unsigned mlo, unsigned mhi, int tid) {
  const int lane = tid & 63, l31 = lane & 31, h = lane >> 5;
  const int f = (l31 >> 1) & 7;
  const int krd = l31 * 128;
  int kx[4];
#pragma unroll
  for (int ks = 0; ks < 4; ++ks) kx[ks] = ((2 * ks + h) ^ f) << 4;
  const int vrdo = 8192 + ((lane >> 4) & 1) * 32 + (lane & 3) * 8 + (4 * h + ((lane & 15) >> 2)) * 64;
  const lds_cptr lbase = (lds_cptr)smem;
  const int ksrc = (tid >> 3) * 64 + (((tid & 7) ^ (((tid >> 3) >> 1) & 7)) << 3);
  const int vsrc = ((tid >> 2) & 63) * 64 + (((tid >> 8) * 4 + (tid & 3)) << 3);
  const int dma = tid * 16;
  auto issue = [&](int t, int st) __attribute__((always_inline)) {
    const int tc = t < j1 ? t : j1;
    glds16(Kg + (size_t)tc * 4096 + ksrc, smem + st * 16384 + dma);
    glds16(Vg + (size_t)tc * 4096 + vsrc, smem + st * 16384 + 8192 + dma);
  };
  auto qk_tile = [&](int st, f32x16& d0, f32x16& d1) __attribute__((always_inline)) {
    const char* kb_ = smem + st * 16384;
    bf16x8 ka[4], kb[4];
#pragma unroll
    for (int ks = 0; ks < 4; ++ks) { ka[ks] = *(const bf16x8*)(kb_ + krd + kx[ks]); kb[ks] = *(const bf16x8*)(kb_ + krd + 4096 + kx[ks]); }
    d0 = mfma32(ka[0], qf[0], zero16()); d1 = mfma32(kb[0], qf[0], zero16());
#pragma unroll
    for (int ks = 1; ks < 4; ++ks) { d0 = mfma32(ka[ks], qf[ks], d0); d1 = mfma32(kb[ks], qf[ks], d1); }
  };
  auto active = [&](int j) __attribute__((always_inline)) -> bool {
    if (MODE != 2) return true;
    const bool b = ((j < 32 ? (mlo >> j) : (mhi >> (j - 32))) & 1u) != 0;
    return __ballot(b) != 0ull;
  };
  int st_cur = 0, st_iss = 5;
  auto step = [&](int j, bool act_c, bool& act_n, f32x16& c0, f32x16& c1, f32x16& n0, f32x16& n1) __attribute__((always_inline)) {
    asm volatile("s_waitcnt vmcnt(6)" ::: "memory");
    __builtin_amdgcn_s_barrier();
    issue(j + 5, st_iss);
    const int st_nxt = (st_cur == RING - 1) ? 0 : st_cur + 1;
    act_n = false;
    if (j < j1) { act_n = active(j + 1); if (act_n) qk_tile(st_nxt, n0, n1); }
    if (act_c) {
      bool bit = true;
      if (MODE == 2) bit = ((j < 32 ? (mlo >> j) : (mhi >> (j - 32))) & 1u) != 0;
      const bool need_mask = (64 * j < lo_max) || (64 * j + 63 > hi_min);
      if (need_mask) {
        const int rlo = lo - 64 * j - 4 * h, span = hi - lo;
#pragma unroll
        for (int i = 0; i < 16; ++i) {
          const int cc = 8 * (i >> 2) + (i & 3);
          if ((unsigned)(cc - rlo) > (unsigned)span || span < 0) c0[i] = NEGF;
          if ((unsigned)(cc + 32 - rlo) > (unsigned)span || span < 0) c1[i] = NEGF;
        }
      }
      float mx = c0[0];
#pragma unroll
      for (int i = 1; i < 16; ++i) mx = fmaxf(mx, c0[i]);
#pragma unroll
      for (int i = 0; i < 16; ++i) mx = fmaxf(mx, c1[i]);
      mx = fmaxf(mx, __shfl_xor(mx, 32));
      if (MODE == 2) mx = bit ? mx : NEGF;
      const float mn = fmaxf(m, mx);
      const float alpha = __builtin_amdgcn_exp2f(m - mn);
      m = mn;
      l *= alpha;
      if (__ballot(alpha != 1.f) != 0ull) {
#pragma unroll
        for (int i = 0; i < 16; ++i) { O[0][i] *= alpha; O[1][i] *= alpha; }
      }
      const float msub = (MODE == 2 && !bit) ? 1e30f : fmaxf(mn, -1e29f);
      const lds_cptr vb = lbase + st_cur * 16384 + vrdo;
      bf16x8 vf[4][2];
#pragma unroll
      for (int s4 = 0; s4 < 4; ++s4)
#pragma unroll
        for (int dt = 0; dt < 2; ++dt) {
          s16x4 vlo = vtr(vb + dt * 4096 + s4 * 1024);
          s16x4 vhi = vtr(vb + dt * 4096 + s4 * 1024 + 512);
          vf[s4][dt] = __builtin_shufflevector(vlo, vhi, 0, 1, 2, 3, 4, 5, 6, 7);
        }
      float rs = 0.f;
#pragma unroll
      for (int i = 0; i < 16; ++i) {
        const float p0 = __builtin_amdgcn_exp2f(c0[i] - msub), p1 = __builtin_amdgcn_exp2f(c1[i] - msub);
        c0[i] = p0; c1[i] = p1;
        rs += p0 + p1;
      }
      l += rs;
#pragma unroll
      for (int s4 = 0; s4 < 4; ++s4) {
        u32x4 pk;
        if (s4 < 2) {
#pragma unroll
          for (int jj = 0; jj < 4; ++jj) pk[jj] = pack_bf2(c0[8 * (s4 & 1) + 2 * jj], c0[8 * (s4 & 1) + 2 * jj + 1]);
        } else {
#pragma unroll
          for (int jj = 0; jj < 4; ++jj) pk[jj] = pack_bf2(c1[8 * (s4 & 1) + 2 * jj], c1[8 * (s4 & 1) + 2 * jj + 1]);
        }
        const bf16x8 pb = __builtin_bit_cast(bf16x8, pk);
        O[0] = mfma32(vf[s4][0], pb, O[0]);
        O[1] = mfma32(vf[s4][1], pb, O[1]);
      }
    }
    st_cur = st_nxt;
    st_iss = (st_iss == RING - 1) ? 0 : st_iss + 1;
  };
#pragma unroll
  for (int i = 0; i < 5; ++i) issue(j0 + i, i);
  asm volatile("s_waitcnt vmcnt(8)" ::: "memory");
  __builtin_amdgcn_s_barrier();
  f32x16 a0, a1, b0, b1;
  bool actA = true, actB = false;
  qk_tile(0, a0, a1);
  for (int j = j0; j <= j1; j += 2) {
    step(j, actA, actB, a0, a1, b0, b1);
    if (j + 1 <= j1) step(j + 1, actB, actA, b0, b1, a0, a1);
  }
  asm volatile("s_waitcnt vmcnt(0)" ::: "memory");
  __syncthreads();
}

DI void attn_cmp(const u16* __restrict__ Kc, const u16* __restrict__ Vc, int nct, char* smem, const bf16x8 (&qf)[4],
                 f32x16 (&O)[2], int hi, int hi_min, int tok_l, int tid) {
  const int lane = tid & 63, l31 = lane & 31, h = lane >> 5;
  const int f = (l31 >> 1) & 7;
  const int krd = l31 * 128;
  int kx[4];
#pragma unroll
  for (int ks = 0; ks < 4; ++ks) kx[ks] = ((2 * ks + h) ^ f) << 4;
  const int vrdo = 8192 + ((lane >> 4) & 1) * 32 + (lane & 3) * 8 + (4 * h + ((lane & 15) >> 2)) * 64;
  const lds_cptr lbase = (lds_cptr)smem;
  const int ksrc = (tid >> 3) * 64 + (((tid & 7) ^ (((tid >> 3) >> 1) & 7)) << 3);
  const int vsrc = ((tid >> 2) & 63) * 64 + (((tid >> 8) * 4 + (tid & 3)) << 3);
#pragma unroll
  for (int t = 0; t < 4; ++t) {
    const int tc = t < nct ? t : nct - 1;
    glds16(Kc + (size_t)tc * 4096 + ksrc, smem + t * 16384 + tid * 16);
    glds16(Vc + (size_t)tc * 4096 + vsrc, smem + t * 16384 + 8192 + tid * 16);
  }
  asm volatile("s_waitcnt vmcnt(0)" ::: "memory");
  __syncthreads();
  f32x16 S[4][2];
  float mx = NEGF;
#pragma unroll
  for (int t = 0; t < 4; ++t) {
    if (t < nct) {
      const char* kb_ = smem + t * 16384;
      bf16x8 ka[4], kb[4];
#pragma unroll
      for (int ks = 0; ks < 4; ++ks) { ka[ks] = *(const bf16x8*)(kb_ + krd + kx[ks]); kb[ks] = *(const bf16x8*)(kb_ + krd + 4096 + kx[ks]); }
      S[t][0] = mfma32(ka[0], qf[0], zero16()); S[t][1] = mfma32(kb[0], qf[0], zero16());
#pragma unroll
      for (int ks = 1; ks < 4; ++ks) { S[t][0] = mfma32(ka[ks], qf[ks], S[t][0]); S[t][1] = mfma32(kb[ks], qf[ks], S[t][1]); }
      if (64 * t + 63 > hi_min) {
        const int rhi = hi - 64 * t - 4 * h;
#pragma unroll
        for (int i = 0; i < 16; ++i) {
          const int cc = 8 * (i >> 2) + (i & 3);
          if (cc > rhi) S[t][0][i] = NEGF;
          if (cc + 32 > rhi) S[t][1][i] = NEGF;
        }
      }
#pragma unroll
      for (int i = 0; i < 16; ++i) mx = fmaxf(mx, fmaxf(S[t][0][i], S[t][1][i]));
    }
  }
  mx = fmaxf(mx, __shfl_xor(mx, 32));
  const float msub = fmaxf(mx, -1e29f);
  float ls = 0.f;
#pragma unroll
  for (int t = 0; t < 4; ++t)
    if (t < nct) {
#pragma unroll
      for (int i = 0; i < 16; ++i) {
        S[t][0][i] = __builtin_amdgcn_exp2f(S[t][0][i] - msub); S[t][1][i] = __builtin_amdgcn_exp2f(S[t][1][i] - msub);
        ls += S[t][0][i] + S[t][1][i];
      }
    }
  ls += __shfl_xor(ls, 32);
  const float inv_l = 1.f / fmaxf(ls, 1e-30f);
  O[0] = zero16(); O[1] = zero16();
#pragma unroll
  for (int t = 0; t < 4; ++t)
    if (t < nct) {
      f32x16& s0 = S[t][0];
      f32x16& s1 = S[t][1];
#pragma unroll
      for (int i = 0; i < 16; ++i) { s0[i] *= inv_l; s1[i] *= inv_l; }
      float* ps = (float*)(smem + AT_P) + tok_l * 256 + 64 * t + 4 * h;
#pragma unroll
      for (int gq = 0; gq < 4; ++gq) {
        float4 a, b;
        float u;
        u = s0[4 * gq + 0]; u += __shfl_xor(u, 1); u += __shfl_xor(u, 2); a.x = u;
        u = s0[4 * gq + 1]; u += __shfl_xor(u, 1); u += __shfl_xor(u, 2); a.y = u;
        u = s0[4 * gq + 2]; u += __shfl_xor(u, 1); u += __shfl_xor(u, 2); a.z = u;
        u = s0[4 * gq + 3]; u += __shfl_xor(u, 1); u += __shfl_xor(u, 2); a.w = u;
        u = s1[4 * gq + 0]; u += __shfl_xor(u, 1); u += __shfl_xor(u, 2); b.x = u;
        u = s1[4 * gq + 1]; u += __shfl_xor(u, 1); u += __shfl_xor(u, 2); b.y = u;
        u = s1[4 * gq + 2]; u += __shfl_xor(u, 1); u += __shfl_xor(u, 2); b.z = u;
        u = s1[4 * gq + 3]; u += __shfl_xor(u, 1); u += __shfl_xor(u, 2); b.w = u;
        if ((l31 & 3) == 0) { *(float4*)(ps + 8 * gq) = a; *(float4*)(ps + 32 + 8 * gq) = b; }
      }
      const lds_cptr vb = lbase + t * 16384 + vrdo;
#pragma unroll
      for (int s4 = 0; s4 < 4; ++s4) {
        u32x4 pk;
        if (s4 < 2) {
#pragma unroll
          for (int jj = 0; jj < 4; ++jj) pk[jj] = pack_bf2(s0[8 * (s4 & 1) + 2 * jj], s0[8 * (s4 & 1) + 2 * jj + 1]);
        } else {
#pragma unroll
          for (int jj = 0; jj < 4; ++jj) pk[jj] = pack_bf2(s1[8 * (s4 & 1) + 2 * jj], s1[8 * (s4 & 1) + 2 * jj + 1]);
        }
        const bf16x8 pb = __builtin_bit_cast(bf16x8, pk);
#pragma unroll
        for (int dt = 0; dt < 2; ++dt) {
          s16x4 vlo = vtr(vb + dt * 4096 + s4 * 1024);
          s16x4 vhi = vtr(vb + dt * 4096 + s4 * 1024 + 512);
          bf16x8 vf = __builtin_shufflevector(vlo, vhi, 0, 1, 2, 3, 4, 5, 6, 7);
          O[dt] = mfma32(vf, pb, O[dt]);
        }
      }
    }
  __syncthreads();
}

DI void attn_item(const Params& p, int bg, int qt, char* smem) {
  const int tid = opaque_tid(), lane = tid & 63, w = tid >> 6, l31 = lane & 31, h = lane >> 5;
  const int b = bg >> 1, g = bg & 1;
  const int t0 = qt * 64;
  const int tok_l = w * 8 + (l31 >> 2);
  const int tpos = t0 + tok_l;
  const int r = l31 & 3;
  const size_t tglob = (size_t)b * SEQ + tpos;
  bf16x8 qf[4];
  {
    const u16* qp = p.qb + tglob * 512 + (g * 4 + r) * 64 + h * 8;
#pragma unroll
    for (int ks = 0; ks < 4; ++ks) qf[ks] = *(const bf16x8*)(qp + ks * 16);
  }
  const float g0 = p.gate[tglob * 24 + 0 + g * 4 + r];
  const float g1 = p.gate[tglob * 24 + 8 + g * 4 + r];
  const float g2 = p.gate[tglob * 24 + 16 + g * 4 + r];
  const int cur = t0 >> 6;
  f32x16 O[2];
  float m, l;
  unsigned* stash = (unsigned*)(smem + AT_S) + w * 1024 + lane;
  {
    const u16* Kc = p.kcmp + (size_t)bg * 256 * 64;
    const u16* Vc = p.vcmp + (size_t)bg * 256 * 64;
    const int nct = ((t0 + 32) >> 10) + 1;
    const int hi = (tpos - 31) >> 4;
    const int hi_min = (t0 - 31) >> 4;
    attn_cmp(Kc, Vc, nct, smem, qf, O, hi, hi_min, tok_l, tid);
    const float* Ps = (const float*)(smem + AT_P);
    unsigned long long* Ms = (unsigned long long*)(smem + AT_M);
    const int ncv = nct * 64;
    for (int tl = 0; tl < 8; ++tl) {
      const int tokl = w * 8 + tl;
      const int j = lane;
      const float* pr = Ps + tokl * 256;
      float imp = 0.f;
      if (4 * j < ncv) {
        float4 v = *(const float4*)(pr + 4 * j);
        imp = 2.f * (v.x + v.y + v.z) + v.w;
        if (j > 0) imp += pr[4 * j - 1];
      }
      unsigned key = ((__float_as_uint(imp) & ~63u) | (unsigned)(63 - j)) + 64u;
      if (j > cur) key = (unsigned)(63 - j);
      if (j == 0 || j == cur || j == cur - 1) key = 0xFFFFFF00u | (unsigned)(63 - j);
      unsigned* kl = (unsigned*)(smem + w * 256);
      kl[lane] = key;
      int cnt = 0;
#pragma unroll
      for (int k4 = 0; k4 < 16; ++k4) {
        const u32x4 q = *(const u32x4*)(kl + 4 * k4);
        cnt += (q[0] > key) + (q[1] > key) + (q[2] > key) + (q[3] > key);
      }
      unsigned long long bal = __ballot(cnt < 16);
      if (lane == 0) Ms[tokl] = bal;
    }
  }
  __syncthreads();
  unsigned mlo, mhi;
  {
    const unsigned* Mw = (const unsigned*)(smem + AT_M);
    mlo = Mw[tok_l * 2]; mhi = Mw[tok_l * 2 + 1];
  }
#pragma unroll
  for (int i = 0; i < 8; ++i) { stash[i * 64] = pack_bf2(g0 * O[0][2 * i], g0 * O[0][2 * i + 1]); stash[(8 + i) * 64] = pack_bf2(g0 * O[1][2 * i], g0 * O[1][2 * i + 1]); }
  {
    m = NEGF; l = 0.f;
    O[0] = zero16(); O[1] = zero16();
    attn_tiles_ring<2>(p.kvb + (size_t)(2 * 16 + bg) * SEQ * 64, p.kvb + (size_t)(3 * 16 + bg) * SEQ * 64, 0, cur, smem, qf, m, l, O,
                  0, tpos, 0, t0, mlo, mhi, tid);
    const float lt = l + __shfl_xor(l, 32);
    const float sc = g1 / fmaxf(lt, 1e-30f);
#pragma unroll
    for (int i = 0; i < 8; ++i) {
      const unsigned u0 = stash[i * 64], u1 = stash[(8 + i) * 64];
      stash[i * 64] = pack_bf2(bf_lo(u0) + sc * O[0][2 * i], bf_hi(u0) + sc * O[0][2 * i + 1]);
      stash[(8 + i) * 64] = pack_bf2(bf_lo(u1) + sc * O[1][2 * i], bf_hi(u1) + sc * O[1][2 * i + 1]);
    }
  }
  {
    m = NEGF; l = 0.f;
    O[0] = zero16(); O[1] = zero16();
    const int jlo = max(t0 - 511, 0) >> 6;
    attn_tiles_ring<3>(p.kvb + (size_t)(4 * 16 + bg) * SEQ * 64, p.kvb + (size_t)(5 * 16 + bg) * SEQ * 64, jlo, cur, smem, qf, m, l, O,
                  tpos - 511, tpos, t0 + 63 - 511, t0, 0u, 0u, tid);
    const float lt = l + __shfl_xor(l, 32);
    const float sc = g2 / fmaxf(lt, 1e-30f);
#pragma unroll
    for (int i = 0; i < 8; ++i) {
      const unsigned u0 = stash[i * 64], u1 = stash[(8 + i) * 64];
      O[0][2 * i] = bf_lo(u0) + sc * O[0][2 * i]; O[0][2 * i + 1] = bf_hi(u0) + sc * O[0][2 * i + 1];
      O[1][2 * i] = bf_lo(u1) + sc * O[1][2 * i]; O[1][2 * i + 1] = bf_hi(u1) + sc * O[1][2 * i + 1];
    }
  }
  u16* op = p.ob + tglob * 512 + (g * 4 + r) * 64 + 4 * h;
#pragma unroll
  for (int dt = 0; dt < 2; ++dt)
#pragma unroll
    for (int gq = 0; gq < 4; ++gq) {
      u32x2 o = {pack_bf2(O[dt][4 * gq], O[dt][4 * gq + 1]), pack_bf2(O[dt][4 * gq + 2], O[dt][4 * gq + 3])};
      *(u32x2*)(op + dt * 32 + 8 * gq) = o;
    }
}

DI void p10_rows(const Params& p, int item) {
  const int w = threadIdx.x >> 6, lane = threadIdx.x & 63;
  const int row = item * 8 + w;
  float s = (lane < 16) ? p.ssq2[(size_t)row * 16 + lane] : 0.f;
#pragma unroll
  for (int o = 8; o; o >>= 1) s += __shfl_xor(s, o);
  s = __shfl(s, 0);
  const float rs = rsqrtf(s * (1.f / DM) + 1e-6f);
  float4* o4 = (float4*)(p.out + (size_t)row * DM);
  const float4* g4 = (const float4*)p.norm_final;
#pragma unroll
  for (int i = 0; i < 4; ++i) {
    float4 v = o4[lane + 64 * i], g = g4[lane + 64 * i];
    v.x *= rs * g.x; v.y *= rs * g.y; v.z *= rs * g.z; v.w *= rs * g.w;
    o4[lane + 64 * i] = v;
  }
}


#define XB_TMO      128
#define XB_XCNT(j)  (256  + 64 * (j))
#define XB_XSUB(j)  (1280 + 64 * (j))
#define XB_XGEN(j)  (2304 + 64 * (j))
#define XB_TOP      3328
#define XB_TOPGEN   3392
#define XCD_BAR_WORDS 3456
#define XB_SPIN_CAP (1u << 18)
DI unsigned xb_xcc_id() { return (unsigned)__builtin_amdgcn_s_getreg((3 << 11) | 20) & 0xFu; }
#define XB_SPIN(cond, bar) do { unsigned _sp = 0; while (cond) { __builtin_amdgcn_s_sleep(1); \
    if ((++_sp & 255u) == 0u) { if (xb_ld(&(bar)[XB_TMO])) break; if (_sp > XB_SPIN_CAP) { atomicAdd(&(bar)[XB_TMO], 1u); break; } } } } while (0)
struct XcdBarrier { unsigned* bar; unsigned x; volatile LAS unsigned* st; };
DI XcdBarrier xcd_barrier_post(unsigned* bar, volatile LAS unsigned* st) {
  XcdBarrier b; b.bar = bar; b.x = xb_xcc_id(); b.st = st;
  if (threadIdx.x == 0) (void)xb_add(&bar[XB_XCNT(b.x)], 1u);
  return b;
}
DI void xcd_barrier_complete(unsigned* bar, unsigned x, unsigned& nloc, unsigned& nx) {
  const unsigned G = gridDim.x * gridDim.y * gridDim.z;
  unsigned sum, cnt, mine, sp = 0u;
  for (;;) {
    sum = 0u; cnt = 0u; mine = 0u;
#pragma unroll
    for (unsigned j = 0; j < 16; ++j) { const unsigned c = xb_ld(&bar[XB_XCNT(j)]); sum += c; cnt += (c > 0u) ? 1u : 0u; mine = (j == x) ? c : mine; }
    if (sum == G) break;
    __builtin_amdgcn_s_sleep(1);
    if ((++sp & 255u) == 0u) { if (xb_ld(&bar[XB_TMO])) break; if (sp > XB_SPIN_CAP) { atomicAdd(&bar[XB_TMO], 1u); break; } }
  }
  nloc = mine > 0u ? mine : 1u; nx = cnt > 0u ? cnt : 1u;
}
DI void xcd_barrier(const XcdBarrier& b) {
  asm volatile("s_waitcnt vmcnt(0)" ::: "memory");
  __syncthreads();
  if (threadIdx.x == 0) {
    unsigned* bar = b.bar;
    __builtin_amdgcn_s_waitcnt(0);
    unsigned nloc = b.st[0], nx = b.st[1];
    if (nloc == 0u) { xcd_barrier_complete(bar, b.x, nloc, nx); b.st[0] = nloc; b.st[1] = nx; }
    const unsigned old = xb_add(&bar[XB_XSUB(b.x)], 1u);
    const unsigned gen = old / nloc;
    if (old + 1u == (gen + 1u) * nloc) {
      __builtin_amdgcn_fence(__ATOMIC_RELEASE, "agent");
      asm volatile("s_waitcnt vmcnt(0)" ::: "memory");
      const unsigned og = xb_add(&bar[XB_TOP], 1u);
      const unsigned tg = og / nx;
      if (og + 1u == (tg + 1u) * nx) xb_add(&bar[XB_TOPGEN], 1u);
      else XB_SPIN(xb_ld(&bar[XB_TOPGEN]) == tg, bar);
      __builtin_amdgcn_fence(__ATOMIC_ACQUIRE, "agent");
      xb_add(&bar[XB_XGEN(b.x)], 1u);
      asm volatile("s_waitcnt vmcnt(0)" ::: "memory");
    } else {
      XB_SPIN(xb_ld(&bar[XB_XGEN(b.x)]) == gen, bar);
      __builtin_amdgcn_fence(__ATOMIC_ACQUIRE, "agent");
      asm volatile("s_waitcnt vmcnt(0)" ::: "memory");
    }
  }
  __syncthreads();
}

__global__ void __launch_bounds__(NTHR, 2) nsa_pool_block_fwd(Params p) {
  extern __shared__ __attribute__((aligned(16))) unsigned char shm[];
  char* smem = (char*)shm;
  LAS unsigned char* lds = (LAS unsigned char*)shm;
  cg::grid_group grid = cg::this_grid();
  const int G = gridDim.x;
  const int bid = blockIdx.x;
  const int L = (G % 8 == 0) ? (bid % 8) * (G / 8) + bid / 8 : bid;
  volatile LAS unsigned* xst = (volatile LAS unsigned*)(lds + 133120);
  if (threadIdx.x < 4) xst[threadIdx.x] = 0u;
  __syncthreads();
  const XcdBarrier xb = xcd_barrier_post(p.bar, xst);

  if (PH_MASK & 1)
  {
    constexpr int N0 = 1024, N1 = N0 + TJ_TOTAL / 2, N2 = N1 + 64, N3 = N2 + 16, N4 = N3 + 64;
    for (int rep = 0; rep < ((REP_MASK & 1) ? 2 : 1); ++rep)
    for (int it = N4 - 1 - bid; it >= 0; it -= G) {
      if (it < N0) p0_rows(p, it);
      else if (it < N1) p0_transpose(p, it - N0, smem);
      else if (it < N2) p0_weff(p, it - N1, smem);
      else if (it < N3) p0_cbias(p, it - N2, smem);
      else p0_rope(p, it - N3);
    }
  }
  if (p.bar == nullptr) grid.sync();
  xcd_barrier(xb);
  if (PH_MASK & 2) {
    Sched S{0, G, bid};
    EpiProj E{p};
    for (int rep = 0; rep < ((REP_MASK & 2) ? 2 : 1); ++rep)
    gemm_phase(lds, Gemm{p.xb, p.w_in_t, DM, DM, DM, 128, 128}, S, E);
  }
  xcd_barrier(xb);
  if (PH_MASK & 4) for (int rep = 0; rep < ((REP_MASK & 4) ? 2 : 1); ++rep)
  {
    Sched S{2, G, bid};
    EpiCmpHid E{(float*)p.mb};
    gemm_phase(lds, Gemm{p.kvb, p.cw1_t, 1024, 2048, 512, 128, 128}, S, E);
    for (int it = bid; it < 4096; it += G) p2a_pool_item(p, it);
  }
  xcd_barrier(xb);
  if (PH_MASK & 8) {
    Sched S{3, G, bid};
    EpiCmpOut E{p};
    for (int i = 0;; ++i) {
      Unit u;
      if (!S.next(i, u)) break;
      const float* h32 = (const float*)p.mb;
      const float* bias = p.cbias + u.pn * 256;
      for (int e0 = threadIdx.x; e0 < 8192; e0 += 4 * NTHR) {
        f32x4 pv[4][4][2];
#pragma unroll
        for (int q = 0; q < 4; ++q) {
          const int e = e0 + q * NTHR, c = e >> 5, n8 = (e & 31) * 8;
#pragma unroll
          for (int ks = 0; ks < 4; ++ks) {
            const f32x4* sp = (const f32x4*)(h32 + ((size_t)((ks * 32 + u.pm) * 256 + c)) * 256 + n8);
            pv[q][ks][0] = sp[0]; pv[q][ks][1] = sp[1];
          }
        }
#pragma unroll
        for (int q = 0; q < 4; ++q) {
          const int e = e0 + q * NTHR, c = e >> 5, n8 = (e & 31) * 8;
          f32x4 v0 = *(const f32x4*)(bias + n8), v1 = *(const f32x4*)(bias + n8 + 4);
#pragma unroll
          for (int ks = 0; ks < 4; ++ks) { v0 += pv[q][ks][0]; v1 += pv[q][ks][1]; }
#pragma unroll
          for (int j = 0; j < 4; ++j) { v0[j] = gelu_tanh(v0[j]); v1[j] = gelu_tanh(v1[j]); }
          *(u32x4*)(p.hid + ((size_t)u.pm * 256 + c) * 256 + n8) = pack8(v0, v1);
        }
      }
    }
    asm volatile("s_waitcnt vmcnt(0)" ::: "memory");
    __syncthreads();
    gemm_phase(lds, Gemm{p.hid, p.cw2_t, 256, 256, 256, 128, 128}, S, E);
  }
  xcd_barrier(xb);
  if (ATTN_PRIO) { if (threadIdx.x >= 256) __builtin_amdgcn_s_setprio(2); }
  if (PH_MASK & 16) for (int rep = 0; rep < ((REP_MASK & 16) ? 2 : 1); ++rep)
  if (G == 256) {
    const int x = bid & 7, j = bid >> 3;
    for (int rd = 0; rd < 4; ++rd) {
      const int idx = rd * 32 + ((rd & 1) ? (31 - j) : j);
      attn_item(p, 2 * x + (idx & 1), 63 - (idx >> 1), smem);
    }
  } else
  for (int rd = 0; rd * G < 1024; ++rd) {
    const int i = rd * G + ((rd & 1) ? (G - 1 - L) : L);
    if (i < 1024) attn_item(p, i & 15, 63 - (i >> 4), smem);
  }
  xcd_barrier(xb);
  if (ATTN_PRIO) __builtin_amdgcn_s_setprio(0);
  if (PH_MASK & 32) {
    Sched S{1, G, bid};
    EpiMerge<0> E0{p};
    EpiMerge<1> E1{p};
    for (int rep = 0; rep < ((REP_MASK & 32) ? 2 : 1); ++rep) {
    gemm_phase(lds, Gemm{p.ob, p.wa_t, 512, 512, 512, 128, 128}, S, E0);
    gemm_phase(lds, Gemm{p.pooled, p.wbe_t, 512, 512, 512, 128, 128}, S, E1);
    }
  }
  xcd_barrier(xb);
  if (PH_MASK & 64) {
    Sched S{1, G, bid};
    EpiResid<true> E{p.x, p.out, p.xb, p.ssq};
    for (int rep = 0; rep < ((REP_MASK & 64) ? 2 : 1); ++rep)
    gemm_phase(lds, Gemm{p.mb, p.wo_t, DM, DM, DM, 128, 128}, S, E);
  }
  xcd_barrier(xb);
  if (PH_MASK & 128) {
    Sched S{0, G, bid};
    EpiFF1 E{p};
    for (int rep = 0; rep < ((REP_MASK & 128) ? 2 : 1); ++rep)
    gemm_phase(lds, Gemm{p.xb, p.w1_t, DM, DM, DM, 128, 128}, S, E);
  }
  xcd_barrier(xb);
#if FUSE_FINAL
  if (PH_MASK & 256) {
    Sched S{1, G, bid};
    EpiFinal E{p.out, p.norm_final, p.ssq2, p.bar + XCD_BAR_WORDS};
    gemm_phase(lds, Gemm{p.act, p.w2_t, 64, 64, 4096, (size_t)T_TOK * 128, (size_t)1024 * 128}, S, E);
  }
#else
  if (PH_MASK & 256) {
    Sched S{1, G, bid};
    EpiResid<false> E{p.out, p.out, nullptr, p.ssq2};
    gemm_phase(lds, Gemm{p.act, p.w2_t, 64, 64, 4096, (size_t)T_TOK * 128, (size_t)1024 * 128}, S, E);
  }
  xcd_barrier(xb);
  for (int it = bid; it < 4096; it += G) p10_rows(p, it);
#endif
}

extern "C" void kernel_launch(void* const* d_in, const int* in_sizes, int n_in, void* d_out, int out_size, void* d_ws,
                              size_t ws_size, hipStream_t stream) {
  (void)in_sizes; (void)n_in; (void)out_size; (void)ws_size;
  static int grid_blocks = 0;
  if (!grid_blocks) {
    int dev = 0, cus = 0, per_cu = 0;
    (void)hipGetDevice(&dev);
    (void)hipDeviceGetAttribute(&cus, hipDeviceAttributeMultiprocessorCount, dev);
    (void)hipFuncSetAttribute((const void*)nsa_pool_block_fwd, hipFuncAttributeMaxDynamicSharedMemorySize, LDS_BYTES);
    (void)hipOccupancyMaxActiveBlocksPerMultiprocessor(&per_cu, nsa_pool_block_fwd, NTHR, LDS_BYTES);
    if (per_cu > 1) per_cu = 1;
    if (per_cu < 1) per_cu = 1;
    grid_blocks = cus * per_cu;
  }
  Params p{};
  const float* const* in = (const float* const*)d_in;
  p.x = in[0]; p.norm_mix = in[1]; p.w_in = in[2]; p.pe_k = in[3]; p.pe_v = in[4]; p.ck_w1 = in[5]; p.ck_w2 = in[6];
  p.cv_w1 = in[7]; p.cv_w2 = in[8]; p.w_ba = in[9]; p.pool_w = in[10]; p.pool_scale = in[11]; p.w_bp = in[12];
  p.w_out = in[13]; p.norm_mlp = in[14]; p.w_ff1 = in[15]; p.w_ff2 = in[16]; p.norm_final = in[17];
  p.out = (float*)d_out;
  char* ws = (char*)d_ws;
  size_t off = 0;
  auto take = [&](size_t bytes) { char* r = ws + off; off += (bytes + 255) & ~(size_t)255; return r; };
  const size_t T = T_TOK;
  p.xb = (u16*)take(T * 1024 * 2);
  p.w_in_t = (u16*)take((size_t)NPROJ * 1024 * 2);
  p.wa_t = (u16*)take(1024 * 512 * 2);
  p.wbe_t = (u16*)take(1024 * 512 * 2);
  p.wo_t = (u16*)take(1024 * 1024 * 2);
  p.w1_t = (u16*)take((size_t)4096 * 1024 * 2);
  p.w2_t = (u16*)take((size_t)4096 * 1024 * 2);
  p.cw1_t = (u16*)take(2 * 256 * 2048 * 2);
  p.cw2_t = (u16*)take(2 * 256 * 256 * 2);
  p.rstd0 = (float*)take(T * 4);
  p.cbias = (float*)take(512 * 4);
  p.rope = (float2*)take((size_t)SEQ * 8 * 8);
  p.ssq = (float*)take(T * 16 * 4);
  p.ssq2 = (float*)take(T * 16 * 4);
  p.mb = (u16*)take(T * 1024 * 2);
  char* regionD = ws + off;
  p.qb = (u16*)take(T * 512 * 2);
  p.kvb = (u16*)take((size_t)6 * 16 * SEQ * 64 * 2);
  p.gate = (float*)take(T * 24 * 4);
  p.ub = (u16*)take(T * 512 * 2);
  p.gm = (u16*)take(T * 2048 * 2);
  p.hid = (u16*)take((size_t)2 * 16 * 256 * 256 * 2);
  p.kcmp = (u16*)take(16 * 256 * 64 * 2);
  p.vcmp = (u16*)take(16 * 256 * 64 * 2);
  p.pooled = (u16*)take(T * 512 * 2);
  p.ob = (u16*)take(T * 512 * 2);
  p.bar = (unsigned*)take((XCD_BAR_WORDS + 4096) * 4);
  p.act = (u16*)regionD;
  (void)hipMemsetAsync(p.bar, 0, (XCD_BAR_WORDS + 4096) * 4, stream);
  void* args[] = {&p};
  hipError_t e = hipLaunchCooperativeKernel((void*)nsa_pool_block_fwd, dim3(grid_blocks), dim3(NTHR), args, LDS_BYTES, stream);
  if (e != hipSuccess) fprintf(stderr, "cooperative launch failed: %s (grid %d)\n", hipGetErrorString(e), grid_blocks);
}
```

```cpp
#include <hip/hip_runtime.h>
#include <hip/hip_cooperative_groups.h>
#include <stdint.h>
#include <stdio.h>
namespace cg = cooperative_groups;

#define DI __device__ __forceinline__
#define LAS __attribute__((address_space(3)))
typedef unsigned short u16;
typedef __attribute__((ext_vector_type(8))) short bf16x8;
typedef __attribute__((ext_vector_type(4))) short s16x4;
typedef __attribute__((ext_vector_type(16))) float f32x16;
typedef __attribute__((ext_vector_type(4))) float f32x4;
typedef __attribute__((ext_vector_type(4))) unsigned u32x4;
typedef __attribute__((ext_vector_type(2))) unsigned u32x2;
typedef __attribute__((ext_vector_type(2))) float f32x2;
typedef __attribute__((ext_vector_type(2))) __bf16 bf16x2_t;
typedef LAS const char* lds_cptr;

constexpr int T_TOK = 32768, SEQ = 4096, DM = 1024;
constexpr int NPROJ = 4096;
constexpr int NTHR = 512;
constexpr int LDS_BYTES = 135168;
constexpr float NEGF = -1e30f;
constexpr float QSCALE = 0.125f * 1.4426950408889634f;
#ifndef REP_MASK
#define REP_MASK 0
#endif
#ifndef ATTN_PRIO
#define ATTN_PRIO 0
#endif
#ifndef FUSE_FINAL
#define FUSE_FINAL 1
#endif
#ifndef PH_MASK
#define PH_MASK 0xffff
#endif

struct Params {
  const float *x, *norm_mix, *w_in, *pe_k, *pe_v, *ck_w1, *ck_w2, *cv_w1, *cv_w2, *w_ba, *pool_w, *pool_scale, *w_bp,
      *w_out, *norm_mlp, *w_ff1, *w_ff2, *norm_final;
  float* out;
  u16 *xb, *w_in_t, *wa_t, *wbe_t, *wo_t, *w1_t, *w2_t, *cw1_t, *cw2_t;
  float *rstd0, *cbias;
  float2* rope;
  u16 *qb, *kvb;
  float* gate;
  u16 *ub, *gm, *hid, *kcmp, *vcmp, *pooled, *ob, *mb, *act;
  float *ssq, *ssq2;
  unsigned* bar;
};

DI unsigned pack_bf2(float a, float b) {
  f32x2 v = {a, b};
  bf16x2_t r = __builtin_convertvector(v, bf16x2_t);
  return __builtin_bit_cast(unsigned, r);
}
DI float bf_lo(unsigned u) { return __uint_as_float(u << 16); }
DI float bf_hi(unsigned u) { return __uint_as_float(u & 0xffff0000u); }
DI float sigmoidf_(float v) { return __builtin_amdgcn_rcpf(1.f + __builtin_amdgcn_exp2f(-1.4426950408889634f * v)); }
DI float gelu_tanh(float x) {
  float u = 0.7978845608028654f * (x + 0.044715f * x * x * x);
  float th = 1.f - 2.f / (__expf(2.f * u) + 1.f);
  return 0.5f * x * (1.f + th);
}
DI f32x16 mfma32(bf16x8 a, bf16x8 b, f32x16 c) { return __builtin_amdgcn_mfma_f32_32x32x16_bf16(a, b, c, 0, 0, 0); }
DI int opaque_tid() { int t; asm volatile("v_mov_b32 %0, %1" : "=v"(t) : "v"((int)threadIdx.x)); return t; }
DI f32x16 zero16() { f32x16 z; for (int i = 0; i < 16; ++i) z[i] = 0.f; return z; }
DI s16x4 vtr(lds_cptr p) { return __builtin_amdgcn_ds_read_tr16_b64_v4i16((LAS s16x4*)p); }
DI u32x4 pack8(const f32x4& a, const f32x4& b) {
  u32x4 w = {pack_bf2(a[0], a[1]), pack_bf2(a[2], a[3]), pack_bf2(b[0], b[1]), pack_bf2(b[2], b[3])};
  return w;
}

constexpr int BM = 256, BK = 64, HALF = 128, HTB = HALF * BK * 2;
DI int lds_byte(int r, int c) { const int st = (r >> 4) * 2 + (c >> 5), rr = r & 15, cc = c & 31, ob = rr * 64 + cc * 2; return st * 1024 + (ob ^ (((ob >> 9) & 1) << 5)); }
DI void stage_rc(int b, int& R, int& C) { const int st = b / 1024, sb = b % 1024, swz = sb ^ (((sb >> 9) & 1) << 5); R = (st >> 1) * 16 + swz / 64; C = (st & 1) * 32 + (swz % 64) / 2; }
DI int perm32(int rho) { const int n = rho >> 4, i = rho & 15; return 8 * (i >> 2) + 4 * n + (i & 3); }

struct Unit { int pm, pn, k0; };
struct Gemm { const u16* A; const u16* Bt; int lda, ldb, K; size_t kstepA, kstepB; };

struct Sched {
  int mode, G, bid;
  DI bool next(int i, Unit& u) const {
    u.k0 = 0;
    if (mode == 2) {
      int t;
      if (G >= 256) { if (i > 0 || (bid & 1) || (bid >> 1) >= 128) return false; t = bid >> 1; }
      else { t = i * G + bid; if (t >= 128) return false; }
      u.pm = t >> 2; u.pn = u.pm >> 4; u.k0 = (t & 3) * 8; return true;
    }
    if (mode == 3) {
      int t;
      if (G >= 256) { t = bid >> 3; if (i > 0 || (bid & 7) != (t & 7) || t >= 32) return false; }
      else { t = i * G + bid; if (t >= 32) return false; }
      u.pm = t; u.pn = t >> 4; return true;
    }
    const int nN = mode == 0 ? 16 : 4;
    if (G == 256) {
      const int x = bid & 7, j = bid >> 3;
      if (mode == 0) { if (i >= 8) return false; u.pn = (x & 3) * 4 + (j & 3); u.pm = (x >> 2) * 64 + i * 8 + (j >> 2); return true; }
      if (i >= 2) return false; u.pn = j & 3; u.pm = x * 16 + i * 8 + (j >> 2); return true;
    }
    const int t = i * G + bid;
    if (t >= nN * 128) return false;
    u.pn = t % nN; u.pm = t / nN; return true;
  }
};

template <class Epi>
DI void gemm_phase(LAS unsigned char* lds, const Gemm g, const Sched& S, const Epi& E) {
  const int tid = opaque_tid(), wid = __builtin_amdgcn_readfirstlane(tid >> 6), lane = tid & 63, wr = wid >> 2, wc = wid & 3, fr = lane & 15, fq = lane >> 4;
  const int nt = g.K / BK;
  unsigned voffA[2], voffB[2];
#pragma unroll
  for (int i = 0; i < 2; ++i) {
    int R, C; stage_rc(tid * 16 + i * 8192, R, C);
    const int Rb = (R & ~31) + perm32(R & 31);
    voffA[i] = (unsigned)(R * g.lda + C) * 2u; voffB[i] = (unsigned)(Rb * g.ldb + C) * 2u;
  }
  const size_t kstep = g.kstepB, kstepA = g.kstepA;
  const size_t hstepA = (size_t)HALF * g.lda * 2, hstepB = (size_t)HALF * g.ldb * 2;
  const size_t tstepA = 2 * hstepA, tstepB = 2 * hstepB;
  const unsigned ldsw = (unsigned)wid * 1024u;
  const int aoff = lds_byte(wr * 64 + fr, fq * 8), boff = lds_byte(wc * 32 + fr, fq * 8);
#define PG8_SA(b, h) (((b) * 2 + (h)) * HTB)
#define PG8_SB(b, h) ((4 + (b) * 2 + (h)) * HTB)
#define PG8_STAGE(bufoff, gbase, voff) do { _Pragma("unroll") for (int _i = 0; _i < 2; ++_i) \
    __builtin_amdgcn_global_load_lds((const unsigned*)((const char*)(gbase) + (voff)[_i]), (LAS unsigned*)(lds + (bufoff) + ldsw + _i * 8192), 16, 0, 0); } while (0)
#define PG8_LDA(dst, b, h) do { _Pragma("unroll") for (int m = 0; m < 4; ++m) _Pragma("unroll") for (int k = 0; k < 2; ++k) dst[m][k] = *(const LAS bf16x8*)(lds + PG8_SA(b, h) + aoff + m * 2048 + k * 1024); } while (0)
#define PG8_LDB(dst, b, h) do { _Pragma("unroll") for (int n = 0; n < 2; ++n) _Pragma("unroll") for (int k = 0; k < 2; ++k) dst[n][k] = *(const LAS bf16x8*)(lds + PG8_SB(b, h) + boff + n * 2048 + k * 1024); } while (0)
#define PG8_MMA(ai, bj, At, Bt) do { __builtin_amdgcn_s_setprio(1); _Pragma("unroll") for (int m = 0; m < 4; ++m) _Pragma("unroll") for (int n = 0; n < 2; ++n) _Pragma("unroll") for (int k = 0; k < 2; ++k) \
    acc[ai][bj][m][n] = __builtin_amdgcn_mfma_f32_16x16x32_bf16(Bt[n][k], At[m][k], acc[ai][bj][m][n], 0, 0, 0); __builtin_amdgcn_s_setprio(0); } while (0)
#define PG8_WAIT_V(n) asm volatile("s_waitcnt vmcnt(" #n ")" ::: "memory")
#define PG8_WAIT_L(n) asm volatile("s_waitcnt lgkmcnt(" #n ")" ::: "memory")
#define PG8_BAR __builtin_amdgcn_s_barrier()
#define PG8_SCHED __builtin_amdgcn_sched_barrier(0)
  Unit cur, nxt; int ui = 0;
  if (!S.next(0, cur)) return;
  f32x4 acc[2][2][4][2];
#pragma unroll
  for (int a = 0; a < 2; ++a)
#pragma unroll
    for (int b = 0; b < 2; ++b)
#pragma unroll
      for (int m = 0; m < 4; ++m)
#pragma unroll
        for (int n = 0; n < 2; ++n) acc[a][b][m][n] = (f32x4){0.f, 0.f, 0.f, 0.f};
  bf16x8 At[4][2], B0[2][2], B1[2][2];
  const char* cA = (const char*)g.A + (size_t)cur.pm * tstepA + (size_t)cur.k0 * kstepA; const char* cB = (const char*)g.Bt + (size_t)cur.pn * tstepB + (size_t)cur.k0 * kstep;
  PG8_STAGE(PG8_SB(0, 0), cB, voffB); PG8_STAGE(PG8_SA(0, 0), cA, voffA); PG8_STAGE(PG8_SB(0, 1), cB + hstepB, voffB); PG8_STAGE(PG8_SA(0, 1), cA + hstepA, voffA);
  if (wr == 1) PG8_BAR;
  PG8_WAIT_V(4); PG8_BAR;
  PG8_STAGE(PG8_SB(1, 0), cB + kstep, voffB); PG8_STAGE(PG8_SA(1, 0), cA + kstepA, voffA); PG8_STAGE(PG8_SB(1, 1), cB + hstepB + kstep, voffB);
  PG8_WAIT_V(6); PG8_BAR;
  for (;;) {
    const bool has_next = S.next(ui + 1, nxt);
    const char* nA = has_next ? (const char*)g.A + (size_t)nxt.pm * tstepA + (size_t)nxt.k0 * kstepA : cA; const char* nB = has_next ? (const char*)g.Bt + (size_t)nxt.pn * tstepB + (size_t)nxt.k0 * kstep : cB;
    for (int t = 0; t < nt; t += 2) {
      const bool last = (t == nt - 2);
      const char* a1 = cA + (size_t)(t + 1) * kstepA;
      const char* a2 = last ? nA : cA + (size_t)(t + 2) * kstepA; const char* b2 = last ? nB : cB + (size_t)(t + 2) * kstep;
      const char* a3 = a2 + kstepA; const char* b3 = b2 + kstep;
      PG8_LDB(B0, 0, 0); PG8_SCHED; PG8_LDA(At, 0, 0); PG8_STAGE(PG8_SA(1, 1), a1 + hstepA, voffA);
      PG8_WAIT_L(8); PG8_BAR; PG8_WAIT_L(0); PG8_MMA(0, 0, At, B0); PG8_BAR; PG8_SCHED;
      PG8_LDB(B1, 0, 1); PG8_STAGE(PG8_SB(0, 0), b2, voffB);
      PG8_BAR; PG8_WAIT_L(0); PG8_MMA(0, 1, At, B1); PG8_BAR;
      PG8_LDA(At, 0, 1); PG8_STAGE(PG8_SA(0, 0), a2, voffA);
      PG8_BAR; PG8_WAIT_L(0); PG8_MMA(1, 0, At, B0); PG8_BAR; PG8_SCHED;
      PG8_STAGE(PG8_SB(0, 1), b2 + hstepB, voffB);
      PG8_WAIT_V(6); PG8_BAR; PG8_MMA(1, 1, At, B1); PG8_BAR;
      PG8_LDB(B0, 1, 0); PG8_SCHED; PG8_LDA(At, 1, 0); PG8_STAGE(PG8_SA(0, 1), a2 + hstepA, voffA);
      PG8_WAIT_L(8); PG8_BAR; PG8_WAIT_L(0); PG8_MMA(0, 0, At, B0); PG8_BAR; PG8_SCHED;
      PG8_LDB(B1, 1, 1); PG8_STAGE(PG8_SB(1, 0), b3, voffB);
      PG8_BAR; PG8_WAIT_L(0); PG8_MMA(0, 1, At, B1); PG8_BAR;
      PG8_LDA(At, 1, 1); PG8_STAGE(PG8_SA(1, 0), a3, voffA);
      PG8_BAR; PG8_WAIT_L(0); PG8_MMA(1, 0, At, B0); PG8_BAR; PG8_SCHED;
      PG8_STAGE(PG8_SB(1, 1), b3 + hstepB, voffB);
      PG8_WAIT_V(6); PG8_BAR; PG8_MMA(1, 1, At, B1); PG8_BAR;
    }
    E(acc, cur, wr, wc, fr, fq);
    if (!has_next) break;
#pragma unroll
    for (int a = 0; a < 2; ++a)
#pragma unroll
      for (int b = 0; b < 2; ++b)
#pragma unroll
        for (int m = 0; m < 4; ++m)
#pragma unroll
          for (int n = 0; n < 2; ++n) acc[a][b][m][n] = (f32x4){0.f, 0.f, 0.f, 0.f};
    cur = nxt; cA = nA; cB = nB; ++ui;
  }
  PG8_WAIT_V(0);
  if (wr == 0) PG8_BAR;
  PG8_BAR;
#undef PG8_SA
#undef PG8_SB
#undef PG8_STAGE
#undef PG8_LDA
#undef PG8_LDB
#undef PG8_MMA
#undef PG8_WAIT_V
#undef PG8_WAIT_L
#undef PG8_BAR
#undef PG8_SCHED
}

typedef f32x4 (&AccRef)[2][2][4][2];
DI unsigned xb_ld(unsigned* p)              { return __hip_atomic_load(p, __ATOMIC_RELAXED, __HIP_MEMORY_SCOPE_AGENT); }
DI unsigned xb_add(unsigned* p, unsigned v) { return __hip_atomic_fetch_add(p, v, __ATOMIC_RELAXED, __HIP_MEMORY_SCOPE_AGENT); }
#define EPI_ROWS for (int ai = 0; ai < 2; ++ai) _Pragma("unroll") for (int m = 0; m < 4; ++m)
#define EPI_ROW(u) ((u).pm * BM + ai * HALF + wr * 64 + m * 16 + fr)
#define EPI_COL(bj) ((bj) * HALF + wc * 32 + fq * 8)

DI void rope8(f32x4& v0, f32x4& v1, const float2* __restrict__ tab, int pos, int fq) {
  const f32x4* t4 = (const f32x4*)(tab + (size_t)pos * 8);
  const f32x4 c0 = t4[0], c1 = t4[1], c2 = t4[2], c3 = t4[3];
  float pv[8];
#pragma unroll
  for (int j = 0; j < 4; ++j) { pv[j] = __shfl_xor(v0[j], 16); pv[4 + j] = __shfl_xor(v1[j], 16); }
  if (fq < 2) {
    const float sg = fq ? 1.f : -1.f;
    v0[0] = v0[0] * c0[0] + sg * pv[0] * c0[1]; v0[1] = v0[1] * c0[2] + sg * pv[1] * c0[3];
    v0[2] = v0[2] * c1[0] + sg * pv[2] * c1[1]; v0[3] = v0[3] * c1[2] + sg * pv[3] * c1[3];
    v1[0] = v1[0] * c2[0] + sg * pv[4] * c2[1]; v1[1] = v1[1] * c2[2] + sg * pv[5] * c2[3];
    v1[2] = v1[2] * c3[0] + sg * pv[6] * c3[1]; v1[3] = v1[3] * c3[2] + sg * pv[7] * c3[3];
  }
}

DI void rope8t(f32x4& v0, f32x4& v1, const f32x4 (&t)[4], int fq) {
  float pv[8];
#pragma unroll
  for (int j = 0; j < 4; ++j) { pv[j] = __shfl_xor(v0[j], 16); pv[4 + j] = __shfl_xor(v1[j], 16); }
  if (fq < 2) {
    const float sg = fq ? 1.f : -1.f;
    v0[0] = v0[0] * t[0][0] + sg * pv[0] * t[0][1]; v0[1] = v0[1] * t[0][2] + sg * pv[1] * t[0][3];
    v0[2] = v0[2] * t[1][0] + sg * pv[2] * t[1][1]; v0[3] = v0[3] * t[1][2] + sg * pv[3] * t[1][3];
    v1[0] = v1[0] * t[2][0] + sg * pv[4] * t[2][1]; v1[1] = v1[1] * t[2][2] + sg * pv[5] * t[2][3];
    v1[2] = v1[2] * t[3][0] + sg * pv[6] * t[3][1]; v1[3] = v1[3] * t[3][2] + sg * pv[7] * t[3][3];
  }
}

struct EpiProj {
  const Params& p;
  DI void operator()(AccRef acc, const Unit& u, int wr, int wc, int fr, int fq) const {
    const int pn = u.pn;
    const bool roped = ((wc & 1) == 0) && (pn < 2 || pn == 3 || pn == 4);
    float rs8[8];
#pragma unroll
    EPI_ROWS rs8[ai * 4 + m] = p.rstd0[EPI_ROW(u)];
#pragma unroll
    for (int ai = 0; ai < 2; ++ai)
#pragma unroll
    for (int mh = 0; mh < 2; ++mh) {
      f32x4 tabx[2][4];
      if (roped) {
#pragma unroll
        for (int mm = 0; mm < 2; ++mm) {
          const int m = mh * 2 + mm;
          const f32x4* t4 = (const f32x4*)(p.rope + (size_t)(EPI_ROW(u) & (SEQ - 1)) * 8);
          tabx[mm][0] = t4[0]; tabx[mm][1] = t4[1]; tabx[mm][2] = t4[2]; tabx[mm][3] = t4[3];
        }
      }
#pragma unroll
      for (int mm = 0; mm < 2; ++mm) {
        const int m = mh * 2 + mm;
        const f32x4 (&tabm)[4] = tabx[mm];
        const int row = EPI_ROW(u);
        const float rs = rs8[ai * 4 + m];
        const int s = row & (SEQ - 1), b = row >> 12;
#pragma unroll
        for (int bj = 0; bj < 2; ++bj) {
          f32x4 v0 = acc[ai][bj][m][0] * rs, v1 = acc[ai][bj][m][1] * rs;
          const int lc = EPI_COL(bj);
          if (pn < 2) {
            if (roped) rope8t(v0, v1, tabm, fq);
            *(u32x4*)(p.qb + (size_t)row * 512 + pn * 256 + lc) = pack8(v0 * QSCALE, v1 * QSCALE);
          } else if (pn < 5) {
            const int which = (pn - 2) * 2 + bj;
            if ((which == 2 || which == 4) && roped) rope8t(v0, v1, tabm, fq);
            const int g = wc >> 1, d = (wc & 1) * 32 + fq * 8;
            *(u32x4*)(p.kvb + ((size_t)((which * 16 + b * 2 + g) * SEQ + s)) * 64 + d) = pack8(v0, v1);
          } else if (pn < 7) {
            *(u32x4*)(p.ub + (size_t)row * 512 + (pn - 5) * 256 + lc) = pack8(v0, v1);
          } else if (pn < 15) {
#pragma unroll
            for (int j = 0; j < 4; ++j) { v0[j] = sigmoidf_(v0[j]); v1[j] = sigmoidf_(v1[j]); }
            *(u32x4*)(p.gm + (size_t)row * 2048 + (pn - 7) * 256 + lc) = pack8(v0, v1);
          } else {
            if (bj == 0 && wc == 0 && fq < 3) {
#pragma unroll
              for (int j = 0; j < 4; ++j) { v0[j] = sigmoidf_(v0[j]); v1[j] = sigmoidf_(v1[j]); }
              f32x4* gp = (f32x4*)(p.gate + (size_t)row * 24 + fq * 8);
              gp[0] = v0; gp[1] = v1;
            }
          }
        }
      }
    }
  }
};

struct EpiCmpHid {
  float* hid32;
  DI void operator()(AccRef acc, const Unit& u, int wr, int wc, int fr, int fq) const {
    float* base = hid32 + ((size_t)((u.k0 >> 3) * 32 + u.pm) * 256) * 256;
#pragma unroll
    EPI_ROWS {
      const int c = ai * HALF + wr * 64 + m * 16 + fr;
#pragma unroll
      for (int bj = 0; bj < 2; ++bj) {
        f32x4* dp = (f32x4*)(base + (size_t)c * 256 + EPI_COL(bj));
        dp[0] = acc[ai][bj][m][0]; dp[1] = acc[ai][bj][m][1];
      }
    }
  }
};

struct EpiCmpOut {
  const Params& p;
  DI void operator()(AccRef acc, const Unit& u, int wr, int wc, int fr, int fq) const {
    const int kv = u.pm >> 4, bg = u.pm & 15;
    const bool roped = (kv == 0) && (wc == 0);
    u16* dst = (kv ? p.vcmp : p.kcmp) + (size_t)bg * 256 * 64;
#pragma unroll
    for (int ai = 0; ai < 2; ++ai) {
      f32x4 tabx[4][4];
      {
#pragma unroll
        for (int m = 0; m < 4; ++m) {
          const int c = ai * HALF + wr * 64 + m * 16 + fr;
          const f32x4* t4 = (const f32x4*)(p.rope + (size_t)min(16 * c + 31, SEQ - 1) * 8);
          tabx[m][0] = t4[0]; tabx[m][1] = t4[1]; tabx[m][2] = t4[2]; tabx[m][3] = t4[3];
        }
      }
#pragma unroll
      for (int m = 0; m < 4; ++m) {
        const int c = ai * HALF + wr * 64 + m * 16 + fr;
        f32x4 v0 = acc[ai][0][m][0], v1 = acc[ai][0][m][1];
        if (roped) rope8t(v0, v1, tabx[m], fq);
        if (c == 255) { v0 = (f32x4){0.f, 0.f, 0.f, 0.f}; v1 = v0; }
        if (wc < 2) *(u32x4*)(dst + c * 64 + wc * 32 + fq * 8) = pack8(v0, v1);
      }
    }
  }
};

template <int PASS>
struct EpiMerge {
  const Params& p;
  DI void operator()(AccRef acc, const Unit& u, int wr, int wc, int fr, int fq) const {
#pragma unroll
    for (int ai = 0; ai < 2; ++ai) {
      u32x4 gq[4][2], ov[4][2];
#pragma unroll
      for (int m = 0; m < 4; ++m)
#pragma unroll
        for (int bj = 0; bj < 2; ++bj) {
          const int row = EPI_ROW(u), col = u.pn * BM + EPI_COL(bj);
          gq[m][bj] = *(const u32x4*)(p.gm + (size_t)row * 2048 + PASS * 1024 + col);
          if (PASS == 1) ov[m][bj] = *(const u32x4*)(p.mb + (size_t)row * 1024 + col);
        }
#pragma unroll
      for (int m = 0; m < 4; ++m) {
        const int row = EPI_ROW(u);
#pragma unroll
        for (int bj = 0; bj < 2; ++bj) {
          const int col = u.pn * BM + EPI_COL(bj);
          const u32x4 g = gq[m][bj];
          f32x4 v0 = acc[ai][bj][m][0], v1 = acc[ai][bj][m][1];
          v0[0] *= bf_lo(g[0]); v0[1] *= bf_hi(g[0]); v0[2] *= bf_lo(g[1]); v0[3] *= bf_hi(g[1]);
          v1[0] *= bf_lo(g[2]); v1[1] *= bf_hi(g[2]); v1[2] *= bf_lo(g[3]); v1[3] *= bf_hi(g[3]);
          if (PASS == 1) {
            const u32x4 o = ov[m][bj];
            v0[0] += bf_lo(o[0]); v0[1] += bf_hi(o[0]); v0[2] += bf_lo(o[1]); v0[3] += bf_hi(o[1]);
            v1[0] += bf_lo(o[2]); v1[1] += bf_hi(o[2]); v1[2] += bf_lo(o[3]); v1[3] += bf_hi(o[3]);
          }
          *(u32x4*)(p.mb + (size_t)row * 1024 + col) = pack8(v0, v1);
        }
      }
    }
  }
};

template <bool WITH_BF16>
struct EpiResid {
  const float* resid; float* out; u16* outb; float* ssq;
  DI void operator()(AccRef acc, const Unit& u, int wr, int wc, int fr, int fq) const {
#pragma unroll
    for (int ai = 0; ai < 2; ++ai) {
      f32x4 rv[4][2][2];
#pragma unroll
      for (int m = 0; m < 4; ++m)
#pragma unroll
        for (int bj = 0; bj < 2; ++bj) {
          const f32x4* rp = (const f32x4*)(resid + (size_t)EPI_ROW(u) * 1024 + u.pn * BM + EPI_COL(bj));
          rv[m][bj][0] = rp[0]; rv[m][bj][1] = rp[1];
        }
#pragma unroll
      for (int m = 0; m < 4; ++m) {
        const int row = EPI_ROW(u);
        float sq = 0.f;
#pragma unroll
        for (int bj = 0; bj < 2; ++bj) {
          const size_t a = (size_t)row * 1024 + u.pn * BM + EPI_COL(bj);
          const f32x4 v0 = rv[m][bj][0] + acc[ai][bj][m][0], v1 = rv[m][bj][1] + acc[ai][bj][m][1];
          f32x4* op = (f32x4*)(out + a);
          op[0] = v0; op[1] = v1;
          if (WITH_BF16) *(u32x4*)(outb + a) = pack8(v0, v1);
#pragma unroll
          for (int j = 0; j < 4; ++j) sq += v0[j] * v0[j] + v1[j] * v1[j];
        }
        sq += __shfl_xor(sq, 16);
        sq += __shfl_xor(sq, 32);
        if (fq == 0) ssq[(size_t)row * 16 + u.pn * 4 + wc] = sq;
      }
    }
  }
};

struct EpiFinal {
  float* out; const float* gfin; float* ssq2; unsigned* cnt;
  DI void operator()(AccRef acc, const Unit& u, int wr, int wc, int fr, int fq) const {
#pragma unroll
    for (int ai = 0; ai < 2; ++ai)
#pragma unroll
    for (int mh = 0; mh < 2; ++mh) {
      f32x4 rv[2][2][2];
#pragma unroll
      for (int mm = 0; mm < 2; ++mm)
#pragma unroll
        for (int bj = 0; bj < 2; ++bj) {
          const int m = mh * 2 + mm;
          const f32x4* rp = (const f32x4*)(out + (size_t)EPI_ROW(u) * 1024 + u.pn * BM + EPI_COL(bj));
          rv[mm][bj][0] = rp[0]; rv[mm][bj][1] = rp[1];
        }
#pragma unroll
      for (int mm = 0; mm < 2; ++mm) {
        const int m = mh * 2 + mm;
        const int row = EPI_ROW(u);
        float sq = 0.f;
#pragma unroll
        for (int bj = 0; bj < 2; ++bj) {
          acc[ai][bj][m][0] += rv[mm][bj][0]; acc[ai][bj][m][1] += rv[mm][bj][1];
#pragma unroll
          for (int j = 0; j < 4; ++j) sq += acc[ai][bj][m][0][j] * acc[ai][bj][m][0][j] + acc[ai][bj][m][1][j] * acc[ai][bj][m][1][j];
        }
        sq += __shfl_xor(sq, 16);
        sq += __shfl_xor(sq, 32);
        if (fq == 0) __hip_atomic_store(ssq2 + (size_t)row * 16 + u.pn * 4 + wc, sq, __ATOMIC_RELAXED, __HIP_MEMORY_SCOPE_AGENT);
      }
    }
    asm volatile("s_waitcnt vmcnt(0)" ::: "memory");
    unsigned* c = cnt + (u.pm * 2 + wr) * 16;
    if (fq == 0 && fr == 0) (void)xb_add(c, 1u);
    { unsigned sp = 0; while (xb_ld(c) < 16u) { __builtin_amdgcn_s_sleep(1); if (++sp > (1u << 20)) break; } }
#pragma unroll
    EPI_ROWS {
      const int row = EPI_ROW(u);
      unsigned long long* sp = (unsigned long long*)(ssq2 + (size_t)row * 16 + fq * 4);
      const unsigned long long q0 = __hip_atomic_load(sp, __ATOMIC_RELAXED, __HIP_MEMORY_SCOPE_AGENT);
      const unsigned long long q1 = __hip_atomic_load(sp + 1, __ATOMIC_RELAXED, __HIP_MEMORY_SCOPE_AGENT);
      float ss = (__uint_as_float((unsigned)q0) + __uint_as_float((unsigned)(q0 >> 32))) + (__uint_as_float((unsigned)q1) + __uint_as_float((unsigned)(q1 >> 32)));
      ss += __shfl_xor(ss, 16);
      ss += __shfl_xor(ss, 32);
      const float rs = rsqrtf(ss * (1.f / DM) + 1e-6f);
#pragma unroll
      for (int bj = 0; bj < 2; ++bj) {
        const int col = u.pn * BM + EPI_COL(bj);
        const f32x4* gp = (const f32x4*)(gfin + col);
        f32x4* op = (f32x4*)(out + (size_t)row * 1024 + col);
        op[0] = acc[ai][bj][m][0] * rs * gp[0]; op[1] = acc[ai][bj][m][1] * rs * gp[1];
      }
    }
  }
};

struct EpiFF1 {
  const Params& p;
  DI void operator()(AccRef acc, const Unit& u, int wr, int wc, int fr, int fq) const {
    f32x4 part[8];
#pragma unroll
    EPI_ROWS part[ai * 4 + m] = *(const f32x4*)(p.ssq + (size_t)EPI_ROW(u) * 16 + fq * 4);
    float rs8[8];
#pragma unroll
    for (int r = 0; r < 8; ++r) {
      float ss = (part[r][0] + part[r][1]) + (part[r][2] + part[r][3]);
      ss += __shfl_xor(ss, 16);
      ss += __shfl_xor(ss, 32);
      rs8[r] = rsqrtf(ss * (1.f / DM) + 1e-6f);
    }
#pragma unroll
    EPI_ROWS {
      const int row = EPI_ROW(u);
      const float rs = rs8[ai * 4 + m];
#pragma unroll
      for (int bj = 0; bj < 2; ++bj) {
        f32x4 v0 = acc[ai][bj][m][0] * rs, v1 = acc[ai][bj][m][1] * rs;
#pragma unroll
        for (int j = 0; j < 4; ++j) { const float r0 = fmaxf(v0[j], 0.f), r1 = fmaxf(v1[j], 0.f); v0[j] = r0 * r0; v1[j] = r1 * r1; }
        const int col = u.pn * BM + EPI_COL(bj);
        *(u32x4*)(p.act + ((size_t)(col >> 6) * T_TOK + row) * 64 + (col & 63)) = pack8(v0, v1);
      }
    }
  }
};

DI void p0_rows(const Params& p, int item) {
  const int w = threadIdx.x >> 6, lane = threadIdx.x & 63;
  const int row0 = item * 32 + w * 4;
  float4 v[4][4];
#pragma unroll
  for (int r = 0; r < 4; ++r) {
    const float4* src = (const float4*)(p.x + (size_t)(row0 + r) * DM);
#pragma unroll
    for (int i = 0; i < 4; ++i) v[r][i] = src[lane + 64 * i];
  }
#pragma unroll
  for (int r = 0; r < 4; ++r) {
    float ss = 0.f;
#pragma unroll
    for (int i = 0; i < 4; ++i) ss += v[r][i].x * v[r][i].x + v[r][i].y * v[r][i].y + v[r][i].z * v[r][i].z + v[r][i].w * v[r][i].w;
#pragma unroll
    for (int o = 32; o; o >>= 1) ss += __shfl_xor(ss, o);
    if (lane == 0) p.rstd0[row0 + r] = rsqrtf(ss * (1.f / DM) + 1e-6f);
    u32x2* dst = (u32x2*)(p.xb + (size_t)(row0 + r) * DM);
#pragma unroll
    for (int i = 0; i < 4; ++i) {
      u32x2 o = {pack_bf2(v[r][i].x, v[r][i].y), pack_bf2(v[r][i].z, v[r][i].w)};
      dst[lane + 64 * i] = o;
    }
  }
}

constexpr int TJ_WIN = 1024, TJ_WA = 128, TJ_WO = 256, TJ_W1 = 1024, TJ_W2 = 1024, TJ_C1 = 128, TJ_C2 = 16;
constexpr int TJ_TOTAL = TJ_WIN + TJ_WA + TJ_WO + TJ_W1 + TJ_W2 + 2 * TJ_C1 + 2 * TJ_C2;

DI void p0_transpose(const Params& p, int item, char* smem) {
  const int half = threadIdx.x >> 8, tid = threadIdx.x & 255;
  int idx = item * 2 + half;
  const float* src; u16* dst; const float* scale = nullptr; int K, N, kind = 0;
  if (idx < TJ_WIN) { src = p.w_in; dst = p.w_in_t; scale = p.norm_mix; K = 1024; N = 3864; kind = 1; }
  else if ((idx -= TJ_WIN) < TJ_WA) { src = p.w_ba; dst = p.wa_t; K = 512; N = 1024; }
  else if ((idx -= TJ_WA) < TJ_WO) { src = p.w_out; dst = p.wo_t; K = 1024; N = 1024; }
  else if ((idx -= TJ_WO) < TJ_W1) { src = p.w_ff1; dst = p.w1_t; scale = p.norm_mlp; K = 1024; N = 4096; }
  else if ((idx -= TJ_W1) < TJ_W2) { src = p.w_ff2; dst = p.w2_t; K = 4096; N = 1024; kind = 2; }
  else if ((idx -= TJ_W2) < TJ_C1) { src = p.ck_w1; dst = p.cw1_t; K = 2048; N = 256; }
  else if ((idx -= TJ_C1) < TJ_C1) { src = p.cv_w1; dst = p.cw1_t + 256 * 2048; K = 2048; N = 256; }
  else if ((idx -= TJ_C1) < TJ_C2) { src = p.ck_w2; dst = p.cw2_t; K = 256; N = 64; }
  else { idx -= TJ_C2; src = p.cv_w2; dst = p.cw2_t + 256 * 256; K = 256; N = 64; }
  const int nk = K >> 6;
  const int k0 = (idx % nk) * 64, n0 = (idx / nk) * 64;
  float* tile = (float*)(smem + half * 16640);
  __syncthreads();
#pragma unroll
  for (int i = 0; i < 4; ++i) {
    const int kk = (tid >> 4) + 16 * i, nn = (tid & 15) * 4;
    const int nd = n0 + nn;
    int sc;
    if (kind == 1) sc = nd < 1280 ? nd : (nd < 3840 ? nd + 24 : (nd < 3864 ? nd - 2560 : -1));
    else sc = nd < N ? nd : -1;
    float4 v = make_float4(0.f, 0.f, 0.f, 0.f);
    if (sc >= 0) v = *(const float4*)(src + (size_t)(k0 + kk) * N + sc);
    if (scale) { float s = scale[k0 + kk]; v.x *= s; v.y *= s; v.z *= s; v.w *= s; }
    tile[kk * 65 + nn + 0] = v.x; tile[kk * 65 + nn + 1] = v.y; tile[kk * 65 + nn + 2] = v.z; tile[kk * 65 + nn + 3] = v.w;
  }
  __syncthreads();
  {
    const int n = tid >> 2, kq = (tid & 3) * 16;
    unsigned o[8];
#pragma unroll
    for (int j = 0; j < 8; ++j) o[j] = pack_bf2(tile[(kq + 2 * j) * 65 + n], tile[(kq + 2 * j + 1) * 65 + n]);
    u32x4* d = (kind == 2) ? (u32x4*)(dst + ((size_t)(k0 >> 6) * 1024 + (n0 + n)) * 64 + kq)
                           : (u32x4*)(dst + (size_t)(n0 + n) * K + k0 + kq);
    u32x4 o0 = {o[0], o[1], o[2], o[3]}, o1 = {o[4], o[5], o[6], o[7]};
    d[0] = o0; d[1] = o1;
  }
}

DI void p0_weff(const Params& p, int item, char* smem) {
  const int g = item >> 4, n0 = (item & 15) * 64, tid = threadIdx.x;
  float* pw = (float*)smem;
  float* ws = (float*)(smem + 66048);
  __syncthreads();
  for (int e = tid; e < 128 * 128; e += NTHR) { const int c = e >> 7, d = e & 127; pw[c * 129 + d] = p.pool_w[(size_t)g * 16384 + e] * p.pool_scale[g * 128 + d]; }
  for (int e = tid; e < 128 * 64; e += NTHR) { const int d = e >> 6, n = e & 63; ws[e] = p.w_bp[(size_t)(g * 128 + d) * 1024 + n0 + n]; }
  __syncthreads();
  const int c = tid & 127, nq = (tid >> 7) * 16;
  float a[16];
#pragma unroll
  for (int j = 0; j < 16; ++j) a[j] = 0.f;
  for (int d = 0; d < 128; ++d) {
    const float w = pw[c * 129 + d];
#pragma unroll
    for (int j = 0; j < 16; ++j) a[j] += w * ws[d * 64 + nq + j];
  }
#pragma unroll
  for (int j = 0; j < 16; ++j) p.wbe_t[(size_t)(n0 + nq + j) * 512 + g * 128 + c] = (u16)(pack_bf2(a[j], 0.f) & 0xffffu);
}

DI void p0_cbias(const Params& p, int idx, char* smem) {
  const int kv = idx >> 3, nc = idx & 7, tid = threadIdx.x, n = tid & 31, part = tid >> 5;
  const float* pe = kv ? p.pe_v : p.pe_k;
  const float* w1 = kv ? p.cv_w1 : p.ck_w1;
  float s = 0.f;
  for (int k = part * 128; k < part * 128 + 128; ++k) s += pe[k] * w1[(size_t)k * 256 + nc * 32 + n];
  float* red = (float*)smem;
  __syncthreads();
  red[part * 32 + n] = s;
  __syncthreads();
  if (tid < 32) {
    float t = 0.f;
#pragma unroll
    for (int j = 0; j < 16; ++j) t += red[j * 32 + tid];
    p.cbias[kv * 256 + nc * 32 + tid] = t;
  }
}

DI void p0_rope(const Params& p, int idx) {
  const int e = idx * NTHR + threadIdx.x;
  const int pos = e >> 3, i = e & 7;
  const float inv = powf(500000.0f, -(float)(2 * i) / 16.0f);
  const float ang = (float)pos * inv;
  float sn, cs;
  sincosf(ang, &sn, &cs);
  p.rope[e] = make_float2(cs, sn);
}

DI void p2a_pool_item(const Params& p, int item) {
  const int idx = item * NTHR + threadIdx.x;
  const int t = idx >> 6, ch = (idx & 63) * 8;
  const int grp = ch >> 7, wlen = 2 << grp, s = t & (SEQ - 1);
  const int cnt = min(s + 1, wlen);
  float a[8];
#pragma unroll
  for (int j = 0; j < 8; ++j) a[j] = 0.f;
  const u16* base = p.ub + (size_t)t * 512 + ch;
  u32x4 v[16];
#pragma unroll
  for (int k = 0; k < 16; ++k) { v[k] = (u32x4){0u, 0u, 0u, 0u}; if (k < cnt) v[k] = *(const u32x4*)(base - (size_t)k * 512); }
  const u32x4 cur = v[0];
#pragma unroll
  for (int k = 0; k < 16; ++k) {
#pragma unroll
    for (int j = 0; j < 4; ++j) { a[2 * j] += bf_lo(v[k][j]); a[2 * j + 1] += bf_hi(v[k][j]); }
  }
  const float ic = 1.f / (float)cnt;
  u32x4 o;
#pragma unroll
  for (int j = 0; j < 4; ++j) o[j] = pack_bf2(a[2 * j] * ic - bf_lo(cur[j]), a[2 * j + 1] * ic - bf_hi(cur[j]));
  *(u32x4*)(p.pooled + (size_t)t * 512 + ch) = o;
}

constexpr int AT_P = 65536, AT_S = 98304, AT_M = 131072;
template <int MODE>
DI void attn_tiles(const u16* __restrict__ Kg, const u16* __restrict__ Vg, int j0, int j1, char* smem,
                   const bf16x8 (&qf)[4], float& m, float& l, f32x16 (&O)[2], int lo, int hi, int lo_max, int hi_min,
                   unsigned mlo, unsigned mhi, float inv_l, int tok_l, int tid) {
  const int lane = tid & 63, l31 = lane & 31, h = lane >> 5;
  const int lk = tid >> 3, lc = tid & 7;
  const int kwr = lk * 128 + ((lc ^ ((lk >> 1) & 7)) << 4);
  const int vwr = 16384 + (lc >> 2) * 4096 + lk * 64 + (lc & 3) * 16;
  const int f = (l31 >> 1) & 7;
  const int krd = l31 * 128;
  int kx[4];
#pragma unroll
  for (int ks = 0; ks < 4; ++ks) kx[ks] = ((2 * ks + h) ^ f) << 4;
  const lds_cptr vrd = (lds_cptr)smem + 16384 + ((lane >> 4) & 1) * 32 + (lane & 3) * 8 + (4 * h + ((lane & 15) >> 2)) * 64;
  const int goff = lk * 64 + lc * 8;
  u32x4 rk, rv;
  rk = *(const u32x4*)(Kg + (size_t)j0 * 4096 + goff);
  if (MODE != 0) rv = *(const u32x4*)(Vg + (size_t)j0 * 4096 + goff);
  for (int j = j0; j <= j1; ++j) {
    const int bo = ((j - j0) & 1) * 8192;
    *(u32x4*)(smem + bo + kwr) = rk;
    if (MODE != 0) *(u32x4*)(smem + bo + vwr) = rv;
    __syncthreads();
    if (j < j1) {
      rk = *(const u32x4*)(Kg + (size_t)(j + 1) * 4096 + goff);
      if (MODE != 0) rv = *(const u32x4*)(Vg + (size_t)(j + 1) * 4096 + goff);
    }
    bool bit = true;
    if (MODE == 2) {
      bit = ((j < 32 ? (mlo >> j) : (mhi >> (j - 32))) & 1u) != 0;
      if (__ballot(bit) == 0ull) continue;
    }
    f32x16 s0 = zero16(), s1 = zero16();
#pragma unroll
    for (int ks = 0; ks < 4; ++ks) {
      bf16x8 a0 = *(const bf16x8*)(smem + bo + krd + kx[ks]);
      bf16x8 a1 = *(const bf16x8*)(smem + bo + krd + 4096 + kx[ks]);
      s0 = mfma32(a0, qf[ks], s0);
      s1 = mfma32(a1, qf[ks], s1);
    }
    const bool need_mask = (64 * j < lo_max) || (64 * j + 63 > hi_min);
    const int rlo = lo - 64 * j - 4 * h, span = hi - lo;
    if (need_mask) {
#pragma unroll
      for (int i = 0; i < 16; ++i) {
        const int c0 = 8 * (i >> 2) + (i & 3);
        if ((unsigned)(c0 - rlo) > (unsigned)span || span < 0) s0[i] = NEGF;
        if ((unsigned)(c0 + 32 - rlo) > (unsigned)span || span < 0) s1[i] = NEGF;
      }
    }
    float msub;
    if (MODE == 1) {
      msub = m;
    } else {
      float mx = s0[0];
#pragma unroll
      for (int i = 1; i < 16; ++i) mx = fmaxf(mx, s0[i]);
#pragma unroll
      for (int i = 0; i < 16; ++i) mx = fmaxf(mx, s1[i]);
      mx = fmaxf(mx, __shfl_xor(mx, 32));
      if (MODE == 2) mx = bit ? mx : NEGF;
      const float mn = fmaxf(m, mx);
      const float alpha = __builtin_amdgcn_exp2f(m - mn);
      m = mn;
      l *= alpha;
      if (MODE != 0) {
        if (__ballot(alpha != 1.f) != 0ull) {
#pragma unroll
          for (int i = 0; i < 16; ++i) { O[0][i] *= alpha; O[1][i] *= alpha; }
        }
      }
      msub = (MODE == 2 && !bit) ? 1e30f : mn;
    }
    msub = fmaxf(msub, -1e29f);
    float rs = 0.f;
#pragma unroll
    for (int i = 0; i < 16; ++i) {
      float p0 = __builtin_amdgcn_exp2f(s0[i] - msub), p1 = __builtin_amdgcn_exp2f(s1[i] - msub);
      if (MODE == 1) { p0 *= inv_l; p1 *= inv_l; }
      s0[i] = p0; s1[i] = p1;
      rs += p0 + p1;
    }
    l += rs;
    if (MODE == 0) continue;
    if (MODE == 1) {
      float* ps = (float*)(smem + AT_P) + tok_l * 256 + 64 * j + 4 * h;
#pragma unroll
      for (int gq = 0; gq < 4; ++gq) {
        float4 a, b;
        float t;
        t = s0[4 * gq + 0]; t += __shfl_xor(t, 1); t += __shfl_xor(t, 2); a.x = t;
        t = s0[4 * gq + 1]; t += __shfl_xor(t, 1); t += __shfl_xor(t, 2); a.y = t;
        t = s0[4 * gq + 2]; t += __shfl_xor(t, 1); t += __shfl_xor(t, 2); a.z = t;
        t = s0[4 * gq + 3]; t += __shfl_xor(t, 1); t += __shfl_xor(t, 2); a.w = t;
        t = s1[4 * gq + 0]; t += __shfl_xor(t, 1); t += __shfl_xor(t, 2); b.x = t;
        t = s1[4 * gq + 1]; t += __shfl_xor(t, 1); t += __shfl_xor(t, 2); b.y = t;
        t = s1[4 * gq + 2]; t += __shfl_xor(t, 1); t += __shfl_xor(t, 2); b.z = t;
        t = s1[4 * gq + 3]; t += __shfl_xor(t, 1); t += __shfl_xor(t, 2); b.w = t;
        if ((l31 & 3) == 0) { *(float4*)(ps + 8 * gq) = a; *(float4*)(ps + 32 + 8 * gq) = b; }
      }
    }
#pragma unroll
    for (int s4 = 0; s4 < 4; ++s4) {
      u32x4 pk;
      if (s4 < 2) {
#pragma unroll
        for (int jj = 0; jj < 4; ++jj) pk[jj] = pack_bf2(s0[8 * (s4 & 1) + 2 * jj], s0[8 * (s4 & 1) + 2 * jj + 1]);
      } else {
#pragma unroll
        for (int jj = 0; jj < 4; ++jj) pk[jj] = pack_bf2(s1[8 * (s4 & 1) + 2 * jj], s1[8 * (s4 & 1) + 2 * jj + 1]);
      }
      const bf16x8 pb = __builtin_bit_cast(bf16x8, pk);
#pragma unroll
      for (int dt = 0; dt < 2; ++dt) {
        s16x4 vlo = vtr(vrd + bo + dt * 4096 + s4 * 1024);
        s16x4 vhi = vtr(vrd + bo + dt * 4096 + s4 * 1024 + 512);
        bf16x8 vf = __builtin_shufflevector(vlo, vhi, 0, 1, 2, 3, 4, 5, 6, 7);
        O[dt] = mfma32(vf, pb, O[dt]);
      }
    }
  }
  __syncthreads();
}

template <int MODE>
DI void attn_tiles_pipe(const u16* __restrict__ Kg, const u16* __restrict__ Vg, int j0, int j1, char* smem,
                        const bf16x8 (&qf)[4], float& m, float& l, f32x16 (&O)[2], int lo, int hi, int lo_max, int hi_min,
                        unsigned mlo, unsigned mhi, int tid) {
  const int lane = tid & 63, l31 = lane & 31, h = lane >> 5;
  const int lk = tid >> 3, lc = tid & 7;
  const int kwr = lk * 128 + ((lc ^ ((lk >> 1) & 7)) << 4);
  const int vwr = 16384 + (lc >> 2) * 4096 + lk * 64 + (lc & 3) * 16;
  const int f = (l31 >> 1) & 7;
  const int krd = l31 * 128;
  int kx[4];
#pragma unroll
  for (int ks = 0; ks < 4; ++ks) kx[ks] = ((2 * ks + h) ^ f) << 4;
  const lds_cptr vrd = (lds_cptr)smem + 16384 + ((lane >> 4) & 1) * 32 + (lane & 3) * 8 + (4 * h + ((lane & 15) >> 2)) * 64;
  const int goff = lk * 64 + lc * 8;
  u32x4 rk, rv;
  auto qk_tile = [&](int bufoff, f32x16& d0, f32x16& d1) __attribute__((always_inline)) {
    bf16x8 ka[4], kb[4];
#pragma unroll
    for (int ks = 0; ks < 4; ++ks) { ka[ks] = *(const bf16x8*)(smem + bufoff + krd + kx[ks]); kb[ks] = *(const bf16x8*)(smem + bufoff + krd + 4096 + kx[ks]); }
    d0 = mfma32(ka[0], qf[0], zero16()); d1 = mfma32(kb[0], qf[0], zero16());
#pragma unroll
    for (int ks = 1; ks < 4; ++ks) { d0 = mfma32(ka[ks], qf[ks], d0); d1 = mfma32(kb[ks], qf[ks], d1); }
  };
  auto active = [&](int j) __attribute__((always_inline)) -> bool {
    if (MODE != 2) return true;
    const bool b = ((j < 32 ? (mlo >> j) : (mhi >> (j - 32))) & 1u) != 0;
    return __ballot(b) != 0ull;
  };
  auto step = [&](int j, bool act_c, bool& act_n, f32x16& c0, f32x16& c1, f32x16& n0, f32x16& n1) __attribute__((always_inline)) {
    const int par = (j - j0) & 1;
    const int bo = par * 8192, bn = (par ^ 1) * 8192;
    if (j < j1) *(u32x4*)(smem + bn + kwr) = rk;
    *(u32x4*)(smem + bo + vwr) = rv;
    __syncthreads();
    if (j + 2 <= j1) rk = *(const u32x4*)(Kg + (size_t)(j + 2) * 4096 + goff);
    if (j + 1 <= j1) rv = *(const u32x4*)(Vg + (size_t)(j + 1) * 4096 + goff);
    act_n = false;
    if (j < j1) { act_n = active(j + 1); if (act_n) qk_tile(bn, n0, n1); }
    if (!act_c) return;
    bool bit = true;
    if (MODE == 2) bit = ((j < 32 ? (mlo >> j) : (mhi >> (j - 32))) & 1u) != 0;
    const bool need_mask = (64 * j < lo_max) || (64 * j + 63 > hi_min);
    if (need_mask) {
      const int rlo = lo - 64 * j - 4 * h, span = hi - lo;
#pragma unroll
      for (int i = 0; i < 16; ++i) {
        const int cc = 8 * (i >> 2) + (i & 3);
        if ((unsigned)(cc - rlo) > (unsigned)span || span < 0) c0[i] = NEGF;
        if ((unsigned)(cc + 32 - rlo) > (unsigned)span || span < 0) c1[i] = NEGF;
      }
    }
    float mx = c0[0];
#pragma unroll
    for (int i = 1; i < 16; ++i) mx = fmaxf(mx, c0[i]);
#pragma unroll
    for (int i = 0; i < 16; ++i) mx = fmaxf(mx, c1[i]);
    mx = fmaxf(mx, __shfl_xor(mx, 32));
    if (MODE == 2) mx = bit ? mx : NEGF;
    const float mn = fmaxf(m, mx);
    const float alpha = __builtin_amdgcn_exp2f(m - mn);
    m = mn;
    l *= alpha;
    if (__ballot(alpha != 1.f) != 0ull) {
#pragma unroll
      for (int i = 0; i < 16; ++i) { O[0][i] *= alpha; O[1][i] *= alpha; }
    }
    const float msub = (MODE == 2 && !bit) ? 1e30f : fmaxf(mn, -1e29f);
    bf16x8 vf[4][2];
#pragma unroll
    for (int s4 = 0; s4 < 4; ++s4)
#pragma unroll
      for (int dt = 0; dt < 2; ++dt) {
        s16x4 vlo = vtr(vrd + bo + dt * 4096 + s4 * 1024);
        s16x4 vhi = vtr(vrd + bo + dt * 4096 + s4 * 1024 + 512);
        vf[s4][dt] = __builtin_shufflevector(vlo, vhi, 0, 1, 2, 3, 4, 5, 6, 7);
      }
    float rs = 0.f;
#pragma unroll
    for (int i = 0; i < 16; ++i) {
      const float p0 = __builtin_amdgcn_exp2f(c0[i] - msub), p1 = __builtin_amdgcn_exp2f(c1[i] - msub);
      c0[i] = p0; c1[i] = p1;
      rs += p0 + p1;
    }
    l += rs;
#pragma unroll
    for (int s4 = 0; s4 < 4; ++s4) {
      u32x4 pk;
      if (s4 < 2) {
#pragma unroll
        for (int jj = 0; jj < 4; ++jj) pk[jj] = pack_bf2(c0[8 * (s4 & 1) + 2 * jj], c0[8 * (s4 & 1) + 2 * jj + 1]);
      } else {
#pragma unroll
        for (int jj = 0; jj < 4; ++jj) pk[jj] = pack_bf2(c1[8 * (s4 & 1) + 2 * jj], c1[8 * (s4 & 1) + 2 * jj + 1]);
      }
      const bf16x8 pb = __builtin_bit_cast(bf16x8, pk);
      O[0] = mfma32(vf[s4][0], pb, O[0]);
      O[1] = mfma32(vf[s4][1], pb, O[1]);
    }
  };
  rk = *(const u32x4*)(Kg + (size_t)j0 * 4096 + goff);
  rv = *(const u32x4*)(Vg + (size_t)j0 * 4096 + goff);
  *(u32x4*)(smem + kwr) = rk;
  if (j0 < j1) rk = *(const u32x4*)(Kg + (size_t)(j0 + 1) * 4096 + goff);
  __syncthreads();
  f32x16 a0, a1, b0, b1;
  bool actA = true, actB = false;
  qk_tile(0, a0, a1);
  for (int j = j0; j <= j1; j += 2) {
    step(j, actA, actB, a0, a1, b0, b1);
    if (j + 1 <= j1) step(j + 1, actB, actA, b0, b1, a0, a1);
  }
  __syncthreads();
}

constexpr int RING = 6;
DI void glds16(const u16* g, char* lds) {
  __builtin_amdgcn_global_load_lds((const unsigned*)g, (LAS unsigned*)lds, 16, 0, 0);
}
template <int MODE>
DI void attn_tiles_ring(const u16* __restrict__ Kg, const u16* __restrict__ Vg, int j0, int j1, char* smem,
                        const bf16x8 (&qf)[4], float& m, float& l, f32x16 (&O)[2], int lo, int hi, int lo_max, int hi_min,
                        unsigned mlo, unsigned mhi, int tid) {
  const int lane = tid & 63, l31 = lane & 31, h = lane >> 5;
  const int f = (l31 >> 1) & 7;
  const int krd = l31 * 128;
  int kx[4];
#pragma unroll
  for (int ks = 0; ks < 4; ++ks) kx[ks] = ((2 * ks + h) ^ f) << 4;
  const int vrdo = 8192 + ((lane >> 4) & 1) * 32 + (lane & 3) * 8 + (4 * h + ((lane & 15) >> 2)) * 64;
  const lds_cptr lbase = (lds_cptr)smem;
  const int ksrc = (tid >> 3) * 64 + (((tid & 7) ^ (((tid >> 3) >> 1) & 7)) << 3);
  const int vsrc = ((tid >> 2) & 63) * 64 + (((tid >> 8) * 4 + (tid & 3)) << 3);
  const int dma = tid * 16;
  auto issue = [&](int t, int st) __attribute__((always_inline)) {
    const int tc = t < j1 ? t : j1;
    glds16(Kg + (size_t)tc * 4096 + ksrc, smem + st * 16384 + dma);
    glds16(Vg + (size_t)tc * 4096 + vsrc, smem + st * 16384 + 8192 + dma);
  };
  auto qk_tile = [&](int st, f32x16& d0, f32x16& d1) __attribute__((always_inline)) {
    const char* kb_ = smem + st * 16384;
    bf16x8 ka[4], kb[4];
#pragma unroll
    for (int ks = 0; ks < 4; ++ks) { ka[ks] = *(const bf16x8*)(kb_ + krd + kx[ks]); kb[ks] = *(const bf16x8*)(kb_ + krd + 4096 + kx[ks]); }
    d0 = mfma32(ka[0], qf[0], zero16()); d1 = mfma32(kb[0], qf[0], zero16());
#pragma unroll
    for (int ks = 1; ks < 4; ++ks) { d0 = mfma32(ka[ks], qf[ks], d0); d1 = mfma32(kb[ks], qf[ks], d1); }
  };
  auto active = [&](int j) __attribute__((always_inline)) -> bool {
    if (MODE != 2) return true;
    const bool b = ((j < 32 ? (mlo >> j) : (mhi >> (j - 32))) & 1u) != 0;
    return __ballot(b) != 0ull;
  };
  int st_cur = 0, st_iss = 5;
  auto step = [&](int j, bool act_c, bool& act_n, f32x16& c0, f32x16& c1, f32x16& n0, f32x16& n1) __attribute__((always_inline)) {
    asm volatile("s_waitcnt vmcnt(6)" ::: "memory");
    __builtin_amdgcn_s_barrier();
    issue(j + 5, st_iss);
    const int st_nxt = (st_cur == RING - 1) ? 0 : st_cur + 1;
    act_n = false;
    if (j < j1) { act_n = active(j + 1); if (act_n) qk_tile(st_nxt, n0, n1); }
    if (act_c) {
      bool bit = true;
      if (MODE == 2) bit = ((j < 32 ? (mlo >> j) : (mhi >> (j - 32))) & 1u) != 0;
      const bool need_mask = (64 * j < lo_max) || (64 * j + 63 > hi_min);
      if (need_mask) {
        const int rlo = lo - 64 * j - 4 * h, span = hi - lo;
#pragma unroll
        for (int i = 0; i < 16; ++i) {
          const int cc = 8 * (i >> 2) + (i & 3);
          if ((unsigned)(cc - rlo) > (unsigned)span || span < 0) c0[i] = NEGF;
          if ((unsigned)(cc + 32 - rlo) > (unsigned)span || span < 0) c1[i] = NEGF;
        }
      }
      float mx = c0[0];
#pragma unroll
      for (int i = 1; i < 16; ++i) mx = fmaxf(mx, c0[i]);
#pragma unroll
      for (int i = 0; i < 16; ++i) mx = fmaxf(mx, c1[i]);
      mx = fmaxf(mx, __shfl_xor(mx, 32));
      if (MODE == 2) mx = bit ? mx : NEGF;
      const float mn = fmaxf(m, mx);
      const float alpha = __builtin_amdgcn_exp2f(m - mn);
      m = mn;
      l *= alpha;
      if (__ballot(alpha != 1.f) != 0ull) {
#pragma unroll
        for (int i = 0; i < 16; ++i) { O[0][i] *= alpha; O[1][i] *= alpha; }
      }
      const float msub = (MODE == 2 && !bit) ? 1e30f : fmaxf(mn, -1e29f);
      const lds_cptr vb = lbase + st_cur * 16384 + vrdo;
      bf16x8 vf[4][2];
#pragma unroll
      for (int s4 = 0; s4 < 4; ++s4)
#pragma unroll
        for (int dt = 0; dt < 2; ++dt) {
          s16x4 vlo = vtr(vb + dt * 4096 + s4 * 1024);
          s16x4 vhi = vtr(vb + dt * 4096 + s4 * 1024 + 512);
          vf[s4][dt] = __builtin_shufflevector(vlo, vhi, 0, 1, 2, 3, 4, 5, 6, 7);
        }
      float rs = 0.f;
#pragma unroll
      for (int i = 0; i < 16; ++i) {
        const float p0 = __builtin_amdgcn_exp2f(c0[i] - msub), p1 = __builtin_amdgcn_exp2f(c1[i] - msub);
        c0[i] = p0; c1[i] = p1;
        rs += p0 + p1;
      }
      l += rs;
#pragma unroll
      for (int s4 = 0; s4 < 4; ++s4) {
        u32x4 pk;
        if (s4 < 2) {
#pragma unroll
          for (int jj = 0; jj < 4; ++jj) pk[jj] = pack_bf2(c0[8 * (s4 & 1) + 2 * jj], c0[8 * (s4 & 1) + 2 * jj + 1]);
        } else {
#pragma unroll
          for (int jj = 0; jj < 4; ++jj) pk[jj] = pack_bf2(c1[8 * (s4 & 1) + 2 * jj], c1[8 * (s4 & 1) + 2 * jj + 1]);
        }
        const bf16x8 pb = __builtin_bit_cast(bf16x8, pk);
        O[0] = mfma32(vf[s4][0], pb, O[0]);
        O[1] = mfma32(vf[s4][1], pb, O[1]);
      }
    }
    st_cur = st_nxt;
    st_iss = (st_iss == RING - 1) ? 0 : st_iss + 1;
  };
#pragma unroll
  for (int i = 0; i < 5; ++i) issue(j0 + i, i);
  asm volatile("s_waitcnt vmcnt(8)" ::: "memory");
  __builtin_amdgcn_s_barrier();
  f32x16 a0, a1, b0, b1;
  bool actA = true, actB = false;
  qk_tile(0, a0, a1);
  for (int j = j0; j <= j1; j += 2) {
    step(j, actA, actB, a0, a1, b0, b1);
    if (j + 1 <= j1) step(j + 1, actB, actA, b0, b1, a0, a1);
  }
  asm volatile("s_waitcnt vmcnt(0)" ::: "memory");
  __syncthreads();
}

DI void attn_cmp(const u16* __restrict__ Kc, const u16* __restrict__ Vc, int nct, char* smem, const bf16x8 (&qf)[4],
                 f32x16 (&O)[2], int hi, int hi_min, int tok_l, int tid) {
  const int lane = tid & 63, l31 = lane & 31, h = lane >> 5;
  const int f = (l31 >> 1) & 7;
  const int krd = l31 * 128;
  int kx[4];
#pragma unroll
  for (int ks = 0; ks < 4; ++ks) kx[ks] = ((2 * ks + h) ^ f) << 4;
  const int vrdo = 8192 + ((lane >> 4) & 1) * 32 + (lane & 3) * 8 + (4 * h + ((lane & 15) >> 2)) * 64;
  const lds_cptr lbase = (lds_cptr)smem;
  const int ksrc = (tid >> 3) * 64 + (((tid & 7) ^ (((tid >> 3) >> 1) & 7)) << 3);
  const int vsrc = ((tid >> 2) & 63) * 64 + (((tid >> 8) * 4 + (tid & 3)) << 3);
#pragma unroll
  for (int t = 0; t < 4; ++t) {
    const int tc = t < nct ? t : nct - 1;
    glds16(Kc + (size_t)tc * 4096 + ksrc, smem + t * 16384 + tid * 16);
    glds16(Vc + (size_t)tc * 4096 + vsrc, smem + t * 16384 + 8192 + tid * 16);
  }
  asm volatile("s_waitcnt vmcnt(0)" ::: "memory");
  __syncthreads();
  f32x16 S[4][2];
  float mx = NEGF;
#pragma unroll
  for (int t = 0; t < 4; ++t) {
    if (t < nct) {
      const char* kb_ = smem + t * 16384;
      bf16x8 ka[4], kb[4];
#pragma unroll
      for (int ks = 0; ks < 4; ++ks) { ka[ks] = *(const bf16x8*)(kb_ + krd + kx[ks]); kb[ks] = *(const bf16x8*)(kb_ + krd + 4096 + kx[ks]); }
      S[t][0] = mfma32(ka[0], qf[0], zero16()); S[t][1] = mfma32(kb[0], qf[0], zero16());
#pragma unroll
      for (int ks = 1; ks < 4; ++ks) { S[t][0] = mfma32(ka[ks], qf[ks], S[t][0]); S[t][1] = mfma32(kb[ks], qf[ks], S[t][1]); }
      if (64 * t + 63 > hi_min) {
        const int rhi = hi - 64 * t - 4 * h;
#pragma unroll
        for (int i = 0; i < 16; ++i) {
          const int cc = 8 * (i >> 2) + (i & 3);
          if (cc > rhi) S[t][0][i] = NEGF;
          if (cc + 32 > rhi) S[t][1][i] = NEGF;
        }
      }
#pragma unroll
      for (int i = 0; i < 16; ++i) mx = fmaxf(mx, fmaxf(S[t][0][i], S[t][1][i]));
    }
  }
  mx = fmaxf(mx, __shfl_xor(mx, 32));
  const float msub = fmaxf(mx, -1e29f);
  float ls = 0.f;
#pragma unroll
  for (int t = 0; t < 4; ++t)
    if (t < nct) {
#pragma unroll
      for (int i = 0; i < 16; ++i) {
        S[t][0][i] = __builtin_amdgcn_exp2f(S[t][0][i] - msub); S[t][1][i] = __builtin_amdgcn_exp2f(S[t][1][i] - msub);
        ls += S[t][0][i] + S[t][1][i];
      }
    }
  ls += __shfl_xor(ls, 32);
  const float inv_l = 1.f / fmaxf(ls, 1e-30f);
  O[0] = zero16(); O[1] = zero16();
#pragma unroll
  for (int t = 0; t < 4; ++t)
    if (t < nct) {
      f32x16& s0 = S[t][0];
      f32x16& s1 = S[t][1];
#pragma unroll
      for (int i = 0; i < 16; ++i) { s0[i] *= inv_l; s1[i] *= inv_l; }
      float* ps = (float*)(smem + AT_P) + tok_l * 256 + 64 * t + 4 * h;
#pragma unroll
      for (int gq = 0; gq < 4; ++gq) {
        float4 a, b;
        float u;
        u = s0[4 * gq + 0]; u += __shfl_xor(u, 1); u += __shfl_xor(u, 2); a.x = u;
        u = s0[4 * gq + 1]; u += __shfl_xor(u, 1); u += __shfl_xor(u, 2); a.y = u;
        u = s0[4 * gq + 2]; u += __shfl_xor(u, 1); u += __shfl_xor(u, 2); a.z = u;
        u = s0[4 * gq + 3]; u += __shfl_xor(u, 1); u += __shfl_xor(u, 2); a.w = u;
        u = s1[4 * gq + 0]; u += __shfl_xor(u, 1); u += __shfl_xor(u, 2); b.x = u;
        u = s1[4 * gq + 1]; u += __shfl_xor(u, 1); u += __shfl_xor(u, 2); b.y = u;
        u = s1[4 * gq + 2]; u += __shfl_xor(u, 1); u += __shfl_xor(u, 2); b.z = u;
        u = s1[4 * gq + 3]; u += __shfl_xor(u, 1); u += __shfl_xor(u, 2); b.w = u;
        if ((l31 & 3) == 0) { *(float4*)(ps + 8 * gq) = a; *(float4*)(ps + 32 + 8 * gq) = b; }
      }
      const lds_cptr vb = lbase + t * 16384 + vrdo;
#pragma unroll
      for (int s4 = 0; s4 < 4; ++s4) {
        u32x4 pk;
        if (s4 < 2) {
#pragma unroll
          for (int jj = 0; jj < 4; ++jj) pk[jj] = pack_bf2(s0[8 * (s4 & 1) + 2 * jj], s0[8 * (s4 & 1) + 2 * jj + 1]);
        } else {
#pragma unroll
          for (int jj = 0; jj < 4; ++jj) pk[jj] = pack_bf2(s1[8 * (s4 & 1) + 2 * jj], s1[8 * (s4 & 1) + 2 * jj + 1]);
        }
        const bf16x8 pb = __builtin_bit_cast(bf16x8, pk);
#pragma unroll
        for (int dt = 0; dt < 2; ++dt) {
          s16x4 vlo = vtr(vb + dt * 4096 + s4 * 1024);
          s16x4 vhi = vtr(vb + dt * 4096 + s4 * 1024 + 512);
          bf16x8 vf = __builtin_shufflevector(vlo, vhi, 0, 1, 2, 3, 4, 5, 6, 7);
          O[dt] = mfma32(vf, pb, O[dt]);
        }
      }
    }
  __syncthreads();
}

DI void attn_item(const Params& p, int bg, int qt, char* smem) {
  const int tid = opaque_tid(), lane = tid & 63, w = tid >> 6, l31 = lane & 31, h = lane >> 5;
  const int b = bg >> 1, g = bg & 1;
  const int t0 = qt * 64;
  const int tok_l = w * 8 + (l31 >> 2);
  const int tpos = t0 + tok_l;
  const int r = l31 & 3;
  const size_t tglob = (size_t)b * SEQ + tpos;
  bf16x8 qf[4];
  {
    const u16* qp = p.qb + tglob * 512 + (g * 4 + r) * 64 + h * 8;
#pragma unroll
    for (int ks = 0; ks < 4; ++ks) qf[ks] = *(const bf16x8*)(qp + ks * 16);
  }
  const float g0 = p.gate[tglob * 24 + 0 + g * 4 + r];
  const float g1 = p.gate[tglob * 24 + 8 + g * 4 + r];
  const float g2 = p.gate[tglob * 24 + 16 + g * 4 + r];
  const int cur = t0 >> 6;
  f32x16 O[2];
  float m, l;
  unsigned* stash = (unsigned*)(smem + AT_S) + w * 1024 + lane;
  {
    const u16* Kc = p.kcmp + (size_t)bg * 256 * 64;
    const u16* Vc = p.vcmp + (size_t)bg * 256 * 64;
    const int nct = ((t0 + 32) >> 10) + 1;
    const int hi = (tpos - 31) >> 4;
    const int hi_min = (t0 - 31) >> 4;
    attn_cmp(Kc, Vc, nct, smem, qf, O, hi, hi_min, tok_l, tid);
    const float* Ps = (const float*)(smem + AT_P);
    unsigned long long* Ms = (unsigned long long*)(smem + AT_M);
    const int ncv = nct * 64;
    for (int tl = 0; tl < 8; ++tl) {
      const int tokl = w * 8 + tl;
      const int j = lane;
      const float* pr = Ps + tokl * 256;
      float imp = 0.f;
      if (4 * j < ncv) {
        float4 v = *(const float4*)(pr + 4 * j);
        imp = 2.f * (v.x + v.y + v.z) + v.w;
        if (j > 0) imp += pr[4 * j - 1];
      }
      unsigned key = ((__float_as_uint(imp) & ~63u) | (unsigned)(63 - j)) + 64u;
      if (j > cur) key = (unsigned)(63 - j);
      if (j == 0 || j == cur || j == cur - 1) key = 0xFFFFFF00u | (unsigned)(63 - j);
      unsigned* kl = (unsigned*)(smem + w * 256);
      kl[lane] = key;
      int cnt = 0;
#pragma unroll
      for (int k4 = 0; k4 < 16; ++k4) {
        const u32x4 q = *(const u32x4*)(kl + 4 * k4);
        cnt += (q[0] > key) + (q[1] > key) + (q[2] > key) + (q[3] > key);
      }
      unsigned long long bal = __ballot(cnt < 16);
      if (lane == 0) Ms[tokl] = bal;
    }
  }
  __syncthreads();
  unsigned mlo, mhi;
  {
    const unsigned* Mw = (const unsigned*)(smem + AT_M);
    mlo = Mw[tok_l * 2]; mhi = Mw[tok_l * 2 + 1];
  }
#pragma unroll
  for (int i = 0; i < 8; ++i) { stash[i * 64] = pack_bf2(g0 * O[0][2 * i], g0 * O[0][2 * i + 1]); stash[(8 + i) * 64] = pack_bf2(g0 * O[1][2 * i], g0 * O[1][2 * i + 1]); }
  {
    m = NEGF; l = 0.f;
    O[0] = zero16(); O[1] = zero16();
    attn_tiles_ring<2>(p.kvb + (size_t)(2 * 16 + bg) * SEQ * 64, p.kvb + (size_t)(3 * 16 + bg) * SEQ * 64, 0, cur, smem, qf, m, l, O,
                  0, tpos, 0, t0, mlo, mhi, tid);
    const float lt = l + __shfl_xor(l, 32);
    const float sc = g1 / fmaxf(lt, 1e-30f);
#pragma unroll
    for (int i = 0; i < 8; ++i) {
      const unsigned u0 = stash[i * 64], u1 = stash[(8 + i) * 64];
      stash[i * 64] = pack_bf2(bf_lo(u0) + sc * O[0][2 * i], bf_hi(u0) + sc * O[0][2 * i + 1]);
      stash[(8 + i) * 64] = pack_bf2(bf_lo(u1) + sc * O[1][2 * i], bf_hi(u1) + sc * O[1][2 * i + 1]);
    }
  }
  {
    m = NEGF; l = 0.f;
    O[0] = zero16(); O[1] = zero16();
    const int jlo = max(t0 - 511, 0) >> 6;
    attn_tiles_ring<3>(p.kvb + (size_t)(4 * 16 + bg) * SEQ * 64, p.kvb + (size_t)(5 * 16 + bg) * SEQ * 64, jlo, cur, smem, qf, m, l, O,
                  tpos - 511, tpos, t0 + 63 - 511, t0, 0u, 0u, tid);
    const float lt = l + __shfl_xor(l, 32);
    const float sc = g2 / fmaxf(lt, 1e-30f);
#pragma unroll
    for (int i = 0; i < 8; ++i) {
      const unsigned u0 = stash[i * 64], u1 = stash[(8 + i) * 64];
      O[0][2 * i] = bf_lo(u0) + sc * O[0][2 * i]; O[0][2 * i + 1] = bf_hi(u0) + sc * O[0][2 * i + 1];
      O[1][2 * i] = bf_lo(u1) + sc * O[1][2 * i]; O[1][2 * i + 1] = bf_hi(u1) + sc * O[1][2 * i + 1];
    }
  }
  u16* op = p.ob + tglob * 512 + (g * 4 + r) * 64 + 4 * h;
#pragma unroll
  for (int dt = 0; dt < 2; ++dt)
#pragma unroll
    for (int gq = 0; gq < 4; ++gq) {
      u32x2 o = {pack_bf2(O[dt][4 * gq], O[dt][4 * gq + 1]), pack_bf2(O[dt][4 * gq + 2], O[dt][4 * gq + 3])};
      *(u32x2*)(op + dt * 32 + 8 * gq) = o;
    }
}

DI void p10_rows(const Params& p, int item) {
  const int w = threadIdx.x >> 6, lane = threadIdx.x & 63;
  const int row = item * 8 + w;
  float s = (lane < 16) ? p.ssq2[(size_t)row * 16 + lane] : 0.f;
#pragma unroll
  for (int o = 8; o; o >>= 1) s += __shfl_xor(s, o);
  s = __shfl(s, 0);
  const float rs = rsqrtf(s * (1.f / DM) + 1e-6f);
  float4* o4 = (float4*)(p.out + (size_t)row * DM);
  const float4* g4 = (const float4*)p.norm_final;
#pragma unroll
  for (int i = 0; i < 4; ++i) {
    float4 v = o4[lane + 64 * i], g = g4[lane + 64 * i];
    v.x *= rs * g.x; v.y *= rs * g.y; v.z *= rs * g.z; v.w *= rs * g.w;
    o4[lane + 64 * i] = v;
  }
}


#define XB_TMO      128
#define XB_XCNT(j)  (256  + 64 * (j))
#define XB_XSUB(j)  (1280 + 64 * (j))
#define XB_XGEN(j)  (2304 + 64 * (j))
#define XB_TOP      3328
#define XB_TOPGEN   3392
#define XCD_BAR_WORDS 3456
#define XB_SPIN_CAP (1u << 18)
DI unsigned xb_xcc_id() { return (unsigned)__builtin_amdgcn_s_getreg((3 << 11) | 20) & 0xFu; }
#define XB_SPIN(cond, bar) do { unsigned _sp = 0; while (cond) { __builtin_amdgcn_s_sleep(1); \
    if ((++_sp & 255u) == 0u) { if (xb_ld(&(bar)[XB_TMO])) break; if (_sp > XB_SPIN_CAP) { atomicAdd(&(bar)[XB_TMO], 1u); break; } } } } while (0)
struct XcdBarrier { unsigned* bar; unsigned x; volatile LAS unsigned* st; };
DI XcdBarrier xcd_barrier_post(unsigned* bar, volatile LAS unsigned* st) {
  XcdBarrier b; b.bar = bar; b.x = xb_xcc_id(); b.st = st;
  if (threadIdx.x == 0) (void)xb_add(&bar[XB_XCNT(b.x)], 1u);
  return b;
}
DI void xcd_barrier_complete(unsigned* bar, unsigned x, unsigned& nloc, unsigned& nx) {
  const unsigned G = gridDim.x * gridDim.y * gridDim.z;
  unsigned sum, cnt, mine, sp = 0u;
  for (;;) {
    sum = 0u; cnt = 0u; mine = 0u;
#pragma unroll
    for (unsigned j = 0; j < 16; ++j) { const unsigned c = xb_ld(&bar[XB_XCNT(j)]); sum += c; cnt += (c > 0u) ? 1u : 0u; mine = (j == x) ? c : mine; }
    if (sum == G) break;
    __builtin_amdgcn_s_sleep(1);
    if ((++sp & 255u) == 0u) { if (xb_ld(&bar[XB_TMO])) break; if (sp > XB_SPIN_CAP) { atomicAdd(&bar[XB_TMO], 1u); break; } }
  }
  nloc = mine > 0u ? mine : 1u; nx = cnt > 0u ? cnt : 1u;
}
DI void xcd_barrier(const XcdBarrier& b) {
  asm volatile("s_waitcnt vmcnt(0)" ::: "memory");
  __syncthreads();
  if (threadIdx.x == 0) {
    unsigned* bar = b.bar;
    __builtin_amdgcn_s_waitcnt(0);
    unsigned nloc = b.st[0], nx = b.st[1];
    if (nloc == 0u) { xcd_barrier_complete(bar, b.x, nloc, nx); b.st[0] = nloc; b.st[1] = nx; }
    const unsigned old = xb_add(&bar[XB_XSUB(b.x)], 1u);
    const unsigned gen = old / nloc;
    if (old + 1u == (gen + 1u) * nloc) {
      __builtin_amdgcn_fence(__ATOMIC_RELEASE, "agent");
      asm volatile("s_waitcnt vmcnt(0)" ::: "memory");
      const unsigned og = xb_add(&bar[XB_TOP], 1u);
      const unsigned tg = og / nx;
      if (og + 1u == (tg + 1u) * nx) xb_add(&bar[XB_TOPGEN], 1u);
      else XB_SPIN(xb_ld(&bar[XB_TOPGEN]) == tg, bar);
      __builtin_amdgcn_fence(__ATOMIC_ACQUIRE, "agent");
      xb_add(&bar[XB_XGEN(b.x)], 1u);
      asm volatile("s_waitcnt vmcnt(0)" ::: "memory");
    } else {
      XB_SPIN(xb_ld(&bar[XB_XGEN(b.x)]) == gen, bar);
      __builtin_amdgcn_fence(__ATOMIC_ACQUIRE, "agent");
      asm volatile("s_waitcnt vmcnt(0)" ::: "memory");
    }
  }
  __syncthreads();
}

__global__ void __launch_bounds__(NTHR, 2) nsa_pool_block_fwd(Params p) {
  extern __shared__ __attribute__((aligned(16))) unsigned char shm[];
  char* smem = (char*)shm;
  LAS unsigned char* lds = (LAS unsigned char*)shm;
  cg::grid_group grid = cg::this_grid();
  const int G = gridDim.x;
  const int bid = blockIdx.x;
  const int L = (G % 8 == 0) ? (bid % 8) * (G / 8) + bid / 8 : bid;
  volatile LAS unsigned* xst = (volatile LAS unsigned*)(lds + 133120);
  if (threadIdx.x < 4) xst[threadIdx.x] = 0u;
  __syncthreads();
  const XcdBarrier xb = xcd_barrier_post(p.bar, xst);

  if (PH_MASK & 1)
  {
    constexpr int N0 = 1024, N1 = N0 + TJ_TOTAL / 2, N2 = N1 + 64, N3 = N2 + 16, N4 = N3 + 64;
    for (int rep = 0; rep < ((REP_MASK & 1) ? 2 : 1); ++rep)
    for (int it = N4 - 1 - bid; it >= 0; it -= G) {
      if (it < N0) p0_rows(p, it);
      else if (it < N1) p0_transpose(p, it - N0, smem);
      else if (it < N2) p0_weff(p, it - N1, smem);
      else if (it < N3) p0_cbias(p, it - N2, smem);
      else p0_rope(p, it - N3);
    }
  }
  if (p.bar == nullptr) grid.sync();
  xcd_barrier(xb);
  if (PH_MASK & 2) {
    Sched S{0, G, bid};
    EpiProj E{p};
    for (int rep = 0; rep < ((REP_MASK & 2) ? 2 : 1); ++rep)
    gemm_phase(lds, Gemm{p.xb, p.w_in_t, DM, DM, DM, 128, 128}, S, E);
  }
  xcd_barrier(xb);
  if (PH_MASK & 4) for (int rep = 0; rep < ((REP_MASK & 4) ? 2 : 1); ++rep)
  {
    Sched S{2, G, bid};
    EpiCmpHid E{(float*)p.mb};
    gemm_phase(lds, Gemm{p.kvb, p.cw1_t, 1024, 2048, 512, 128, 128}, S, E);
    for (int it = bid; it < 4096; it += G) p2a_pool_item(p, it);
  }
  xcd_barrier(xb);
  if (PH_MASK & 8) {
    Sched S{3, G, bid};
    EpiCmpOut E{p};
    for (int i = 0;; ++i) {
      Unit u;
      if (!S.next(i, u)) break;
      const float* h32 = (const float*)p.mb;
      const float* bias = p.cbias + u.pn * 256;
      for (int e0 = threadIdx.x; e0 < 8192; e0 += 4 * NTHR) {
        f32x4 pv[4][4][2];
#pragma unroll
        for (int q = 0; q < 4; ++q) {
          const int e = e0 + q * NTHR, c = e >> 5, n8 = (e & 31) * 8;
#pragma unroll
          for (int ks = 0; ks < 4; ++ks) {
            const f32x4* sp = (const f32x4*)(h32 + ((size_t)((ks * 32 + u.pm) * 256 + c)) * 256 + n8);
            pv[q][ks][0] = sp[0]; pv[q][ks][1] = sp[1];
          }
        }
#pragma unroll
        for (int q = 0; q < 4; ++q) {
          const int e = e0 + q * NTHR, c = e >> 5, n8 = (e & 31) * 8;
          f32x4 v0 = *(const f32x4*)(bias + n8), v1 = *(const f32x4*)(bias + n8 + 4);
#pragma unroll
          for (int ks = 0; ks < 4; ++ks) { v0 += pv[q][ks][0]; v1 += pv[q][ks][1]; }
#pragma unroll
          for (int j = 0; j < 4; ++j) { v0[j] = gelu_tanh(v0[j]); v1[j] = gelu_tanh(v1[j]); }
          *(u32x4*)(p.hid + ((size_t)u.pm * 256 + c) * 256 + n8) = pack8(v0, v1);
        }
      }
    }
    asm volatile("s_waitcnt vmcnt(0)" ::: "memory");
    __syncthreads();
    gemm_phase(lds, Gemm{p.hid, p.cw2_t, 256, 256, 256, 128, 128}, S, E);
  }
  xcd_barrier(xb);
  if (ATTN_PRIO) { if (threadIdx.x >= 256) __builtin_amdgcn_s_setprio(2); }
  if (PH_MASK & 16) for (int rep = 0; rep < ((REP_MASK & 16) ? 2 : 1); ++rep)
  if (G == 256) {
    const int x = bid & 7, j = bid >> 3;
    for (int rd = 0; rd < 4; ++rd) {
      const int idx = rd * 32 + ((rd & 1) ? (31 - j) : j);
      attn_item(p, 2 * x + (idx & 1), 63 - (idx >> 1), smem);
    }
  } else
  for (int rd = 0; rd * G < 1024; ++rd) {
    const int i = rd * G + ((rd & 1) ? (G - 1 - L) : L);
    if (i < 1024) attn_item(p, i & 15, 63 - (i >> 4), smem);
  }
  xcd_barrier(xb);
  if (ATTN_PRIO) __builtin_amdgcn_s_setprio(0);
  if (PH_MASK & 32) {
    Sched S{1, G, bid};
    EpiMerge<0> E0{p};
    EpiMerge<1> E1{p};
    for (int rep = 0; rep < ((REP_MASK & 32) ? 2 : 1); ++rep) {
    gemm_phase(lds, Gemm{p.ob, p.wa_t, 512, 512, 512, 128, 128}, S, E0);
    gemm_phase(lds, Gemm{p.pooled, p.wbe_t, 512, 512, 512, 128, 128}, S, E1);
    }
  }
  xcd_barrier(xb);
  if (PH_MASK & 64) {
    Sched S{1, G, bid};
    EpiResid<true> E{p.x, p.out, p.xb, p.ssq};
    for (int rep = 0; rep < ((REP_MASK & 64) ? 2 : 1); ++rep)
    gemm_phase(lds, Gemm{p.mb, p.wo_t, DM, DM, DM, 128, 128}, S, E);
  }
  xcd_barrier(xb);
  if (PH_MASK & 128) {
    Sched S{0, G, bid};
    EpiFF1 E{p};
    for (int rep = 0; rep < ((REP_MASK & 128) ? 2 : 1); ++rep)
    gemm_phase(lds, Gemm{p.xb, p.w1_t, DM, DM, DM, 128, 128}, S, E);
  }
  xcd_barrier(xb);
#if FUSE_FINAL
  if (PH_MASK & 256) {
    Sched S{1, G, bid};
    EpiFinal E{p.out, p.norm_final, p.ssq2, p.bar + XCD_BAR_WORDS};
    gemm_phase(lds, Gemm{p.act, p.w2_t, 64, 64, 4096, (size_t)T_TOK * 128, (size_t)1024 * 128}, S, E);
  }
#else
  if (PH_MASK & 256) {
    Sched S{1, G, bid};
    EpiResid<false> E{p.out, p.out, nullptr, p.ssq2};
    gemm_phase(lds, Gemm{p.act, p.w2_t, 64, 64, 4096, (size_t)T_TOK * 128, (size_t)1024 * 128}, S, E);
  }
  xcd_barrier(xb);
  for (int it = bid; it < 4096; it += G) p10_rows(p, it);
#endif
}

extern "C" void kernel_launch(void* const* d_in, const int* in_sizes, int n_in, void* d_out, int out_size, void* d_ws,
                              size_t ws_size, hipStream_t stream) {
  (void)in_sizes; (void)n_in; (void)out_size; (void)ws_size;
  static int grid_blocks = 0;
  if (!grid_blocks) {
    int dev = 0, cus = 0, per_cu = 0;
    (void)hipGetDevice(&dev);
    (void)hipDeviceGetAttribute(&cus, hipDeviceAttributeMultiprocessorCount, dev);
    (void)hipFuncSetAttribute((const void*)nsa_pool_block_fwd, hipFuncAttributeMaxDynamicSharedMemorySize, LDS_BYTES);
    (void)hipOccupancyMaxActiveBlocksPerMultiprocessor(&per_cu, nsa_pool_block_fwd, NTHR, LDS_BYTES);
    if (per_cu > 1) per_cu = 1;
    if (per_cu < 1) per_cu = 1;
    grid_blocks = cus * per_cu;
  }
  Params p{};
  const float* const* in = (const float* const*)d_in;
  p.x = in[0]; p.norm_mix = in[1]; p.w_in = in[2]; p.pe_k = in[3]; p.pe_v = in[4]; p.ck_w1 = in[5]; p.ck_w2 = in[6];
  p.cv_w1 = in[7]; p.cv_w2 = in[8]; p.w_ba = in[9]; p.pool_w = in[10]; p.pool_scale = in[11]; p.w_bp = in[12];
  p.w_out = in[13]; p.norm_mlp = in[14]; p.w_ff1 = in[15]; p.w_ff2 = in[16]; p.norm_final = in[17];
  p.out = (float*)d_out;
  char* ws = (char*)d_ws;
  size_t off = 0;
  auto take = [&](size_t bytes) { char* r = ws + off; off += (bytes + 255) & ~(size_t)255; return r; };
  const size_t T = T_TOK;
  p.xb = (u16*)take(T * 1024 * 2);
  p.w_in_t = (u16*)take((size_t)NPROJ * 1024 * 2);
  p.wa_t = (u16*)take(1024 * 512 * 2);
  p.wbe_t = (u16*)take(1024 * 512 * 2);
  p.wo_t = (u16*)take(1024 * 1024 * 2);
  p.w1_t = (u16*)take((size_t)4096 * 1024 * 2);
  p.w2_t = (u16*)take((size_t)4096 * 1024 * 2);
  p.cw1_t = (u16*)take(2 * 256 * 2048 * 2);
  p.cw2_t = (u16*)take(2 * 256 * 256 * 2);
  p.rstd0 = (float*)take(T * 4);
  p.cbias = (float*)take(512 * 4);
  p.rope = (float2*)take((size_t)SEQ * 8 * 8);
  p.ssq = (float*)take(T * 16 * 4);
  p.ssq2 = (float*)take(T * 16 * 4);
  p.mb = (u16*)take(T * 1024 * 2);
  char* regionD = ws + off;
  p.qb = (u16*)take(T * 512 * 2);
  p.kvb = (u16*)take((size_t)6 * 16 * SEQ * 64 * 2);
  p.gate = (float*)take(T * 24 * 4);
  p.ub = (u16*)take(T * 512 * 2);
  p.gm = (u16*)take(T * 2048 * 2);
  p.hid = (u16*)take((size_t)2 * 16 * 256 * 256 * 2);
  p.kcmp = (u16*)take(16 * 256 * 64 * 2);
  p.vcmp = (u16*)take(16 * 256 * 64 * 2);
  p.pooled = (u16*)take(T * 512 * 2);
  p.ob = (u16*)take(T * 512 * 2);
  p.bar = (unsigned*)take((XCD_BAR_WORDS + 4096) * 4);
  p.act = (u16*)regionD;
  (void)hipMemsetAsync(p.bar, 0, (XCD_BAR_WORDS + 4096) * 4, stream);
  void* args[] = {&p};
  hipError_t e = hipLaunchCooperativeKernel((void*)nsa_pool_block_fwd, dim3(grid_blocks), dim3(NTHR), args, LDS_BYTES, stream);
  if (e != hipSuccess) fprintf(stderr, "cooperative launch failed: %s (grid %d)\n", hipGetErrorString(e), grid_blocks);
}
```

```cpp
#include <hip/hip_runtime.h>
#include <hip/hip_cooperative_groups.h>
#include <stdint.h>
#include <stdio.h>
namespace cg = cooperative_groups;

#define DI __device__ __forceinline__
#define LAS __attribute__((address_space(3)))
typedef unsigned short u16;
typedef __attribute__((ext_vector_type(8))) short bf16x8;
typedef __attribute__((ext_vector_type(4))) short s16x4;
typedef __attribute__((ext_vector_type(16))) float f32x16;
typedef __attribute__((ext_vector_type(4))) float f32x4;
typedef __attribute__((ext_vector_type(4))) unsigned u32x4;
typedef __attribute__((ext_vector_type(2))) unsigned u32x2;
typedef __attribute__((ext_vector_type(2))) float f32x2;
typedef __attribute__((ext_vector_type(2))) __bf16 bf16x2_t;
typedef LAS const char* lds_cptr;

constexpr int T_TOK = 32768, SEQ = 4096, DM = 1024;
constexpr int NPROJ = 4096;
constexpr int NTHR = 512;
constexpr int LDS_BYTES = 135168;
constexpr float NEGF = -1e30f;
constexpr float QSCALE = 0.125f * 1.4426950408889634f;
#ifndef REP_MASK
#define REP_MASK 0
#endif
#ifndef ATTN_PRIO
#define ATTN_PRIO 0
#endif
#ifndef FUSE_FINAL
#define FUSE_FINAL 1
#endif
#ifndef PH_MASK
#define PH_MASK 0xffff
#endif

struct Params {
  const float *x, *norm_mix, *w_in, *pe_k, *pe_v, *ck_w1, *ck_w2, *cv_w1, *cv_w2, *w_ba, *pool_w, *pool_scale, *w_bp,
      *w_out, *norm_mlp, *w_ff1, *w_ff2, *norm_final;
  float* out;
  u16 *xb, *w_in_t, *wa_t, *wbe_t, *wo_t, *w1_t, *w2_t, *cw1_t, *cw2_t;
  float *rstd0, *cbias;
  float2* rope;
  u16 *qb, *kvb;
  float* gate;
  u16 *ub, *gm, *hid, *kcmp, *vcmp, *pooled, *ob, *mb, *act;
  float *ssq, *ssq2;
  unsigned* bar;
};

DI unsigned pack_bf2(float a, float b) {
  f32x2 v = {a, b};
  bf16x2_t r = __builtin_convertvector(v, bf16x2_t);
  return __builtin_bit_cast(unsigned, r);
}
DI float bf_lo(unsigned u) { return __uint_as_float(u << 16); }
DI float bf_hi(unsigned u) { return __uint_as_float(u & 0xffff0000u); }
DI float sigmoidf_(float v) { return __builtin_amdgcn_rcpf(1.f + __builtin_amdgcn_exp2f(-1.4426950408889634f * v)); }
DI float gelu_tanh(float x) {
  float u = 0.7978845608028654f * (x + 0.044715f * x * x * x);
  float th = 1.f - 2.f / (__expf(2.f * u) + 1.f);
  return 0.5f * x * (1.f + th);
}
DI f32x16 mfma32(bf16x8 a, bf16x8 b, f32x16 c) { return __builtin_amdgcn_mfma_f32_32x32x16_bf16(a, b, c, 0, 0, 0); }
DI int opaque_tid() { int t; asm volatile("v_mov_b32 %0, %1" : "=v"(t) : "v"((int)threadIdx.x)); return t; }
DI f32x16 zero16() { f32x16 z; for (int i = 0; i < 16; ++i) z[i] = 0.f; return z; }
DI s16x4 vtr(lds_cptr p) { return __builtin_amdgcn_ds_read_tr16_b64_v4i16((LAS s16x4*)p); }
DI u32x4 pack8(const f32x4& a, const f32x4& b) {
  u32x4 w = {pack_bf2(a[0], a[1]), pack_bf2(a[2], a[3]), pack_bf2(b[0], b[1]), pack_bf2(b[2], b[3])};
  return w;
}

constexpr int BM = 256, BK = 64, HALF = 128, HTB = HALF * BK * 2;
DI int lds_byte(int r, int c) { const int st = (r >> 4) * 2 + (c >> 5), rr = r & 15, cc = c & 31, ob = rr * 64 + cc * 2; return st * 1024 + (ob ^ (((ob >> 9) & 1) << 5)); }
DI void stage_rc(int b, int& R, int& C) { const int st = b / 1024, sb = b % 1024, swz = sb ^ (((sb >> 9) & 1) << 5); R = (st >> 1) * 16 + swz / 64; C = (st & 1) * 32 + (swz % 64) / 2; }
DI int perm32(int rho) { const int n = rho >> 4, i = rho & 15; return 8 * (i >> 2) + 4 * n + (i & 3); }

struct Unit { int pm, pn, k0; };
struct Gemm { const u16* A; const u16* Bt; int lda, ldb, K; size_t kstepA, kstepB; };

struct Sched {
  int mode, G, bid;
  DI bool next(int i, Unit& u) const {
    u.k0 = 0;
    if (mode == 2) {
      int t;
      if (G >= 256) { if (i > 0 || (bid & 1) != ((bid >> 3) & 1) || (bid >> 1) >= 128) return false; t = bid >> 1; }
      else { t = i * G + bid; if (t >= 128) return false; }
      u.pm = t >> 2; u.pn = u.pm >> 4; u.k0 = (t & 3) * 8; return true;
    }
    if (mode == 3) {
      int t;
      if (G >= 256) { t = bid >> 3; if (i > 0 || (bid & 7) != (t & 7) || t >= 32) return false; }
      else { t = i * G + bid; if (t >= 32) return false; }
      u.pm = t; u.pn = t >> 4; return true;
    }
    const int nN = mode == 0 ? 16 : 4;
    if (G == 256) {
      const int x = bid & 7, j = bid >> 3;
      if (mode == 0) { if (i >= 8) return false; u.pn = (x & 3) * 4 + (j & 3); u.pm = (x >> 2) * 64 + i * 8 + (j >> 2); return true; }
      if (i >= 2) return false; u.pn = j & 3; u.pm = x * 16 + i * 8 + (j >> 2); return true;
    }
    const int t = i * G + bid;
    if (t >= nN * 128) return false;
    u.pn = t % nN; u.pm = t / nN; return true;
  }
};

template <class Epi>
DI void gemm_phase(LAS unsigned char* lds, const Gemm g, const Sched& S, const Epi& E) {
  const int tid = opaque_tid(), wid = __builtin_amdgcn_readfirstlane(tid >> 6), lane = tid & 63, wr = wid >> 2, wc = wid & 3, fr = lane & 15, fq = lane >> 4;
  const int nt = g.K / BK;
  unsigned voffA[2], voffB[2];
#pragma unroll
  for (int i = 0; i < 2; ++i) {
    int R, C; stage_rc(tid * 16 + i * 8192, R, C);
    const int Rb = (R & ~31) + perm32(R & 31);
    voffA[i] = (unsigned)(R * g.lda + C) * 2u; voffB[i] = (unsigned)(Rb * g.ldb + C) * 2u;
  }
  const size_t kstep = g.kstepB, kstepA = g.kstepA;
  const size_t hstepA = (size_t)HALF * g.lda * 2, hstepB = (size_t)HALF * g.ldb * 2;
  const size_t tstepA = 2 * hstepA, tstepB = 2 * hstepB;
  const unsigned ldsw = (unsigned)wid * 1024u;
  const int aoff = lds_byte(wr * 64 + fr, fq * 8), boff = lds_byte(wc * 32 + fr, fq * 8);
#define PG8_SA(b, h) (((b) * 2 + (h)) * HTB)
#define PG8_SB(b, h) ((4 + (b) * 2 + (h)) * HTB)
#define PG8_STAGE(bufoff, gbase, voff) do { _Pragma("unroll") for (int _i = 0; _i < 2; ++_i) \
    __builtin_amdgcn_global_load_lds((const unsigned*)((const char*)(gbase) + (voff)[_i]), (LAS unsigned*)(lds + (bufoff) + ldsw + _i * 8192), 16, 0, 0); } while (0)
#define PG8_LDA(dst, b, h) do { _Pragma("unroll") for (int m = 0; m < 4; ++m) _Pragma("unroll") for (int k = 0; k < 2; ++k) dst[m][k] = *(const LAS bf16x8*)(lds + PG8_SA(b, h) + aoff + m * 2048 + k * 1024); } while (0)
#define PG8_LDB(dst, b, h) do { _Pragma("unroll") for (int n = 0; n < 2; ++n) _Pragma("unroll") for (int k = 0; k < 2; ++k) dst[n][k] = *(const LAS bf16x8*)(lds + PG8_SB(b, h) + boff + n * 2048 + k * 1024); } while (0)
#define PG8_MMA(ai, bj, At, Bt) do { __builtin_amdgcn_s_setprio(1); _Pragma("unroll") for (int m = 0; m < 4; ++m) _Pragma("unroll") for (int n = 0; n < 2; ++n) _Pragma("unroll") for (int k = 0; k < 2; ++k) \
    acc[ai][bj][m][n] = __builtin_amdgcn_mfma_f32_16x16x32_bf16(Bt[n][k], At[m][k], acc[ai][bj][m][n], 0, 0, 0); __builtin_amdgcn_s_setprio(0); } while (0)
#define PG8_WAIT_V(n) asm volatile("s_waitcnt vmcnt(" #n ")" ::: "memory")
#define PG8_WAIT_L(n) asm volatile("s_waitcnt lgkmcnt(" #n ")" ::: "memory")
#define PG8_BAR __builtin_amdgcn_s_barrier()
#define PG8_SCHED __builtin_amdgcn_sched_barrier(0)
  Unit cur, nxt; int ui = 0;
  if (!S.next(0, cur)) return;
  f32x4 acc[2][2][4][2];
#pragma unroll
  for (int a = 0; a < 2; ++a)
#pragma unroll
    for (int b = 0; b < 2; ++b)
#pragma unroll
      for (int m = 0; m < 4; ++m)
#pragma unroll
        for (int n = 0; n < 2; ++n) acc[a][b][m][n] = (f32x4){0.f, 0.f, 0.f, 0.f};
  bf16x8 At[4][2], B0[2][2], B1[2][2];
  const char* cA = (const char*)g.A + (size_t)cur.pm * tstepA + (size_t)cur.k0 * kstepA; const char* cB = (const char*)g.Bt + (size_t)cur.pn * tstepB + (size_t)cur.k0 * kstep;
  PG8_STAGE(PG8_SB(0, 0), cB, voffB); PG8_STAGE(PG8_SA(0, 0), cA, voffA); PG8_STAGE(PG8_SB(0, 1), cB + hstepB, voffB); PG8_STAGE(PG8_SA(0, 1), cA + hstepA, voffA);
  if (wr == 1) PG8_BAR;
  PG8_WAIT_V(4); PG8_BAR;
  PG8_STAGE(PG8_SB(1, 0), cB + kstep, voffB); PG8_STAGE(PG8_SA(1, 0), cA + kstepA, voffA); PG8_STAGE(PG8_SB(1, 1), cB + hstepB + kstep, voffB);
  PG8_WAIT_V(6); PG8_BAR;
  for (;;) {
    const bool has_next = S.next(ui + 1, nxt);
    const char* nA = has_next ? (const char*)g.A + (size_t)nxt.pm * tstepA + (size_t)nxt.k0 * kstepA : cA; const char* nB = has_next ? (const char*)g.Bt + (size_t)nxt.pn * tstepB + (size_t)nxt.k0 * kstep : cB;
    for (int t = 0; t < nt; t += 2) {
      const bool last = (t == nt - 2);
      const char* a1 = cA + (size_t)(t + 1) * kstepA;
      const char* a2 = last ? nA : cA + (size_t)(t + 2) * kstepA; const char* b2 = last ? nB : cB + (size_t)(t + 2) * kstep;
      const char* a3 = a2 + kstepA; const char* b3 = b2 + kstep;
      PG8_LDB(B0, 0, 0); PG8_SCHED; PG8_LDA(At, 0, 0); PG8_STAGE(PG8_SA(1, 1), a1 + hstepA, voffA);
      PG8_WAIT_L(8); PG8_BAR; PG8_WAIT_L(0); PG8_MMA(0, 0, At, B0); PG8_BAR; PG8_SCHED;
      PG8_LDB(B1, 0, 1); PG8_STAGE(PG8_SB(0, 0), b2, voffB);
      PG8_BAR; PG8_WAIT_L(0); PG8_MMA(0, 1, At, B1); PG8_BAR;
      PG8_LDA(At, 0, 1); PG8_STAGE(PG8_SA(0, 0), a2, voffA);
      PG8_BAR; PG8_WAIT_L(0); PG8_MMA(1, 0, At, B0); PG8_BAR; PG8_SCHED;
      PG8_STAGE(PG8_SB(0, 1), b2 + hstepB, voffB);
      PG8_WAIT_V(6); PG8_BAR; PG8_MMA(1, 1, At, B1); PG8_BAR;
      PG8_LDB(B0, 1, 0); PG8_SCHED; PG8_LDA(At, 1, 0); PG8_STAGE(PG8_SA(0, 1), a2 + hstepA, voffA);
      PG8_WAIT_L(8); PG8_BAR; PG8_WAIT_L(0); PG8_MMA(0, 0, At, B0); PG8_BAR; PG8_SCHED;
      PG8_LDB(B1, 1, 1); PG8_STAGE(PG8_SB(1, 0), b3, voffB);
      PG8_BAR; PG8_WAIT_L(0); PG8_MMA(0, 1, At, B1); PG8_BAR;
      PG8_LDA(At, 1, 1); PG8_STAGE(PG8_SA(1, 0), a3, voffA);
      PG8_BAR; PG8_WAIT_L(0); PG8_MMA(1, 0, At, B0); PG8_BAR; PG8_SCHED;
      PG8_STAGE(PG8_SB(1, 1), b3 + hstepB, voffB);
      PG8_WAIT_V(6); PG8_BAR; PG8_MMA(1, 1, At, B1); PG8_BAR;
    }
    E(acc, cur, wr, wc, fr, fq);
    if (!has_next) break;
#pragma unroll
    for (int a = 0; a < 2; ++a)
#pragma unroll
      for (int b = 0; b < 2; ++b)
#pragma unroll
        for (int m = 0; m < 4; ++m)
#pragma unroll
          for (int n = 0; n < 2; ++n) acc[a][b][m][n] = (f32x4){0.f, 0.f, 0.f, 0.f};
    cur = nxt; cA = nA; cB = nB; ++ui;
  }
  PG8_WAIT_V(0);
  if (wr == 0) PG8_BAR;
  PG8_BAR;
#undef PG8_SA
#undef PG8_SB
#undef PG8_STAGE
#undef PG8_LDA
#undef PG8_LDB
#undef PG8_MMA
#undef PG8_WAIT_V
#undef PG8_WAIT_L
#undef PG8_BAR
#undef PG8_SCHED
}

typedef f32x4 (&AccRef)[2][2][4][2];
DI unsigned xb_ld(unsigned* p)              { return __hip_atomic_load(p, __ATOMIC_RELAXED, __HIP_MEMORY_SCOPE_AGENT); }
DI unsigned xb_add(unsigned* p, unsigned v) { return __hip_atomic_fetch_add(p, v, __ATOMIC_RELAXED, __HIP_MEMORY_SCOPE_AGENT); }
#define EPI_ROWS for (int ai = 0; ai < 2; ++ai) _Pragma("unroll") for (int m = 0; m < 4; ++m)
#define EPI_ROW(u) ((u).pm * BM + ai * HALF + wr * 64 + m * 16 + fr)
#define EPI_COL(bj) ((bj) * HALF + wc * 32 + fq * 8)

DI void rope8(f32x4& v0, f32x4& v1, const float2* __restrict__ tab, int pos, int fq) {
  const f32x4* t4 = (const f32x4*)(tab + (size_t)pos * 8);
  const f32x4 c0 = t4[0], c1 = t4[1], c2 = t4[2], c3 = t4[3];
  float pv[8];
#pragma unroll
  for (int j = 0; j < 4; ++j) { pv[j] = __shfl_xor(v0[j], 16); pv[4 + j] = __shfl_xor(v1[j], 16); }
  if (fq < 2) {
    const float sg = fq ? 1.f : -1.f;
    v0[0] = v0[0] * c0[0] + sg * pv[0] * c0[1]; v0[1] = v0[1] * c0[2] + sg * pv[1] * c0[3];
    v0[2] = v0[2] * c1[0] + sg * pv[2] * c1[1]; v0[3] = v0[3] * c1[2] + sg * pv[3] * c1[3];
    v1[0] = v1[0] * c2[0] + sg * pv[4] * c2[1]; v1[1] = v1[1] * c2[2] + sg * pv[5] * c2[3];
    v1[2] = v1[2] * c3[0] + sg * pv[6] * c3[1]; v1[3] = v1[3] * c3[2] + sg * pv[7] * c3[3];
  }
}

DI void rope8t(f32x4& v0, f32x4& v1, const f32x4 (&t)[4], int fq) {
  float pv[8];
#pragma unroll
  for (int j = 0; j < 4; ++j) { pv[j] = __shfl_xor(v0[j], 16); pv[4 + j] = __shfl_xor(v1[j], 16); }
  if (fq < 2) {
    const float sg = fq ? 1.f : -1.f;
    v0[0] = v0[0] * t[0][0] + sg * pv[0] * t[0][1]; v0[1] = v0[1] * t[0][2] + sg * pv[1] * t[0][3];
    v0[2] = v0[2] * t[1][0] + sg * pv[2] * t[1][1]; v0[3] = v0[3] * t[1][2] + sg * pv[3] * t[1][3];
    v1[0] = v1[0] * t[2][0] + sg * pv[4] * t[2][1]; v1[1] = v1[1] * t[2][2] + sg * pv[5] * t[2][3];
    v1[2] = v1[2] * t[3][0] + sg * pv[6] * t[3][1]; v1[3] = v1[3] * t[3][2] + sg * pv[7] * t[3][3];
  }
}

struct EpiProj {
  const Params& p;
  DI void operator()(AccRef acc, const Unit& u, int wr, int wc, int fr, int fq) const {
    const int pn = u.pn;
    const bool roped = ((wc & 1) == 0) && (pn < 2 || pn == 3 || pn == 4);
    float rs8[8];
#pragma unroll
    EPI_ROWS rs8[ai * 4 + m] = p.rstd0[EPI_ROW(u)];
#pragma unroll
    for (int ai = 0; ai < 2; ++ai)
#pragma unroll
    for (int mh = 0; mh < 2; ++mh) {
      f32x4 tabx[2][4];
      if (roped) {
#pragma unroll
        for (int mm = 0; mm < 2; ++mm) {
          const int m = mh * 2 + mm;
          const f32x4* t4 = (const f32x4*)(p.rope + (size_t)(EPI_ROW(u) & (SEQ - 1)) * 8);
          tabx[mm][0] = t4[0]; tabx[mm][1] = t4[1]; tabx[mm][2] = t4[2]; tabx[mm][3] = t4[3];
        }
      }
#pragma unroll
      for (int mm = 0; mm < 2; ++mm) {
        const int m = mh * 2 + mm;
        const f32x4 (&tabm)[4] = tabx[mm];
        const int row = EPI_ROW(u);
        const float rs = rs8[ai * 4 + m];
        const int s = row & (SEQ - 1), b = row >> 12;
#pragma unroll
        for (int bj = 0; bj < 2; ++bj) {
          f32x4 v0 = acc[ai][bj][m][0] * rs, v1 = acc[ai][bj][m][1] * rs;
          const int lc = EPI_COL(bj);
          if (pn < 2) {
            if (roped) rope8t(v0, v1, tabm, fq);
            *(u32x4*)(p.qb + (size_t)row * 512 + pn * 256 + lc) = pack8(v0 * QSCALE, v1 * QSCALE);
          } else if (pn < 5) {
            const int which = (pn - 2) * 2 + bj;
            if ((which == 2 || which == 4) && roped) rope8t(v0, v1, tabm, fq);
            const int g = wc >> 1, d = (wc & 1) * 32 + fq * 8;
            *(u32x4*)(p.kvb + ((size_t)((which * 16 + b * 2 + g) * SEQ + s)) * 64 + d) = pack8(v0, v1);
          } else if (pn < 7) {
            *(u32x4*)(p.ub + (size_t)row * 512 + (pn - 5) * 256 + lc) = pack8(v0, v1);
          } else if (pn < 15) {
#pragma unroll
            for (int j = 0; j < 4; ++j) { v0[j] = sigmoidf_(v0[j]); v1[j] = sigmoidf_(v1[j]); }
            *(u32x4*)(p.gm + (size_t)row * 2048 + (pn - 7) * 256 + lc) = pack8(v0, v1);
          } else {
            if (bj == 0 && wc == 0 && fq < 3) {
#pragma unroll
              for (int j = 0; j < 4; ++j) { v0[j] = sigmoidf_(v0[j]); v1[j] = sigmoidf_(v1[j]); }
              f32x4* gp = (f32x4*)(p.gate + (size_t)row * 24 + fq * 8);
              gp[0] = v0; gp[1] = v1;
            }
          }
        }
      }
    }
  }
};

struct EpiCmpHid {
  float* hid32;
  DI void operator()(AccRef acc, const Unit& u, int wr, int wc, int fr, int fq) const {
    float* base = hid32 + ((size_t)((u.k0 >> 3) * 32 + u.pm) * 256) * 256;
#pragma unroll
    EPI_ROWS {
      const int c = ai * HALF + wr * 64 + m * 16 + fr;
#pragma unroll
      for (int bj = 0; bj < 2; ++bj) {
        f32x4* dp = (f32x4*)(base + (size_t)c * 256 + EPI_COL(bj));
        dp[0] = acc[ai][bj][m][0]; dp[1] = acc[ai][bj][m][1];
      }
    }
  }
};

struct EpiCmpOut {
  const Params& p;
  DI void operator()(AccRef acc, const Unit& u, int wr, int wc, int fr, int fq) const {
    const int kv = u.pm >> 4, bg = u.pm & 15;
    const bool roped = (kv == 0) && (wc == 0);
    u16* dst = (kv ? p.vcmp : p.kcmp) + (size_t)bg * 256 * 64;
#pragma unroll
    for (int ai = 0; ai < 2; ++ai) {
      f32x4 tabx[4][4];
      {
#pragma unroll
        for (int m = 0; m < 4; ++m) {
          const int c = ai * HALF + wr * 64 + m * 16 + fr;
          const f32x4* t4 = (const f32x4*)(p.rope + (size_t)min(16 * c + 31, SEQ - 1) * 8);
          tabx[m][0] = t4[0]; tabx[m][1] = t4[1]; tabx[m][2] = t4[2]; tabx[m][3] = t4[3];
        }
      }
#pragma unroll
      for (int m = 0; m < 4; ++m) {
        const int c = ai * HALF + wr * 64 + m * 16 + fr;
        f32x4 v0 = acc[ai][0][m][0], v1 = acc[ai][0][m][1];
        if (roped) rope8t(v0, v1, tabx[m], fq);
        if (c == 255) { v0 = (f32x4){0.f, 0.f, 0.f, 0.f}; v1 = v0; }
        if (wc < 2) *(u32x4*)(dst + c * 64 + wc * 32 + fq * 8) = pack8(v0, v1);
      }
    }
  }
};

template <int PASS>
struct EpiMerge {
  const Params& p;
  DI void operator()(AccRef acc, const Unit& u, int wr, int wc, int fr, int fq) const {
#pragma unroll
    for (int ai = 0; ai < 2; ++ai) {
      u32x4 gq[4][2], ov[4][2];
#pragma unroll
      for (int m = 0; m < 4; ++m)
#pragma unroll
        for (int bj = 0; bj < 2; ++bj) {
          const int row = EPI_ROW(u), col = u.pn * BM + EPI_COL(bj);
          gq[m][bj] = *(const u32x4*)(p.gm + (size_t)row * 2048 + PASS * 1024 + col);
          if (PASS == 1) ov[m][bj] = *(const u32x4*)(p.mb + (size_t)row * 1024 + col);
        }
#pragma unroll
      for (int m = 0; m < 4; ++m) {
        const int row = EPI_ROW(u);
#pragma unroll
        for (int bj = 0; bj < 2; ++bj) {
          const int col = u.pn * BM + EPI_COL(bj);
          const u32x4 g = gq[m][bj];
          f32x4 v0 = acc[ai][bj][m][0], v1 = acc[ai][bj][m][1];
          v0[0] *= bf_lo(g[0]); v0[1] *= bf_hi(g[0]); v0[2] *= bf_lo(g[1]); v0[3] *= bf_hi(g[1]);
          v1[0] *= bf_lo(g[2]); v1[1] *= bf_hi(g[2]); v1[2] *= bf_lo(g[3]); v1[3] *= bf_hi(g[3]);
          if (PASS == 1) {
            const u32x4 o = ov[m][bj];
            v0[0] += bf_lo(o[0]); v0[1] += bf_hi(o[0]); v0[2] += bf_lo(o[1]); v0[3] += bf_hi(o[1]);
            v1[0] += bf_lo(o[2]); v1[1] += bf_hi(o[2]); v1[2] += bf_lo(o[3]); v1[3] += bf_hi(o[3]);
          }
          *(u32x4*)(p.mb + (size_t)row * 1024 + col) = pack8(v0, v1);
        }
      }
    }
  }
};

template <bool WITH_BF16>
struct EpiResid {
  const float* resid; float* out; u16* outb; float* ssq;
  DI void operator()(AccRef acc, const Unit& u, int wr, int wc, int fr, int fq) const {
#pragma unroll
    for (int ai = 0; ai < 2; ++ai) {
      f32x4 rv[4][2][2];
#pragma unroll
      for (int m = 0; m < 4; ++m)
#pragma unroll
        for (int bj = 0; bj < 2; ++bj) {
          const f32x4* rp = (const f32x4*)(resid + (size_t)EPI_ROW(u) * 1024 + u.pn * BM + EPI_COL(bj));
          rv[m][bj][0] = rp[0]; rv[m][bj][1] = rp[1];
        }
#pragma unroll
      for (int m = 0; m < 4; ++m) {
        const int row = EPI_ROW(u);
        float sq = 0.f;
#pragma unroll
        for (int bj = 0; bj < 2; ++bj) {
          const size_t a = (size_t)row * 1024 + u.pn * BM + EPI_COL(bj);
          const f32x4 v0 = rv[m][bj][0] + acc[ai][bj][m][0], v1 = rv[m][bj][1] + acc[ai][bj][m][1];
          f32x4* op = (f32x4*)(out + a);
          op[0] = v0; op[1] = v1;
          if (WITH_BF16) *(u32x4*)(outb + a) = pack8(v0, v1);
#pragma unroll
          for (int j = 0; j < 4; ++j) sq += v0[j] * v0[j] + v1[j] * v1[j];
        }
        sq += __shfl_xor(sq, 16);
        sq += __shfl_xor(sq, 32);
        if (fq == 0) ssq[(size_t)row * 16 + u.pn * 4 + wc] = sq;
      }
    }
  }
};

struct EpiFinal {
  float* out; const float* gfin; float* ssq2; unsigned* cnt;
  DI void operator()(AccRef acc, const Unit& u, int wr, int wc, int fr, int fq) const {
#pragma unroll
    for (int ai = 0; ai < 2; ++ai)
#pragma unroll
    for (int mh = 0; mh < 2; ++mh) {
      f32x4 rv[2][2][2];
#pragma unroll
      for (int mm = 0; mm < 2; ++mm)
#pragma unroll
        for (int bj = 0; bj < 2; ++bj) {
          const int m = mh * 2 + mm;
          const f32x4* rp = (const f32x4*)(out + (size_t)EPI_ROW(u) * 1024 + u.pn * BM + EPI_COL(bj));
          rv[mm][bj][0] = rp[0]; rv[mm][bj][1] = rp[1];
        }
#pragma unroll
      for (int mm = 0; mm < 2; ++mm) {
        const int m = mh * 2 + mm;
        const int row = EPI_ROW(u);
        float sq = 0.f;
#pragma unroll
        for (int bj = 0; bj < 2; ++bj) {
          acc[ai][bj][m][0] += rv[mm][bj][0]; acc[ai][bj][m][1] += rv[mm][bj][1];
#pragma unroll
          for (int j = 0; j < 4; ++j) sq += acc[ai][bj][m][0][j] * acc[ai][bj][m][0][j] + acc[ai][bj][m][1][j] * acc[ai][bj][m][1][j];
        }
        sq += __shfl_xor(sq, 16);
        sq += __shfl_xor(sq, 32);
        if (fq == 0) __hip_atomic_store(ssq2 + (size_t)row * 16 + u.pn * 4 + wc, sq, __ATOMIC_RELAXED, __HIP_MEMORY_SCOPE_AGENT);
      }
    }
    asm volatile("s_waitcnt vmcnt(0)" ::: "memory");
    unsigned* c = cnt + (u.pm * 2 + wr) * 16;
    if (fq == 0 && fr == 0) (void)xb_add(c, 1u);
    { unsigned sp = 0; while (xb_ld(c) < 16u) { __builtin_amdgcn_s_sleep(1); if (++sp > (1u << 20)) break; } }
#pragma unroll
    EPI_ROWS {
      const int row = EPI_ROW(u);
      unsigned long long* sp = (unsigned long long*)(ssq2 + (size_t)row * 16 + fq * 4);
      const unsigned long long q0 = __hip_atomic_load(sp, __ATOMIC_RELAXED, __HIP_MEMORY_SCOPE_AGENT);
      const unsigned long long q1 = __hip_atomic_load(sp + 1, __ATOMIC_RELAXED, __HIP_MEMORY_SCOPE_AGENT);
      float ss = (__uint_as_float((unsigned)q0) + __uint_as_float((unsigned)(q0 >> 32))) + (__uint_as_float((unsigned)q1) + __uint_as_float((unsigned)(q1 >> 32)));
      ss += __shfl_xor(ss, 16);
      ss += __shfl_xor(ss, 32);
      const float rs = rsqrtf(ss * (1.f / DM) + 1e-6f);
#pragma unroll
      for (int bj = 0; bj < 2; ++bj) {
        const int col = u.pn * BM + EPI_COL(bj);
        const f32x4* gp = (const f32x4*)(gfin + col);
        f32x4* op = (f32x4*)(out + (size_t)row * 1024 + col);
        op[0] = acc[ai][bj][m][0] * rs * gp[0]; op[1] = acc[ai][bj][m][1] * rs * gp[1];
      }
    }
  }
};

struct EpiFF1 {
  const Params& p;
  DI void operator()(AccRef acc, const Unit& u, int wr, int wc, int fr, int fq) const {
    f32x4 part[8];
#pragma unroll
    EPI_ROWS part[ai * 4 + m] = *(const f32x4*)(p.ssq + (size_t)EPI_ROW(u) * 16 + fq * 4);
    float rs8[8];
#pragma unroll
    for (int r = 0; r < 8; ++r) {
      float ss = (part[r][0] + part[r][1]) + (part[r][2] + part[r][3]);
      ss += __shfl_xor(ss, 16);
      ss += __shfl_xor(ss, 32);
      rs8[r] = rsqrtf(ss * (1.f / DM) + 1e-6f);
    }
#pragma unroll
    EPI_ROWS {
      const int row = EPI_ROW(u);
      const float rs = rs8[ai * 4 + m];
#pragma unroll
      for (int bj = 0; bj < 2; ++bj) {
        f32x4 v0 = acc[ai][bj][m][0] * rs, v1 = acc[ai][bj][m][1] * rs;
#pragma unroll
        for (int j = 0; j < 4; ++j) { const float r0 = fmaxf(v0[j], 0.f), r1 = fmaxf(v1[j], 0.f); v0[j] = r0 * r0; v1[j] = r1 * r1; }
        const int col = u.pn * BM + EPI_COL(bj);
        *(u32x4*)(p.act + ((size_t)(col >> 6) * T_TOK + row) * 64 + (col & 63)) = pack8(v0, v1);
      }
    }
  }
};

DI void p0_rows(const Params& p, int item) {
  const int w = threadIdx.x >> 6, lane = threadIdx.x & 63;
  const int row0 = item * 32 + w * 4;
  float4 v[4][4];
#pragma unroll
  for (int r = 0; r < 4; ++r) {
    const float4* src = (const float4*)(p.x + (size_t)(row0 + r) * DM);
#pragma unroll
    for (int i = 0; i < 4; ++i) v[r][i] = src[lane + 64 * i];
  }
#pragma unroll
  for (int r = 0; r < 4; ++r) {
    float ss = 0.f;
#pragma unroll
    for (int i = 0; i < 4; ++i) ss += v[r][i].x * v[r][i].x + v[r][i].y * v[r][i].y + v[r][i].z * v[r][i].z + v[r][i].w * v[r][i].w;
#pragma unroll
    for (int o = 32; o; o >>= 1) ss += __shfl_xor(ss, o);
    if (lane == 0) p.rstd0[row0 + r] = rsqrtf(ss * (1.f / DM) + 1e-6f);
    u32x2* dst = (u32x2*)(p.xb + (size_t)(row0 + r) * DM);
#pragma unroll
    for (int i = 0; i < 4; ++i) {
      u32x2 o = {pack_bf2(v[r][i].x, v[r][i].y), pack_bf2(v[r][i].z, v[r][i].w)};
      dst[lane + 64 * i] = o;
    }
  }
}

constexpr int TJ_WIN = 1024, TJ_WA = 128, TJ_WO = 256, TJ_W1 = 1024, TJ_W2 = 1024, TJ_C1 = 128, TJ_C2 = 16;
constexpr int TJ_TOTAL = TJ_WIN + TJ_WA + TJ_WO + TJ_W1 + TJ_W2 + 2 * TJ_C1 + 2 * TJ_C2;

constexpr int TJ_EARLY = TJ_WIN + 2 * TJ_C1 + 2 * TJ_C2;
DI void p0_transpose(const Params& p, int item, char* smem, int base) {
  const int half = threadIdx.x >> 8, tid = threadIdx.x & 255;
  int idx = item * 2 + half + base;
  const float* src; u16* dst; const float* scale = nullptr; int K, N, kind = 0;
  if (idx < TJ_WIN) { src = p.w_in; dst = p.w_in_t; scale = p.norm_mix; K = 1024; N = 3864; kind = 1; }
  else if ((idx -= TJ_WIN) < TJ_C1) { src = p.ck_w1; dst = p.cw1_t; K = 2048; N = 256; }
  else if ((idx -= TJ_C1) < TJ_C1) { src = p.cv_w1; dst = p.cw1_t + 256 * 2048; K = 2048; N = 256; }
  else if ((idx -= TJ_C1) < TJ_C2) { src = p.ck_w2; dst = p.cw2_t; K = 256; N = 64; }
  else if ((idx -= TJ_C2) < TJ_C2) { src = p.cv_w2; dst = p.cw2_t + 256 * 256; K = 256; N = 64; }
  else if ((idx -= TJ_C2) < TJ_WA) { src = p.w_ba; dst = p.wa_t; K = 512; N = 1024; }
  else if ((idx -= TJ_WA) < TJ_WO) { src = p.w_out; dst = p.wo_t; K = 1024; N = 1024; }
  else if ((idx -= TJ_WO) < TJ_W1) { src = p.w_ff1; dst = p.w1_t; scale = p.norm_mlp; K = 1024; N = 4096; }
  else { idx -= TJ_W1; src = p.w_ff2; dst = p.w2_t; K = 4096; N = 1024; kind = 2; }
  const int nk = K >> 6;
  const int k0 = (idx % nk) * 64, n0 = (idx / nk) * 64;
  float* tile = (float*)(smem + half * 16640);
  __syncthreads();
#pragma unroll
  for (int i = 0; i < 4; ++i) {
    const int kk = (tid >> 4) + 16 * i, nn = (tid & 15) * 4;
    const int nd = n0 + nn;
    int sc;
    if (kind == 1) sc = nd < 1280 ? nd : (nd < 3840 ? nd + 24 : (nd < 3864 ? nd - 2560 : -1));
    else sc = nd < N ? nd : -1;
    float4 v = make_float4(0.f, 0.f, 0.f, 0.f);
    if (sc >= 0) v = *(const float4*)(src + (size_t)(k0 + kk) * N + sc);
    if (scale) { float s = scale[k0 + kk]; v.x *= s; v.y *= s; v.z *= s; v.w *= s; }
    tile[kk * 65 + nn + 0] = v.x; tile[kk * 65 + nn + 1] = v.y; tile[kk * 65 + nn + 2] = v.z; tile[kk * 65 + nn + 3] = v.w;
  }
  __syncthreads();
  {
    const int n = tid >> 2, kq = (tid & 3) * 16;
    unsigned o[8];
#pragma unroll
    for (int j = 0; j < 8; ++j) o[j] = pack_bf2(tile[(kq + 2 * j) * 65 + n], tile[(kq + 2 * j + 1) * 65 + n]);
    u32x4* d = (kind == 2) ? (u32x4*)(dst + ((size_t)(k0 >> 6) * 1024 + (n0 + n)) * 64 + kq)
                           : (u32x4*)(dst + (size_t)(n0 + n) * K + k0 + kq);
    u32x4 o0 = {o[0], o[1], o[2], o[3]}, o1 = {o[4], o[5], o[6], o[7]};
    d[0] = o0; d[1] = o1;
  }
}

DI void p0_weff(const Params& p, int item, char* smem) {
  const int g = item >> 4, n0 = (item & 15) * 64, tid = threadIdx.x;
  float* pw = (float*)smem;
  float* ws = (float*)(smem + 66048);
  __syncthreads();
  for (int e = tid; e < 128 * 128; e += NTHR) { const int c = e >> 7, d = e & 127; pw[c * 129 + d] = p.pool_w[(size_t)g * 16384 + e] * p.pool_scale[g * 128 + d]; }
  for (int e = tid; e < 128 * 64; e += NTHR) { const int d = e >> 6, n = e & 63; ws[e] = p.w_bp[(size_t)(g * 128 + d) * 1024 + n0 + n]; }
  __syncthreads();
  const int c = tid & 127, nq = (tid >> 7) * 16;
  float a[16];
#pragma unroll
  for (int j = 0; j < 16; ++j) a[j] = 0.f;
  for (int d = 0; d < 128; ++d) {
    const float w = pw[c * 129 + d];
#pragma unroll
    for (int j = 0; j < 16; ++j) a[j] += w * ws[d * 64 + nq + j];
  }
#pragma unroll
  for (int j = 0; j < 16; ++j) p.wbe_t[(size_t)(n0 + nq + j) * 512 + g * 128 + c] = (u16)(pack_bf2(a[j], 0.f) & 0xffffu);
}

DI void p0_cbias(const Params& p, int idx, char* smem) {
  const int kv = idx >> 3, nc = idx & 7, tid = threadIdx.x, n = tid & 31, part = tid >> 5;
  const float* pe = kv ? p.pe_v : p.pe_k;
  const float* w1 = kv ? p.cv_w1 : p.ck_w1;
  float s = 0.f;
  for (int k = part * 128; k < part * 128 + 128; ++k) s += pe[k] * w1[(size_t)k * 256 + nc * 32 + n];
  float* red = (float*)smem;
  __syncthreads();
  red[part * 32 + n] = s;
  __syncthreads();
  if (tid < 32) {
    float t = 0.f;
#pragma unroll
    for (int j = 0; j < 16; ++j) t += red[j * 32 + tid];
    p.cbias[kv * 256 + nc * 32 + tid] = t;
  }
}

DI void p0_rope(const Params& p, int idx) {
  const int e = idx * NTHR + threadIdx.x;
  const int pos = e >> 3, i = e & 7;
  const float inv = powf(500000.0f, -(float)(2 * i) / 16.0f);
  const float ang = (float)pos * inv;
  float sn, cs;
  sincosf(ang, &sn, &cs);
  p.rope[e] = make_float2(cs, sn);
}

DI void p2a_pool_item(const Params& p, int item) {
  const int idx = item * NTHR + threadIdx.x;
  const int t = idx >> 6, ch = (idx & 63) * 8;
  const int grp = ch >> 7, wlen = 2 << grp, s = t & (SEQ - 1);
  const int cnt = min(s + 1, wlen);
  float a[8];
#pragma unroll
  for (int j = 0; j < 8; ++j) a[j] = 0.f;
  const u16* base = p.ub + (size_t)t * 512 + ch;
  u32x4 v[16];
#pragma unroll
  for (int k = 0; k < 16; ++k) { v[k] = (u32x4){0u, 0u, 0u, 0u}; if (k < cnt) v[k] = *(const u32x4*)(base - (size_t)k * 512); }
  const u32x4 cur = v[0];
#pragma unroll
  for (int k = 0; k < 16; ++k) {
#pragma unroll
    for (int j = 0; j < 4; ++j) { a[2 * j] += bf_lo(v[k][j]); a[2 * j + 1] += bf_hi(v[k][j]); }
  }
  const float ic = 1.f / (float)cnt;
  u32x4 o;
#pragma unroll
  for (int j = 0; j < 4; ++j) o[j] = pack_bf2(a[2 * j] * ic - bf_lo(cur[j]), a[2 * j + 1] * ic - bf_hi(cur[j]));
  *(u32x4*)(p.pooled + (size_t)t * 512 + ch) = o;
}

constexpr int AT_P = 65536, AT_S = 98304, AT_M = 131072;
template <int MODE>
DI void attn_tiles(const u16* __restrict__ Kg, const u16* __restrict__ Vg, int j0, int j1, char* smem,
                   const bf16x8 (&qf)[4], float& m, float& l, f32x16 (&O)[2], int lo, int hi, int lo_max, int hi_min,
                   unsigned mlo, unsigned mhi, float inv_l, int tok_l, int tid) {
  const int lane = tid & 63, l31 = lane & 31, h = lane >> 5;
  const int lk = tid >> 3, lc = tid & 7;
  const int kwr = lk * 128 + ((lc ^ ((lk >> 1) & 7)) << 4);
  const int vwr = 16384 + (lc >> 2) * 4096 + lk * 64 + (lc & 3) * 16;
  const int f = (l31 >> 1) & 7;
  const int krd = l31 * 128;
  int kx[4];
#pragma unroll
  for (int ks = 0; ks < 4; ++ks) kx[ks] = ((2 * ks + h) ^ f) << 4;
  const lds_cptr vrd = (lds_cptr)smem + 16384 + ((lane >> 4) & 1) * 32 + (lane & 3) * 8 + (4 * h + ((lane & 15) >> 2)) * 64;
  const int goff = lk * 64 + lc * 8;
  u32x4 rk, rv;
  rk = *(const u32x4*)(Kg + (size_t)j0 * 4096 + goff);
  if (MODE != 0) rv = *(const u32x4*)(Vg + (size_t)j0 * 4096 + goff);
  for (int j = j0; j <= j1; ++j) {
    const int bo = ((j - j0) & 1) * 8192;
    *(u32x4*)(smem + bo + kwr) = rk;
    if (MODE != 0) *(u32x4*)(smem + bo + vwr) = rv;
    __syncthreads();
    if (j < j1) {
      rk = *(const u32x4*)(Kg + (size_t)(j + 1) * 4096 + goff);
      if (MODE != 0) rv = *(const u32x4*)(Vg + (size_t)(j + 1) * 4096 + goff);
    }
    bool bit = true;
    if (MODE == 2) {
      bit = ((j < 32 ? (mlo >> j) : (mhi >> (j - 32))) & 1u) != 0;
      if (__ballot(bit) == 0ull) continue;
    }
    f32x16 s0 = zero16(), s1 = zero16();
#pragma unroll
    for (int ks = 0; ks < 4; ++ks) {
      bf16x8 a0 = *(const bf16x8*)(smem + bo + krd + kx[ks]);
      bf16x8 a1 = *(const bf16x8*)(smem + bo + krd + 4096 + kx[ks]);
      s0 = mfma32(a0, qf[ks], s0);
      s1 = mfma32(a1, qf[ks], s1);
    }
    const bool need_mask = (64 * j < lo_max) || (64 * j + 63 > hi_min);
    const int rlo = lo - 64 * j - 4 * h, span = hi - lo;
    if (need_mask) {
#pragma unroll
      for (int i = 0; i < 16; ++i) {
        const int c0 = 8 * (i >> 2) + (i & 3);
        if ((unsigned)(c0 - rlo) > (unsigned)span || span < 0) s0[i] = NEGF;
        if ((unsigned)(c0 + 32 - rlo) > (unsigned)span || span < 0) s1[i] = NEGF;
      }
    }
    float msub;
    if (MODE == 1) {
      msub = m;
    } else {
      float mx = s0[0];
#pragma unroll
      for (int i = 1; i < 16; ++i) mx = fmaxf(mx, s0[i]);
#pragma unroll
      for (int i = 0; i < 16; ++i) mx = fmaxf(mx, s1[i]);
      mx = fmaxf(mx, __shfl_xor(mx, 32));
      if (MODE == 2) mx = bit ? mx : NEGF;
      const float mn = fmaxf(m, mx);
      const float alpha = __builtin_amdgcn_exp2f(m - mn);
      m = mn;
      l *= alpha;
      if (MODE != 0) {
        if (__ballot(alpha != 1.f) != 0ull) {
#pragma unroll
          for (int i = 0; i < 16; ++i) { O[0][i] *= alpha; O[1][i] *= alpha; }
        }
      }
      msub = (MODE == 2 && !bit) ? 1e30f : mn;
    }
    msub = fmaxf(msub, -1e29f);
    float rs = 0.f;
#pragma unroll
    for (int i = 0; i < 16; ++i) {
      float p0 = __builtin_amdgcn_exp2f(s0[i] - msub), p1 = __builtin_amdgcn_exp2f(s1[i] - msub);
      if (MODE == 1) { p0 *= inv_l; p1 *= inv_l; }
      s0[i] = p0; s1[i] = p1;
      rs += p0 + p1;
    }
    l += rs;
    if (MODE == 0) continue;
    if (MODE == 1) {
      float* ps = (float*)(smem + AT_P) + tok_l * 256 + 64 * j + 4 * h;
#pragma unroll
      for (int gq = 0; gq < 4; ++gq) {
        float4 a, b;
        float t;
        t = s0[4 * gq + 0]; t += __shfl_xor(t, 1); t += __shfl_xor(t, 2); a.x = t;
        t = s0[4 * gq + 1]; t += __shfl_xor(t, 1); t += __shfl_xor(t, 2); a.y = t;
        t = s0[4 * gq + 2]; t += __shfl_xor(t, 1); t += __shfl_xor(t, 2); a.z = t;
        t = s0[4 * gq + 3]; t += __shfl_xor(t, 1); t += __shfl_xor(t, 2); a.w = t;
        t = s1[4 * gq + 0]; t += __shfl_xor(t, 1); t += __shfl_xor(t, 2); b.x = t;
        t = s1[4 * gq + 1]; t += __shfl_xor(t, 1); t += __shfl_xor(t, 2); b.y = t;
        t = s1[4 * gq + 2]; t += __shfl_xor(t, 1); t += __shfl_xor(t, 2); b.z = t;
        t = s1[4 * gq + 3]; t += __shfl_xor(t, 1); t += __shfl_xor(t, 2); b.w = t;
        if ((l31 & 3) == 0) { *(float4*)(ps + 8 * gq) = a; *(float4*)(ps + 32 + 8 * gq) = b; }
      }
    }
#pragma unroll
    for (int s4 = 0; s4 < 4; ++s4) {
      u32x4 pk;
      if (s4 < 2) {
#pragma unroll
        for (int jj = 0; jj < 4; ++jj) pk[jj] = pack_bf2(s0[8 * (s4 & 1) + 2 * jj], s0[8 * (s4 & 1) + 2 * jj + 1]);
      } else {
#pragma unroll
        for (int jj = 0; jj < 4; ++jj) pk[jj] = pack_bf2(s1[8 * (s4 & 1) + 2 * jj], s1[8 * (s4 & 1) + 2 * jj + 1]);
      }
      const bf16x8 pb = __builtin_bit_cast(bf16x8, pk);
#pragma unroll
      for (int dt = 0; dt < 2; ++dt) {
        s16x4 vlo = vtr(vrd + bo + dt * 4096 + s4 * 1024);
        s16x4 vhi = vtr(vrd + bo + dt * 4096 + s4 * 1024 + 512);
        bf16x8 vf = __builtin_shufflevector(vlo, vhi, 0, 1, 2, 3, 4, 5, 6, 7);
        O[dt] = mfma32(vf, pb, O[dt]);
      }
    }
  }
  __syncthreads();
}

template <int MODE>
DI void attn_tiles_pipe(const u16* __restrict__ Kg, const u16* __restrict__ Vg, int j0, int j1, char* smem,
                        const bf16x8 (&qf)[4], float& m, float& l, f32x16 (&O)[2], int lo, int hi, int lo_max, int hi_min,
                        unsigned mlo, unsigned mhi, int tid) {
  const int lane = tid & 63, l31 = lane & 31, h = lane >> 5;
  const int lk = tid >> 3, lc = tid & 7;
  const int kwr = lk * 128 + ((lc ^ ((lk >> 1) & 7)) << 4);
  const int vwr = 16384 + (lc >> 2) * 4096 + lk * 64 + (lc & 3) * 16;
  const int f = (l31 >> 1) & 7;
  const int krd = l31 * 128;
  int kx[4];
#pragma unroll
  for (int ks = 0; ks < 4; ++ks) kx[ks] = ((2 * ks + h) ^ f) << 4;
  const lds_cptr vrd = (lds_cptr)smem + 16384 + ((lane >> 4) & 1) * 32 + (lane & 3) * 8 + (4 * h + ((lane & 15) >> 2)) * 64;
  const int goff = lk * 64 + lc * 8;
  u32x4 rk, rv;
  auto qk_tile = [&](int bufoff, f32x16& d0, f32x16& d1) __attribute__((always_inline)) {
    bf16x8 ka[4], kb[4];
#pragma unroll
    for (int ks = 0; ks < 4; ++ks) { ka[ks] = *(const bf16x8*)(smem + bufoff + krd + kx[ks]); kb[ks] = *(const bf16x8*)(smem + bufoff + krd + 4096 + kx[ks]); }
    d0 = mfma32(ka[0], qf[0], zero16()); d1 = mfma32(kb[0], qf[0], zero16());
#pragma unroll
    for (int ks = 1; ks < 4; ++ks) { d0 = mfma32(ka[ks], qf[ks], d0); d1 = mfma32(kb[ks], qf[ks], d1); }
  };
  auto active = [&](int j) __attribute__((always_inline)) -> bool {
    if (MODE != 2) return true;
    const bool b = ((j < 32 ? (mlo >> j) : (mhi >> (j - 32))) & 1u) != 0;
    return __ballot(b) != 0ull;
  };
  auto step = [&](int j, bool act_c, bool& act_n, f32x16& c0, f32x16& c1, f32x16& n0, f32x16& n1) __attribute__((always_inline)) {
    const int par = (j - j0) & 1;
    const int bo = par * 8192, bn = (par ^ 1) * 8192;
    if (j < j1) *(u32x4*)(smem + bn + kwr) = rk;
    *(u32x4*)(smem + bo + vwr) = rv;
    __syncthreads();
    if (j + 2 <= j1) rk = *(const u32x4*)(Kg + (size_t)(j + 2) * 4096 + goff);
    if (j + 1 <= j1) rv = *(const u32x4*)(Vg + (size_t)(j + 1) * 4096 + goff);
    act_n = false;
    if (j < j1) { act_n = active(j + 1); if (act_n) qk_tile(bn, n0, n1); }
    if (!act_c) return;
    bool bit = true;
    if (MODE == 2) bit = ((j < 32 ? (mlo >> j) : (mhi >> (j - 32))) & 1u) != 0;
    const bool need_mask = (64 * j < lo_max) || (64 * j + 63 > hi_min);
    if (need_mask) {
      const int rlo = lo - 64 * j - 4 * h, span = hi - lo;
#pragma unroll
      for (int i = 0; i < 16; ++i) {
        const int cc = 8 * (i >> 2) + (i & 3);
        if ((unsigned)(cc - rlo) > (unsigned)span || span < 0) c0[i] = NEGF;
        if ((unsigned)(cc + 32 - rlo) > (unsigned)span || span < 0) c1[i] = NEGF;
      }
    }
    float mx = c0[0];
#pragma unroll
    for (int i = 1; i < 16; ++i) mx = fmaxf(mx, c0[i]);
#pragma unroll
    for (int i = 0; i < 16; ++i) mx = fmaxf(mx, c1[i]);
    mx = fmaxf(mx, __shfl_xor(mx, 32));
    if (MODE == 2) mx = bit ? mx : NEGF;
    const float mn = fmaxf(m, mx);
    const float alpha = __builtin_amdgcn_exp2f(m - mn);
    m = mn;
    l *= alpha;
    if (__ballot(alpha != 1.f) != 0ull) {
#pragma unroll
      for (int i = 0; i < 16; ++i) { O[0][i] *= alpha; O[1][i] *= alpha; }
    }
    const float msub = (MODE == 2 && !bit) ? 1e30f : fmaxf(mn, -1e29f);
    bf16x8 vf[4][2];
#pragma unroll
    for (int s4 = 0; s4 < 4; ++s4)
#pragma unroll
      for (int dt = 0; dt < 2; ++dt) {
        s16x4 vlo = vtr(vrd + bo + dt * 4096 + s4 * 1024);
        s16x4 vhi = vtr(vrd + bo + dt * 4096 + s4 * 1024 + 512);
        vf[s4][dt] = __builtin_shufflevector(vlo, vhi, 0, 1, 2, 3, 4, 5, 6, 7);
      }
    float rs = 0.f;
#pragma unroll
    for (int i = 0; i < 16; ++i) {
      const float p0 = __builtin_amdgcn_exp2f(c0[i] - msub), p1 = __builtin_amdgcn_exp2f(c1[i] - msub);
      c0[i] = p0; c1[i] = p1;
      rs += p0 + p1;
    }
    l += rs;
#pragma unroll
    for (int s4 = 0; s4 < 4; ++s4) {
      u32x4 pk;
      if (s4 < 2) {
#pragma unroll
        for (int jj = 0; jj < 4; ++jj) pk[jj] = pack_bf2(c0[8 * (s4 & 1) + 2 * jj], c0[8 * (s4 & 1) + 2 * jj + 1]);
      } else {
#pragma unroll
        for (int jj = 0; jj < 4; ++jj) pk[jj] = pack_bf2(c1[8 * (s4 & 1) + 2 * jj], c1[8 * (s4 & 1) + 2 * jj + 1]);
      }
      const bf16x8 pb = __builtin_bit_cast(bf16x8, pk);
      O[0] = mfma32(vf[s4][0], pb, O[0]);
      O[1] = mfma32(vf[s4][1], pb, O[1]);
    }
  };
  rk = *(const u32x4*)(Kg + (size_t)j0 * 4096 + goff);
  rv = *(const u32x4*)(Vg + (size_t)j0 * 4096 + goff);
  *(u32x4*)(smem + kwr) = rk;
  if (j0 < j1) rk = *(const u32x4*)(Kg + (size_t)(j0 + 1) * 4096 + goff);
  __syncthreads();
  f32x16 a0, a1, b0, b1;
  bool actA = true, actB = false;
  qk_tile(0, a0, a1);
  for (int j = j0; j <= j1; j += 2) {
    step(j, actA, actB, a0, a1, b0, b1);
    if (j + 1 <= j1) step(j + 1, actB, actA, b0, b1, a0, a1);
  }
  __syncthreads();
}

constexpr int RING = 6;
DI void glds16(const u16* g, char* lds) {
  __builtin_amdgcn_global_load_lds((const unsigned*)g, (LAS unsigned*)lds, 16, 0, 0);
}
template <int MODE>
DI void attn_tiles_ring(const u16* __restrict__ Kg, const u16* __restrict__ Vg, int j0, int j1, char* smem,
                        const bf16x8 (&qf)[4], float& m, float& l, f32x16 (&O)[2], int lo, int hi, int lo_max, int hi_min,
                        unsigned mlo, unsigned mhi, int tid) {
  const int lane = tid & 63, l31 = lane & 31, h = lane >> 5;
  const int f = (l31 >> 1) & 7;
  const int krd = l31 * 128;
  int kx[4];
#pragma unroll
  for (int ks = 0; ks < 4; ++ks) kx[ks] = ((2 * ks + h) ^ f) << 4;
  const int vrdo = 8192 + ((lane >> 4) & 1) * 32 + (lane & 3) * 8 + (4 * h + ((lane & 15) >> 2)) * 64;
  const lds_cptr lbase = (lds_cptr)smem;
  const int ksrc = (tid >> 3) * 64 + (((tid & 7) ^ (((tid >> 3) >> 1) & 7)) << 3);
  const int vsrc = ((tid >> 2) & 63) * 64 + (((tid >> 8) * 4 + (tid & 3)) << 3);
  const int dma = tid * 16;
  auto issue = [&](int t, int st) __attribute__((always_inline)) {
    const int tc = t < j1 ? t : j1;
    glds16(Kg + (size_t)tc * 4096 + ksrc, smem + st * 16384 + dma);
    glds16(Vg + (size_t)tc * 4096 + vsrc, smem + st * 16384 + 8192 + dma);
  };
  auto qk_tile = [&](int st, f32x16& d0, f32x16& d1) __attribute__((always_inline)) {
    const char* kb_ = smem + st * 16384;
    bf16x8 ka[4], kb[4];
#pragma unroll
    for (int ks = 0; ks < 4; ++ks) { ka[ks] = *(const bf16x8*)(kb_ + krd + kx[ks]); kb[ks] = *(const bf16x8*)(kb_ + krd + 4096 + kx[ks]); }
    d0 = mfma32(ka[0], qf[0], zero16()); d1 = mfma32(kb[0], qf[0], zero16());
#pragma unroll
    for (int ks = 1; ks < 4; ++ks) { d0 = mfma32(ka[ks], qf[ks], d0); d1 = mfma32(kb[ks], qf[ks], d1); }
  };
  auto active = [&](int j) __attribute__((always_inline)) -> bool {
    if (MODE != 2) return true;
    const bool b = ((j < 32 ? (mlo >> j) : (mhi >> (j - 32))) & 1u) != 0;
    return __ballot(b) != 0ull;
  };
  int st_cur = 0, st_iss = 5;
  auto step = [&](int j, bool act_c, bool& act_n, f32x16& c0, f32x16& c1, f32x16& n0, f32x16& n1) __attribute__((always_inline)) {
    asm volatile("s_waitcnt vmcnt(6)" ::: "memory");
    __builtin_amdgcn_s_barrier();
    issue(j + 5, st_iss);
    const int st_nxt = (st_cur == RING - 1) ? 0 : st_cur + 1;
    act_n = false;
    if (j < j1) { act_n = active(j + 1); if (act_n) qk_tile(st_nxt, n0, n1); }
    if (act_c) {
      bool bit = true;
      if (MODE == 2) bit = ((j < 32 ? (mlo >> j) : (mhi >> (j - 32))) & 1u) != 0;
      const bool need_mask = (64 * j < lo_max) || (64 * j + 63 > hi_min);
      if (need_mask) {
        const int rlo = lo - 64 * j - 4 * h, span = hi - lo;
#pragma unroll
        for (int i = 0; i < 16; ++i) {
          const int cc = 8 * (i >> 2) + (i & 3);
          if ((unsigned)(cc - rlo) > (unsigned)span || span < 0) c0[i] = NEGF;
          if ((unsigned)(cc + 32 - rlo) > (unsigned)span || span < 0) c1[i] = NEGF;
        }
      }
      float mx = c0[0];
#pragma unroll
      for (int i = 1; i < 16; ++i) mx = fmaxf(mx, c0[i]);
#pragma unroll
      for (int i = 0; i < 16; ++i) mx = fmaxf(mx, c1[i]);
      mx = fmaxf(mx, __shfl_xor(mx, 32));
      if (MODE == 2) mx = bit ? mx : NEGF;
      const float mn = fmaxf(m, mx);
      const float alpha = __builtin_amdgcn_exp2f(m - mn);
      m = mn;
      l *= alpha;
      if (__ballot(alpha != 1.f) != 0ull) {
#pragma unroll
        for (int i = 0; i < 16; ++i) { O[0][i] *= alpha; O[1][i] *= alpha; }
      }
      const float msub = (MODE == 2 && !bit) ? 1e30f : fmaxf(mn, -1e29f);
      const lds_cptr vb = lbase + st_cur * 16384 + vrdo;
      bf16x8 vf[4][2];
#pragma unroll
      for (int s4 = 0; s4 < 4; ++s4)
#pragma unroll
        for (int dt = 0; dt < 2; ++dt) {
          s16x4 vlo = vtr(vb + dt * 4096 + s4 * 1024);
          s16x4 vhi = vtr(vb + dt * 4096 + s4 * 1024 + 512);
          vf[s4][dt] = __builtin_shufflevector(vlo, vhi, 0, 1, 2, 3, 4, 5, 6, 7);
        }
      float rs = 0.f;
#pragma unroll
      for (int i = 0; i < 16; ++i) {
        const float p0 = __builtin_amdgcn_exp2f(c0[i] - msub), p1 = __builtin_amdgcn_exp2f(c1[i] - msub);
        c0[i] = p0; c1[i] = p1;
        rs += p0 + p1;
      }
      l += rs;
#pragma unroll
      for (int s4 = 0; s4 < 4; ++s4) {
        u32x4 pk;
        if (s4 < 2) {
#pragma unroll
          for (int jj = 0; jj < 4; ++jj) pk[jj] = pack_bf2(c0[8 * (s4 & 1) + 2 * jj], c0[8 * (s4 & 1) + 2 * jj + 1]);
        } else {
#pragma unroll
          for (int jj = 0; jj < 4; ++jj) pk[jj] = pack_bf2(c1[8 * (s4 & 1) + 2 * jj], c1[8 * (s4 & 1) + 2 * jj + 1]);
        }
        const bf16x8 pb = __builtin_bit_cast(bf16x8, pk);
        O[0] = mfma32(vf[s4][0], pb, O[0]);
        O[1] = mfma32(vf[s4][1], pb, O[1]);
      }
    }
    st_cur = st_nxt;
    st_iss = (st_iss == RING - 1) ? 0 : st_iss + 1;
  };
#pragma unroll
  for (int i = 0; i < 5; ++i) issue(j0 + i, i);
  asm volatile("s_waitcnt vmcnt(8)" ::: "memory");
  __builtin_amdgcn_s_barrier();
  f32x16 a0, a1, b0, b1;
  bool actA = true, actB = false;
  qk_tile(0, a0, a1);
  for (int j = j0; j <= j1; j += 2) {
    step(j, actA, actB, a0, a1, b0, b1);
    if (j + 1 <= j1) step(j + 1, actB, actA, b0, b1, a0, a1);
  }
  asm volatile("s_waitcnt vmcnt(0)" ::: "memory");
  __syncthreads();
}

DI void attn_cmp(const u16* __restrict__ Kc, const u16* __restrict__ Vc, int nct, char* smem, const bf16x8 (&qf)[4],
                 f32x16 (&O)[2], int hi, int hi_min, int tok_l, int tid) {
  const int lane = tid & 63, l31 = lane & 31, h = lane >> 5;
  const int f = (l31 >> 1) & 7;
  const int krd = l31 * 128;
  int kx[4];
#pragma unroll
  for (int ks = 0; ks < 4; ++ks) kx[ks] = ((2 * ks + h) ^ f) << 4;
  const int vrdo = 8192 + ((lane >> 4) & 1) * 32 + (lane & 3) * 8 + (4 * h + ((lane & 15) >> 2)) * 64;
  const lds_cptr lbase = (lds_cptr)smem;
  const int ksrc = (tid >> 3) * 64 + (((tid & 7) ^ (((tid >> 3) >> 1) & 7)) << 3);
  const int vsrc = ((tid >> 2) & 63) * 64 + (((tid >> 8) * 4 + (tid & 3)) << 3);
#pragma unroll
  for (int t = 0; t < 4; ++t) {
    const int tc = t < nct ? t : nct - 1;
    glds16(Kc + (size_t)tc * 4096 + ksrc, smem + t * 16384 + tid * 16);
    glds16(Vc + (size_t)tc * 4096 + vsrc, smem + t * 16384 + 8192 + tid * 16);
  }
  asm volatile("s_waitcnt vmcnt(0)" ::: "memory");
  __syncthreads();
  f32x16 S[4][2];
  float mx = NEGF;
#pragma unroll
  for (int t = 0; t < 4; ++t) {
    if (t < nct) {
      const char* kb_ = smem + t * 16384;
      bf16x8 ka[4], kb[4];
#pragma unroll
      for (int ks = 0; ks < 4; ++ks) { ka[ks] = *(const bf16x8*)(kb_ + krd + kx[ks]); kb[ks] = *(const bf16x8*)(kb_ + krd + 4096 + kx[ks]); }
      S[t][0] = mfma32(ka[0], qf[0], zero16()); S[t][1] = mfma32(kb[0], qf[0], zero16());
#pragma unroll
      for (int ks = 1; ks < 4; ++ks) { S[t][0] = mfma32(ka[ks], qf[ks], S[t][0]); S[t][1] = mfma32(kb[ks], qf[ks], S[t][1]); }
      if (64 * t + 63 > hi_min) {
        const int rhi = hi - 64 * t - 4 * h;
#pragma unroll
        for (int i = 0; i < 16; ++i) {
          const int cc = 8 * (i >> 2) + (i & 3);
          if (cc > rhi) S[t][0][i] = NEGF;
          if (cc + 32 > rhi) S[t][1][i] = NEGF;
        }
      }
#pragma unroll
      for (int i = 0; i < 16; ++i) mx = fmaxf(mx, fmaxf(S[t][0][i], S[t][1][i]));
    }
  }
  mx = fmaxf(mx, __shfl_xor(mx, 32));
  const float msub = fmaxf(mx, -1e29f);
  float ls = 0.f;
#pragma unroll
  for (int t = 0; t < 4; ++t)
    if (t < nct) {
#pragma unroll
      for (int i = 0; i < 16; ++i) {
        S[t][0][i] = __builtin_amdgcn_exp2f(S[t][0][i] - msub); S[t][1][i] = __builtin_amdgcn_exp2f(S[t][1][i] - msub);
        ls += S[t][0][i] + S[t][1][i];
      }
    }
  ls += __shfl_xor(ls, 32);
  const float inv_l = 1.f / fmaxf(ls, 1e-30f);
  O[0] = zero16(); O[1] = zero16();
#pragma unroll
  for (int t = 0; t < 4; ++t)
    if (t < nct) {
      f32x16& s0 = S[t][0];
      f32x16& s1 = S[t][1];
#pragma unroll
      for (int i = 0; i < 16; ++i) { s0[i] *= inv_l; s1[i] *= inv_l; }
      float* ps = (float*)(smem + AT_P) + tok_l * 256 + 64 * t + 4 * h;
#pragma unroll
      for (int gq = 0; gq < 4; ++gq) {
        float4 a, b;
        float u;
        u = s0[4 * gq + 0]; u += __shfl_xor(u, 1); u += __shfl_xor(u, 2); a.x = u;
        u = s0[4 * gq + 1]; u += __shfl_xor(u, 1); u += __shfl_xor(u, 2); a.y = u;
        u = s0[4 * gq + 2]; u += __shfl_xor(u, 1); u += __shfl_xor(u, 2); a.z = u;
        u = s0[4 * gq + 3]; u += __shfl_xor(u, 1); u += __shfl_xor(u, 2); a.w = u;
        u = s1[4 * gq + 0]; u += __shfl_xor(u, 1); u += __shfl_xor(u, 2); b.x = u;
        u = s1[4 * gq + 1]; u += __shfl_xor(u, 1); u += __shfl_xor(u, 2); b.y = u;
        u = s1[4 * gq + 2]; u += __shfl_xor(u, 1); u += __shfl_xor(u, 2); b.z = u;
        u = s1[4 * gq + 3]; u += __shfl_xor(u, 1); u += __shfl_xor(u, 2); b.w = u;
        if ((l31 & 3) == 0) { *(float4*)(ps + 8 * gq) = a; *(float4*)(ps + 32 + 8 * gq) = b; }
      }
      const lds_cptr vb = lbase + t * 16384 + vrdo;
#pragma unroll
      for (int s4 = 0; s4 < 4; ++s4) {
        u32x4 pk;
        if (s4 < 2) {
#pragma unroll
          for (int jj = 0; jj < 4; ++jj) pk[jj] = pack_bf2(s0[8 * (s4 & 1) + 2 * jj], s0[8 * (s4 & 1) + 2 * jj + 1]);
        } else {
#pragma unroll
          for (int jj = 0; jj < 4; ++jj) pk[jj] = pack_bf2(s1[8 * (s4 & 1) + 2 * jj], s1[8 * (s4 & 1) + 2 * jj + 1]);
        }
        const bf16x8 pb = __builtin_bit_cast(bf16x8, pk);
#pragma unroll
        for (int dt = 0; dt < 2; ++dt) {
          s16x4 vlo = vtr(vb + dt * 4096 + s4 * 1024);
          s16x4 vhi = vtr(vb + dt * 4096 + s4 * 1024 + 512);
          bf16x8 vf = __builtin_shufflevector(vlo, vhi, 0, 1, 2, 3, 4, 5, 6, 7);
          O[dt] = mfma32(vf, pb, O[dt]);
        }
      }
    }
  __syncthreads();
}

DI void attn_item(const Params& p, int bg, int qt, char* smem) {
  const int tid = opaque_tid(), lane = tid & 63, w = tid >> 6, l31 = lane & 31, h = lane >> 5;
  const int b = bg >> 1, g = bg & 1;
  const int t0 = qt * 64;
  const int tok_l = w * 8 + (l31 >> 2);
  const int tpos = t0 + tok_l;
  const int r = l31 & 3;
  const size_t tglob = (size_t)b * SEQ + tpos;
  bf16x8 qf[4];
  {
    const u16* qp = p.qb + tglob * 512 + (g * 4 + r) * 64 + h * 8;
#pragma unroll
    for (int ks = 0; ks < 4; ++ks) qf[ks] = *(const bf16x8*)(qp + ks * 16);
  }
  const float g0 = p.gate[tglob * 24 + 0 + g * 4 + r];
  const float g1 = p.gate[tglob * 24 + 8 + g * 4 + r];
  const float g2 = p.gate[tglob * 24 + 16 + g * 4 + r];
  const int cur = t0 >> 6;
  f32x16 O[2];
  float m, l;
  unsigned* stash = (unsigned*)(smem + AT_S) + w * 1024 + lane;
  {
    const u16* Kc = p.kcmp + (size_t)bg * 256 * 64;
    const u16* Vc = p.vcmp + (size_t)bg * 256 * 64;
    const int nct = ((t0 + 32) >> 10) + 1;
    const int hi = (tpos - 31) >> 4;
    const int hi_min = (t0 - 31) >> 4;
    attn_cmp(Kc, Vc, nct, smem, qf, O, hi, hi_min, tok_l, tid);
    const float* Ps = (const float*)(smem + AT_P);
    unsigned long long* Ms = (unsigned long long*)(smem + AT_M);
    const int ncv = nct * 64;
    for (int tl = 0; tl < 8; ++tl) {
      const int tokl = w * 8 + tl;
      const int j = lane;
      const float* pr = Ps + tokl * 256;
      float imp = 0.f;
      if (4 * j < ncv) {
        float4 v = *(const float4*)(pr + 4 * j);
        imp = 2.f * (v.x + v.y + v.z) + v.w;
        if (j > 0) imp += pr[4 * j - 1];
      }
      unsigned key = ((__float_as_uint(imp) & ~63u) | (unsigned)(63 - j)) + 64u;
      if (j > cur) key = (unsigned)(63 - j);
      if (j == 0 || j == cur || j == cur - 1) key = 0xFFFFFF00u | (unsigned)(63 - j);
      unsigned* kl = (unsigned*)(smem + w * 256);
      kl[lane] = key;
      int cnt = 0;
#pragma unroll
      for (int k4 = 0; k4 < 16; ++k4) {
        const u32x4 q = *(const u32x4*)(kl + 4 * k4);
        cnt += (q[0] > key) + (q[1] > key) + (q[2] > key) + (q[3] > key);
      }
      unsigned long long bal = __ballot(cnt < 16);
      if (lane == 0) Ms[tokl] = bal;
    }
  }
  __syncthreads();
  unsigned mlo, mhi;
  {
    const unsigned* Mw = (const unsigned*)(smem + AT_M);
    mlo = Mw[tok_l * 2]; mhi = Mw[tok_l * 2 + 1];
  }
#pragma unroll
  for (int i = 0; i < 8; ++i) { stash[i * 64] = pack_bf2(g0 * O[0][2 * i], g0 * O[0][2 * i + 1]); stash[(8 + i) * 64] = pack_bf2(g0 * O[1][2 * i], g0 * O[1][2 * i + 1]); }
  {
    m = NEGF; l = 0.f;
    O[0] = zero16(); O[1] = zero16();
    attn_tiles_ring<2>(p.kvb + (size_t)(2 * 16 + bg) * SEQ * 64, p.kvb + (size_t)(3 * 16 + bg) * SEQ * 64, 0, cur, smem, qf, m, l, O,
                  0, tpos, 0, t0, mlo, mhi, tid);
    const float lt = l + __shfl_xor(l, 32);
    const float sc = g1 / fmaxf(lt, 1e-30f);
#pragma unroll
    for (int i = 0; i < 8; ++i) {
      const unsigned u0 = stash[i * 64], u1 = stash[(8 + i) * 64];
      stash[i * 64] = pack_bf2(bf_lo(u0) + sc * O[0][2 * i], bf_hi(u0) + sc * O[0][2 * i + 1]);
      stash[(8 + i) * 64] = pack_bf2(bf_lo(u1) + sc * O[1][2 * i], bf_hi(u1) + sc * O[1][2 * i + 1]);
    }
  }
  {
    m = NEGF; l = 0.f;
    O[0] = zero16(); O[1] = zero16();
    const int jlo = max(t0 - 511, 0) >> 6;
    attn_tiles_ring<3>(p.kvb + (size_t)(4 * 16 + bg) * SEQ * 64, p.kvb + (size_t)(5 * 16 + bg) * SEQ * 64, jlo, cur, smem, qf, m, l, O,
                  tpos - 511, tpos, t0 + 63 - 511, t0, 0u, 0u, tid);
    const float lt = l + __shfl_xor(l, 32);
    const float sc = g2 / fmaxf(lt, 1e-30f);
#pragma unroll
    for (int i = 0; i < 8; ++i) {
      const unsigned u0 = stash[i * 64], u1 = stash[(8 + i) * 64];
      O[0][2 * i] = bf_lo(u0) + sc * O[0][2 * i]; O[0][2 * i + 1] = bf_hi(u0) + sc * O[0][2 * i + 1];
      O[1][2 * i] = bf_lo(u1) + sc * O[1][2 * i]; O[1][2 * i + 1] = bf_hi(u1) + sc * O[1][2 * i + 1];
    }
  }
  u16* op = p.ob + tglob * 512 + (g * 4 + r) * 64 + 4 * h;
#pragma unroll
  for (int dt = 0; dt < 2; ++dt)
#pragma unroll
    for (int gq = 0; gq < 4; ++gq) {
      u32x2 o = {pack_bf2(O[dt][4 * gq], O[dt][4 * gq + 1]), pack_bf2(O[dt][4 * gq + 2], O[dt][4 * gq + 3])};
      *(u32x2*)(op + dt * 32 + 8 * gq) = o;
    }
}

DI void p10_rows(const Params& p, int item) {
  const int w = threadIdx.x >> 6, lane = threadIdx.x & 63;
  const int row = item * 8 + w;
  float s = (lane < 16) ? p.ssq2[(size_t)row * 16 + lane] : 0.f;
#pragma unroll
  for (int o = 8; o; o >>= 1) s += __shfl_xor(s, o);
  s = __shfl(s, 0);
  const float rs = rsqrtf(s * (1.f / DM) + 1e-6f);
  float4* o4 = (float4*)(p.out + (size_t)row * DM);
  const float4* g4 = (const float4*)p.norm_final;
#pragma unroll
  for (int i = 0; i < 4; ++i) {
    float4 v = o4[lane + 64 * i], g = g4[lane + 64 * i];
    v.x *= rs * g.x; v.y *= rs * g.y; v.z *= rs * g.z; v.w *= rs * g.w;
    o4[lane + 64 * i] = v;
  }
}


#define XB_TMO      128
#define XB_XCNT(j)  (256  + 64 * (j))
#define XB_XSUB(j)  (1280 + 64 * (j))
#define XB_XGEN(j)  (2304 + 64 * (j))
#define XB_TOP      3328
#define XB_TOPGEN   3392
#define XCD_BAR_WORDS 3456
#define XB_SPIN_CAP (1u << 18)
DI unsigned xb_xcc_id() { return (unsigned)__builtin_amdgcn_s_getreg((3 << 11) | 20) & 0xFu; }
#define XB_SPIN(cond, bar) do { unsigned _sp = 0; while (cond) { __builtin_amdgcn_s_sleep(1); \
    if ((++_sp & 255u) == 0u) { if (xb_ld(&(bar)[XB_TMO])) break; if (_sp > XB_SPIN_CAP) { atomicAdd(&(bar)[XB_TMO], 1u); break; } } } } while (0)
struct XcdBarrier { unsigned* bar; unsigned x; volatile LAS unsigned* st; };
DI XcdBarrier xcd_barrier_post(unsigned* bar, volatile LAS unsigned* st) {
  XcdBarrier b; b.bar = bar; b.x = xb_xcc_id(); b.st = st;
  if (threadIdx.x == 0) (void)xb_add(&bar[XB_XCNT(b.x)], 1u);
  return b;
}
DI void xcd_barrier_complete(unsigned* bar, unsigned x, unsigned& nloc, unsigned& nx) {
  const unsigned G = gridDim.x * gridDim.y * gridDim.z;
  unsigned sum, cnt, mine, sp = 0u;
  for (;;) {
    sum = 0u; cnt = 0u; mine = 0u;
#pragma unroll
    for (unsigned j = 0; j < 16; ++j) { const unsigned c = xb_ld(&bar[XB_XCNT(j)]); sum += c; cnt += (c > 0u) ? 1u : 0u; mine = (j == x) ? c : mine; }
    if (sum == G) break;
    __builtin_amdgcn_s_sleep(1);
    if ((++sp & 255u) == 0u) { if (xb_ld(&bar[XB_TMO])) break; if (sp > XB_SPIN_CAP) { atomicAdd(&bar[XB_TMO], 1u); break; } }
  }
  nloc = mine > 0u ? mine : 1u; nx = cnt > 0u ? cnt : 1u;
}
DI void xcd_barrier(const XcdBarrier& b) {
  asm volatile("s_waitcnt vmcnt(0)" ::: "memory");
  __syncthreads();
  if (threadIdx.x == 0) {
    unsigned* bar = b.bar;
    __builtin_amdgcn_s_waitcnt(0);
    unsigned nloc = b.st[0], nx = b.st[1];
    if (nloc == 0u) { xcd_barrier_complete(bar, b.x, nloc, nx); b.st[0] = nloc; b.st[1] = nx; }
    const unsigned old = xb_add(&bar[XB_XSUB(b.x)], 1u);
    const unsigned gen = old / nloc;
    if (old + 1u == (gen + 1u) * nloc) {
      __builtin_amdgcn_fence(__ATOMIC_RELEASE, "agent");
      asm volatile("s_waitcnt vmcnt(0)" ::: "memory");
      const unsigned og = xb_add(&bar[XB_TOP], 1u);
      const unsigned tg = og / nx;
      if (og + 1u == (tg + 1u) * nx) xb_add(&bar[XB_TOPGEN], 1u);
      else XB_SPIN(xb_ld(&bar[XB_TOPGEN]) == tg, bar);
      __builtin_amdgcn_fence(__ATOMIC_ACQUIRE, "agent");
      xb_add(&bar[XB_XGEN(b.x)], 1u);
      asm volatile("s_waitcnt vmcnt(0)" ::: "memory");
    } else {
      XB_SPIN(xb_ld(&bar[XB_XGEN(b.x)]) == gen, bar);
      __builtin_amdgcn_fence(__ATOMIC_ACQUIRE, "agent");
      asm volatile("s_waitcnt vmcnt(0)" ::: "memory");
    }
  }
  __syncthreads();
}

__global__ void __launch_bounds__(NTHR, 2) nsa_pool_block_fwd(Params p) {
  extern __shared__ __attribute__((aligned(16))) unsigned char shm[];
  char* smem = (char*)shm;
  LAS unsigned char* lds = (LAS unsigned char*)shm;
  cg::grid_group grid = cg::this_grid();
  const int G = gridDim.x;
  const int bid = blockIdx.x;
  const int L = (G % 8 == 0) ? (bid % 8) * (G / 8) + bid / 8 : bid;
  volatile LAS unsigned* xst = (volatile LAS unsigned*)(lds + 133120);
  if (threadIdx.x < 4) xst[threadIdx.x] = 0u;
  __syncthreads();
  const XcdBarrier xb = xcd_barrier_post(p.bar, xst);

  if (PH_MASK & 1)
  {
    constexpr int N0 = 1024, N1 = N0 + TJ_EARLY / 2, N2 = N1 + 64, N3 = N2 + 16, N4 = N3 + 64;
    for (int rep = 0; rep < ((REP_MASK & 1) ? 2 : 1); ++rep)
    for (int it = N4 - 1 - bid; it >= 0; it -= G) {
      if (it < N0) p0_rows(p, it);
      else if (it < N1) p0_transpose(p, it - N0, smem, 0);
      else if (it < N2) p0_weff(p, it - N1, smem);
      else if (it < N3) p0_cbias(p, it - N2, smem);
      else p0_rope(p, it - N3);
    }
  }
  if (p.bar == nullptr) grid.sync();
  xcd_barrier(xb);
  if (PH_MASK & 2) {
    Sched S{0, G, bid};
    EpiProj E{p};
    for (int rep = 0; rep < ((REP_MASK & 2) ? 2 : 1); ++rep)
    gemm_phase(lds, Gemm{p.xb, p.w_in_t, DM, DM, DM, 128, 128}, S, E);
  }
  xcd_barrier(xb);
  if (PH_MASK & 4) for (int rep = 0; rep < ((REP_MASK & 4) ? 2 : 1); ++rep)
  {
    Sched S{2, G, bid};
    EpiCmpHid E{(float*)p.mb};
    gemm_phase(lds, Gemm{p.kvb, p.cw1_t, 1024, 2048, 512, 128, 128}, S, E);
    for (int it = bid; it < 4096; it += G) p2a_pool_item(p, it);
  }
  xcd_barrier(xb);
  if (PH_MASK & 8) {
    Sched S{3, G, bid};
    EpiCmpOut E{p};
    for (int i = 0;; ++i) {
      Unit u;
      if (!S.next(i, u)) break;
      const float* h32 = (const float*)p.mb;
      const float* bias = p.cbias + u.pn * 256;
      for (int e0 = threadIdx.x; e0 < 8192; e0 += 4 * NTHR) {
        f32x4 pv[4][4][2];
#pragma unroll
        for (int q = 0; q < 4; ++q) {
          const int e = e0 + q * NTHR, c = e >> 5, n8 = (e & 31) * 8;
#pragma unroll
          for (int ks = 0; ks < 4; ++ks) {
            const f32x4* sp = (const f32x4*)(h32 + ((size_t)((ks * 32 + u.pm) * 256 + c)) * 256 + n8);
            pv[q][ks][0] = sp[0]; pv[q][ks][1] = sp[1];
          }
        }
#pragma unroll
        for (int q = 0; q < 4; ++q) {
          const int e = e0 + q * NTHR, c = e >> 5, n8 = (e & 31) * 8;
          f32x4 v0 = *(const f32x4*)(bias + n8), v1 = *(const f32x4*)(bias + n8 + 4);
#pragma unroll
          for (int ks = 0; ks < 4; ++ks) { v0 += pv[q][ks][0]; v1 += pv[q][ks][1]; }
#pragma unroll
          for (int j = 0; j < 4; ++j) { v0[j] = gelu_tanh(v0[j]); v1[j] = gelu_tanh(v1[j]); }
          *(u32x4*)(p.hid + ((size_t)u.pm * 256 + c) * 256 + n8) = pack8(v0, v1);
        }
      }
    }
    asm volatile("s_waitcnt vmcnt(0)" ::: "memory");
    __syncthreads();
    gemm_phase(lds, Gemm{p.hid, p.cw2_t, 256, 256, 256, 128, 128}, S, E);
    { Unit u0; const bool has_unit = S.next(0, u0);
      if (G >= 256) {
        if (!has_unit) {
          const int rank = bid - (bid >> 3) - (((bid & 7) > ((bid >> 3) & 7)) ? 1 : 0);
          for (int it = rank; it < (TJ_TOTAL - TJ_EARLY) / 2; it += G - 32) p0_transpose(p, it, smem, TJ_EARLY);
        }
      } else {
        __syncthreads();
        for (int it = bid; it < (TJ_TOTAL - TJ_EARLY) / 2; it += G) p0_transpose(p, it, smem, TJ_EARLY);
      }
    }
  }
  xcd_barrier(xb);
  if (ATTN_PRIO) { if (threadIdx.x >= 256) __builtin_amdgcn_s_setprio(2); }
  if (PH_MASK & 16) for (int rep = 0; rep < ((REP_MASK & 16) ? 2 : 1); ++rep)
  if (G == 256) {
    const int x = bid & 7, j = bid >> 3;
    for (int rd = 0; rd < 4; ++rd) {
      const int idx = rd * 32 + ((rd & 1) ? (31 - j) : j);
      attn_item(p, 2 * x + (idx & 1), 63 - (idx >> 1), smem);
    }
  } else
  for (int rd = 0; rd * G < 1024; ++rd) {
    const int i = rd * G + ((rd & 1) ? (G - 1 - L) : L);
    if (i < 1024) attn_item(p, i & 15, 63 - (i >> 4), smem);
  }
  xcd_barrier(xb);
  if (ATTN_PRIO) __builtin_amdgcn_s_setprio(0);
  if (PH_MASK & 32) {
    Sched S{1, G, bid};
    EpiMerge<0> E0{p};
    EpiMerge<1> E1{p};
    for (int rep = 0; rep < ((REP_MASK & 32) ? 2 : 1); ++rep) {
    gemm_phase(lds, Gemm{p.ob, p.wa_t, 512, 512, 512, 128, 128}, S, E0);
    gemm_phase(lds, Gemm{p.pooled, p.wbe_t, 512, 512, 512, 128, 128}, S, E1);
    }
  }
  xcd_barrier(xb);
  if (PH_MASK & 64) {
    Sched S{1, G, bid};
    EpiResid<true> E{p.x, p.out, p.xb, p.ssq};
    for (int rep = 0; rep < ((REP_MASK & 64) ? 2 : 1); ++rep)
    gemm_phase(lds, Gemm{p.mb, p.wo_t, DM, DM, DM, 128, 128}, S, E);
  }
  xcd_barrier(xb);
  if (PH_MASK & 128) {
    Sched S{0, G, bid};
    EpiFF1 E{p};
    for (int rep = 0; rep < ((REP_MASK & 128) ? 2 : 1); ++rep)
    gemm_phase(lds, Gemm{p.xb, p.w1_t, DM, DM, DM, 128, 128}, S, E);
  }
  xcd_barrier(xb);
#if FUSE_FINAL
  if (PH_MASK & 256) {
    Sched S{1, G, bid};
    EpiFinal E{p.out, p.norm_final, p.ssq2, p.bar + XCD_BAR_WORDS};
    gemm_phase(lds, Gemm{p.act, p.w2_t, 64, 64, 4096, (size_t)T_TOK * 128, (size_t)1024 * 128}, S, E);
  }
#else
  if (PH_MASK & 256) {
    Sched S{1, G, bid};
    EpiResid<false> E{p.out, p.out, nullptr, p.ssq2};
    gemm_phase(lds, Gemm{p.act, p.w2_t, 64, 64, 4096, (size_t)T_TOK * 128, (size_t)1024 * 128}, S, E);
  }
  xcd_barrier(xb);
  for (int it = bid; it < 4096; it += G) p10_rows(p, it);
#endif
}

extern "C" void kernel_launch(void* const* d_in, const int* in_sizes, int n_in, void* d_out, int out_size, void* d_ws,
                              size_t ws_size, hipStream_t stream) {
  (void)in_sizes; (void)n_in; (void)out_size; (void)ws_size;
  static int grid_blocks = 0;
  if (!grid_blocks) {
    int dev = 0, cus = 0, per_cu = 0;
    (void)hipGetDevice(&dev);
    (void)hipDeviceGetAttribute(&cus, hipDeviceAttributeMultiprocessorCount, dev);
    (void)hipFuncSetAttribute((const void*)nsa_pool_block_fwd, hipFuncAttributeMaxDynamicSharedMemorySize, LDS_BYTES);
    (void)hipOccupancyMaxActiveBlocksPerMultiprocessor(&per_cu, nsa_pool_block_fwd, NTHR, LDS_BYTES);
    if (per_cu > 1) per_cu = 1;
    if (per_cu < 1) per_cu = 1;
    grid_blocks = cus * per_cu;
  }
  Params p{};
  const float* const* in = (const float* const*)d_in;
  p.x = in[0]; p.norm_mix = in[1]; p.w_in = in[2]; p.pe_k = in[3]; p.pe_v = in[4]; p.ck_w1 = in[5]; p.ck_w2 = in[6];
  p.cv_w1 = in[7]; p.cv_w2 = in[8]; p.w_ba = in[9]; p.pool_w = in[10]; p.pool_scale = in[11]; p.w_bp = in[12];
  p.w_out = in[13]; p.norm_mlp = in[14]; p.w_ff1 = in[15]; p.w_ff2 = in[16]; p.norm_final = in[17];
  p.out = (float*)d_out;
  char* ws = (char*)d_ws;
  size_t off = 0;
  auto take = [&](size_t bytes) { char* r = ws + off; off += (bytes + 255) & ~(size_t)255; return r; };
  const size_t T = T_TOK;
  p.xb = (u16*)take(T * 1024 * 2);
  p.w_in_t = (u16*)take((size_t)NPROJ * 1024 * 2);
  p.wa_t = (u16*)take(1024 * 512 * 2);
  p.wbe_t = (u16*)take(1024 * 512 * 2);
  p.wo_t = (u16*)take(1024 * 1024 * 2);
  p.w1_t = (u16*)take((size_t)4096 * 1024 * 2);
  p.w2_t = (u16*)take((size_t)4096 * 1024 * 2);
  p.cw1_t = (u16*)take(2 * 256 * 2048 * 2);
  p.cw2_t = (u16*)take(2 * 256 * 256 * 2);
  p.rstd0 = (float*)take(T * 4);
  p.cbias = (float*)take(512 * 4);
  p.rope = (float2*)take((size_t)SEQ * 8 * 8);
  p.ssq = (float*)take(T * 16 * 4);
  p.ssq2 = (float*)take(T * 16 * 4);
  p.mb = (u16*)take(T * 1024 * 2);
  char* regionD = ws + off;
  p.qb = (u16*)take(T * 512 * 2);
  p.kvb = (u16*)take((size_t)6 * 16 * SEQ * 64 * 2);
  p.gate = (float*)take(T * 24 * 4);
  p.ub = (u16*)take(T * 512 * 2);
  p.gm = (u16*)take(T * 2048 * 2);
  p.hid = (u16*)take((size_t)2 * 16 * 256 * 256 * 2);
  p.kcmp = (u16*)take(16 * 256 * 64 * 2);
  p.vcmp = (u16*)take(16 * 256 * 64 * 2);
  p.pooled = (u16*)take(T * 512 * 2);
  p.ob = (u16*)take(T * 512 * 2);
  p.bar = (unsigned*)take((XCD_BAR_WORDS + 4096) * 4);
  p.act = (u16*)regionD;
  (void)hipMemsetAsync(p.bar, 0, (XCD_BAR_WORDS + 4096) * 4, stream);
  void* args[] = {&p};
  hipError_t e = hipLaunchCooperativeKernel((void*)nsa_pool_block_fwd, dim3(grid_blocks), dim3(NTHR), args, LDS_BYTES, stream);
  if (e != hipSuccess) fprintf(stderr, "cooperative launch failed: %s (grid %d)\n", hipGetErrorString(e), grid_blocks);
}
```

```cpp
#include <hip/hip_runtime.h>
#include <hip/hip_cooperative_groups.h>
#include <stdint.h>
#include <stdio.h>
namespace cg = cooperative_groups;

#define DI __device__ __forceinline__
#define LAS __attribute__((address_space(3)))
typedef unsigned short u16;
typedef __attribute__((ext_vector_type(8))) short bf16x8;
typedef __attribute__((ext_vector_type(4))) short s16x4;
typedef __attribute__((ext_vector_type(16))) float f32x16;
typedef __attribute__((ext_vector_type(4))) float f32x4;
typedef __attribute__((ext_vector_type(4))) unsigned u32x4;
typedef __attribute__((ext_vector_type(2))) unsigned u32x2;
typedef __attribute__((ext_vector_type(2))) float f32x2;
typedef __attribute__((ext_vector_type(2))) __bf16 bf16x2_t;
typedef LAS const char* lds_cptr;

constexpr int T_TOK = 32768, SEQ = 4096, DM = 1024;
constexpr int NPROJ = 4096;
constexpr int NTHR = 512;
constexpr int LDS_BYTES = 135168;
constexpr float NEGF = -1e30f;
constexpr float QSCALE = 0.125f * 1.4426950408889634f;
#ifndef REP_MASK
#define REP_MASK 0
#endif
#ifndef ATTN_PRIO
#define ATTN_PRIO 0
#endif
#ifndef FUSE_FINAL
#define FUSE_FINAL 1
#endif
#ifndef PH_MASK
#define PH_MASK 0xffff
#endif

struct Params {
  const float *x, *norm_mix, *w_in, *pe_k, *pe_v, *ck_w1, *ck_w2, *cv_w1, *cv_w2, *w_ba, *pool_w, *pool_scale, *w_bp,
      *w_out, *norm_mlp, *w_ff1, *w_ff2, *norm_final;
  float* out;
  u16 *xb, *w_in_t, *wa_t, *wbe_t, *wo_t, *w1_t, *w2_t, *cw1_t, *cw2_t;
  float *rstd0, *cbias;
  float2* rope;
  u16 *qb, *kvb;
  float* gate;
  u16 *ub, *gm, *hid, *kcmp, *vcmp, *pooled, *ob, *mb, *act;
  float *ssq, *ssq2;
  unsigned* bar;
};

DI unsigned pack_bf2(float a, float b) {
  f32x2 v = {a, b};
  bf16x2_t r = __builtin_convertvector(v, bf16x2_t);
  return __builtin_bit_cast(unsigned, r);
}
DI float bf_lo(unsigned u) { return __uint_as_float(u << 16); }
DI float bf_hi(unsigned u) { return __uint_as_float(u & 0xffff0000u); }
DI float sigmoidf_(float v) { return __builtin_amdgcn_rcpf(1.f + __builtin_amdgcn_exp2f(-1.4426950408889634f * v)); }
DI float gelu_tanh(float x) {
  float u = 0.7978845608028654f * (x + 0.044715f * x * x * x);
  float th = 1.f - 2.f / (__expf(2.f * u) + 1.f);
  return 0.5f * x * (1.f + th);
}
DI f32x16 mfma32(bf16x8 a, bf16x8 b, f32x16 c) { return __builtin_amdgcn_mfma_f32_32x32x16_bf16(a, b, c, 0, 0, 0); }
DI int opaque_tid() { int t; asm volatile("v_mov_b32 %0, %1" : "=v"(t) : "v"((int)threadIdx.x)); return t; }
DI f32x16 zero16() { f32x16 z; for (int i = 0; i < 16; ++i) z[i] = 0.f; return z; }
DI s16x4 vtr(lds_cptr p) { return __builtin_amdgcn_ds_read_tr16_b64_v4i16((LAS s16x4*)p); }
DI u32x4 pack8(const f32x4& a, const f32x4& b) {
  u32x4 w = {pack_bf2(a[0], a[1]), pack_bf2(a[2], a[3]), pack_bf2(b[0], b[1]), pack_bf2(b[2], b[3])};
  return w;
}

constexpr int BM = 256, BK = 64, HALF = 128, HTB = HALF * BK * 2;
DI int lds_byte(int r, int c) { const int st = (r >> 4) * 2 + (c >> 5), rr = r & 15, cc = c & 31, ob = rr * 64 + cc * 2; return st * 1024 + (ob ^ (((ob >> 9) & 1) << 5)); }
DI void stage_rc(int b, int& R, int& C) { const int st = b / 1024, sb = b % 1024, swz = sb ^ (((sb >> 9) & 1) << 5); R = (st >> 1) * 16 + swz / 64; C = (st & 1) * 32 + (swz % 64) / 2; }
DI int perm32(int rho) { const int n = rho >> 4, i = rho & 15; return 8 * (i >> 2) + 4 * n + (i & 3); }

struct Unit { int pm, pn, k0; };
struct Gemm { const u16* A; const u16* Bt; int lda, ldb, K; size_t kstepA, kstepB; };

struct Sched {
  int mode, G, bid;
  DI bool next(int i, Unit& u) const {
    u.k0 = 0;
    if (mode == 2) {
      int t;
      if (G >= 256) { if (i > 0 || (bid & 1) != ((bid >> 3) & 1) || (bid >> 1) >= 128) return false; t = bid >> 1; }
      else { t = i * G + bid; if (t >= 128) return false; }
      u.pm = t >> 2; u.pn = u.pm >> 4; u.k0 = (t & 3) * 8; return true;
    }
    if (mode == 3) {
      int t;
      if (G >= 256) { t = bid >> 3; if (i > 0 || (bid & 7) != (t & 7) || t >= 32) return false; }
      else { t = i * G + bid; if (t >= 32) return false; }
      u.pm = t; u.pn = t >> 4; return true;
    }
    const int nN = mode == 0 ? 16 : 4;
    if (G == 256) {
      const int x = bid & 7, j = bid >> 3;
      if (mode == 0) { if (i >= 8) return false; u.pn = (x & 3) * 4 + (j & 3); u.pm = (x >> 2) * 64 + i * 8 + (j >> 2); return true; }
      if (i >= 2) return false; u.pn = j & 3; u.pm = x * 16 + i * 8 + (j >> 2); return true;
    }
    const int t = i * G + bid;
    if (t >= nN * 128) return false;
    u.pn = t % nN; u.pm = t / nN; return true;
  }
};

template <class Epi>
DI void gemm_phase(LAS unsigned char* lds, const Gemm g, const Sched& S, const Epi& E) {
  const int tid = opaque_tid(), wid = __builtin_amdgcn_readfirstlane(tid >> 6), lane = tid & 63, wr = wid >> 2, wc = wid & 3, fr = lane & 15, fq = lane >> 4;
  const int nt = g.K / BK;
  unsigned voffA[2], voffB[2];
#pragma unroll
  for (int i = 0; i < 2; ++i) {
    int R, C; stage_rc(tid * 16 + i * 8192, R, C);
    const int Rb = (R & ~31) + perm32(R & 31);
    voffA[i] = (unsigned)(R * g.lda + C) * 2u; voffB[i] = (unsigned)(Rb * g.ldb + C) * 2u;
  }
  const size_t kstep = g.kstepB, kstepA = g.kstepA;
  const size_t hstepA = (size_t)HALF * g.lda * 2, hstepB = (size_t)HALF * g.ldb * 2;
  const size_t tstepA = 2 * hstepA, tstepB = 2 * hstepB;
  const unsigned ldsw = (unsigned)wid * 1024u;
  const int aoff = lds_byte(wr * 64 + fr, fq * 8), boff = lds_byte(wc * 32 + fr, fq * 8);
#define PG8_SA(b, h) (((b) * 2 + (h)) * HTB)
#define PG8_SB(b, h) ((4 + (b) * 2 + (h)) * HTB)
#define PG8_STAGE(bufoff, gbase, voff) do { _Pragma("unroll") for (int _i = 0; _i < 2; ++_i) \
    __builtin_amdgcn_global_load_lds((const unsigned*)((const char*)(gbase) + (voff)[_i]), (LAS unsigned*)(lds + (bufoff) + ldsw + _i * 8192), 16, 0, 0); } while (0)
#define PG8_LDA(dst, b, h) do { _Pragma("unroll") for (int m = 0; m < 4; ++m) _Pragma("unroll") for (int k = 0; k < 2; ++k) dst[m][k] = *(const LAS bf16x8*)(lds + PG8_SA(b, h) + aoff + m * 2048 + k * 1024); } while (0)
#define PG8_LDB(dst, b, h) do { _Pragma("unroll") for (int n = 0; n < 2; ++n) _Pragma("unroll") for (int k = 0; k < 2; ++k) dst[n][k] = *(const LAS bf16x8*)(lds + PG8_SB(b, h) + boff + n * 2048 + k * 1024); } while (0)
#define PG8_MMA(ai, bj, At, Bt) do { __builtin_amdgcn_s_setprio(1); _Pragma("unroll") for (int m = 0; m < 4; ++m) _Pragma("unroll") for (int n = 0; n < 2; ++n) _Pragma("unroll") for (int k = 0; k < 2; ++k) \
    acc[ai][bj][m][n] = __builtin_amdgcn_mfma_f32_16x16x32_bf16(Bt[n][k], At[m][k], acc[ai][bj][m][n], 0, 0, 0); __builtin_amdgcn_s_setprio(0); } while (0)
#define PG8_WAIT_V(n) asm volatile("s_waitcnt vmcnt(" #n ")" ::: "memory")
#define PG8_WAIT_L(n) asm volatile("s_waitcnt lgkmcnt(" #n ")" ::: "memory")
#define PG8_BAR __builtin_amdgcn_s_barrier()
#define PG8_SCHED __builtin_amdgcn_sched_barrier(0)
  Unit cur, nxt; int ui = 0;
  if (!S.next(0, cur)) return;
  f32x4 acc[2][2][4][2];
#pragma unroll
  for (int a = 0; a < 2; ++a)
#pragma unroll
    for (int b = 0; b < 2; ++b)
#pragma unroll
      for (int m = 0; m < 4; ++m)
#pragma unroll
        for (int n = 0; n < 2; ++n) acc[a][b][m][n] = (f32x4){0.f, 0.f, 0.f, 0.f};
  bf16x8 At[4][2], B0[2][2], B1[2][2];
  const char* cA = (const char*)g.A + (size_t)cur.pm * tstepA + (size_t)cur.k0 * kstepA; const char* cB = (const char*)g.Bt + (size_t)cur.pn * tstepB + (size_t)cur.k0 * kstep;
  PG8_STAGE(PG8_SB(0, 0), cB, voffB); PG8_STAGE(PG8_SA(0, 0), cA, voffA); PG8_STAGE(PG8_SB(0, 1), cB + hstepB, voffB); PG8_STAGE(PG8_SA(0, 1), cA + hstepA, voffA);
  if (wr == 1) PG8_BAR;
  PG8_WAIT_V(4); PG8_BAR;
  PG8_STAGE(PG8_SB(1, 0), cB + kstep, voffB); PG8_STAGE(PG8_SA(1, 0), cA + kstepA, voffA); PG8_STAGE(PG8_SB(1, 1), cB + hstepB + kstep, voffB);
  PG8_WAIT_V(6); PG8_BAR;
  for (;;) {
    const bool has_next = S.next(ui + 1, nxt);
    const char* nA = has_next ? (const char*)g.A + (size_t)nxt.pm * tstepA + (size_t)nxt.k0 * kstepA : cA; const char* nB = has_next ? (const char*)g.Bt + (size_t)nxt.pn * tstepB + (size_t)nxt.k0 * kstep : cB;
    for (int t = 0; t < nt; t += 2) {
      const bool last = (t == nt - 2);
      const char* a1 = cA + (size_t)(t + 1) * kstepA;
      const char* a2 = last ? nA : cA + (size_t)(t + 2) * kstepA; const char* b2 = last ? nB : cB + (size_t)(t + 2) * kstep;
      const char* a3 = a2 + kstepA; const char* b3 = b2 + kstep;
      PG8_LDB(B0, 0, 0); PG8_SCHED; PG8_LDA(At, 0, 0); PG8_STAGE(PG8_SA(1, 1), a1 + hstepA, voffA);
      PG8_WAIT_L(8); PG8_BAR; PG8_WAIT_L(0); PG8_MMA(0, 0, At, B0); PG8_BAR; PG8_SCHED;
      PG8_LDB(B1, 0, 1); PG8_STAGE(PG8_SB(0, 0), b2, voffB);
      PG8_BAR; PG8_WAIT_L(0); PG8_MMA(0, 1, At, B1); PG8_BAR;
      PG8_LDA(At, 0, 1); PG8_STAGE(PG8_SA(0, 0), a2, voffA);
      PG8_BAR; PG8_WAIT_L(0); PG8_MMA(1, 0, At, B0); PG8_BAR; PG8_SCHED;
      PG8_STAGE(PG8_SB(0, 1), b2 + hstepB, voffB);
      PG8_WAIT_V(6); PG8_BAR; PG8_MMA(1, 1, At, B1); PG8_BAR;
      PG8_LDB(B0, 1, 0); PG8_SCHED; PG8_LDA(At, 1, 0); PG8_STAGE(PG8_SA(0, 1), a2 + hstepA, voffA);
      PG8_WAIT_L(8); PG8_BAR; PG8_WAIT_L(0); PG8_MMA(0, 0, At, B0); PG8_BAR; PG8_SCHED;
      PG8_LDB(B1, 1, 1); PG8_STAGE(PG8_SB(1, 0), b3, voffB);
      PG8_BAR; PG8_WAIT_L(0); PG8_MMA(0, 1, At, B1); PG8_BAR;
      PG8_LDA(At, 1, 1); PG8_STAGE(PG8_SA(1, 0), a3, voffA);
      PG8_BAR; PG8_WAIT_L(0); PG8_MMA(1, 0, At, B0); PG8_BAR; PG8_SCHED;
      PG8_STAGE(PG8_SB(1, 1), b3 + hstepB, voffB);
      PG8_WAIT_V(6); PG8_BAR; PG8_MMA(1, 1, At, B1); PG8_BAR;
    }
    E(acc, cur, wr, wc, fr, fq);
    if (!has_next) break;
#pragma unroll
    for (int a = 0; a < 2; ++a)
#pragma unroll
      for (int b = 0; b < 2; ++b)
#pragma unroll
        for (int m = 0; m < 4; ++m)
#pragma unroll
          for (int n = 0; n < 2; ++n) acc[a][b][m][n] = (f32x4){0.f, 0.f, 0.f, 0.f};
    cur = nxt; cA = nA; cB = nB; ++ui;
  }
  PG8_WAIT_V(0);
  if (wr == 0) PG8_BAR;
  PG8_BAR;
#undef PG8_SA
#undef PG8_SB
#undef PG8_STAGE
#undef PG8_LDA
#undef PG8_LDB
#undef PG8_MMA
#undef PG8_WAIT_V
#undef PG8_WAIT_L
#undef PG8_BAR
#undef PG8_SCHED
}

typedef f32x4 (&AccRef)[2][2][4][2];
DI unsigned xb_ld(unsigned* p)              { return __hip_atomic_load(p, __ATOMIC_RELAXED, __HIP_MEMORY_SCOPE_AGENT); }
DI unsigned xb_add(unsigned* p, unsigned v) { return __hip_atomic_fetch_add(p, v, __ATOMIC_RELAXED, __HIP_MEMORY_SCOPE_AGENT); }
#define EPI_ROWS for (int ai = 0; ai < 2; ++ai) _Pragma("unroll") for (int m = 0; m < 4; ++m)
#define EPI_ROW(u) ((u).pm * BM + ai * HALF + wr * 64 + m * 16 + fr)
#define EPI_COL(bj) ((bj) * HALF + wc * 32 + fq * 8)

DI void rope8(f32x4& v0, f32x4& v1, const float2* __restrict__ tab, int pos, int fq) {
  const f32x4* t4 = (const f32x4*)(tab + (size_t)pos * 8);
  const f32x4 c0 = t4[0], c1 = t4[1], c2 = t4[2], c3 = t4[3];
  float pv[8];
#pragma unroll
  for (int j = 0; j < 4; ++j) { pv[j] = __shfl_xor(v0[j], 16); pv[4 + j] = __shfl_xor(v1[j], 16); }
  if (fq < 2) {
    const float sg = fq ? 1.f : -1.f;
    v0[0] = v0[0] * c0[0] + sg * pv[0] * c0[1]; v0[1] = v0[1] * c0[2] + sg * pv[1] * c0[3];
    v0[2] = v0[2] * c1[0] + sg * pv[2] * c1[1]; v0[3] = v0[3] * c1[2] + sg * pv[3] * c1[3];
    v1[0] = v1[0] * c2[0] + sg * pv[4] * c2[1]; v1[1] = v1[1] * c2[2] + sg * pv[5] * c2[3];
    v1[2] = v1[2] * c3[0] + sg * pv[6] * c3[1]; v1[3] = v1[3] * c3[2] + sg * pv[7] * c3[3];
  }
}

DI void rope8t(f32x4& v0, f32x4& v1, const f32x4 (&t)[4], int fq) {
  float pv[8];
#pragma unroll
  for (int j = 0; j < 4; ++j) { pv[j] = __shfl_xor(v0[j], 16); pv[4 + j] = __shfl_xor(v1[j], 16); }
  if (fq < 2) {
    const float sg = fq ? 1.f : -1.f;
    v0[0] = v0[0] * t[0][0] + sg * pv[0] * t[0][1]; v0[1] = v0[1] * t[0][2] + sg * pv[1] * t[0][3];
    v0[2] = v0[2] * t[1][0] + sg * pv[2] * t[1][1]; v0[3] = v0[3] * t[1][2] + sg * pv[3] * t[1][3];
    v1[0] = v1[0] * t[2][0] + sg * pv[4] * t[2][1]; v1[1] = v1[1] * t[2][2] + sg * pv[5] * t[2][3];
    v1[2] = v1[2] * t[3][0] + sg * pv[6] * t[3][1]; v1[3] = v1[3] * t[3][2] + sg * pv[7] * t[3][3];
  }
}

struct EpiProj {
  const Params& p;
  DI void operator()(AccRef acc, const Unit& u, int wr, int wc, int fr, int fq) const {
    const int pn = u.pn;
    const bool roped = ((wc & 1) == 0) && (pn < 2 || pn == 3 || pn == 4);
    float rs8[8];
#pragma unroll
    EPI_ROWS rs8[ai * 4 + m] = p.rstd0[EPI_ROW(u)];
#pragma unroll
    for (int ai = 0; ai < 2; ++ai)
#pragma unroll
    for (int mh = 0; mh < 2; ++mh) {
      f32x4 tabx[2][4];
      if (roped) {
#pragma unroll
        for (int mm = 0; mm < 2; ++mm) {
          const int m = mh * 2 + mm;
          const f32x4* t4 = (const f32x4*)(p.rope + (size_t)(EPI_ROW(u) & (SEQ - 1)) * 8);
          tabx[mm][0] = t4[0]; tabx[mm][1] = t4[1]; tabx[mm][2] = t4[2]; tabx[mm][3] = t4[3];
        }
      }
#pragma unroll
      for (int mm = 0; mm < 2; ++mm) {
        const int m = mh * 2 + mm;
        const f32x4 (&tabm)[4] = tabx[mm];
        const int row = EPI_ROW(u);
        const float rs = rs8[ai * 4 + m];
        const int s = row & (SEQ - 1), b = row >> 12;
#pragma unroll
        for (int bj = 0; bj < 2; ++bj) {
          f32x4 v0 = acc[ai][bj][m][0] * rs, v1 = acc[ai][bj][m][1] * rs;
          const int lc = EPI_COL(bj);
          if (pn < 2) {
            if (roped) rope8t(v0, v1, tabm, fq);
            *(u32x4*)(p.qb + (size_t)row * 512 + pn * 256 + lc) = pack8(v0 * QSCALE, v1 * QSCALE);
          } else if (pn < 5) {
            const int which = (pn - 2) * 2 + bj;
            if ((which == 2 || which == 4) && roped) rope8t(v0, v1, tabm, fq);
            const int g = wc >> 1, d = (wc & 1) * 32 + fq * 8;
            *(u32x4*)(p.kvb + ((size_t)((which * 16 + b * 2 + g) * SEQ + s)) * 64 + d) = pack8(v0, v1);
          } else if (pn < 7) {
            *(u32x4*)(p.ub + (size_t)row * 512 + (pn - 5) * 256 + lc) = pack8(v0, v1);
          } else if (pn < 15) {
#pragma unroll
            for (int j = 0; j < 4; ++j) { v0[j] = sigmoidf_(v0[j]); v1[j] = sigmoidf_(v1[j]); }
            *(u32x4*)(p.gm + (size_t)row * 2048 + (pn - 7) * 256 + lc) = pack8(v0, v1);
          } else {
            if (bj == 0 && wc == 0 && fq < 3) {
#pragma unroll
              for (int j = 0; j < 4; ++j) { v0[j] = sigmoidf_(v0[j]); v1[j] = sigmoidf_(v1[j]); }
              f32x4* gp = (f32x4*)(p.gate + (size_t)row * 24 + fq * 8);
              gp[0] = v0; gp[1] = v1;
            }
          }
        }
      }
    }
  }
};

struct EpiCmpHid {
  float* hid32;
  DI void operator()(AccRef acc, const Unit& u, int wr, int wc, int fr, int fq) const {
    float* base = hid32 + ((size_t)((u.k0 >> 3) * 32 + u.pm) * 256) * 256;
#pragma unroll
    EPI_ROWS {
      const int c = ai * HALF + wr * 64 + m * 16 + fr;
#pragma unroll
      for (int bj = 0; bj < 2; ++bj) {
        f32x4* dp = (f32x4*)(base + (size_t)c * 256 + EPI_COL(bj));
        dp[0] = acc[ai][bj][m][0]; dp[1] = acc[ai][bj][m][1];
      }
    }
  }
};

struct EpiCmpOut {
  const Params& p;
  DI void operator()(AccRef acc, const Unit& u, int wr, int wc, int fr, int fq) const {
    const int kv = u.pm >> 4, bg = u.pm & 15;
    const bool roped = (kv == 0) && (wc == 0);
    u16* dst = (kv ? p.vcmp : p.kcmp) + (size_t)bg * 256 * 64;
#pragma unroll
    for (int ai = 0; ai < 2; ++ai) {
      f32x4 tabx[4][4];
      {
#pragma unroll
        for (int m = 0; m < 4; ++m) {
          const int c = ai * HALF + wr * 64 + m * 16 + fr;
          const f32x4* t4 = (const f32x4*)(p.rope + (size_t)min(16 * c + 31, SEQ - 1) * 8);
          tabx[m][0] = t4[0]; tabx[m][1] = t4[1]; tabx[m][2] = t4[2]; tabx[m][3] = t4[3];
        }
      }
#pragma unroll
      for (int m = 0; m < 4; ++m) {
        const int c = ai * HALF + wr * 64 + m * 16 + fr;
        f32x4 v0 = acc[ai][0][m][0], v1 = acc[ai][0][m][1];
        if (roped) rope8t(v0, v1, tabx[m], fq);
        if (c == 255) { v0 = (f32x4){0.f, 0.f, 0.f, 0.f}; v1 = v0; }
        if (wc < 2) *(u32x4*)(dst + c * 64 + wc * 32 + fq * 8) = pack8(v0, v1);
      }
    }
  }
};

template <int PASS>
struct EpiMerge {
  const Params& p;
  DI void operator()(AccRef acc, const Unit& u, int wr, int wc, int fr, int fq) const {
#pragma unroll
    for (int ai = 0; ai < 2; ++ai) {
      u32x4 gq[4][2], ov[4][2];
#pragma unroll
      for (int m = 0; m < 4; ++m)
#pragma unroll
        for (int bj = 0; bj < 2; ++bj) {
          const int row = EPI_ROW(u), col = u.pn * BM + EPI_COL(bj);
          gq[m][bj] = *(const u32x4*)(p.gm + (size_t)row * 2048 + PASS * 1024 + col);
          if (PASS == 1) ov[m][bj] = *(const u32x4*)(p.mb + (size_t)row * 1024 + col);
        }
#pragma unroll
      for (int m = 0; m < 4; ++m) {
        const int row = EPI_ROW(u);
#pragma unroll
        for (int bj = 0; bj < 2; ++bj) {
          const int col = u.pn * BM + EPI_COL(bj);
          const u32x4 g = gq[m][bj];
          f32x4 v0 = acc[ai][bj][m][0], v1 = acc[ai][bj][m][1];
          v0[0] *= bf_lo(g[0]); v0[1] *= bf_hi(g[0]); v0[2] *= bf_lo(g[1]); v0[3] *= bf_hi(g[1]);
          v1[0] *= bf_lo(g[2]); v1[1] *= bf_hi(g[2]); v1[2] *= bf_lo(g[3]); v1[3] *= bf_hi(g[3]);
          if (PASS == 1) {
            const u32x4 o = ov[m][bj];
            v0[0] += bf_lo(o[0]); v0[1] += bf_hi(o[0]); v0[2] += bf_lo(o[1]); v0[3] += bf_hi(o[1]);
            v1[0] += bf_lo(o[2]); v1[1] += bf_hi(o[2]); v1[2] += bf_lo(o[3]); v1[3] += bf_hi(o[3]);
          }
          *(u32x4*)(p.mb + (size_t)row * 1024 + col) = pack8(v0, v1);
        }
      }
    }
  }
};

template <bool WITH_BF16, bool WITH_F32 = true>
struct EpiResid {
  const float* resid; float* out; u16* outb; float* ssq;
  DI void operator()(AccRef acc, const Unit& u, int wr, int wc, int fr, int fq) const {
#pragma unroll
    for (int ai = 0; ai < 2; ++ai) {
      f32x4 rv[4][2][2];
#pragma unroll
      for (int m = 0; m < 4; ++m)
#pragma unroll
        for (int bj = 0; bj < 2; ++bj) {
          const f32x4* rp = (const f32x4*)(resid + (size_t)EPI_ROW(u) * 1024 + u.pn * BM + EPI_COL(bj));
          rv[m][bj][0] = rp[0]; rv[m][bj][1] = rp[1];
        }
#pragma unroll
      for (int m = 0; m < 4; ++m) {
        const int row = EPI_ROW(u);
        float sq = 0.f;
#pragma unroll
        for (int bj = 0; bj < 2; ++bj) {
          const size_t a = (size_t)row * 1024 + u.pn * BM + EPI_COL(bj);
          const f32x4 v0 = rv[m][bj][0] + acc[ai][bj][m][0], v1 = rv[m][bj][1] + acc[ai][bj][m][1];
          if (WITH_F32) { f32x4* op = (f32x4*)(out + a); op[0] = v0; op[1] = v1; }
          if (WITH_BF16) *(u32x4*)(outb + a) = pack8(v0, v1);
#pragma unroll
          for (int j = 0; j < 4; ++j) sq += v0[j] * v0[j] + v1[j] * v1[j];
        }
        sq += __shfl_xor(sq, 16);
        sq += __shfl_xor(sq, 32);
        if (fq == 0) ssq[(size_t)row * 16 + u.pn * 4 + wc] = sq;
      }
    }
  }
};

struct EpiFinal {
  float* out; const u16* x1b; const float* gfin; float* ssq2; unsigned* cnt;
  DI void operator()(AccRef acc, const Unit& u, int wr, int wc, int fr, int fq) const {
#pragma unroll
    for (int ai = 0; ai < 2; ++ai)
#pragma unroll
    for (int mh = 0; mh < 2; ++mh) {
      f32x4 rv[2][2][2];
#pragma unroll
      for (int mm = 0; mm < 2; ++mm)
#pragma unroll
        for (int bj = 0; bj < 2; ++bj) {
          const int m = mh * 2 + mm;
          const u32x4 r8 = *(const u32x4*)(x1b + (size_t)EPI_ROW(u) * 1024 + u.pn * BM + EPI_COL(bj));
          rv[mm][bj][0] = (f32x4){bf_lo(r8[0]), bf_hi(r8[0]), bf_lo(r8[1]), bf_hi(r8[1])};
          rv[mm][bj][1] = (f32x4){bf_lo(r8[2]), bf_hi(r8[2]), bf_lo(r8[3]), bf_hi(r8[3])};
        }
#pragma unroll
      for (int mm = 0; mm < 2; ++mm) {
        const int m = mh * 2 + mm;
        const int row = EPI_ROW(u);
        float sq = 0.f;
#pragma unroll
        for (int bj = 0; bj < 2; ++bj) {
          acc[ai][bj][m][0] += rv[mm][bj][0]; acc[ai][bj][m][1] += rv[mm][bj][1];
#pragma unroll
          for (int j = 0; j < 4; ++j) sq += acc[ai][bj][m][0][j] * acc[ai][bj][m][0][j] + acc[ai][bj][m][1][j] * acc[ai][bj][m][1][j];
        }
        sq += __shfl_xor(sq, 16);
        sq += __shfl_xor(sq, 32);
        if (fq == 0) __hip_atomic_store(ssq2 + (size_t)row * 16 + u.pn * 4 + wc, sq, __ATOMIC_RELAXED, __HIP_MEMORY_SCOPE_AGENT);
      }
    }
    asm volatile("s_waitcnt vmcnt(0)" ::: "memory");
    unsigned* c = cnt + (u.pm * 2 + wr) * 16;
    if (fq == 0 && fr == 0) (void)xb_add(c, 1u);
    { unsigned sp = 0; while (xb_ld(c) < 16u) { __builtin_amdgcn_s_sleep(1); if (++sp > (1u << 20)) break; } }
#pragma unroll
    EPI_ROWS {
      const int row = EPI_ROW(u);
      unsigned long long* sp = (unsigned long long*)(ssq2 + (size_t)row * 16 + fq * 4);
      const unsigned long long q0 = __hip_atomic_load(sp, __ATOMIC_RELAXED, __HIP_MEMORY_SCOPE_AGENT);
      const unsigned long long q1 = __hip_atomic_load(sp + 1, __ATOMIC_RELAXED, __HIP_MEMORY_SCOPE_AGENT);
      float ss = (__uint_as_float((unsigned)q0) + __uint_as_float((unsigned)(q0 >> 32))) + (__uint_as_float((unsigned)q1) + __uint_as_float((unsigned)(q1 >> 32)));
      ss += __shfl_xor(ss, 16);
      ss += __shfl_xor(ss, 32);
      const float rs = rsqrtf(ss * (1.f / DM) + 1e-6f);
#pragma unroll
      for (int bj = 0; bj < 2; ++bj) {
        const int col = u.pn * BM + EPI_COL(bj);
        const f32x4* gp = (const f32x4*)(gfin + col);
        f32x4* op = (f32x4*)(out + (size_t)row * 1024 + col);
        op[0] = acc[ai][bj][m][0] * rs * gp[0]; op[1] = acc[ai][bj][m][1] * rs * gp[1];
      }
    }
  }
};

struct EpiFF1 {
  const Params& p;
  DI void operator()(AccRef acc, const Unit& u, int wr, int wc, int fr, int fq) const {
    f32x4 part[8];
#pragma unroll
    EPI_ROWS part[ai * 4 + m] = *(const f32x4*)(p.ssq + (size_t)EPI_ROW(u) * 16 + fq * 4);
    float rs8[8];
#pragma unroll
    for (int r = 0; r < 8; ++r) {
      float ss = (part[r][0] + part[r][1]) + (part[r][2] + part[r][3]);
      ss += __shfl_xor(ss, 16);
      ss += __shfl_xor(ss, 32);
      rs8[r] = rsqrtf(ss * (1.f / DM) + 1e-6f);
    }
#pragma unroll
    EPI_ROWS {
      const int row = EPI_ROW(u);
      const float rs = rs8[ai * 4 + m];
#pragma unroll
      for (int bj = 0; bj < 2; ++bj) {
        f32x4 v0 = acc[ai][bj][m][0] * rs, v1 = acc[ai][bj][m][1] * rs;
#pragma unroll
        for (int j = 0; j < 4; ++j) { const float r0 = fmaxf(v0[j], 0.f), r1 = fmaxf(v1[j], 0.f); v0[j] = r0 * r0; v1[j] = r1 * r1; }
        const int col = u.pn * BM + EPI_COL(bj);
        *(u32x4*)(p.act + ((size_t)(col >> 6) * T_TOK + row) * 64 + (col & 63)) = pack8(v0, v1);
      }
    }
  }
};

DI void p0_rows(const Params& p, int item) {
  const int w = threadIdx.x >> 6, lane = threadIdx.x & 63;
  const int row0 = item * 32 + w * 4;
  float4 v[4][4];
#pragma unroll
  for (int r = 0; r < 4; ++r) {
    const float4* src = (const float4*)(p.x + (size_t)(row0 + r) * DM);
#pragma unroll
    for (int i = 0; i < 4; ++i) v[r][i] = src[lane + 64 * i];
  }
#pragma unroll
  for (int r = 0; r < 4; ++r) {
    float ss = 0.f;
#pragma unroll
    for (int i = 0; i < 4; ++i) ss += v[r][i].x * v[r][i].x + v[r][i].y * v[r][i].y + v[r][i].z * v[r][i].z + v[r][i].w * v[r][i].w;
#pragma unroll
    for (int o = 32; o; o >>= 1) ss += __shfl_xor(ss, o);
    if (lane == 0) p.rstd0[row0 + r] = rsqrtf(ss * (1.f / DM) + 1e-6f);
    u32x2* dst = (u32x2*)(p.xb + (size_t)(row0 + r) * DM);
#pragma unroll
    for (int i = 0; i < 4; ++i) {
      u32x2 o = {pack_bf2(v[r][i].x, v[r][i].y), pack_bf2(v[r][i].z, v[r][i].w)};
      dst[lane + 64 * i] = o;
    }
  }
}

constexpr int TJ_WIN = 1024, TJ_WA = 128, TJ_WO = 256, TJ_W1 = 1024, TJ_W2 = 1024, TJ_C1 = 128, TJ_C2 = 16;
constexpr int TJ_TOTAL = TJ_WIN + TJ_WA + TJ_WO + TJ_W1 + TJ_W2 + 2 * TJ_C1 + 2 * TJ_C2;

constexpr int TJ_EARLY = TJ_WIN + 2 * TJ_C1 + 2 * TJ_C2;
DI void p0_transpose(const Params& p, int item, char* smem, int base) {
  const int half = threadIdx.x >> 8, tid = threadIdx.x & 255;
  int idx = item * 2 + half + base;
  const float* src; u16* dst; const float* scale = nullptr; int K, N, kind = 0;
  if (idx < TJ_WIN) { src = p.w_in; dst = p.w_in_t; scale = p.norm_mix; K = 1024; N = 3864; kind = 1; }
  else if ((idx -= TJ_WIN) < TJ_C1) { src = p.ck_w1; dst = p.cw1_t; K = 2048; N = 256; }
  else if ((idx -= TJ_C1) < TJ_C1) { src = p.cv_w1; dst = p.cw1_t + 256 * 2048; K = 2048; N = 256; }
  else if ((idx -= TJ_C1) < TJ_C2) { src = p.ck_w2; dst = p.cw2_t; K = 256; N = 64; }
  else if ((idx -= TJ_C2) < TJ_C2) { src = p.cv_w2; dst = p.cw2_t + 256 * 256; K = 256; N = 64; }
  else if ((idx -= TJ_C2) < TJ_WA) { src = p.w_ba; dst = p.wa_t; K = 512; N = 1024; }
  else if ((idx -= TJ_WA) < TJ_WO) { src = p.w_out; dst = p.wo_t; K = 1024; N = 1024; }
  else if ((idx -= TJ_WO) < TJ_W1) { src = p.w_ff1; dst = p.w1_t; scale = p.norm_mlp; K = 1024; N = 4096; }
  else { idx -= TJ_W1; src = p.w_ff2; dst = p.w2_t; K = 4096; N = 1024; kind = 2; }
  const int nk = K >> 6;
  const int k0 = (idx % nk) * 64, n0 = (idx / nk) * 64;
  float* tile = (float*)(smem + half * 16640);
  __syncthreads();
#pragma unroll
  for (int i = 0; i < 4; ++i) {
    const int kk = (tid >> 4) + 16 * i, nn = (tid & 15) * 4;
    const int nd = n0 + nn;
    int sc;
    if (kind == 1) sc = nd < 1280 ? nd : (nd < 3840 ? nd + 24 : (nd < 3864 ? nd - 2560 : -1));
    else sc = nd < N ? nd : -1;
    float4 v = make_float4(0.f, 0.f, 0.f, 0.f);
    if (sc >= 0) v = *(const float4*)(src + (size_t)(k0 + kk) * N + sc);
    if (scale) { float s = scale[k0 + kk]; v.x *= s; v.y *= s; v.z *= s; v.w *= s; }
    tile[kk * 65 + nn + 0] = v.x; tile[kk * 65 + nn + 1] = v.y; tile[kk * 65 + nn + 2] = v.z; tile[kk * 65 + nn + 3] = v.w;
  }
  __syncthreads();
  {
    const int n = tid >> 2, kq = (tid & 3) * 16;
    unsigned o[8];
#pragma unroll
    for (int j = 0; j < 8; ++j) o[j] = pack_bf2(tile[(kq + 2 * j) * 65 + n], tile[(kq + 2 * j + 1) * 65 + n]);
    u32x4* d = (kind == 2) ? (u32x4*)(dst + ((size_t)(k0 >> 6) * 1024 + (n0 + n)) * 64 + kq)
                           : (u32x4*)(dst + (size_t)(n0 + n) * K + k0 + kq);
    u32x4 o0 = {o[0], o[1], o[2], o[3]}, o1 = {o[4], o[5], o[6], o[7]};
    d[0] = o0; d[1] = o1;
  }
}

DI void p0_weff(const Params& p, int item, char* smem) {
  const int g = item >> 4, n0 = (item & 15) * 64, tid = threadIdx.x;
  float* pw = (float*)smem;
  float* ws = (float*)(smem + 66048);
  __syncthreads();
  for (int e = tid; e < 128 * 128; e += NTHR) { const int c = e >> 7, d = e & 127; pw[c * 129 + d] = p.pool_w[(size_t)g * 16384 + e] * p.pool_scale[g * 128 + d]; }
  for (int e = tid; e < 128 * 64; e += NTHR) { const int d = e >> 6, n = e & 63; ws[e] = p.w_bp[(size_t)(g * 128 + d) * 1024 + n0 + n]; }
  __syncthreads();
  const int c = tid & 127, nq = (tid >> 7) * 16;
  float a[16];
#pragma unroll
  for (int j = 0; j < 16; ++j) a[j] = 0.f;
  for (int d = 0; d < 128; ++d) {
    const float w = pw[c * 129 + d];
#pragma unroll
    for (int j = 0; j < 16; ++j) a[j] += w * ws[d * 64 + nq + j];
  }
#pragma unroll
  for (int j = 0; j < 16; ++j) p.wbe_t[(size_t)(n0 + nq + j) * 512 + g * 128 + c] = (u16)(pack_bf2(a[j], 0.f) & 0xffffu);
}

DI void p0_cbias(const Params& p, int idx, char* smem) {
  const int kv = idx >> 3, nc = idx & 7, tid = threadIdx.x, n = tid & 31, part = tid >> 5;
  const float* pe = kv ? p.pe_v : p.pe_k;
  const float* w1 = kv ? p.cv_w1 : p.ck_w1;
  float s = 0.f;
  for (int k = part * 128; k < part * 128 + 128; ++k) s += pe[k] * w1[(size_t)k * 256 + nc * 32 + n];
  float* red = (float*)smem;
  __syncthreads();
  red[part * 32 + n] = s;
  __syncthreads();
  if (tid < 32) {
    float t = 0.f;
#pragma unroll
    for (int j = 0; j < 16; ++j) t += red[j * 32 + tid];
    p.cbias[kv * 256 + nc * 32 + tid] = t;
  }
}

DI void p0_rope(const Params& p, int idx) {
  const int e = idx * NTHR + threadIdx.x;
  const int pos = e >> 3, i = e & 7;
  const float inv = powf(500000.0f, -(float)(2 * i) / 16.0f);
  const float ang = (float)pos * inv;
  float sn, cs;
  sincosf(ang, &sn, &cs);
  p.rope[e] = make_float2(cs, sn);
}

DI void p2a_pool_item(const Params& p, int item) {
  const int idx = item * NTHR + threadIdx.x;
  const int t = idx >> 6, ch = (idx & 63) * 8;
  const int grp = ch >> 7, wlen = 2 << grp, s = t & (SEQ - 1);
  const int cnt = min(s + 1, wlen);
  float a[8];
#pragma unroll
  for (int j = 0; j < 8; ++j) a[j] = 0.f;
  const u16* base = p.ub + (size_t)t * 512 + ch;
  u32x4 v[16];
#pragma unroll
  for (int k = 0; k < 16; ++k) { v[k] = (u32x4){0u, 0u, 0u, 0u}; if (k < cnt) v[k] = *(const u32x4*)(base - (size_t)k * 512); }
  const u32x4 cur = v[0];
#pragma unroll
  for (int k = 0; k < 16; ++k) {
#pragma unroll
    for (int j = 0; j < 4; ++j) { a[2 * j] += bf_lo(v[k][j]); a[2 * j + 1] += bf_hi(v[k][j]); }
  }
  const float ic = 1.f / (float)cnt;
  u32x4 o;
#pragma unroll
  for (int j = 0; j < 4; ++j) o[j] = pack_bf2(a[2 * j] * ic - bf_lo(cur[j]), a[2 * j + 1] * ic - bf_hi(cur[j]));
  *(u32x4*)(p.pooled + (size_t)t * 512 + ch) = o;
}

constexpr int AT_P = 65536, AT_S = 98304, AT_M = 131072;
template <int MODE>
DI void attn_tiles(const u16* __restrict__ Kg, const u16* __restrict__ Vg, int j0, int j1, char* smem,
                   const bf16x8 (&qf)[4], float& m, float& l, f32x16 (&O)[2], int lo, int hi, int lo_max, int hi_min,
                   unsigned mlo, unsigned mhi, float inv_l, int tok_l, int tid) {
  const int lane = tid & 63, l31 = lane & 31, h = lane >> 5;
  const int lk = tid >> 3, lc = tid & 7;
  const int kwr = lk * 128 + ((lc ^ ((lk >> 1) & 7)) << 4);
  const int vwr = 16384 + (lc >> 2) * 4096 + lk * 64 + (lc & 3) * 16;
  const int f = (l31 >> 1) & 7;
  const int krd = l31 * 128;
  int kx[4];
#pragma unroll
  for (int ks = 0; ks < 4; ++ks) kx[ks] = ((2 * ks + h) ^ f) << 4;
  const lds_cptr vrd = (lds_cptr)smem + 16384 + ((lane >> 4) & 1) * 32 + (lane & 3) * 8 + (4 * h + ((lane & 15) >> 2)) * 64;
  const int goff = lk * 64 + lc * 8;
  u32x4 rk, rv;
  rk = *(const u32x4*)(Kg + (size_t)j0 * 4096 + goff);
  if (MODE != 0) rv = *(const u32x4*)(Vg + (size_t)j0 * 4096 + goff);
  for (int j = j0; j <= j1; ++j) {
    const int bo = ((j - j0) & 1) * 8192;
    *(u32x4*)(smem + bo + kwr) = rk;
    if (MODE != 0) *(u32x4*)(smem + bo + vwr) = rv;
    __syncthreads();
    if (j < j1) {
      rk = *(const u32x4*)(Kg + (size_t)(j + 1) * 4096 + goff);
      if (MODE != 0) rv = *(const u32x4*)(Vg + (size_t)(j + 1) * 4096 + goff);
    }
    bool bit = true;
    if (MODE == 2) {
      bit = ((j < 32 ? (mlo >> j) : (mhi >> (j - 32))) & 1u) != 0;
      if (__ballot(bit) == 0ull) continue;
    }
    f32x16 s0 = zero16(), s1 = zero16();
#pragma unroll
    for (int ks = 0; ks < 4; ++ks) {
      bf16x8 a0 = *(const bf16x8*)(smem + bo + krd + kx[ks]);
      bf16x8 a1 = *(const bf16x8*)(smem + bo + krd + 4096 + kx[ks]);
      s0 = mfma32(a0, qf[ks], s0);
      s1 = mfma32(a1, qf[ks], s1);
    }
    const bool need_mask = (64 * j < lo_max) || (64 * j + 63 > hi_min);
    const int rlo = lo - 64 * j - 4 * h, span = hi - lo;
    if (need_mask) {
#pragma unroll
      for (int i = 0; i < 16; ++i) {
        const int c0 = 8 * (i >> 2) + (i & 3);
        if ((unsigned)(c0 - rlo) > (unsigned)span || span < 0) s0[i] = NEGF;
        if ((unsigned)(c0 + 32 - rlo) > (unsigned)span || span < 0) s1[i] = NEGF;
      }
    }
    float msub;
    if (MODE == 1) {
      msub = m;
    } else {
      float mx = s0[0];
#pragma unroll
      for (int i = 1; i < 16; ++i) mx = fmaxf(mx, s0[i]);
#pragma unroll
      for (int i = 0; i < 16; ++i) mx = fmaxf(mx, s1[i]);
      mx = fmaxf(mx, __shfl_xor(mx, 32));
      if (MODE == 2) mx = bit ? mx : NEGF;
      const float mn = fmaxf(m, mx);
      const float alpha = __builtin_amdgcn_exp2f(m - mn);
      m = mn;
      l *= alpha;
      if (MODE != 0) {
        if (__ballot(alpha != 1.f) != 0ull) {
#pragma unroll
          for (int i = 0; i < 16; ++i) { O[0][i] *= alpha; O[1][i] *= alpha; }
        }
      }
      msub = (MODE == 2 && !bit) ? 1e30f : mn;
    }
    msub = fmaxf(msub, -1e29f);
    float rs = 0.f;
#pragma unroll
    for (int i = 0; i < 16; ++i) {
      float p0 = __builtin_amdgcn_exp2f(s0[i] - msub), p1 = __builtin_amdgcn_exp2f(s1[i] - msub);
      if (MODE == 1) { p0 *= inv_l; p1 *= inv_l; }
      s0[i] = p0; s1[i] = p1;
      rs += p0 + p1;
    }
    l += rs;
    if (MODE == 0) continue;
    if (MODE == 1) {
      float* ps = (float*)(smem + AT_P) + tok_l * 256 + 64 * j + 4 * h;
#pragma unroll
      for (int gq = 0; gq < 4; ++gq) {
        float4 a, b;
        float t;
        t = s0[4 * gq + 0]; t += __shfl_xor(t, 1); t += __shfl_xor(t, 2); a.x = t;
        t = s0[4 * gq + 1]; t += __shfl_xor(t, 1); t += __shfl_xor(t, 2); a.y = t;
        t = s0[4 * gq + 2]; t += __shfl_xor(t, 1); t += __shfl_xor(t, 2); a.z = t;
        t = s0[4 * gq + 3]; t += __shfl_xor(t, 1); t += __shfl_xor(t, 2); a.w = t;
        t = s1[4 * gq + 0]; t += __shfl_xor(t, 1); t += __shfl_xor(t, 2); b.x = t;
        t = s1[4 * gq + 1]; t += __shfl_xor(t, 1); t += __shfl_xor(t, 2); b.y = t;
        t = s1[4 * gq + 2]; t += __shfl_xor(t, 1); t += __shfl_xor(t, 2); b.z = t;
        t = s1[4 * gq + 3]; t += __shfl_xor(t, 1); t += __shfl_xor(t, 2); b.w = t;
        if ((l31 & 3) == 0) { *(float4*)(ps + 8 * gq) = a; *(float4*)(ps + 32 + 8 * gq) = b; }
      }
    }
#pragma unroll
    for (int s4 = 0; s4 < 4; ++s4) {
      u32x4 pk;
      if (s4 < 2) {
#pragma unroll
        for (int jj = 0; jj < 4; ++jj) pk[jj] = pack_bf2(s0[8 * (s4 & 1) + 2 * jj], s0[8 * (s4 & 1) + 2 * jj + 1]);
      } else {
#pragma unroll
        for (int jj = 0; jj < 4; ++jj) pk[jj] = pack_bf2(s1[8 * (s4 & 1) + 2 * jj], s1[8 * (s4 & 1) + 2 * jj + 1]);
      }
      const bf16x8 pb = __builtin_bit_cast(bf16x8, pk);
#pragma unroll
      for (int dt = 0; dt < 2; ++dt) {
        s16x4 vlo = vtr(vrd + bo + dt * 4096 + s4 * 1024);
        s16x4 vhi = vtr(vrd + bo + dt * 4096 + s4 * 1024 + 512);
        bf16x8 vf = __builtin_shufflevector(vlo, vhi, 0, 1, 2, 3, 4, 5, 6, 7);
        O[dt] = mfma32(vf, pb, O[dt]);
      }
    }
  }
  __syncthreads();
}

template <int MODE>
DI void attn_tiles_pipe(const u16* __restrict__ Kg, const u16* __restrict__ Vg, int j0, int j1, char* smem,
                        const bf16x8 (&qf)[4], float& m, float& l, f32x16 (&O)[2], int lo, int hi, int lo_max, int hi_min,
                        unsigned mlo, unsigned mhi, int tid) {
  const int lane = tid & 63, l31 = lane & 31, h = lane >> 5;
  const int lk = tid >> 3, lc = tid & 7;
  const int kwr = lk * 128 + ((lc ^ ((lk >> 1) & 7)) << 4);
  const int vwr = 16384 + (lc >> 2) * 4096 + lk * 64 + (lc & 3) * 16;
  const int f = (l31 >> 1) & 7;
  const int krd = l31 * 128;
  int kx[4];
#pragma unroll
  for (int ks = 0; ks < 4; ++ks) kx[ks] = ((2 * ks + h) ^ f) << 4;
  const lds_cptr vrd = (lds_cptr)smem + 16384 + ((lane >> 4) & 1) * 32 + (lane & 3) * 8 + (4 * h + ((lane & 15) >> 2)) * 64;
  const int goff = lk * 64 + lc * 8;
  u32x4 rk, rv;
  auto qk_tile = [&](int bufoff, f32x16& d0, f32x16& d1) __attribute__((always_inline)) {
    bf16x8 ka[4], kb[4];
#pragma unroll
    for (int ks = 0; ks < 4; ++ks) { ka[ks] = *(const bf16x8*)(smem + bufoff + krd + kx[ks]); kb[ks] = *(const bf16x8*)(smem + bufoff + krd + 4096 + kx[ks]); }
    d0 = mfma32(ka[0], qf[0], zero16()); d1 = mfma32(kb[0], qf[0], zero16());
#pragma unroll
    for (int ks = 1; ks < 4; ++ks) { d0 = mfma32(ka[ks], qf[ks], d0); d1 = mfma32(kb[ks], qf[ks], d1); }
  };
  auto active = [&](int j) __attribute__((always_inline)) -> bool {
    if (MODE != 2) return true;
    const bool b = ((j < 32 ? (mlo >> j) : (mhi >> (j - 32))) & 1u) != 0;
    return __ballot(b) != 0ull;
  };
  auto step = [&](int j, bool act_c, bool& act_n, f32x16& c0, f32x16& c1, f32x16& n0, f32x16& n1) __attribute__((always_inline)) {
    const int par = (j - j0) & 1;
    const int bo = par * 8192, bn = (par ^ 1) * 8192;
    if (j < j1) *(u32x4*)(smem + bn + kwr) = rk;
    *(u32x4*)(smem + bo + vwr) = rv;
    __syncthreads();
    if (j + 2 <= j1) rk = *(const u32x4*)(Kg + (size_t)(j + 2) * 4096 + goff);
    if (j + 1 <= j1) rv = *(const u32x4*)(Vg + (size_t)(j + 1) * 4096 + goff);
    act_n = false;
    if (j < j1) { act_n = active(j + 1); if (act_n) qk_tile(bn, n0, n1); }
    if (!act_c) return;
    bool bit = true;
    if (MODE == 2) bit = ((j < 32 ? (mlo >> j) : (mhi >> (j - 32))) & 1u) != 0;
    const bool need_mask = (64 * j < lo_max) || (64 * j + 63 > hi_min);
    if (need_mask) {
      const int rlo = lo - 64 * j - 4 * h, span = hi - lo;
#pragma unroll
      for (int i = 0; i < 16; ++i) {
        const int cc = 8 * (i >> 2) + (i & 3);
        if ((unsigned)(cc - rlo) > (unsigned)span || span < 0) c0[i] = NEGF;
        if ((unsigned)(cc + 32 - rlo) > (unsigned)span || span < 0) c1[i] = NEGF;
      }
    }
    float mx = c0[0];
#pragma unroll
    for (int i = 1; i < 16; ++i) mx = fmaxf(mx, c0[i]);
#pragma unroll
    for (int i = 0; i < 16; ++i) mx = fmaxf(mx, c1[i]);
    mx = fmaxf(mx, __shfl_xor(mx, 32));
    if (MODE == 2) mx = bit ? mx : NEGF;
    const float mn = fmaxf(m, mx);
    const float alpha = __builtin_amdgcn_exp2f(m - mn);
    m = mn;
    l *= alpha;
    if (__ballot(alpha != 1.f) != 0ull) {
#pragma unroll
      for (int i = 0; i < 16; ++i) { O[0][i] *= alpha; O[1][i] *= alpha; }
    }
    const float msub = (MODE == 2 && !bit) ? 1e30f : fmaxf(mn, -1e29f);
    bf16x8 vf[4][2];
#pragma unroll
    for (int s4 = 0; s4 < 4; ++s4)
#pragma unroll
      for (int dt = 0; dt < 2; ++dt) {
        s16x4 vlo = vtr(vrd + bo + dt * 4096 + s4 * 1024);
        s16x4 vhi = vtr(vrd + bo + dt * 4096 + s4 * 1024 + 512);
        vf[s4][dt] = __builtin_shufflevector(vlo, vhi, 0, 1, 2, 3, 4, 5, 6, 7);
      }
    float rs = 0.f;
#pragma unroll
    for (int i = 0; i < 16; ++i) {
      const float p0 = __builtin_amdgcn_exp2f(c0[i] - msub), p1 = __builtin_amdgcn_exp2f(c1[i] - msub);
      c0[i] = p0; c1[i] = p1;
      rs += p0 + p1;
    }
    l += rs;
#pragma unroll
    for (int s4 = 0; s4 < 4; ++s4) {
      u32x4 pk;
      if (s4 < 2) {
#pragma unroll
        for (int jj = 0; jj < 4; ++jj) pk[jj] = pack_bf2(c0[8 * (s4 & 1) + 2 * jj], c0[8 * (s4 & 1) + 2 * jj + 1]);
      } else {
#pragma unroll
        for (int jj = 0; jj < 4; ++jj) pk[jj] = pack_bf2(c1[8 * (s4 & 1) + 2 * jj], c1[8 * (s4 & 1) + 2 * jj + 1]);
      }
      const bf16x8 pb = __builtin_bit_cast(bf16x8, pk);
      O[0] = mfma32(vf[s4][0], pb, O[0]);
      O[1] = mfma32(vf[s4][1], pb, O[1]);
    }
  };
  rk = *(const u32x4*)(Kg + (size_t)j0 * 4096 + goff);
  rv = *(const u32x4*)(Vg + (size_t)j0 * 4096 + goff);
  *(u32x4*)(smem + kwr) = rk;
  if (j0 < j1) rk = *(const u32x4*)(Kg + (size_t)(j0 + 1) * 4096 + goff);
  __syncthreads();
  f32x16 a0, a1, b0, b1;
  bool actA = true, actB = false;
  qk_tile(0, a0, a1);
  for (int j = j0; j <= j1; j += 2) {
    step(j, actA, actB, a0, a1, b0, b1);
    if (j + 1 <= j1) step(j + 1, actB, actA, b0, b1, a0, a1);
  }
  __syncthreads();
}

constexpr int RING = 6;
DI void glds16(const u16* g, char* lds) {
  __builtin_amdgcn_global_load_lds((const unsigned*)g, (LAS unsigned*)lds, 16, 0, 0);
}
template <int MODE>
DI void attn_tiles_ring(const u16* __restrict__ Kg, const u16* __restrict__ Vg, int j0, int j1, char* smem,
                        const bf16x8 (&qf)[4], float& m, float& l, f32x16 (&O)[2], int lo, int hi, int lo_max, int hi_min,
                        unsigned mlo, unsigned mhi, int tid) {
  const int lane = tid & 63, l31 = lane & 31, h = lane >> 5;
  const int f = (l31 >> 1) & 7;
  const int krd = l31 * 128;
  int kx[4];
#pragma unroll
  for (int ks = 0; ks < 4; ++ks) kx[ks] = ((2 * ks + h) ^ f) << 4;
  const int vrdo = 8192 + ((lane >> 4) & 1) * 32 + (lane & 3) * 8 + (4 * h + ((lane & 15) >> 2)) * 64;
  const lds_cptr lbase = (lds_cptr)smem;
  const int ksrc = (tid >> 3) * 64 + (((tid & 7) ^ (((tid >> 3) >> 1) & 7)) << 3);
  const int vsrc = ((tid >> 2) & 63) * 64 + (((tid >> 8) * 4 + (tid & 3)) << 3);
  const int dma = tid * 16;
  auto issue = [&](int t, int st) __attribute__((always_inline)) {
    const int tc = t < j1 ? t : j1;
    glds16(Kg + (size_t)tc * 4096 + ksrc, smem + st * 16384 + dma);
    glds16(Vg + (size_t)tc * 4096 + vsrc, smem + st * 16384 + 8192 + dma);
  };
  auto qk_tile = [&](int st, f32x16& d0, f32x16& d1) __attribute__((always_inline)) {
    const char* kb_ = smem + st * 16384;
    bf16x8 ka[4], kb[4];
#pragma unroll
    for (int ks = 0; ks < 4; ++ks) { ka[ks] = *(const bf16x8*)(kb_ + krd + kx[ks]); kb[ks] = *(const bf16x8*)(kb_ + krd + 4096 + kx[ks]); }
    d0 = mfma32(ka[0], qf[0], zero16()); d1 = mfma32(kb[0], qf[0], zero16());
#pragma unroll
    for (int ks = 1; ks < 4; ++ks) { d0 = mfma32(ka[ks], qf[ks], d0); d1 = mfma32(kb[ks], qf[ks], d1); }
  };
  auto active = [&](int j) __attribute__((always_inline)) -> bool {
    if (MODE != 2) return true;
    const bool b = ((j < 32 ? (mlo >> j) : (mhi >> (j - 32))) & 1u) != 0;
    return __ballot(b) != 0ull;
  };
  int st_cur = 0, st_iss = 5;
  auto step = [&](int j, bool act_c, bool& act_n, f32x16& c0, f32x16& c1, f32x16& n0, f32x16& n1) __attribute__((always_inline)) {
    asm volatile("s_waitcnt vmcnt(6)" ::: "memory");
    __builtin_amdgcn_s_barrier();
    issue(j + 5, st_iss);
    const int st_nxt = (st_cur == RING - 1) ? 0 : st_cur + 1;
    act_n = false;
    if (j < j1) { act_n = active(j + 1); if (act_n) qk_tile(st_nxt, n0, n1); }
    if (act_c) {
      bool bit = true;
      if (MODE == 2) bit = ((j < 32 ? (mlo >> j) : (mhi >> (j - 32))) & 1u) != 0;
      const bool need_mask = (64 * j < lo_max) || (64 * j + 63 > hi_min);
      if (need_mask) {
        const int rlo = lo - 64 * j - 4 * h, span = hi - lo;
#pragma unroll
        for (int i = 0; i < 16; ++i) {
          const int cc = 8 * (i >> 2) + (i & 3);
          if ((unsigned)(cc - rlo) > (unsigned)span || span < 0) c0[i] = NEGF;
          if ((unsigned)(cc + 32 - rlo) > (unsigned)span || span < 0) c1[i] = NEGF;
        }
      }
      float mx = c0[0];
#pragma unroll
      for (int i = 1; i < 16; ++i) mx = fmaxf(mx, c0[i]);
#pragma unroll
      for (int i = 0; i < 16; ++i) mx = fmaxf(mx, c1[i]);
      mx = fmaxf(mx, __shfl_xor(mx, 32));
      if (MODE == 2) mx = bit ? mx : NEGF;
      const float mn = fmaxf(m, mx);
      const float alpha = __builtin_amdgcn_exp2f(m - mn);
      m = mn;
      l *= alpha;
      if (__ballot(alpha != 1.f) != 0ull) {
#pragma unroll
        for (int i = 0; i < 16; ++i) { O[0][i] *= alpha; O[1][i] *= alpha; }
      }
      const float msub = (MODE == 2 && !bit) ? 1e30f : fmaxf(mn, -1e29f);
      const lds_cptr vb = lbase + st_cur * 16384 + vrdo;
      bf16x8 vf[4][2];
#pragma unroll
      for (int s4 = 0; s4 < 4; ++s4)
#pragma unroll
        for (int dt = 0; dt < 2; ++dt) {
          s16x4 vlo = vtr(vb + dt * 4096 + s4 * 1024);
          s16x4 vhi = vtr(vb + dt * 4096 + s4 * 1024 + 512);
          vf[s4][dt] = __builtin_shufflevector(vlo, vhi, 0, 1, 2, 3, 4, 5, 6, 7);
        }
      float rs = 0.f;
#pragma unroll
      for (int i = 0; i < 16; ++i) {
        const float p0 = __builtin_amdgcn_exp2f(c0[i] - msub), p1 = __builtin_amdgcn_exp2f(c1[i] - msub);
        c0[i] = p0; c1[i] = p1;
        rs += p0 + p1;
      }
      l += rs;
#pragma unroll
      for (int s4 = 0; s4 < 4; ++s4) {
        u32x4 pk;
        if (s4 < 2) {
#pragma unroll
          for (int jj = 0; jj < 4; ++jj) pk[jj] = pack_bf2(c0[8 * (s4 & 1) + 2 * jj], c0[8 * (s4 & 1) + 2 * jj + 1]);
        } else {
#pragma unroll
          for (int jj = 0; jj < 4; ++jj) pk[jj] = pack_bf2(c1[8 * (s4 & 1) + 2 * jj], c1[8 * (s4 & 1) + 2 * jj + 1]);
        }
        const bf16x8 pb = __builtin_bit_cast(bf16x8, pk);
        O[0] = mfma32(vf[s4][0], pb, O[0]);
        O[1] = mfma32(vf[s4][1], pb, O[1]);
      }
    }
    st_cur = st_nxt;
    st_iss = (st_iss == RING - 1) ? 0 : st_iss + 1;
  };
#pragma unroll
  for (int i = 0; i < 5; ++i) issue(j0 + i, i);
  asm volatile("s_waitcnt vmcnt(8)" ::: "memory");
  __builtin_amdgcn_s_barrier();
  f32x16 a0, a1, b0, b1;
  bool actA = true, actB = false;
  qk_tile(0, a0, a1);
  for (int j = j0; j <= j1; j += 2) {
    step(j, actA, actB, a0, a1, b0, b1);
    if (j + 1 <= j1) step(j + 1, actB, actA, b0, b1, a0, a1);
  }
  asm volatile("s_waitcnt vmcnt(0)" ::: "memory");
  __syncthreads();
}

DI void attn_cmp(const u16* __restrict__ Kc, const u16* __restrict__ Vc, int nct, char* smem, const bf16x8 (&qf)[4],
                 f32x16 (&O)[2], int hi, int hi_min, int tok_l, int tid) {
  const int lane = tid & 63, l31 = lane & 31, h = lane >> 5;
  const int f = (l31 >> 1) & 7;
  const int krd = l31 * 128;
  int kx[4];
#pragma unroll
  for (int ks = 0; ks < 4; ++ks) kx[ks] = ((2 * ks + h) ^ f) << 4;
  const int vrdo = 8192 + ((lane >> 4) & 1) * 32 + (lane & 3) * 8 + (4 * h + ((lane & 15) >> 2)) * 64;
  const lds_cptr lbase = (lds_cptr)smem;
  const int ksrc = (tid >> 3) * 64 + (((tid & 7) ^ (((tid >> 3) >> 1) & 7)) << 3);
  const int vsrc = ((tid >> 2) & 63) * 64 + (((tid >> 8) * 4 + (tid & 3)) << 3);
#pragma unroll
  for (int t = 0; t < 4; ++t) {
    const int tc = t < nct ? t : nct - 1;
    glds16(Kc + (size_t)tc * 4096 + ksrc, smem + t * 16384 + tid * 16);
    glds16(Vc + (size_t)tc * 4096 + vsrc, smem + t * 16384 + 8192 + tid * 16);
  }
  asm volatile("s_waitcnt vmcnt(0)" ::: "memory");
  __syncthreads();
  f32x16 S[4][2];
  float mx = NEGF;
#pragma unroll
  for (int t = 0; t < 4; ++t) {
    if (t < nct) {
      const char* kb_ = smem + t * 16384;
      bf16x8 ka[4], kb[4];
#pragma unroll
      for (int ks = 0; ks < 4; ++ks) { ka[ks] = *(const bf16x8*)(kb_ + krd + kx[ks]); kb[ks] = *(const bf16x8*)(kb_ + krd + 4096 + kx[ks]); }
      S[t][0] = mfma32(ka[0], qf[0], zero16()); S[t][1] = mfma32(kb[0], qf[0], zero16());
#pragma unroll
      for (int ks = 1; ks < 4; ++ks) { S[t][0] = mfma32(ka[ks], qf[ks], S[t][0]); S[t][1] = mfma32(kb[ks], qf[ks], S[t][1]); }
      if (64 * t + 63 > hi_min) {
        const int rhi = hi - 64 * t - 4 * h;
#pragma unroll
        for (int i = 0; i < 16; ++i) {
          const int cc = 8 * (i >> 2) + (i & 3);
          if (cc > rhi) S[t][0][i] = NEGF;
          if (cc + 32 > rhi) S[t][1][i] = NEGF;
        }
      }
#pragma unroll
      for (int i = 0; i < 16; ++i) mx = fmaxf(mx, fmaxf(S[t][0][i], S[t][1][i]));
    }
  }
  mx = fmaxf(mx, __shfl_xor(mx, 32));
  const float msub = fmaxf(mx, -1e29f);
  float ls = 0.f;
#pragma unroll
  for (int t = 0; t < 4; ++t)
    if (t < nct) {
#pragma unroll
      for (int i = 0; i < 16; ++i) {
        S[t][0][i] = __builtin_amdgcn_exp2f(S[t][0][i] - msub); S[t][1][i] = __builtin_amdgcn_exp2f(S[t][1][i] - msub);
        ls += S[t][0][i] + S[t][1][i];
      }
    }
  ls += __shfl_xor(ls, 32);
  const float inv_l = 1.f / fmaxf(ls, 1e-30f);
  O[0] = zero16(); O[1] = zero16();
#pragma unroll
  for (int t = 0; t < 4; ++t)
    if (t < nct) {
      f32x16& s0 = S[t][0];
      f32x16& s1 = S[t][1];
#pragma unroll
      for (int i = 0; i < 16; ++i) { s0[i] *= inv_l; s1[i] *= inv_l; }
      float* ps = (float*)(smem + AT_P) + tok_l * 256 + 64 * t + 4 * h;
#pragma unroll
      for (int gq = 0; gq < 4; ++gq) {
        float4 a, b;
        float u;
        u = s0[4 * gq + 0]; u += __shfl_xor(u, 1); u += __shfl_xor(u, 2); a.x = u;
        u = s0[4 * gq + 1]; u += __shfl_xor(u, 1); u += __shfl_xor(u, 2); a.y = u;
        u = s0[4 * gq + 2]; u += __shfl_xor(u, 1); u += __shfl_xor(u, 2); a.z = u;
        u = s0[4 * gq + 3]; u += __shfl_xor(u, 1); u += __shfl_xor(u, 2); a.w = u;
        u = s1[4 * gq + 0]; u += __shfl_xor(u, 1); u += __shfl_xor(u, 2); b.x = u;
        u = s1[4 * gq + 1]; u += __shfl_xor(u, 1); u += __shfl_xor(u, 2); b.y = u;
        u = s1[4 * gq + 2]; u += __shfl_xor(u, 1); u += __shfl_xor(u, 2); b.z = u;
        u = s1[4 * gq + 3]; u += __shfl_xor(u, 1); u += __shfl_xor(u, 2); b.w = u;
        if ((l31 & 3) == 0) { *(float4*)(ps + 8 * gq) = a; *(float4*)(ps + 32 + 8 * gq) = b; }
      }
      const lds_cptr vb = lbase + t * 16384 + vrdo;
#pragma unroll
      for (int s4 = 0; s4 < 4; ++s4) {
        u32x4 pk;
        if (s4 < 2) {
#pragma unroll
          for (int jj = 0; jj < 4; ++jj) pk[jj] = pack_bf2(s0[8 * (s4 & 1) + 2 * jj], s0[8 * (s4 & 1) + 2 * jj + 1]);
        } else {
#pragma unroll
          for (int jj = 0; jj < 4; ++jj) pk[jj] = pack_bf2(s1[8 * (s4 & 1) + 2 * jj], s1[8 * (s4 & 1) + 2 * jj + 1]);
        }
        const bf16x8 pb = __builtin_bit_cast(bf16x8, pk);
#pragma unroll
        for (int dt = 0; dt < 2; ++dt) {
          s16x4 vlo = vtr(vb + dt * 4096 + s4 * 1024);
          s16x4 vhi = vtr(vb + dt * 4096 + s4 * 1024 + 512);
          bf16x8 vf = __builtin_shufflevector(vlo, vhi, 0, 1, 2, 3, 4, 5, 6, 7);
          O[dt] = mfma32(vf, pb, O[dt]);
        }
      }
    }
  __syncthreads();
}

DI void attn_item(const Params& p, int bg, int qt, char* smem) {
  const int tid = opaque_tid(), lane = tid & 63, w = tid >> 6, l31 = lane & 31, h = lane >> 5;
  const int b = bg >> 1, g = bg & 1;
  const int t0 = qt * 64;
  const int tok_l = w * 8 + (l31 >> 2);
  const int tpos = t0 + tok_l;
  const int r = l31 & 3;
  const size_t tglob = (size_t)b * SEQ + tpos;
  bf16x8 qf[4];
  {
    const u16* qp = p.qb + tglob * 512 + (g * 4 + r) * 64 + h * 8;
#pragma unroll
    for (int ks = 0; ks < 4; ++ks) qf[ks] = *(const bf16x8*)(qp + ks * 16);
  }
  const float g0 = p.gate[tglob * 24 + 0 + g * 4 + r];
  const float g1 = p.gate[tglob * 24 + 8 + g * 4 + r];
  const float g2 = p.gate[tglob * 24 + 16 + g * 4 + r];
  const int cur = t0 >> 6;
  f32x16 O[2];
  float m, l;
  unsigned* stash = (unsigned*)(smem + AT_S) + w * 1024 + lane;
  {
    const u16* Kc = p.kcmp + (size_t)bg * 256 * 64;
    const u16* Vc = p.vcmp + (size_t)bg * 256 * 64;
    const int nct = ((t0 + 32) >> 10) + 1;
    const int hi = (tpos - 31) >> 4;
    const int hi_min = (t0 - 31) >> 4;
    attn_cmp(Kc, Vc, nct, smem, qf, O, hi, hi_min, tok_l, tid);
    const float* Ps = (const float*)(smem + AT_P);
    unsigned long long* Ms = (unsigned long long*)(smem + AT_M);
    const int ncv = nct * 64;
    for (int tl = 0; tl < 8; ++tl) {
      const int tokl = w * 8 + tl;
      const int j = lane;
      const float* pr = Ps + tokl * 256;
      float imp = 0.f;
      if (4 * j < ncv) {
        float4 v = *(const float4*)(pr + 4 * j);
        imp = 2.f * (v.x + v.y + v.z) + v.w;
        if (j > 0) imp += pr[4 * j - 1];
      }
      unsigned key = ((__float_as_uint(imp) & ~63u) | (unsigned)(63 - j)) + 64u;
      if (j > cur) key = (unsigned)(63 - j);
      if (j == 0 || j == cur || j == cur - 1) key = 0xFFFFFF00u | (unsigned)(63 - j);
      unsigned* kl = (unsigned*)(smem + w * 256);
      kl[lane] = key;
      int cnt = 0;
#pragma unroll
      for (int k4 = 0; k4 < 16; ++k4) {
        const u32x4 q = *(const u32x4*)(kl + 4 * k4);
        cnt += (q[0] > key) + (q[1] > key) + (q[2] > key) + (q[3] > key);
      }
      unsigned long long bal = __ballot(cnt < 16);
      if (lane == 0) Ms[tokl] = bal;
    }
  }
  __syncthreads();
  unsigned mlo, mhi;
  {
    const unsigned* Mw = (const unsigned*)(smem + AT_M);
    mlo = Mw[tok_l * 2]; mhi = Mw[tok_l * 2 + 1];
  }
#pragma unroll
  for (int i = 0; i < 8; ++i) { stash[i * 64] = pack_bf2(g0 * O[0][2 * i], g0 * O[0][2 * i + 1]); stash[(8 + i) * 64] = pack_bf2(g0 * O[1][2 * i], g0 * O[1][2 * i + 1]); }
  {
    m = NEGF; l = 0.f;
    O[0] = zero16(); O[1] = zero16();
    attn_tiles_ring<2>(p.kvb + (size_t)(2 * 16 + bg) * SEQ * 64, p.kvb + (size_t)(3 * 16 + bg) * SEQ * 64, 0, cur, smem, qf, m, l, O,
                  0, tpos, 0, t0, mlo, mhi, tid);
    const float lt = l + __shfl_xor(l, 32);
    const float sc = g1 / fmaxf(lt, 1e-30f);
#pragma unroll
    for (int i = 0; i < 8; ++i) {
      const unsigned u0 = stash[i * 64], u1 = stash[(8 + i) * 64];
      stash[i * 64] = pack_bf2(bf_lo(u0) + sc * O[0][2 * i], bf_hi(u0) + sc * O[0][2 * i + 1]);
      stash[(8 + i) * 64] = pack_bf2(bf_lo(u1) + sc * O[1][2 * i], bf_hi(u1) + sc * O[1][2 * i + 1]);
    }
  }
  {
    m = NEGF; l = 0.f;
    O[0] = zero16(); O[1] = zero16();
    const int jlo = max(t0 - 511, 0) >> 6;
    attn_tiles_ring<3>(p.kvb + (size_t)(4 * 16 + bg) * SEQ * 64, p.kvb + (size_t)(5 * 16 + bg) * SEQ * 64, jlo, cur, smem, qf, m, l, O,
                  tpos - 511, tpos, t0 + 63 - 511, t0, 0u, 0u, tid);
    const float lt = l + __shfl_xor(l, 32);
    const float sc = g2 / fmaxf(lt, 1e-30f);
#pragma unroll
    for (int i = 0; i < 8; ++i) {
      const unsigned u0 = stash[i * 64], u1 = stash[(8 + i) * 64];
      O[0][2 * i] = bf_lo(u0) + sc * O[0][2 * i]; O[0][2 * i + 1] = bf_hi(u0) + sc * O[0][2 * i + 1];
      O[1][2 * i] = bf_lo(u1) + sc * O[1][2 * i]; O[1][2 * i + 1] = bf_hi(u1) + sc * O[1][2 * i + 1];
    }
  }
  u16* op = p.ob + tglob * 512 + (g * 4 + r) * 64 + 4 * h;
#pragma unroll
  for (int dt = 0; dt < 2; ++dt)
#pragma unroll
    for (int gq = 0; gq < 4; ++gq) {
      u32x2 o = {pack_bf2(O[dt][4 * gq], O[dt][4 * gq + 1]), pack_bf2(O[dt][4 * gq + 2], O[dt][4 * gq + 3])};
      *(u32x2*)(op + dt * 32 + 8 * gq) = o;
    }
}

DI void p10_rows(const Params& p, int item) {
  const int w = threadIdx.x >> 6, lane = threadIdx.x & 63;
  const int row = item * 8 + w;
  float s = (lane < 16) ? p.ssq2[(size_t)row * 16 + lane] : 0.f;
#pragma unroll
  for (int o = 8; o; o >>= 1) s += __shfl_xor(s, o);
  s = __shfl(s, 0);
  const float rs = rsqrtf(s * (1.f / DM) + 1e-6f);
  float4* o4 = (float4*)(p.out + (size_t)row * DM);
  const float4* g4 = (const float4*)p.norm_final;
#pragma unroll
  for (int i = 0; i < 4; ++i) {
    float4 v = o4[lane + 64 * i], g = g4[lane + 64 * i];
    v.x *= rs * g.x; v.y *= rs * g.y; v.z *= rs * g.z; v.w *= rs * g.w;
    o4[lane + 64 * i] = v;
  }
}


#define XB_TMO      128
#define XB_XCNT(j)  (256  + 64 * (j))
#define XB_XSUB(j)  (1280 + 64 * (j))
#define XB_XGEN(j)  (2304 + 64 * (j))
#define XB_TOP      3328
#define XB_TOPGEN   3392
#define XCD_BAR_WORDS 3456
#define XB_SPIN_CAP (1u << 18)
DI unsigned xb_xcc_id() { return (unsigned)__builtin_amdgcn_s_getreg((3 << 11) | 20) & 0xFu; }
#define XB_SPIN(cond, bar) do { unsigned _sp = 0; while (cond) { __builtin_amdgcn_s_sleep(1); \
    if ((++_sp & 255u) == 0u) { if (xb_ld(&(bar)[XB_TMO])) break; if (_sp > XB_SPIN_CAP) { atomicAdd(&(bar)[XB_TMO], 1u); break; } } } } while (0)
struct XcdBarrier { unsigned* bar; unsigned x; volatile LAS unsigned* st; };
DI XcdBarrier xcd_barrier_post(unsigned* bar, volatile LAS unsigned* st) {
  XcdBarrier b; b.bar = bar; b.x = xb_xcc_id(); b.st = st;
  if (threadIdx.x == 0) (void)xb_add(&bar[XB_XCNT(b.x)], 1u);
  return b;
}
DI void xcd_barrier_complete(unsigned* bar, unsigned x, unsigned& nloc, unsigned& nx) {
  const unsigned G = gridDim.x * gridDim.y * gridDim.z;
  unsigned sum, cnt, mine, sp = 0u;
  for (;;) {
    sum = 0u; cnt = 0u; mine = 0u;
#pragma unroll
    for (unsigned j = 0; j < 16; ++j) { const unsigned c = xb_ld(&bar[XB_XCNT(j)]); sum += c; cnt += (c > 0u) ? 1u : 0u; mine = (j == x) ? c : mine; }
    if (sum == G) break;
    __builtin_amdgcn_s_sleep(1);
    if ((++sp & 255u) == 0u) { if (xb_ld(&bar[XB_TMO])) break; if (sp > XB_SPIN_CAP) { atomicAdd(&bar[XB_TMO], 1u); break; } }
  }
  nloc = mine > 0u ? mine : 1u; nx = cnt > 0u ? cnt : 1u;
}
DI void xcd_barrier(const XcdBarrier& b) {
  asm volatile("s_waitcnt vmcnt(0)" ::: "memory");
  __syncthreads();
  if (threadIdx.x == 0) {
    unsigned* bar = b.bar;
    __builtin_amdgcn_s_waitcnt(0);
    unsigned nloc = b.st[0], nx = b.st[1];
    if (nloc == 0u) { xcd_barrier_complete(bar, b.x, nloc, nx); b.st[0] = nloc; b.st[1] = nx; }
    const unsigned old = xb_add(&bar[XB_XSUB(b.x)], 1u);
    const unsigned gen = old / nloc;
    if (old + 1u == (gen + 1u) * nloc) {
      __builtin_amdgcn_fence(__ATOMIC_RELEASE, "agent");
      asm volatile("s_waitcnt vmcnt(0)" ::: "memory");
      const unsigned og = xb_add(&bar[XB_TOP], 1u);
      const unsigned tg = og / nx;
      if (og + 1u == (tg + 1u) * nx) xb_add(&bar[XB_TOPGEN], 1u);
      else XB_SPIN(xb_ld(&bar[XB_TOPGEN]) == tg, bar);
      __builtin_amdgcn_fence(__ATOMIC_ACQUIRE, "agent");
      xb_add(&bar[XB_XGEN(b.x)], 1u);
      asm volatile("s_waitcnt vmcnt(0)" ::: "memory");
    } else {
      XB_SPIN(xb_ld(&bar[XB_XGEN(b.x)]) == gen, bar);
      __builtin_amdgcn_fence(__ATOMIC_ACQUIRE, "agent");
      asm volatile("s_waitcnt vmcnt(0)" ::: "memory");
    }
  }
  __syncthreads();
}

__global__ void __launch_bounds__(NTHR, 2) nsa_pool_block_fwd(Params p) {
  extern __shared__ __attribute__((aligned(16))) unsigned char shm[];
  char* smem = (char*)shm;
  LAS unsigned char* lds = (LAS unsigned char*)shm;
  cg::grid_group grid = cg::this_grid();
  const int G = gridDim.x;
  const int bid = blockIdx.x;
  const int L = (G % 8 == 0) ? (bid % 8) * (G / 8) + bid / 8 : bid;
  volatile LAS unsigned* xst = (volatile LAS unsigned*)(lds + 133120);
  if (threadIdx.x < 4) xst[threadIdx.x] = 0u;
  __syncthreads();
  const XcdBarrier xb = xcd_barrier_post(p.bar, xst);

  if (PH_MASK & 1)
  {
    constexpr int N0 = 1024, N1 = N0 + TJ_EARLY / 2, N2 = N1 + 64, N3 = N2 + 16, N4 = N3 + 64;
    for (int rep = 0; rep < ((REP_MASK & 1) ? 2 : 1); ++rep)
    for (int it = N4 - 1 - bid; it >= 0; it -= G) {
      if (it < N0) p0_rows(p, it);
      else if (it < N1) p0_transpose(p, it - N0, smem, 0);
      else if (it < N2) p0_weff(p, it - N1, smem);
      else if (it < N3) p0_cbias(p, it - N2, smem);
      else p0_rope(p, it - N3);
    }
  }
  if (p.bar == nullptr) grid.sync();
  xcd_barrier(xb);
  if (PH_MASK & 2) {
    Sched S{0, G, bid};
    EpiProj E{p};
    for (int rep = 0; rep < ((REP_MASK & 2) ? 2 : 1); ++rep)
    gemm_phase(lds, Gemm{p.xb, p.w_in_t, DM, DM, DM, 128, 128}, S, E);
  }
  xcd_barrier(xb);
  if (PH_MASK & 4) for (int rep = 0; rep < ((REP_MASK & 4) ? 2 : 1); ++rep)
  {
    Sched S{2, G, bid};
    EpiCmpHid E{(float*)p.mb};
    gemm_phase(lds, Gemm{p.kvb, p.cw1_t, 1024, 2048, 512, 128, 128}, S, E);
    for (int it = bid; it < 4096; it += G) p2a_pool_item(p, it);
  }
  xcd_barrier(xb);
  if (PH_MASK & 8) {
    Sched S{3, G, bid};
    EpiCmpOut E{p};
    for (int i = 0;; ++i) {
      Unit u;
      if (!S.next(i, u)) break;
      const float* h32 = (const float*)p.mb;
      const float* bias = p.cbias + u.pn * 256;
      for (int e0 = threadIdx.x; e0 < 8192; e0 += 4 * NTHR) {
        f32x4 pv[4][4][2];
#pragma unroll
        for (int q = 0; q < 4; ++q) {
          const int e = e0 + q * NTHR, c = e >> 5, n8 = (e & 31) * 8;
#pragma unroll
          for (int ks = 0; ks < 4; ++ks) {
            const f32x4* sp = (const f32x4*)(h32 + ((size_t)((ks * 32 + u.pm) * 256 + c)) * 256 + n8);
            pv[q][ks][0] = sp[0]; pv[q][ks][1] = sp[1];
          }
        }
#pragma unroll
        for (int q = 0; q < 4; ++q) {
          const int e = e0 + q * NTHR, c = e >> 5, n8 = (e & 31) * 8;
          f32x4 v0 = *(const f32x4*)(bias + n8), v1 = *(const f32x4*)(bias + n8 + 4);
#pragma unroll
          for (int ks = 0; ks < 4; ++ks) { v0 += pv[q][ks][0]; v1 += pv[q][ks][1]; }
#pragma unroll
          for (int j = 0; j < 4; ++j) { v0[j] = gelu_tanh(v0[j]); v1[j] = gelu_tanh(v1[j]); }
          *(u32x4*)(p.hid + ((size_t)u.pm * 256 + c) * 256 + n8) = pack8(v0, v1);
        }
      }
    }
    asm volatile("s_waitcnt vmcnt(0)" ::: "memory");
    __syncthreads();
    gemm_phase(lds, Gemm{p.hid, p.cw2_t, 256, 256, 256, 128, 128}, S, E);
    { Unit u0; const bool has_unit = S.next(0, u0);
      if (G >= 256) {
        if (!has_unit) {
          const int rank = bid - (bid >> 3) - (((bid & 7) > ((bid >> 3) & 7)) ? 1 : 0);
          for (int it = rank; it < (TJ_TOTAL - TJ_EARLY) / 2; it += G - 32) p0_transpose(p, it, smem, TJ_EARLY);
        }
      } else {
        __syncthreads();
        for (int it = bid; it < (TJ_TOTAL - TJ_EARLY) / 2; it += G) p0_transpose(p, it, smem, TJ_EARLY);
      }
    }
  }
  xcd_barrier(xb);
  if (ATTN_PRIO) { if (threadIdx.x >= 256) __builtin_amdgcn_s_setprio(2); }
  if (PH_MASK & 16) for (int rep = 0; rep < ((REP_MASK & 16) ? 2 : 1); ++rep)
  if (G == 256) {
    const int x = bid & 7, j = bid >> 3;
    for (int rd = 0; rd < 4; ++rd) {
      const int idx = rd * 32 + ((rd & 1) ? (31 - j) : j);
      attn_item(p, 2 * x + (idx & 1), 63 - (idx >> 1), smem);
    }
  } else
  for (int rd = 0; rd * G < 1024; ++rd) {
    const int i = rd * G + ((rd & 1) ? (G - 1 - L) : L);
    if (i < 1024) attn_item(p, i & 15, 63 - (i >> 4), smem);
  }
  xcd_barrier(xb);
  if (ATTN_PRIO) __builtin_amdgcn_s_setprio(0);
  if (PH_MASK & 32) {
    Sched S{1, G, bid};
    EpiMerge<0> E0{p};
    EpiMerge<1> E1{p};
    for (int rep = 0; rep < ((REP_MASK & 32) ? 2 : 1); ++rep) {
    gemm_phase(lds, Gemm{p.ob, p.wa_t, 512, 512, 512, 128, 128}, S, E0);
    gemm_phase(lds, Gemm{p.pooled, p.wbe_t, 512, 512, 512, 128, 128}, S, E1);
    }
  }
  xcd_barrier(xb);
  if (PH_MASK & 64) {
    Sched S{1, G, bid};
    EpiResid<true, false> E{p.x, p.out, p.xb, p.ssq};
    for (int rep = 0; rep < ((REP_MASK & 64) ? 2 : 1); ++rep)
    gemm_phase(lds, Gemm{p.mb, p.wo_t, DM, DM, DM, 128, 128}, S, E);
  }
  xcd_barrier(xb);
  if (PH_MASK & 128) {
    Sched S{0, G, bid};
    EpiFF1 E{p};
    for (int rep = 0; rep < ((REP_MASK & 128) ? 2 : 1); ++rep)
    gemm_phase(lds, Gemm{p.xb, p.w1_t, DM, DM, DM, 128, 128}, S, E);
  }
  xcd_barrier(xb);
#if FUSE_FINAL
  if (PH_MASK & 256) {
    Sched S{1, G, bid};
    EpiFinal E{p.out, p.xb, p.norm_final, p.ssq2, p.bar + XCD_BAR_WORDS};
    gemm_phase(lds, Gemm{p.act, p.w2_t, 64, 64, 4096, (size_t)T_TOK * 128, (size_t)1024 * 128}, S, E);
  }
#else
  if (PH_MASK & 256) {
    Sched S{1, G, bid};
    EpiResid<false> E{p.out, p.out, nullptr, p.ssq2};
    gemm_phase(lds, Gemm{p.act, p.w2_t, 64, 64, 4096, (size_t)T_TOK * 128, (size_t)1024 * 128}, S, E);
  }
  xcd_barrier(xb);
  for (int it = bid; it < 4096; it += G) p10_rows(p, it);
#endif
}

extern "C" void kernel_launch(void* const* d_in, const int* in_sizes, int n_in, void* d_out, int out_size, void* d_ws,
                              size_t ws_size, hipStream_t stream) {
  (void)in_sizes; (void)n_in; (void)out_size; (void)ws_size;
  static int grid_blocks = 0;
  if (!grid_blocks) {
    int dev = 0, cus = 0, per_cu = 0;
    (void)hipGetDevice(&dev);
    (void)hipDeviceGetAttribute(&cus, hipDeviceAttributeMultiprocessorCount, dev);
    (void)hipFuncSetAttribute((const void*)nsa_pool_block_fwd, hipFuncAttributeMaxDynamicSharedMemorySize, LDS_BYTES);
    (void)hipOccupancyMaxActiveBlocksPerMultiprocessor(&per_cu, nsa_pool_block_fwd, NTHR, LDS_BYTES);
    if (per_cu > 1) per_cu = 1;
    if (per_cu < 1) per_cu = 1;
    grid_blocks = cus * per_cu;
  }
  Params p{};
  const float* const* in = (const float* const*)d_in;
  p.x = in[0]; p.norm_mix = in[1]; p.w_in = in[2]; p.pe_k = in[3]; p.pe_v = in[4]; p.ck_w1 = in[5]; p.ck_w2 = in[6];
  p.cv_w1 = in[7]; p.cv_w2 = in[8]; p.w_ba = in[9]; p.pool_w = in[10]; p.pool_scale = in[11]; p.w_bp = in[12];
  p.w_out = in[13]; p.norm_mlp = in[14]; p.w_ff1 = in[15]; p.w_ff2 = in[16]; p.norm_final = in[17];
  p.out = (float*)d_out;
  char* ws = (char*)d_ws;
  size_t off = 0;
  auto take = [&](size_t bytes) { char* r = ws + off; off += (bytes + 255) & ~(size_t)255; return r; };
  const size_t T = T_TOK;
  p.xb = (u16*)take(T * 1024 * 2);
  p.w_in_t = (u16*)take((size_t)NPROJ * 1024 * 2);
  p.wa_t = (u16*)take(1024 * 512 * 2);
  p.wbe_t = (u16*)take(1024 * 512 * 2);
  p.wo_t = (u16*)take(1024 * 1024 * 2);
  p.w1_t = (u16*)take((size_t)4096 * 1024 * 2);
  p.w2_t = (u16*)take((size_t)4096 * 1024 * 2);
  p.cw1_t = (u16*)take(2 * 256 * 2048 * 2);
  p.cw2_t = (u16*)take(2 * 256 * 256 * 2);
  p.rstd0 = (float*)take(T * 4);
  p.cbias = (float*)take(512 * 4);
  p.rope = (float2*)take((size_t)SEQ * 8 * 8);
  p.ssq = (float*)take(T * 16 * 4);
  p.ssq2 = (float*)take(T * 16 * 4);
  p.mb = (u16*)take(T * 1024 * 2);
  char* regionD = ws + off;
  p.qb = (u16*)take(T * 512 * 2);
  p.kvb = (u16*)take((size_t)6 * 16 * SEQ * 64 * 2);
  p.gate = (float*)take(T * 24 * 4);
  p.ub = (u16*)take(T * 512 * 2);
  p.gm = (u16*)take(T * 2048 * 2);
  p.hid = (u16*)take((size_t)2 * 16 * 256 * 256 * 2);
  p.kcmp = (u16*)take(16 * 256 * 64 * 2);
  p.vcmp = (u16*)take(16 * 256 * 64 * 2);
  p.pooled = (u16*)take(T * 512 * 2);
  p.ob = (u16*)take(T * 512 * 2);
  p.bar = (unsigned*)take((XCD_BAR_WORDS + 4096) * 4);
  p.act = (u16*)regionD;
  (void)hipMemsetAsync(p.bar, 0, (XCD_BAR_WORDS + 4096) * 4, stream);
  void* args[] = {&p};
  hipError_t e = hipLaunchCooperativeKernel((void*)nsa_pool_block_fwd, dim3(grid_blocks), dim3(NTHR), args, LDS_BYTES, stream);
  if (e != hipSuccess) fprintf(stderr, "cooperative launch failed: %s (grid %d)\n", hipGetErrorString(e), grid_blocks);
}
```

```cpp
#include <hip/hip_runtime.h>
#include <hip/hip_cooperative_groups.h>
#include <stdint.h>
#include <stdio.h>
namespace cg = cooperative_groups;

#define DI __device__ __forceinline__
#define LAS __attribute__((address_space(3)))
typedef unsigned short u16;
typedef __attribute__((ext_vector_type(8))) short bf16x8;
typedef __attribute__((ext_vector_type(4))) short s16x4;
typedef __attribute__((ext_vector_type(16))) float f32x16;
typedef __attribute__((ext_vector_type(4))) float f32x4;
typedef __attribute__((ext_vector_type(4))) unsigned u32x4;
typedef __attribute__((ext_vector_type(2))) unsigned u32x2;
typedef __attribute__((ext_vector_type(2))) float f32x2;
typedef __attribute__((ext_vector_type(2))) __bf16 bf16x2_t;
typedef LAS const char* lds_cptr;

constexpr int T_TOK = 32768, SEQ = 4096, DM = 1024;
constexpr int NPROJ = 4096;
constexpr int NTHR = 512;
constexpr int LDS_BYTES = 135168;
constexpr float NEGF = -1e30f;
constexpr float QSCALE = 0.125f * 1.4426950408889634f;
#ifndef REP_MASK
#define REP_MASK 0
#endif
#ifndef ATTN_PRIO
#define ATTN_PRIO 0
#endif
#ifndef FUSE_FINAL
#define FUSE_FINAL 1
#endif
#ifndef PH_MASK
#define PH_MASK 0xffff
#endif

struct Params {
  const float *x, *norm_mix, *w_in, *pe_k, *pe_v, *ck_w1, *ck_w2, *cv_w1, *cv_w2, *w_ba, *pool_w, *pool_scale, *w_bp,
      *w_out, *norm_mlp, *w_ff1, *w_ff2, *norm_final;
  float* out;
  u16 *xb, *w_in_t, *wa_t, *wbe_t, *wo_t, *w1_t, *w2_t, *cw1_t, *cw2_t;
  float *rstd0, *cbias;
  float2* rope;
  u16 *qb, *kvb;
  float* gate;
  u16 *ub, *gm, *hid, *kcmp, *vcmp, *pooled, *ob, *mb, *act;
  float *ssq, *ssq2;
  unsigned* bar;
};

DI unsigned pack_bf2(float a, float b) {
  f32x2 v = {a, b};
  bf16x2_t r = __builtin_convertvector(v, bf16x2_t);
  return __builtin_bit_cast(unsigned, r);
}
DI float bf_lo(unsigned u) { return __uint_as_float(u << 16); }
DI float bf_hi(unsigned u) { return __uint_as_float(u & 0xffff0000u); }
DI float sigmoidf_(float v) { return __builtin_amdgcn_rcpf(1.f + __builtin_amdgcn_exp2f(-1.4426950408889634f * v)); }
DI float gelu_tanh(float x) {
  float u = 0.7978845608028654f * (x + 0.044715f * x * x * x);
  float th = 1.f - 2.f / (__expf(2.f * u) + 1.f);
  return 0.5f * x * (1.f + th);
}
DI f32x16 mfma32(bf16x8 a, bf16x8 b, f32x16 c) { return __builtin_amdgcn_mfma_f32_32x32x16_bf16(a, b, c, 0, 0, 0); }
DI int opaque_tid() { int t; asm volatile("v_mov_b32 %0, %1" : "=v"(t) : "v"((int)threadIdx.x)); return t; }
DI f32x16 zero16() { f32x16 z; for (int i = 0; i < 16; ++i) z[i] = 0.f; return z; }
DI s16x4 vtr(lds_cptr p) { return __builtin_amdgcn_ds_read_tr16_b64_v4i16((LAS s16x4*)p); }
DI u32x4 pack8(const f32x4& a, const f32x4& b) {
  u32x4 w = {pack_bf2(a[0], a[1]), pack_bf2(a[2], a[3]), pack_bf2(b[0], b[1]), pack_bf2(b[2], b[3])};
  return w;
}

constexpr int BM = 256, BK = 64, HALF = 128, HTB = HALF * BK * 2;
DI int lds_byte(int r, int c) { const int st = (r >> 4) * 2 + (c >> 5), rr = r & 15, cc = c & 31, ob = rr * 64 + cc * 2; return st * 1024 + (ob ^ (((ob >> 9) & 1) << 5)); }
DI void stage_rc(int b, int& R, int& C) { const int st = b / 1024, sb = b % 1024, swz = sb ^ (((sb >> 9) & 1) << 5); R = (st >> 1) * 16 + swz / 64; C = (st & 1) * 32 + (swz % 64) / 2; }
DI int perm32(int rho) { const int n = rho >> 4, i = rho & 15; return 8 * (i >> 2) + 4 * n + (i & 3); }

struct Unit { int pm, pn, k0; };
struct Gemm { const u16* A; const u16* Bt; int lda, ldb, K; size_t kstepA, kstepB; };

struct Sched {
  int mode, G, bid;
  DI bool next(int i, Unit& u) const {
    u.k0 = 0;
    if (mode == 2) {
      int t;
      if (G >= 256) { if (i > 0 || (bid & 1) != ((bid >> 3) & 1) || (bid >> 1) >= 128) return false; t = bid >> 1; }
      else { t = i * G + bid; if (t >= 128) return false; }
      u.pm = t >> 2; u.pn = u.pm >> 4; u.k0 = (t & 3) * 8; return true;
    }
    if (mode == 3) {
      int t;
      if (G >= 256) { t = bid >> 3; if (i > 0 || (bid & 7) != (t & 7) || t >= 32) return false; }
      else { t = i * G + bid; if (t >= 32) return false; }
      u.pm = t; u.pn = t >> 4; return true;
    }
    const int nN = mode == 0 ? 16 : 4;
    if (G == 256) {
      const int x = bid & 7, j = bid >> 3;
      if (mode == 0) { if (i >= 8) return false; u.pn = (x & 3) * 4 + (j & 3); u.pm = (x >> 2) * 64 + i * 8 + (j >> 2); return true; }
      if (i >= 2) return false; u.pn = j & 3; u.pm = x * 16 + i * 8 + (j >> 2); return true;
    }
    const int t = i * G + bid;
    if (t >= nN * 128) return false;
    u.pn = t % nN; u.pm = t / nN; return true;
  }
};

template <class Epi>
DI void gemm_phase(LAS unsigned char* lds, const Gemm g, const Sched& S, const Epi& E) {
  const int tid = opaque_tid(), wid = __builtin_amdgcn_readfirstlane(tid >> 6), lane = tid & 63, wr = wid >> 2, wc = wid & 3, fr = lane & 15, fq = lane >> 4;
  const int nt = g.K / BK;
  unsigned voffA[2], voffB[2];
#pragma unroll
  for (int i = 0; i < 2; ++i) {
    int R, C; stage_rc(tid * 16 + i * 8192, R, C);
    const int Rb = (R & ~31) + perm32(R & 31);
    voffA[i] = (unsigned)(R * g.lda + C) * 2u; voffB[i] = (unsigned)(Rb * g.ldb + C) * 2u;
  }
  const size_t kstep = g.kstepB, kstepA = g.kstepA;
  const size_t hstepA = (size_t)HALF * g.lda * 2, hstepB = (size_t)HALF * g.ldb * 2;
  const size_t tstepA = 2 * hstepA, tstepB = 2 * hstepB;
  const unsigned ldsw = (unsigned)wid * 1024u;
  const int aoff = lds_byte(wr * 64 + fr, fq * 8), boff = lds_byte(wc * 32 + fr, fq * 8);
#define PG8_SA(b, h) (((b) * 2 + (h)) * HTB)
#define PG8_SB(b, h) ((4 + (b) * 2 + (h)) * HTB)
#define PG8_STAGE(bufoff, gbase, voff) do { _Pragma("unroll") for (int _i = 0; _i < 2; ++_i) \
    __builtin_amdgcn_global_load_lds((const unsigned*)((const char*)(gbase) + (voff)[_i]), (LAS unsigned*)(lds + (bufoff) + ldsw + _i * 8192), 16, 0, 0); } while (0)
#define PG8_LDA(dst, b, h) do { _Pragma("unroll") for (int m = 0; m < 4; ++m) _Pragma("unroll") for (int k = 0; k < 2; ++k) dst[m][k] = *(const LAS bf16x8*)(lds + PG8_SA(b, h) + aoff + m * 2048 + k * 1024); } while (0)
#define PG8_LDB(dst, b, h) do { _Pragma("unroll") for (int n = 0; n < 2; ++n) _Pragma("unroll") for (int k = 0; k < 2; ++k) dst[n][k] = *(const LAS bf16x8*)(lds + PG8_SB(b, h) + boff + n * 2048 + k * 1024); } while (0)
#define PG8_MMA(ai, bj, At, Bt) do { __builtin_amdgcn_s_setprio(1); _Pragma("unroll") for (int m = 0; m < 4; ++m) _Pragma("unroll") for (int n = 0; n < 2; ++n) _Pragma("unroll") for (int k = 0; k < 2; ++k) \
    acc[ai][bj][m][n] = __builtin_amdgcn_mfma_f32_16x16x32_bf16(Bt[n][k], At[m][k], acc[ai][bj][m][n], 0, 0, 0); __builtin_amdgcn_s_setprio(0); } while (0)
#define PG8_WAIT_V(n) asm volatile("s_waitcnt vmcnt(" #n ")" ::: "memory")
#define PG8_WAIT_L(n) asm volatile("s_waitcnt lgkmcnt(" #n ")" ::: "memory")
#define PG8_BAR __builtin_amdgcn_s_barrier()
#define PG8_SCHED __builtin_amdgcn_sched_barrier(0)
  Unit cur, nxt; int ui = 0;
  if (!S.next(0, cur)) return;
  f32x4 acc[2][2][4][2];
#pragma unroll
  for (int a = 0; a < 2; ++a)
#pragma unroll
    for (int b = 0; b < 2; ++b)
#pragma unroll
      for (int m = 0; m < 4; ++m)
#pragma unroll
        for (int n = 0; n < 2; ++n) acc[a][b][m][n] = (f32x4){0.f, 0.f, 0.f, 0.f};
  bf16x8 At[4][2], B0[2][2], B1[2][2];
  const char* cA = (const char*)g.A + (size_t)cur.pm * tstepA + (size_t)cur.k0 * kstepA; const char* cB = (const char*)g.Bt + (size_t)cur.pn * tstepB + (size_t)cur.k0 * kstep;
  PG8_STAGE(PG8_SB(0, 0), cB, voffB); PG8_STAGE(PG8_SA(0, 0), cA, voffA); PG8_STAGE(PG8_SB(0, 1), cB + hstepB, voffB); PG8_STAGE(PG8_SA(0, 1), cA + hstepA, voffA);
  if (wr == 1) PG8_BAR;
  PG8_WAIT_V(4); PG8_BAR;
  PG8_STAGE(PG8_SB(1, 0), cB + kstep, voffB); PG8_STAGE(PG8_SA(1, 0), cA + kstepA, voffA); PG8_STAGE(PG8_SB(1, 1), cB + hstepB + kstep, voffB);
  PG8_WAIT_V(6); PG8_BAR;
  for (;;) {
    const bool has_next = S.next(ui + 1, nxt);
    const char* nA = has_next ? (const char*)g.A + (size_t)nxt.pm * tstepA + (size_t)nxt.k0 * kstepA : cA; const char* nB = has_next ? (const char*)g.Bt + (size_t)nxt.pn * tstepB + (size_t)nxt.k0 * kstep : cB;
    for (int t = 0; t < nt; t += 2) {
      const bool last = (t == nt - 2);
      const char* a1 = cA + (size_t)(t + 1) * kstepA;
      const char* a2 = last ? nA : cA + (size_t)(t + 2) * kstepA; const char* b2 = last ? nB : cB + (size_t)(t + 2) * kstep;
      const char* a3 = a2 + kstepA; const char* b3 = b2 + kstep;
      PG8_LDB(B0, 0, 0); PG8_SCHED; PG8_LDA(At, 0, 0); PG8_STAGE(PG8_SA(1, 1), a1 + hstepA, voffA);
      PG8_WAIT_L(8); PG8_BAR; PG8_WAIT_L(0); PG8_MMA(0, 0, At, B0); PG8_BAR; PG8_SCHED;
      PG8_LDB(B1, 0, 1); PG8_STAGE(PG8_SB(0, 0), b2, voffB);
      PG8_BAR; PG8_WAIT_L(0); PG8_MMA(0, 1, At, B1); PG8_BAR;
      PG8_LDA(At, 0, 1); PG8_STAGE(PG8_SA(0, 0), a2, voffA);
      PG8_BAR; PG8_WAIT_L(0); PG8_MMA(1, 0, At, B0); PG8_BAR; PG8_SCHED;
      PG8_STAGE(PG8_SB(0, 1), b2 + hstepB, voffB);
      PG8_WAIT_V(6); PG8_BAR; PG8_MMA(1, 1, At, B1); PG8_BAR;
      PG8_LDB(B0, 1, 0); PG8_SCHED; PG8_LDA(At, 1, 0); PG8_STAGE(PG8_SA(0, 1), a2 + hstepA, voffA);
      PG8_WAIT_L(8); PG8_BAR; PG8_WAIT_L(0); PG8_MMA(0, 0, At, B0); PG8_BAR; PG8_SCHED;
      PG8_LDB(B1, 1, 1); PG8_STAGE(PG8_SB(1, 0), b3, voffB);
      PG8_BAR; PG8_WAIT_L(0); PG8_MMA(0, 1, At, B1); PG8_BAR;
      PG8_LDA(At, 1, 1); PG8_STAGE(PG8_SA(1, 0), a3, voffA);
      PG8_BAR; PG8_WAIT_L(0); PG8_MMA(1, 0, At, B0); PG8_BAR; PG8_SCHED;
      PG8_STAGE(PG8_SB(1, 1), b3 + hstepB, voffB);
      PG8_WAIT_V(6); PG8_BAR; PG8_MMA(1, 1, At, B1); PG8_BAR;
    }
    E(acc, cur, wr, wc, fr, fq);
    if (!has_next) break;
#pragma unroll
    for (int a = 0; a < 2; ++a)
#pragma unroll
      for (int b = 0; b < 2; ++b)
#pragma unroll
        for (int m = 0; m < 4; ++m)
#pragma unroll
          for (int n = 0; n < 2; ++n) acc[a][b][m][n] = (f32x4){0.f, 0.f, 0.f, 0.f};
    cur = nxt; cA = nA; cB = nB; ++ui;
  }
  PG8_WAIT_V(0);
  if (wr == 0) PG8_BAR;
  PG8_BAR;
#undef PG8_SA
#undef PG8_SB
#undef PG8_STAGE
#undef PG8_LDA
#undef PG8_LDB
#undef PG8_MMA
#undef PG8_WAIT_V
#undef PG8_WAIT_L
#undef PG8_BAR
#undef PG8_SCHED
}

typedef f32x4 (&AccRef)[2][2][4][2];
DI unsigned xb_ld(unsigned* p)              { return __hip_atomic_load(p, __ATOMIC_RELAXED, __HIP_MEMORY_SCOPE_AGENT); }
DI unsigned xb_add(unsigned* p, unsigned v) { return __hip_atomic_fetch_add(p, v, __ATOMIC_RELAXED, __HIP_MEMORY_SCOPE_AGENT); }
#define EPI_ROWS for (int ai = 0; ai < 2; ++ai) _Pragma("unroll") for (int m = 0; m < 4; ++m)
#define EPI_ROW(u) ((u).pm * BM + ai * HALF + wr * 64 + m * 16 + fr)
#define EPI_COL(bj) ((bj) * HALF + wc * 32 + fq * 8)

DI void rope8(f32x4& v0, f32x4& v1, const float2* __restrict__ tab, int pos, int fq) {
  const f32x4* t4 = (const f32x4*)(tab + (size_t)pos * 8);
  const f32x4 c0 = t4[0], c1 = t4[1], c2 = t4[2], c3 = t4[3];
  float pv[8];
#pragma unroll
  for (int j = 0; j < 4; ++j) { pv[j] = __shfl_xor(v0[j], 16); pv[4 + j] = __shfl_xor(v1[j], 16); }
  if (fq < 2) {
    const float sg = fq ? 1.f : -1.f;
    v0[0] = v0[0] * c0[0] + sg * pv[0] * c0[1]; v0[1] = v0[1] * c0[2] + sg * pv[1] * c0[3];
    v0[2] = v0[2] * c1[0] + sg * pv[2] * c1[1]; v0[3] = v0[3] * c1[2] + sg * pv[3] * c1[3];
    v1[0] = v1[0] * c2[0] + sg * pv[4] * c2[1]; v1[1] = v1[1] * c2[2] + sg * pv[5] * c2[3];
    v1[2] = v1[2] * c3[0] + sg * pv[6] * c3[1]; v1[3] = v1[3] * c3[2] + sg * pv[7] * c3[3];
  }
}

DI void rope8t(f32x4& v0, f32x4& v1, const f32x4 (&t)[4], int fq) {
  float pv[8];
#pragma unroll
  for (int j = 0; j < 4; ++j) { pv[j] = __shfl_xor(v0[j], 16); pv[4 + j] = __shfl_xor(v1[j], 16); }
  if (fq < 2) {
    const float sg = fq ? 1.f : -1.f;
    v0[0] = v0[0] * t[0][0] + sg * pv[0] * t[0][1]; v0[1] = v0[1] * t[0][2] + sg * pv[1] * t[0][3];
    v0[2] = v0[2] * t[1][0] + sg * pv[2] * t[1][1]; v0[3] = v0[3] * t[1][2] + sg * pv[3] * t[1][3];
    v1[0] = v1[0] * t[2][0] + sg * pv[4] * t[2][1]; v1[1] = v1[1] * t[2][2] + sg * pv[5] * t[2][3];
    v1[2] = v1[2] * t[3][0] + sg * pv[6] * t[3][1]; v1[3] = v1[3] * t[3][2] + sg * pv[7] * t[3][3];
  }
}

struct EpiProj {
  const Params& p;
  DI void operator()(AccRef acc, const Unit& u, int wr, int wc, int fr, int fq) const {
    const int pn = u.pn;
    const bool roped = ((wc & 1) == 0) && (pn < 2 || pn == 3 || pn == 4);
    float rs8[8];
#pragma unroll
    EPI_ROWS rs8[ai * 4 + m] = p.rstd0[EPI_ROW(u)];
#pragma unroll
    for (int ai = 0; ai < 2; ++ai)
#pragma unroll
    for (int mh = 0; mh < 2; ++mh) {
      f32x4 tabx[2][4];
      if (roped) {
#pragma unroll
        for (int mm = 0; mm < 2; ++mm) {
          const int m = mh * 2 + mm;
          const f32x4* t4 = (const f32x4*)(p.rope + (size_t)(EPI_ROW(u) & (SEQ - 1)) * 8);
          tabx[mm][0] = t4[0]; tabx[mm][1] = t4[1]; tabx[mm][2] = t4[2]; tabx[mm][3] = t4[3];
        }
      }
#pragma unroll
      for (int mm = 0; mm < 2; ++mm) {
        const int m = mh * 2 + mm;
        const f32x4 (&tabm)[4] = tabx[mm];
        const int row = EPI_ROW(u);
        const float rs = rs8[ai * 4 + m];
        const int s = row & (SEQ - 1), b = row >> 12;
#pragma unroll
        for (int bj = 0; bj < 2; ++bj) {
          f32x4 v0 = acc[ai][bj][m][0] * rs, v1 = acc[ai][bj][m][1] * rs;
          const int lc = EPI_COL(bj);
          if (pn < 2) {
            if (roped) rope8t(v0, v1, tabm, fq);
            *(u32x4*)(p.qb + (size_t)row * 512 + pn * 256 + lc) = pack8(v0 * QSCALE, v1 * QSCALE);
          } else if (pn < 5) {
            const int which = (pn - 2) * 2 + bj;
            if ((which == 2 || which == 4) && roped) rope8t(v0, v1, tabm, fq);
            const int g = wc >> 1, d = (wc & 1) * 32 + fq * 8;
            *(u32x4*)(p.kvb + ((size_t)((which * 16 + b * 2 + g) * SEQ + s)) * 64 + d) = pack8(v0, v1);
          } else if (pn < 7) {
            *(u32x4*)(p.ub + (size_t)row * 512 + (pn - 5) * 256 + lc) = pack8(v0, v1);
          } else if (pn < 15) {
#pragma unroll
            for (int j = 0; j < 4; ++j) { v0[j] = sigmoidf_(v0[j]); v1[j] = sigmoidf_(v1[j]); }
            *(u32x4*)(p.gm + (size_t)row * 2048 + (pn - 7) * 256 + lc) = pack8(v0, v1);
          } else {
            if (bj == 0 && wc == 0 && fq < 3) {
#pragma unroll
              for (int j = 0; j < 4; ++j) { v0[j] = sigmoidf_(v0[j]); v1[j] = sigmoidf_(v1[j]); }
              f32x4* gp = (f32x4*)(p.gate + (size_t)row * 24 + fq * 8);
              gp[0] = v0; gp[1] = v1;
            }
          }
        }
      }
    }
  }
};

struct EpiCmpHid {
  float* hid32;
  DI void operator()(AccRef acc, const Unit& u, int wr, int wc, int fr, int fq) const {
    float* base = hid32 + ((size_t)((u.k0 >> 3) * 32 + u.pm) * 256) * 256;
#pragma unroll
    EPI_ROWS {
      const int c = ai * HALF + wr * 64 + m * 16 + fr;
#pragma unroll
      for (int bj = 0; bj < 2; ++bj) {
        f32x4* dp = (f32x4*)(base + (size_t)c * 256 + EPI_COL(bj));
        dp[0] = acc[ai][bj][m][0]; dp[1] = acc[ai][bj][m][1];
      }
    }
  }
};

struct EpiCmpOut {
  const Params& p;
  DI void operator()(AccRef acc, const Unit& u, int wr, int wc, int fr, int fq) const {
    const int kv = u.pm >> 4, bg = u.pm & 15;
    const bool roped = (kv == 0) && (wc == 0);
    u16* dst = (kv ? p.vcmp : p.kcmp) + (size_t)bg * 256 * 64;
#pragma unroll
    for (int ai = 0; ai < 2; ++ai) {
      f32x4 tabx[4][4];
      {
#pragma unroll
        for (int m = 0; m < 4; ++m) {
          const int c = ai * HALF + wr * 64 + m * 16 + fr;
          const f32x4* t4 = (const f32x4*)(p.rope + (size_t)min(16 * c + 31, SEQ - 1) * 8);
          tabx[m][0] = t4[0]; tabx[m][1] = t4[1]; tabx[m][2] = t4[2]; tabx[m][3] = t4[3];
        }
      }
#pragma unroll
      for (int m = 0; m < 4; ++m) {
        const int c = ai * HALF + wr * 64 + m * 16 + fr;
        f32x4 v0 = acc[ai][0][m][0], v1 = acc[ai][0][m][1];
        if (roped) rope8t(v0, v1, tabx[m], fq);
        if (c == 255) { v0 = (f32x4){0.f, 0.f, 0.f, 0.f}; v1 = v0; }
        if (wc < 2) *(u32x4*)(dst + c * 64 + wc * 32 + fq * 8) = pack8(v0, v1);
      }
    }
  }
};

template <int PASS>
struct EpiMerge {
  const Params& p;
  DI void operator()(AccRef acc, const Unit& u, int wr, int wc, int fr, int fq) const {
#pragma unroll
    for (int ai = 0; ai < 2; ++ai) {
      u32x4 gq[4][2], ov[4][2];
#pragma unroll
      for (int m = 0; m < 4; ++m)
#pragma unroll
        for (int bj = 0; bj < 2; ++bj) {
          const int row = EPI_ROW(u), col = u.pn * BM + EPI_COL(bj);
          gq[m][bj] = *(const u32x4*)(p.gm + (size_t)row * 2048 + PASS * 1024 + col);
          if (PASS == 1) ov[m][bj] = *(const u32x4*)(p.mb + (size_t)row * 1024 + col);
        }
#pragma unroll
      for (int m = 0; m < 4; ++m) {
        const int row = EPI_ROW(u);
#pragma unroll
        for (int bj = 0; bj < 2; ++bj) {
          const int col = u.pn * BM + EPI_COL(bj);
          const u32x4 g = gq[m][bj];
          f32x4 v0 = acc[ai][bj][m][0], v1 = acc[ai][bj][m][1];
          v0[0] *= bf_lo(g[0]); v0[1] *= bf_hi(g[0]); v0[2] *= bf_lo(g[1]); v0[3] *= bf_hi(g[1]);
          v1[0] *= bf_lo(g[2]); v1[1] *= bf_hi(g[2]); v1[2] *= bf_lo(g[3]); v1[3] *= bf_hi(g[3]);
          if (PASS == 1) {
            const u32x4 o = ov[m][bj];
            v0[0] += bf_lo(o[0]); v0[1] += bf_hi(o[0]); v0[2] += bf_lo(o[1]); v0[3] += bf_hi(o[1]);
            v1[0] += bf_lo(o[2]); v1[1] += bf_hi(o[2]); v1[2] += bf_lo(o[3]); v1[3] += bf_hi(o[3]);
          }
          *(u32x4*)(p.mb + (size_t)row * 1024 + col) = pack8(v0, v1);
        }
      }
    }
  }
};

template <bool WITH_BF16, bool WITH_F32 = true>
struct EpiResid {
  const float* resid; float* out; u16* outb; float* ssq;
  DI void operator()(AccRef acc, const Unit& u, int wr, int wc, int fr, int fq) const {
#pragma unroll
    for (int ai = 0; ai < 2; ++ai) {
      f32x4 rv[4][2][2];
#pragma unroll
      for (int m = 0; m < 4; ++m)
#pragma unroll
        for (int bj = 0; bj < 2; ++bj) {
          const f32x4* rp = (const f32x4*)(resid + (size_t)EPI_ROW(u) * 1024 + u.pn * BM + EPI_COL(bj));
          rv[m][bj][0] = rp[0]; rv[m][bj][1] = rp[1];
        }
#pragma unroll
      for (int m = 0; m < 4; ++m) {
        const int row = EPI_ROW(u);
        float sq = 0.f;
#pragma unroll
        for (int bj = 0; bj < 2; ++bj) {
          const size_t a = (size_t)row * 1024 + u.pn * BM + EPI_COL(bj);
          const f32x4 v0 = rv[m][bj][0] + acc[ai][bj][m][0], v1 = rv[m][bj][1] + acc[ai][bj][m][1];
          if (WITH_F32) { f32x4* op = (f32x4*)(out + a); op[0] = v0; op[1] = v1; }
          if (WITH_BF16) *(u32x4*)(outb + a) = pack8(v0, v1);
#pragma unroll
          for (int j = 0; j < 4; ++j) sq += v0[j] * v0[j] + v1[j] * v1[j];
        }
        sq += __shfl_xor(sq, 16);
        sq += __shfl_xor(sq, 32);
        if (fq == 0) ssq[(size_t)row * 16 + u.pn * 4 + wc] = sq;
      }
    }
  }
};

struct EpiResidBf {
  u16* xb; float* ssq;
  DI void operator()(AccRef acc, const Unit& u, int wr, int wc, int fr, int fq) const {
#pragma unroll
    for (int ai = 0; ai < 2; ++ai) {
      u32x4 rv[4][2];
#pragma unroll
      for (int m = 0; m < 4; ++m)
#pragma unroll
        for (int bj = 0; bj < 2; ++bj) rv[m][bj] = *(const u32x4*)(xb + (size_t)EPI_ROW(u) * 1024 + u.pn * BM + EPI_COL(bj));
#pragma unroll
      for (int m = 0; m < 4; ++m) {
        const int row = EPI_ROW(u);
        float sq = 0.f;
#pragma unroll
        for (int bj = 0; bj < 2; ++bj) {
          const u32x4 r8 = rv[m][bj];
          f32x4 v0 = acc[ai][bj][m][0], v1 = acc[ai][bj][m][1];
          v0[0] += bf_lo(r8[0]); v0[1] += bf_hi(r8[0]); v0[2] += bf_lo(r8[1]); v0[3] += bf_hi(r8[1]);
          v1[0] += bf_lo(r8[2]); v1[1] += bf_hi(r8[2]); v1[2] += bf_lo(r8[3]); v1[3] += bf_hi(r8[3]);
          *(u32x4*)(xb + (size_t)row * 1024 + u.pn * BM + EPI_COL(bj)) = pack8(v0, v1);
#pragma unroll
          for (int j = 0; j < 4; ++j) sq += v0[j] * v0[j] + v1[j] * v1[j];
        }
        sq += __shfl_xor(sq, 16);
        sq += __shfl_xor(sq, 32);
        if (fq == 0) ssq[(size_t)row * 16 + u.pn * 4 + wc] = sq;
      }
    }
  }
};

struct EpiFinal {
  float* out; const u16* x1b; const float* gfin; float* ssq2; unsigned* cnt;
  DI void operator()(AccRef acc, const Unit& u, int wr, int wc, int fr, int fq) const {
#pragma unroll
    for (int ai = 0; ai < 2; ++ai)
#pragma unroll
    for (int mh = 0; mh < 2; ++mh) {
      f32x4 rv[2][2][2];
#pragma unroll
      for (int mm = 0; mm < 2; ++mm)
#pragma unroll
        for (int bj = 0; bj < 2; ++bj) {
          const int m = mh * 2 + mm;
          const u32x4 r8 = *(const u32x4*)(x1b + (size_t)EPI_ROW(u) * 1024 + u.pn * BM + EPI_COL(bj));
          rv[mm][bj][0] = (f32x4){bf_lo(r8[0]), bf_hi(r8[0]), bf_lo(r8[1]), bf_hi(r8[1])};
          rv[mm][bj][1] = (f32x4){bf_lo(r8[2]), bf_hi(r8[2]), bf_lo(r8[3]), bf_hi(r8[3])};
        }
#pragma unroll
      for (int mm = 0; mm < 2; ++mm) {
        const int m = mh * 2 + mm;
        const int row = EPI_ROW(u);
        float sq = 0.f;
#pragma unroll
        for (int bj = 0; bj < 2; ++bj) {
          acc[ai][bj][m][0] += rv[mm][bj][0]; acc[ai][bj][m][1] += rv[mm][bj][1];
#pragma unroll
          for (int j = 0; j < 4; ++j) sq += acc[ai][bj][m][0][j] * acc[ai][bj][m][0][j] + acc[ai][bj][m][1][j] * acc[ai][bj][m][1][j];
        }
        sq += __shfl_xor(sq, 16);
        sq += __shfl_xor(sq, 32);
        if (fq == 0) __hip_atomic_store(ssq2 + (size_t)row * 16 + u.pn * 4 + wc, sq, __ATOMIC_RELAXED, __HIP_MEMORY_SCOPE_AGENT);
      }
    }
    asm volatile("s_waitcnt vmcnt(0)" ::: "memory");
    unsigned* c = cnt + (u.pm * 2 + wr) * 16;
    if (fq == 0 && fr == 0) (void)xb_add(c, 1u);
    { unsigned sp = 0; while (xb_ld(c) < 16u) { __builtin_amdgcn_s_sleep(1); if (++sp > (1u << 20)) break; } }
#pragma unroll
    EPI_ROWS {
      const int row = EPI_ROW(u);
      unsigned long long* sp = (unsigned long long*)(ssq2 + (size_t)row * 16 + fq * 4);
      const unsigned long long q0 = __hip_atomic_load(sp, __ATOMIC_RELAXED, __HIP_MEMORY_SCOPE_AGENT);
      const unsigned long long q1 = __hip_atomic_load(sp + 1, __ATOMIC_RELAXED, __HIP_MEMORY_SCOPE_AGENT);
      float ss = (__uint_as_float((unsigned)q0) + __uint_as_float((unsigned)(q0 >> 32))) + (__uint_as_float((unsigned)q1) + __uint_as_float((unsigned)(q1 >> 32)));
      ss += __shfl_xor(ss, 16);
      ss += __shfl_xor(ss, 32);
      const float rs = rsqrtf(ss * (1.f / DM) + 1e-6f);
#pragma unroll
      for (int bj = 0; bj < 2; ++bj) {
        const int col = u.pn * BM + EPI_COL(bj);
        const f32x4* gp = (const f32x4*)(gfin + col);
        f32x4* op = (f32x4*)(out + (size_t)row * 1024 + col);
        op[0] = acc[ai][bj][m][0] * rs * gp[0]; op[1] = acc[ai][bj][m][1] * rs * gp[1];
      }
    }
  }
};

struct EpiFF1 {
  const Params& p;
  DI void operator()(AccRef acc, const Unit& u, int wr, int wc, int fr, int fq) const {
    f32x4 part[8];
#pragma unroll
    EPI_ROWS part[ai * 4 + m] = *(const f32x4*)(p.ssq + (size_t)EPI_ROW(u) * 16 + fq * 4);
    float rs8[8];
#pragma unroll
    for (int r = 0; r < 8; ++r) {
      float ss = (part[r][0] + part[r][1]) + (part[r][2] + part[r][3]);
      ss += __shfl_xor(ss, 16);
      ss += __shfl_xor(ss, 32);
      rs8[r] = rsqrtf(ss * (1.f / DM) + 1e-6f);
    }
#pragma unroll
    EPI_ROWS {
      const int row = EPI_ROW(u);
      const float rs = rs8[ai * 4 + m];
#pragma unroll
      for (int bj = 0; bj < 2; ++bj) {
        f32x4 v0 = acc[ai][bj][m][0] * rs, v1 = acc[ai][bj][m][1] * rs;
#pragma unroll
        for (int j = 0; j < 4; ++j) { const float r0 = fmaxf(v0[j], 0.f), r1 = fmaxf(v1[j], 0.f); v0[j] = r0 * r0; v1[j] = r1 * r1; }
        const int col = u.pn * BM + EPI_COL(bj);
        *(u32x4*)(p.act + ((size_t)(col >> 6) * T_TOK + row) * 64 + (col & 63)) = pack8(v0, v1);
      }
    }
  }
};

DI void p0_rows(const Params& p, int item) {
  const int w = threadIdx.x >> 6, lane = threadIdx.x & 63;
  const int row0 = item * 32 + w * 4;
  float4 v[4][4];
#pragma unroll
  for (int r = 0; r < 4; ++r) {
    const float4* src = (const float4*)(p.x + (size_t)(row0 + r) * DM);
#pragma unroll
    for (int i = 0; i < 4; ++i) v[r][i] = src[lane + 64 * i];
  }
#pragma unroll
  for (int r = 0; r < 4; ++r) {
    float ss = 0.f;
#pragma unroll
    for (int i = 0; i < 4; ++i) ss += v[r][i].x * v[r][i].x + v[r][i].y * v[r][i].y + v[r][i].z * v[r][i].z + v[r][i].w * v[r][i].w;
#pragma unroll
    for (int o = 32; o; o >>= 1) ss += __shfl_xor(ss, o);
    if (lane == 0) p.rstd0[row0 + r] = rsqrtf(ss * (1.f / DM) + 1e-6f);
    u32x2* dst = (u32x2*)(p.xb + (size_t)(row0 + r) * DM);
#pragma unroll
    for (int i = 0; i < 4; ++i) {
      u32x2 o = {pack_bf2(v[r][i].x, v[r][i].y), pack_bf2(v[r][i].z, v[r][i].w)};
      dst[lane + 64 * i] = o;
    }
  }
}

constexpr int TJ_WIN = 1024, TJ_WA = 128, TJ_WO = 256, TJ_W1 = 1024, TJ_W2 = 1024, TJ_C1 = 128, TJ_C2 = 16;
constexpr int TJ_TOTAL = TJ_WIN + TJ_WA + TJ_WO + TJ_W1 + TJ_W2 + 2 * TJ_C1 + 2 * TJ_C2;

constexpr int TJ_EARLY = TJ_WIN + 2 * TJ_C1 + 2 * TJ_C2;
DI void p0_transpose(const Params& p, int item, char* smem, int base) {
  const int half = threadIdx.x >> 8, tid = threadIdx.x & 255;
  int idx = item * 2 + half + base;
  const float* src; u16* dst; const float* scale = nullptr; int K, N, kind = 0;
  if (idx < TJ_WIN) { src = p.w_in; dst = p.w_in_t; scale = p.norm_mix; K = 1024; N = 3864; kind = 1; }
  else if ((idx -= TJ_WIN) < TJ_C1) { src = p.ck_w1; dst = p.cw1_t; K = 2048; N = 256; }
  else if ((idx -= TJ_C1) < TJ_C1) { src = p.cv_w1; dst = p.cw1_t + 256 * 2048; K = 2048; N = 256; }
  else if ((idx -= TJ_C1) < TJ_C2) { src = p.ck_w2; dst = p.cw2_t; K = 256; N = 64; }
  else if ((idx -= TJ_C2) < TJ_C2) { src = p.cv_w2; dst = p.cw2_t + 256 * 256; K = 256; N = 64; }
  else if ((idx -= TJ_C2) < TJ_WA) { src = p.w_ba; dst = p.wa_t; K = 512; N = 1024; }
  else if ((idx -= TJ_WA) < TJ_WO) { src = p.w_out; dst = p.wo_t; K = 1024; N = 1024; }
  else if ((idx -= TJ_WO) < TJ_W1) { src = p.w_ff1; dst = p.w1_t; scale = p.norm_mlp; K = 1024; N = 4096; }
  else { idx -= TJ_W1; src = p.w_ff2; dst = p.w2_t; K = 4096; N = 1024; kind = 2; }
  const int nk = K >> 6;
  const int k0 = (idx % nk) * 64, n0 = (idx / nk) * 64;
  float* tile = (float*)(smem + half * 16640);
  __syncthreads();
#pragma unroll
  for (int i = 0; i < 4; ++i) {
    const int kk = (tid >> 4) + 16 * i, nn = (tid & 15) * 4;
    const int nd = n0 + nn;
    int sc;
    if (kind == 1) sc = nd < 1280 ? nd : (nd < 3840 ? nd + 24 : (nd < 3864 ? nd - 2560 : -1));
    else sc = nd < N ? nd : -1;
    float4 v = make_float4(0.f, 0.f, 0.f, 0.f);
    if (sc >= 0) v = *(const float4*)(src + (size_t)(k0 + kk) * N + sc);
    if (scale) { float s = scale[k0 + kk]; v.x *= s; v.y *= s; v.z *= s; v.w *= s; }
    tile[kk * 65 + nn + 0] = v.x; tile[kk * 65 + nn + 1] = v.y; tile[kk * 65 + nn + 2] = v.z; tile[kk * 65 + nn + 3] = v.w;
  }
  __syncthreads();
  {
    const int n = tid >> 2, kq = (tid & 3) * 16;
    unsigned o[8];
#pragma unroll
    for (int j = 0; j < 8; ++j) o[j] = pack_bf2(tile[(kq + 2 * j) * 65 + n], tile[(kq + 2 * j + 1) * 65 + n]);
    u32x4* d = (kind == 2) ? (u32x4*)(dst + ((size_t)(k0 >> 6) * 1024 + (n0 + n)) * 64 + kq)
                           : (u32x4*)(dst + (size_t)(n0 + n) * K + k0 + kq);
    u32x4 o0 = {o[0], o[1], o[2], o[3]}, o1 = {o[4], o[5], o[6], o[7]};
    d[0] = o0; d[1] = o1;
  }
}

DI void p0_weff(const Params& p, int item, char* smem) {
  const int g = item >> 4, n0 = (item & 15) * 64, tid = threadIdx.x;
  float* pw = (float*)smem;
  float* ws = (float*)(smem + 66048);
  __syncthreads();
  for (int e = tid; e < 128 * 128; e += NTHR) { const int c = e >> 7, d = e & 127; pw[c * 129 + d] = p.pool_w[(size_t)g * 16384 + e] * p.pool_scale[g * 128 + d]; }
  for (int e = tid; e < 128 * 64; e += NTHR) { const int d = e >> 6, n = e & 63; ws[e] = p.w_bp[(size_t)(g * 128 + d) * 1024 + n0 + n]; }
  __syncthreads();
  const int c = tid & 127, nq = (tid >> 7) * 16;
  float a[16];
#pragma unroll
  for (int j = 0; j < 16; ++j) a[j] = 0.f;
  for (int d = 0; d < 128; ++d) {
    const float w = pw[c * 129 + d];
#pragma unroll
    for (int j = 0; j < 16; ++j) a[j] += w * ws[d * 64 + nq + j];
  }
#pragma unroll
  for (int j = 0; j < 16; ++j) p.wbe_t[(size_t)(n0 + nq + j) * 512 + g * 128 + c] = (u16)(pack_bf2(a[j], 0.f) & 0xffffu);
}

DI void p0_cbias(const Params& p, int idx, char* smem) {
  const int kv = idx >> 3, nc = idx & 7, tid = threadIdx.x, n = tid & 31, part = tid >> 5;
  const float* pe = kv ? p.pe_v : p.pe_k;
  const float* w1 = kv ? p.cv_w1 : p.ck_w1;
  float s = 0.f;
  for (int k = part * 128; k < part * 128 + 128; ++k) s += pe[k] * w1[(size_t)k * 256 + nc * 32 + n];
  float* red = (float*)smem;
  __syncthreads();
  red[part * 32 + n] = s;
  __syncthreads();
  if (tid < 32) {
    float t = 0.f;
#pragma unroll
    for (int j = 0; j < 16; ++j) t += red[j * 32 + tid];
    p.cbias[kv * 256 + nc * 32 + tid] = t;
  }
}

DI void p0_rope(const Params& p, int idx) {
  const int e = idx * NTHR + threadIdx.x;
  const int pos = e >> 3, i = e & 7;
  const float inv = powf(500000.0f, -(float)(2 * i) / 16.0f);
  const float ang = (float)pos * inv;
  float sn, cs;
  sincosf(ang, &sn, &cs);
  p.rope[e] = make_float2(cs, sn);
}

DI void p2a_pool_item(const Params& p, int item) {
  const int idx = item * NTHR + threadIdx.x;
  const int t = idx >> 6, ch = (idx & 63) * 8;
  const int grp = ch >> 7, wlen = 2 << grp, s = t & (SEQ - 1);
  const int cnt = min(s + 1, wlen);
  float a[8];
#pragma unroll
  for (int j = 0; j < 8; ++j) a[j] = 0.f;
  const u16* base = p.ub + (size_t)t * 512 + ch;
  u32x4 v[16];
#pragma unroll
  for (int k = 0; k < 16; ++k) { v[k] = (u32x4){0u, 0u, 0u, 0u}; if (k < cnt) v[k] = *(const u32x4*)(base - (size_t)k * 512); }
  const u32x4 cur = v[0];
#pragma unroll
  for (int k = 0; k < 16; ++k) {
#pragma unroll
    for (int j = 0; j < 4; ++j) { a[2 * j] += bf_lo(v[k][j]); a[2 * j + 1] += bf_hi(v[k][j]); }
  }
  const float ic = 1.f / (float)cnt;
  u32x4 o;
#pragma unroll
  for (int j = 0; j < 4; ++j) o[j] = pack_bf2(a[2 * j] * ic - bf_lo(cur[j]), a[2 * j + 1] * ic - bf_hi(cur[j]));
  *(u32x4*)(p.pooled + (size_t)t * 512 + ch) = o;
}

constexpr int AT_P = 65536, AT_S = 98304, AT_M = 131072;
template <int MODE>
DI void attn_tiles(const u16* __restrict__ Kg, const u16* __restrict__ Vg, int j0, int j1, char* smem,
                   const bf16x8 (&qf)[4], float& m, float& l, f32x16 (&O)[2], int lo, int hi, int lo_max, int hi_min,
                   unsigned mlo, unsigned mhi, float inv_l, int tok_l, int tid) {
  const int lane = tid & 63, l31 = lane & 31, h = lane >> 5;
  const int lk = tid >> 3, lc = tid & 7;
  const int kwr = lk * 128 + ((lc ^ ((lk >> 1) & 7)) << 4);
  const int vwr = 16384 + (lc >> 2) * 4096 + lk * 64 + (lc & 3) * 16;
  const int f = (l31 >> 1) & 7;
  const int krd = l31 * 128;
  int kx[4];
#pragma unroll
  for (int ks = 0; ks < 4; ++ks) kx[ks] = ((2 * ks + h) ^ f) << 4;
  const lds_cptr vrd = (lds_cptr)smem + 16384 + ((lane >> 4) & 1) * 32 + (lane & 3) * 8 + (4 * h + ((lane & 15) >> 2)) * 64;
  const int goff = lk * 64 + lc * 8;
  u32x4 rk, rv;
  rk = *(const u32x4*)(Kg + (size_t)j0 * 4096 + goff);
  if (MODE != 0) rv = *(const u32x4*)(Vg + (size_t)j0 * 4096 + goff);
  for (int j = j0; j <= j1; ++j) {
    const int bo = ((j - j0) & 1) * 8192;
    *(u32x4*)(smem + bo + kwr) = rk;
    if (MODE != 0) *(u32x4*)(smem + bo + vwr) = rv;
    __syncthreads();
    if (j < j1) {
      rk = *(const u32x4*)(Kg + (size_t)(j + 1) * 4096 + goff);
      if (MODE != 0) rv = *(const u32x4*)(Vg + (size_t)(j + 1) * 4096 + goff);
    }
    bool bit = true;
    if (MODE == 2) {
      bit = ((j < 32 ? (mlo >> j) : (mhi >> (j - 32))) & 1u) != 0;
      if (__ballot(bit) == 0ull) continue;
    }
    f32x16 s0 = zero16(), s1 = zero16();
#pragma unroll
    for (int ks = 0; ks < 4; ++ks) {
      bf16x8 a0 = *(const bf16x8*)(smem + bo + krd + kx[ks]);
      bf16x8 a1 = *(const bf16x8*)(smem + bo + krd + 4096 + kx[ks]);
      s0 = mfma32(a0, qf[ks], s0);
      s1 = mfma32(a1, qf[ks], s1);
    }
    const bool need_mask = (64 * j < lo_max) || (64 * j + 63 > hi_min);
    const int rlo = lo - 64 * j - 4 * h, span = hi - lo;
    if (need_mask) {
#pragma unroll
      for (int i = 0; i < 16; ++i) {
        const int c0 = 8 * (i >> 2) + (i & 3);
        if ((unsigned)(c0 - rlo) > (unsigned)span || span < 0) s0[i] = NEGF;
        if ((unsigned)(c0 + 32 - rlo) > (unsigned)span || span < 0) s1[i] = NEGF;
      }
    }
    float msub;
    if (MODE == 1) {
      msub = m;
    } else {
      float mx = s0[0];
#pragma unroll
      for (int i = 1; i < 16; ++i) mx = fmaxf(mx, s0[i]);
#pragma unroll
      for (int i = 0; i < 16; ++i) mx = fmaxf(mx, s1[i]);
      mx = fmaxf(mx, __shfl_xor(mx, 32));
      if (MODE == 2) mx = bit ? mx : NEGF;
      const float mn = fmaxf(m, mx);
      const float alpha = __builtin_amdgcn_exp2f(m - mn);
      m = mn;
      l *= alpha;
      if (MODE != 0) {
        if (__ballot(alpha != 1.f) != 0ull) {
#pragma unroll
          for (int i = 0; i < 16; ++i) { O[0][i] *= alpha; O[1][i] *= alpha; }
        }
      }
      msub = (MODE == 2 && !bit) ? 1e30f : mn;
    }
    msub = fmaxf(msub, -1e29f);
    float rs = 0.f;
#pragma unroll
    for (int i = 0; i < 16; ++i) {
      float p0 = __builtin_amdgcn_exp2f(s0[i] - msub), p1 = __builtin_amdgcn_exp2f(s1[i] - msub);
      if (MODE == 1) { p0 *= inv_l; p1 *= inv_l; }
      s0[i] = p0; s1[i] = p1;
      rs += p0 + p1;
    }
    l += rs;
    if (MODE == 0) continue;
    if (MODE == 1) {
      float* ps = (float*)(smem + AT_P) + tok_l * 256 + 64 * j + 4 * h;
#pragma unroll
      for (int gq = 0; gq < 4; ++gq) {
        float4 a, b;
        float t;
        t = s0[4 * gq + 0]; t += __shfl_xor(t, 1); t += __shfl_xor(t, 2); a.x = t;
        t = s0[4 * gq + 1]; t += __shfl_xor(t, 1); t += __shfl_xor(t, 2); a.y = t;
        t = s0[4 * gq + 2]; t += __shfl_xor(t, 1); t += __shfl_xor(t, 2); a.z = t;
        t = s0[4 * gq + 3]; t += __shfl_xor(t, 1); t += __shfl_xor(t, 2); a.w = t;
        t = s1[4 * gq + 0]; t += __shfl_xor(t, 1); t += __shfl_xor(t, 2); b.x = t;
        t = s1[4 * gq + 1]; t += __shfl_xor(t, 1); t += __shfl_xor(t, 2); b.y = t;
        t = s1[4 * gq + 2]; t += __shfl_xor(t, 1); t += __shfl_xor(t, 2); b.z = t;
        t = s1[4 * gq + 3]; t += __shfl_xor(t, 1); t += __shfl_xor(t, 2); b.w = t;
        if ((l31 & 3) == 0) { *(float4*)(ps + 8 * gq) = a; *(float4*)(ps + 32 + 8 * gq) = b; }
      }
    }
#pragma unroll
    for (int s4 = 0; s4 < 4; ++s4) {
      u32x4 pk;
      if (s4 < 2) {
#pragma unroll
        for (int jj = 0; jj < 4; ++jj) pk[jj] = pack_bf2(s0[8 * (s4 & 1) + 2 * jj], s0[8 * (s4 & 1) + 2 * jj + 1]);
      } else {
#pragma unroll
        for (int jj = 0; jj < 4; ++jj) pk[jj] = pack_bf2(s1[8 * (s4 & 1) + 2 * jj], s1[8 * (s4 & 1) + 2 * jj + 1]);
      }
      const bf16x8 pb = __builtin_bit_cast(bf16x8, pk);
#pragma unroll
      for (int dt = 0; dt < 2; ++dt) {
        s16x4 vlo = vtr(vrd + bo + dt * 4096 + s4 * 1024);
        s16x4 vhi = vtr(vrd + bo + dt * 4096 + s4 * 1024 + 512);
        bf16x8 vf = __builtin_shufflevector(vlo, vhi, 0, 1, 2, 3, 4, 5, 6, 7);
        O[dt] = mfma32(vf, pb, O[dt]);
      }
    }
  }
  __syncthreads();
}

template <int MODE>
DI void attn_tiles_pipe(const u16* __restrict__ Kg, const u16* __restrict__ Vg, int j0, int j1, char* smem,
                        const bf16x8 (&qf)[4], float& m, float& l, f32x16 (&O)[2], int lo, int hi, int lo_max, int hi_min,
                        unsigned mlo, unsigned mhi, int tid) {
  const int lane = tid & 63, l31 = lane & 31, h = lane >> 5;
  const int lk = tid >> 3, lc = tid & 7;
  const int kwr = lk * 128 + ((lc ^ ((lk >> 1) & 7)) << 4);
  const int vwr = 16384 + (lc >> 2) * 4096 + lk * 64 + (lc & 3) * 16;
  const int f = (l31 >> 1) & 7;
  const int krd = l31 * 128;
  int kx[4];
#pragma unroll
  for (int ks = 0; ks < 4; ++ks) kx[ks] = ((2 * ks + h) ^ f) << 4;
  const lds_cptr vrd = (lds_cptr)smem + 16384 + ((lane >> 4) & 1) * 32 + (lane & 3) * 8 + (4 * h + ((lane & 15) >> 2)) * 64;
  const int goff = lk * 64 + lc * 8;
  u32x4 rk, rv;
  auto qk_tile = [&](int bufoff, f32x16& d0, f32x16& d1) __attribute__((always_inline)) {
    bf16x8 ka[4], kb[4];
#pragma unroll
    for (int ks = 0; ks < 4; ++ks) { ka[ks] = *(const bf16x8*)(smem + bufoff + krd + kx[ks]); kb[ks] = *(const bf16x8*)(smem + bufoff + krd + 4096 + kx[ks]); }
    d0 = mfma32(ka[0], qf[0], zero16()); d1 = mfma32(kb[0], qf[0], zero16());
#pragma unroll
    for (int ks = 1; ks < 4; ++ks) { d0 = mfma32(ka[ks], qf[ks], d0); d1 = mfma32(kb[ks], qf[ks], d1); }
  };
  auto active = [&](int j) __attribute__((always_inline)) -> bool {
    if (MODE != 2) return true;
    const bool b = ((j < 32 ? (mlo >> j) : (mhi >> (j - 32))) & 1u) != 0;
    return __ballot(b) != 0ull;
  };
  auto step = [&](int j, bool act_c, bool& act_n, f32x16& c0, f32x16& c1, f32x16& n0, f32x16& n1) __attribute__((always_inline)) {
    const int par = (j - j0) & 1;
    const int bo = par * 8192, bn = (par ^ 1) * 8192;
    if (j < j1) *(u32x4*)(smem + bn + kwr) = rk;
    *(u32x4*)(smem + bo + vwr) = rv;
    __syncthreads();
    if (j + 2 <= j1) rk = *(const u32x4*)(Kg + (size_t)(j + 2) * 4096 + goff);
    if (j + 1 <= j1) rv = *(const u32x4*)(Vg + (size_t)(j + 1) * 4096 + goff);
    act_n = false;
    if (j < j1) { act_n = active(j + 1); if (act_n) qk_tile(bn, n0, n1); }
    if (!act_c) return;
    bool bit = true;
    if (MODE == 2) bit = ((j < 32 ? (mlo >> j) : (mhi >> (j - 32))) & 1u) != 0;
    const bool need_mask = (64 * j < lo_max) || (64 * j + 63 > hi_min);
    if (need_mask) {
      const int rlo = lo - 64 * j - 4 * h, span = hi - lo;
#pragma unroll
      for (int i = 0; i < 16; ++i) {
        const int cc = 8 * (i >> 2) + (i & 3);
        if ((unsigned)(cc - rlo) > (unsigned)span || span < 0) c0[i] = NEGF;
        if ((unsigned)(cc + 32 - rlo) > (unsigned)span || span < 0) c1[i] = NEGF;
      }
    }
    float mx = c0[0];
#pragma unroll
    for (int i = 1; i < 16; ++i) mx = fmaxf(mx, c0[i]);
#pragma unroll
    for (int i = 0; i < 16; ++i) mx = fmaxf(mx, c1[i]);
    mx = fmaxf(mx, __shfl_xor(mx, 32));
    if (MODE == 2) mx = bit ? mx : NEGF;
    const float mn = fmaxf(m, mx);
    const float alpha = __builtin_amdgcn_exp2f(m - mn);
    m = mn;
    l *= alpha;
    if (__ballot(alpha != 1.f) != 0ull) {
#pragma unroll
      for (int i = 0; i < 16; ++i) { O[0][i] *= alpha; O[1][i] *= alpha; }
    }
    const float msub = (MODE == 2 && !bit) ? 1e30f : fmaxf(mn, -1e29f);
    bf16x8 vf[4][2];
#pragma unroll
    for (int s4 = 0; s4 < 4; ++s4)
#pragma unroll
      for (int dt = 0; dt < 2; ++dt) {
        s16x4 vlo = vtr(vrd + bo + dt * 4096 + s4 * 1024);
        s16x4 vhi = vtr(vrd + bo + dt * 4096 + s4 * 1024 + 512);
        vf[s4][dt] = __builtin_shufflevector(vlo, vhi, 0, 1, 2, 3, 4, 5, 6, 7);
      }
    float rs = 0.f;
#pragma unroll
    for (int i = 0; i < 16; ++i) {
      const float p0 = __builtin_amdgcn_exp2f(c0[i] - msub), p1 = __builtin_amdgcn_exp2f(c1[i] - msub);
      c0[i] = p0; c1[i] = p1;
      rs += p0 + p1;
    }
    l += rs;
#pragma unroll
    for (int s4 = 0; s4 < 4; ++s4) {
      u32x4 pk;
      if (s4 < 2) {
#pragma unroll
        for (int jj = 0; jj < 4; ++jj) pk[jj] = pack_bf2(c0[8 * (s4 & 1) + 2 * jj], c0[8 * (s4 & 1) + 2 * jj + 1]);
      } else {
#pragma unroll
        for (int jj = 0; jj < 4; ++jj) pk[jj] = pack_bf2(c1[8 * (s4 & 1) + 2 * jj], c1[8 * (s4 & 1) + 2 * jj + 1]);
      }
      const bf16x8 pb = __builtin_bit_cast(bf16x8, pk);
      O[0] = mfma32(vf[s4][0], pb, O[0]);
      O[1] = mfma32(vf[s4][1], pb, O[1]);
    }
  };
  rk = *(const u32x4*)(Kg + (size_t)j0 * 4096 + goff);
  rv = *(const u32x4*)(Vg + (size_t)j0 * 4096 + goff);
  *(u32x4*)(smem + kwr) = rk;
  if (j0 < j1) rk = *(const u32x4*)(Kg + (size_t)(j0 + 1) * 4096 + goff);
  __syncthreads();
  f32x16 a0, a1, b0, b1;
  bool actA = true, actB = false;
  qk_tile(0, a0, a1);
  for (int j = j0; j <= j1; j += 2) {
    step(j, actA, actB, a0, a1, b0, b1);
    if (j + 1 <= j1) step(j + 1, actB, actA, b0, b1, a0, a1);
  }
  __syncthreads();
}

constexpr int RING = 6;
DI void glds16(const u16* g, char* lds) {
  __builtin_amdgcn_global_load_lds((const unsigned*)g, (LAS unsigned*)lds, 16, 0, 0);
}
template <int MODE>
DI void attn_tiles_ring(const u16* __restrict__ Kg, const u16* __restrict__ Vg, int j0, int j1, char* smem,
                        const bf16x8 (&qf)[4], float& m, float& l, f32x16 (&O)[2], int lo, int hi, int lo_max, int hi_min,
                        unsigned mlo, unsigned mhi, int tid) {
  const int lane = tid & 63, l31 = lane & 31, h = lane >> 5;
  const int f = (l31 >> 1) & 7;
  const int krd = l31 * 128;
  int kx[4];
#pragma unroll
  for (int ks = 0; ks < 4; ++ks) kx[ks] = ((2 * ks + h) ^ f) << 4;
  const int vrdo = 8192 + ((lane >> 4) & 1) * 32 + (lane & 3) * 8 + (4 * h + ((lane & 15) >> 2)) * 64;
  const lds_cptr lbase = (lds_cptr)smem;
  const int ksrc = (tid >> 3) * 64 + (((tid & 7) ^ (((tid >> 3) >> 1) & 7)) << 3);
  const int vsrc = ((tid >> 2) & 63) * 64 + (((tid >> 8) * 4 + (tid & 3)) << 3);
  const int dma = tid * 16;
  auto issue = [&](int t, int st) __attribute__((always_inline)) {
    const int tc = t < j1 ? t : j1;
    glds16(Kg + (size_t)tc * 4096 + ksrc, smem + st * 16384 + dma);
    glds16(Vg + (size_t)tc * 4096 + vsrc, smem + st * 16384 + 8192 + dma);
  };
  auto qk_tile = [&](int st, f32x16& d0, f32x16& d1) __attribute__((always_inline)) {
    const char* kb_ = smem + st * 16384;
    bf16x8 ka[4], kb[4];
#pragma unroll
    for (int ks = 0; ks < 4; ++ks) { ka[ks] = *(const bf16x8*)(kb_ + krd + kx[ks]); kb[ks] = *(const bf16x8*)(kb_ + krd + 4096 + kx[ks]); }
    d0 = mfma32(ka[0], qf[0], zero16()); d1 = mfma32(kb[0], qf[0], zero16());
#pragma unroll
    for (int ks = 1; ks < 4; ++ks) { d0 = mfma32(ka[ks], qf[ks], d0); d1 = mfma32(kb[ks], qf[ks], d1); }
  };
  auto active = [&](int j) __attribute__((always_inline)) -> bool {
    if (MODE != 2) return true;
    const bool b = ((j < 32 ? (mlo >> j) : (mhi >> (j - 32))) & 1u) != 0;
    return __ballot(b) != 0ull;
  };
  int st_cur = 0, st_iss = 5;
  auto step = [&](int j, bool act_c, bool& act_n, f32x16& c0, f32x16& c1, f32x16& n0, f32x16& n1) __attribute__((always_inline)) {
    asm volatile("s_waitcnt vmcnt(6)" ::: "memory");
    __builtin_amdgcn_s_barrier();
    issue(j + 5, st_iss);
    const int st_nxt = (st_cur == RING - 1) ? 0 : st_cur + 1;
    act_n = false;
    if (j < j1) { act_n = active(j + 1); if (act_n) qk_tile(st_nxt, n0, n1); }
    if (act_c) {
      bool bit = true;
      if (MODE == 2) bit = ((j < 32 ? (mlo >> j) : (mhi >> (j - 32))) & 1u) != 0;
      const bool need_mask = (64 * j < lo_max) || (64 * j + 63 > hi_min);
      if (need_mask) {
        const int rlo = lo - 64 * j - 4 * h, span = hi - lo;
#pragma unroll
        for (int i = 0; i < 16; ++i) {
          const int cc = 8 * (i >> 2) + (i & 3);
          if ((unsigned)(cc - rlo) > (unsigned)span || span < 0) c0[i] = NEGF;
          if ((unsigned)(cc + 32 - rlo) > (unsigned)span || span < 0) c1[i] = NEGF;
        }
      }
      float mx = c0[0];
#pragma unroll
      for (int i = 1; i < 16; ++i) mx = fmaxf(mx, c0[i]);
#pragma unroll
      for (int i = 0; i < 16; ++i) mx = fmaxf(mx, c1[i]);
      mx = fmaxf(mx, __shfl_xor(mx, 32));
      if (MODE == 2) mx = bit ? mx : NEGF;
      const float mn = fmaxf(m, mx);
      const float alpha = __builtin_amdgcn_exp2f(m - mn);
      m = mn;
      l *= alpha;
      if (__ballot(alpha != 1.f) != 0ull) {
#pragma unroll
        for (int i = 0; i < 16; ++i) { O[0][i] *= alpha; O[1][i] *= alpha; }
      }
      const float msub = (MODE == 2 && !bit) ? 1e30f : fmaxf(mn, -1e29f);
      const lds_cptr vb = lbase + st_cur * 16384 + vrdo;
      bf16x8 vf[4][2];
#pragma unroll
      for (int s4 = 0; s4 < 4; ++s4)
#pragma unroll
        for (int dt = 0; dt < 2; ++dt) {
          s16x4 vlo = vtr(vb + dt * 4096 + s4 * 1024);
          s16x4 vhi = vtr(vb + dt * 4096 + s4 * 1024 + 512);
          vf[s4][dt] = __builtin_shufflevector(vlo, vhi, 0, 1, 2, 3, 4, 5, 6, 7);
        }
      float rs = 0.f;
#pragma unroll
      for (int i = 0; i < 16; ++i) {
        const float p0 = __builtin_amdgcn_exp2f(c0[i] - msub), p1 = __builtin_amdgcn_exp2f(c1[i] - msub);
        c0[i] = p0; c1[i] = p1;
        rs += p0 + p1;
      }
      l += rs;
#pragma unroll
      for (int s4 = 0; s4 < 4; ++s4) {
        u32x4 pk;
        if (s4 < 2) {
#pragma unroll
          for (int jj = 0; jj < 4; ++jj) pk[jj] = pack_bf2(c0[8 * (s4 & 1) + 2 * jj], c0[8 * (s4 & 1) + 2 * jj + 1]);
        } else {
#pragma unroll
          for (int jj = 0; jj < 4; ++jj) pk[jj] = pack_bf2(c1[8 * (s4 & 1) + 2 * jj], c1[8 * (s4 & 1) + 2 * jj + 1]);
        }
        const bf16x8 pb = __builtin_bit_cast(bf16x8, pk);
        O[0] = mfma32(vf[s4][0], pb, O[0]);
        O[1] = mfma32(vf[s4][1], pb, O[1]);
      }
    }
    st_cur = st_nxt;
    st_iss = (st_iss == RING - 1) ? 0 : st_iss + 1;
  };
#pragma unroll
  for (int i = 0; i < 5; ++i) issue(j0 + i, i);
  asm volatile("s_waitcnt vmcnt(8)" ::: "memory");
  __builtin_amdgcn_s_barrier();
  f32x16 a0, a1, b0, b1;
  bool actA = true, actB = false;
  qk_tile(0, a0, a1);
  for (int j = j0; j <= j1; j += 2) {
    step(j, actA, actB, a0, a1, b0, b1);
    if (j + 1 <= j1) step(j + 1, actB, actA, b0, b1, a0, a1);
  }
  asm volatile("s_waitcnt vmcnt(0)" ::: "memory");
  __syncthreads();
}

DI void attn_cmp(const u16* __restrict__ Kc, const u16* __restrict__ Vc, int nct, char* smem, const bf16x8 (&qf)[4],
                 f32x16 (&O)[2], int hi, int hi_min, int tok_l, int tid) {
  const int lane = tid & 63, l31 = lane & 31, h = lane >> 5;
  const int f = (l31 >> 1) & 7;
  const int krd = l31 * 128;
  int kx[4];
#pragma unroll
  for (int ks = 0; ks < 4; ++ks) kx[ks] = ((2 * ks + h) ^ f) << 4;
  const int vrdo = 8192 + ((lane >> 4) & 1) * 32 + (lane & 3) * 8 + (4 * h + ((lane & 15) >> 2)) * 64;
  const lds_cptr lbase = (lds_cptr)smem;
  const int ksrc = (tid >> 3) * 64 + (((tid & 7) ^ (((tid >> 3) >> 1) & 7)) << 3);
  const int vsrc = ((tid >> 2) & 63) * 64 + (((tid >> 8) * 4 + (tid & 3)) << 3);
#pragma unroll
  for (int t = 0; t < 4; ++t) {
    const int tc = t < nct ? t : nct - 1;
    glds16(Kc + (size_t)tc * 4096 + ksrc, smem + t * 16384 + tid * 16);
    glds16(Vc + (size_t)tc * 4096 + vsrc, smem + t * 16384 + 8192 + tid * 16);
  }
  asm volatile("s_waitcnt vmcnt(0)" ::: "memory");
  __syncthreads();
  f32x16 S[4][2];
  float mx = NEGF;
#pragma unroll
  for (int t = 0; t < 4; ++t) {
    if (t < nct) {
      const char* kb_ = smem + t * 16384;
      bf16x8 ka[4], kb[4];
#pragma unroll
      for (int ks = 0; ks < 4; ++ks) { ka[ks] = *(const bf16x8*)(kb_ + krd + kx[ks]); kb[ks] = *(const bf16x8*)(kb_ + krd + 4096 + kx[ks]); }
      S[t][0] = mfma32(ka[0], qf[0], zero16()); S[t][1] = mfma32(kb[0], qf[0], zero16());
#pragma unroll
      for (int ks = 1; ks < 4; ++ks) { S[t][0] = mfma32(ka[ks], qf[ks], S[t][0]); S[t][1] = mfma32(kb[ks], qf[ks], S[t][1]); }
      if (64 * t + 63 > hi_min) {
        const int rhi = hi - 64 * t - 4 * h;
#pragma unroll
        for (int i = 0; i < 16; ++i) {
          const int cc = 8 * (i >> 2) + (i & 3);
          if (cc > rhi) S[t][0][i] = NEGF;
          if (cc + 32 > rhi) S[t][1][i] = NEGF;
        }
      }
#pragma unroll
      for (int i = 0; i < 16; ++i) mx = fmaxf(mx, fmaxf(S[t][0][i], S[t][1][i]));
    }
  }
  mx = fmaxf(mx, __shfl_xor(mx, 32));
  const float msub = fmaxf(mx, -1e29f);
  float ls = 0.f;
#pragma unroll
  for (int t = 0; t < 4; ++t)
    if (t < nct) {
#pragma unroll
      for (int i = 0; i < 16; ++i) {
        S[t][0][i] = __builtin_amdgcn_exp2f(S[t][0][i] - msub); S[t][1][i] = __builtin_amdgcn_exp2f(S[t][1][i] - msub);
        ls += S[t][0][i] + S[t][1][i];
      }
    }
  ls += __shfl_xor(ls, 32);
  const float inv_l = 1.f / fmaxf(ls, 1e-30f);
  O[0] = zero16(); O[1] = zero16();
#pragma unroll
  for (int t = 0; t < 4; ++t)
    if (t < nct) {
      f32x16& s0 = S[t][0];
      f32x16& s1 = S[t][1];
#pragma unroll
      for (int i = 0; i < 16; ++i) { s0[i] *= inv_l; s1[i] *= inv_l; }
      float* ps = (float*)(smem + AT_P) + tok_l * 256 + 64 * t + 4 * h;
#pragma unroll
      for (int gq = 0; gq < 4; ++gq) {
        float4 a, b;
        float u;
        u = s0[4 * gq + 0]; u += __shfl_xor(u, 1); u += __shfl_xor(u, 2); a.x = u;
        u = s0[4 * gq + 1]; u += __shfl_xor(u, 1); u += __shfl_xor(u, 2); a.y = u;
        u = s0[4 * gq + 2]; u += __shfl_xor(u, 1); u += __shfl_xor(u, 2); a.z = u;
        u = s0[4 * gq + 3]; u += __shfl_xor(u, 1); u += __shfl_xor(u, 2); a.w = u;
        u = s1[4 * gq + 0]; u += __shfl_xor(u, 1); u += __shfl_xor(u, 2); b.x = u;
        u = s1[4 * gq + 1]; u += __shfl_xor(u, 1); u += __shfl_xor(u, 2); b.y = u;
        u = s1[4 * gq + 2]; u += __shfl_xor(u, 1); u += __shfl_xor(u, 2); b.z = u;
        u = s1[4 * gq + 3]; u += __shfl_xor(u, 1); u += __shfl_xor(u, 2); b.w = u;
        if ((l31 & 3) == 0) { *(float4*)(ps + 8 * gq) = a; *(float4*)(ps + 32 + 8 * gq) = b; }
      }
      const lds_cptr vb = lbase + t * 16384 + vrdo;
#pragma unroll
      for (int s4 = 0; s4 < 4; ++s4) {
        u32x4 pk;
        if (s4 < 2) {
#pragma unroll
          for (int jj = 0; jj < 4; ++jj) pk[jj] = pack_bf2(s0[8 * (s4 & 1) + 2 * jj], s0[8 * (s4 & 1) + 2 * jj + 1]);
        } else {
#pragma unroll
          for (int jj = 0; jj < 4; ++jj) pk[jj] = pack_bf2(s1[8 * (s4 & 1) + 2 * jj], s1[8 * (s4 & 1) + 2 * jj + 1]);
        }
        const bf16x8 pb = __builtin_bit_cast(bf16x8, pk);
#pragma unroll
        for (int dt = 0; dt < 2; ++dt) {
          s16x4 vlo = vtr(vb + dt * 4096 + s4 * 1024);
          s16x4 vhi = vtr(vb + dt * 4096 + s4 * 1024 + 512);
          bf16x8 vf = __builtin_shufflevector(vlo, vhi, 0, 1, 2, 3, 4, 5, 6, 7);
          O[dt] = mfma32(vf, pb, O[dt]);
        }
      }
    }
  __syncthreads();
}

DI void attn_item(const Params& p, int bg, int qt, char* smem) {
  const int tid = opaque_tid(), lane = tid & 63, w = tid >> 6, l31 = lane & 31, h = lane >> 5;
  const int b = bg >> 1, g = bg & 1;
  const int t0 = qt * 64;
  const int tok_l = w * 8 + (l31 >> 2);
  const int tpos = t0 + tok_l;
  const int r = l31 & 3;
  const size_t tglob = (size_t)b * SEQ + tpos;
  bf16x8 qf[4];
  {
    const u16* qp = p.qb + tglob * 512 + (g * 4 + r) * 64 + h * 8;
#pragma unroll
    for (int ks = 0; ks < 4; ++ks) qf[ks] = *(const bf16x8*)(qp + ks * 16);
  }
  const float g0 = p.gate[tglob * 24 + 0 + g * 4 + r];
  const float g1 = p.gate[tglob * 24 + 8 + g * 4 + r];
  const float g2 = p.gate[tglob * 24 + 16 + g * 4 + r];
  const int cur = t0 >> 6;
  f32x16 O[2];
  float m, l;
  unsigned* stash = (unsigned*)(smem + AT_S) + w * 1024 + lane;
  {
    const u16* Kc = p.kcmp + (size_t)bg * 256 * 64;
    const u16* Vc = p.vcmp + (size_t)bg * 256 * 64;
    const int nct = ((t0 + 32) >> 10) + 1;
    const int hi = (tpos - 31) >> 4;
    const int hi_min = (t0 - 31) >> 4;
    attn_cmp(Kc, Vc, nct, smem, qf, O, hi, hi_min, tok_l, tid);
    const float* Ps = (const float*)(smem + AT_P);
    unsigned long long* Ms = (unsigned long long*)(smem + AT_M);
    const int ncv = nct * 64;
    for (int tl = 0; tl < 8; ++tl) {
      const int tokl = w * 8 + tl;
      const int j = lane;
      const float* pr = Ps + tokl * 256;
      float imp = 0.f;
      if (4 * j < ncv) {
        float4 v = *(const float4*)(pr + 4 * j);
        imp = 2.f * (v.x + v.y + v.z) + v.w;
        if (j > 0) imp += pr[4 * j - 1];
      }
      unsigned key = ((__float_as_uint(imp) & ~63u) | (unsigned)(63 - j)) + 64u;
      if (j > cur) key = (unsigned)(63 - j);
      if (j == 0 || j == cur || j == cur - 1) key = 0xFFFFFF00u | (unsigned)(63 - j);
      unsigned* kl = (unsigned*)(smem + w * 256);
      kl[lane] = key;
      int cnt = 0;
#pragma unroll
      for (int k4 = 0; k4 < 16; ++k4) {
        const u32x4 q = *(const u32x4*)(kl + 4 * k4);
        cnt += (q[0] > key) + (q[1] > key) + (q[2] > key) + (q[3] > key);
      }
      unsigned long long bal = __ballot(cnt < 16);
      if (lane == 0) Ms[tokl] = bal;
    }
  }
  __syncthreads();
  unsigned mlo, mhi;
  {
    const unsigned* Mw = (const unsigned*)(smem + AT_M);
    mlo = Mw[tok_l * 2]; mhi = Mw[tok_l * 2 + 1];
  }
#pragma unroll
  for (int i = 0; i < 8; ++i) { stash[i * 64] = pack_bf2(g0 * O[0][2 * i], g0 * O[0][2 * i + 1]); stash[(8 + i) * 64] = pack_bf2(g0 * O[1][2 * i], g0 * O[1][2 * i + 1]); }
  {
    m = NEGF; l = 0.f;
    O[0] = zero16(); O[1] = zero16();
    attn_tiles_ring<2>(p.kvb + (size_t)(2 * 16 + bg) * SEQ * 64, p.kvb + (size_t)(3 * 16 + bg) * SEQ * 64, 0, cur, smem, qf, m, l, O,
                  0, tpos, 0, t0, mlo, mhi, tid);
    const float lt = l + __shfl_xor(l, 32);
    const float sc = g1 / fmaxf(lt, 1e-30f);
#pragma unroll
    for (int i = 0; i < 8; ++i) {
      const unsigned u0 = stash[i * 64], u1 = stash[(8 + i) * 64];
      stash[i * 64] = pack_bf2(bf_lo(u0) + sc * O[0][2 * i], bf_hi(u0) + sc * O[0][2 * i + 1]);
      stash[(8 + i) * 64] = pack_bf2(bf_lo(u1) + sc * O[1][2 * i], bf_hi(u1) + sc * O[1][2 * i + 1]);
    }
  }
  {
    m = NEGF; l = 0.f;
    O[0] = zero16(); O[1] = zero16();
    const int jlo = max(t0 - 511, 0) >> 6;
    attn_tiles_ring<3>(p.kvb + (size_t)(4 * 16 + bg) * SEQ * 64, p.kvb + (size_t)(5 * 16 + bg) * SEQ * 64, jlo, cur, smem, qf, m, l, O,
                  tpos - 511, tpos, t0 + 63 - 511, t0, 0u, 0u, tid);
    const float lt = l + __shfl_xor(l, 32);
    const float sc = g2 / fmaxf(lt, 1e-30f);
#pragma unroll
    for (int i = 0; i < 8; ++i) {
      const unsigned u0 = stash[i * 64], u1 = stash[(8 + i) * 64];
      O[0][2 * i] = bf_lo(u0) + sc * O[0][2 * i]; O[0][2 * i + 1] = bf_hi(u0) + sc * O[0][2 * i + 1];
      O[1][2 * i] = bf_lo(u1) + sc * O[1][2 * i]; O[1][2 * i + 1] = bf_hi(u1) + sc * O[1][2 * i + 1];
    }
  }
  u16* op = p.ob + tglob * 512 + (g * 4 + r) * 64 + 4 * h;
#pragma unroll
  for (int dt = 0; dt < 2; ++dt)
#pragma unroll
    for (int gq = 0; gq < 4; ++gq) {
      u32x2 o = {pack_bf2(O[dt][4 * gq], O[dt][4 * gq + 1]), pack_bf2(O[dt][4 * gq + 2], O[dt][4 * gq + 3])};
      *(u32x2*)(op + dt * 32 + 8 * gq) = o;
    }
}

DI void p10_rows(const Params& p, int item) {
  const int w = threadIdx.x >> 6, lane = threadIdx.x & 63;
  const int row = item * 8 + w;
  float s = (lane < 16) ? p.ssq2[(size_t)row * 16 + lane] : 0.f;
#pragma unroll
  for (int o = 8; o; o >>= 1) s += __shfl_xor(s, o);
  s = __shfl(s, 0);
  const float rs = rsqrtf(s * (1.f / DM) + 1e-6f);
  float4* o4 = (float4*)(p.out + (size_t)row * DM);
  const float4* g4 = (const float4*)p.norm_final;
#pragma unroll
  for (int i = 0; i < 4; ++i) {
    float4 v = o4[lane + 64 * i], g = g4[lane + 64 * i];
    v.x *= rs * g.x; v.y *= rs * g.y; v.z *= rs * g.z; v.w *= rs * g.w;
    o4[lane + 64 * i] = v;
  }
}


#define XB_TMO      128
#define XB_XCNT(j)  (256  + 64 * (j))
#define XB_XSUB(j)  (1280 + 64 * (j))
#define XB_XGEN(j)  (2304 + 64 * (j))
#define XB_TOP      3328
#define XB_TOPGEN   3392
#define XCD_BAR_WORDS 3456
#define XB_SPIN_CAP (1u << 18)
DI unsigned xb_xcc_id() { return (unsigned)__builtin_amdgcn_s_getreg((3 << 11) | 20) & 0xFu; }
#define XB_SPIN(cond, bar) do { unsigned _sp = 0; while (cond) { __builtin_amdgcn_s_sleep(1); \
    if ((++_sp & 255u) == 0u) { if (xb_ld(&(bar)[XB_TMO])) break; if (_sp > XB_SPIN_CAP) { atomicAdd(&(bar)[XB_TMO], 1u); break; } } } } while (0)
struct XcdBarrier { unsigned* bar; unsigned x; volatile LAS unsigned* st; };
DI XcdBarrier xcd_barrier_post(unsigned* bar, volatile LAS unsigned* st) {
  XcdBarrier b; b.bar = bar; b.x = xb_xcc_id(); b.st = st;
  if (threadIdx.x == 0) (void)xb_add(&bar[XB_XCNT(b.x)], 1u);
  return b;
}
DI void xcd_barrier_complete(unsigned* bar, unsigned x, unsigned& nloc, unsigned& nx) {
  const unsigned G = gridDim.x * gridDim.y * gridDim.z;
  unsigned sum, cnt, mine, sp = 0u;
  for (;;) {
    sum = 0u; cnt = 0u; mine = 0u;
#pragma unroll
    for (unsigned j = 0; j < 16; ++j) { const unsigned c = xb_ld(&bar[XB_XCNT(j)]); sum += c; cnt += (c > 0u) ? 1u : 0u; mine = (j == x) ? c : mine; }
    if (sum == G) break;
    __builtin_amdgcn_s_sleep(1);
    if ((++sp & 255u) == 0u) { if (xb_ld(&bar[XB_TMO])) break; if (sp > XB_SPIN_CAP) { atomicAdd(&bar[XB_TMO], 1u); break; } }
  }
  nloc = mine > 0u ? mine : 1u; nx = cnt > 0u ? cnt : 1u;
}
DI void xcd_barrier(const XcdBarrier& b) {
  asm volatile("s_waitcnt vmcnt(0)" ::: "memory");
  __syncthreads();
  if (threadIdx.x == 0) {
    unsigned* bar = b.bar;
    __builtin_amdgcn_s_waitcnt(0);
    unsigned nloc = b.st[0], nx = b.st[1];
    if (nloc == 0u) { xcd_barrier_complete(bar, b.x, nloc, nx); b.st[0] = nloc; b.st[1] = nx; }
    const unsigned old = xb_add(&bar[XB_XSUB(b.x)], 1u);
    const unsigned gen = old / nloc;
    if (old + 1u == (gen + 1u) * nloc) {
      __builtin_amdgcn_fence(__ATOMIC_RELEASE, "agent");
      asm volatile("s_waitcnt vmcnt(0)" ::: "memory");
      const unsigned og = xb_add(&bar[XB_TOP], 1u);
      const unsigned tg = og / nx;
      if (og + 1u == (tg + 1u) * nx) xb_add(&bar[XB_TOPGEN], 1u);
      else XB_SPIN(xb_ld(&bar[XB_TOPGEN]) == tg, bar);
      __builtin_amdgcn_fence(__ATOMIC_ACQUIRE, "agent");
      xb_add(&bar[XB_XGEN(b.x)], 1u);
      asm volatile("s_waitcnt vmcnt(0)" ::: "memory");
    } else {
      XB_SPIN(xb_ld(&bar[XB_XGEN(b.x)]) == gen, bar);
      __builtin_amdgcn_fence(__ATOMIC_ACQUIRE, "agent");
      asm volatile("s_waitcnt vmcnt(0)" ::: "memory");
    }
  }
  __syncthreads();
}

__global__ void __launch_bounds__(NTHR, 2) nsa_pool_block_fwd(Params p) {
  extern __shared__ __attribute__((aligned(16))) unsigned char shm[];
  char* smem = (char*)shm;
  LAS unsigned char* lds = (LAS unsigned char*)shm;
  cg::grid_group grid = cg::this_grid();
  const int G = gridDim.x;
  const int bid = blockIdx.x;
  const int L = (G % 8 == 0) ? (bid % 8) * (G / 8) + bid / 8 : bid;
  volatile LAS unsigned* xst = (volatile LAS unsigned*)(lds + 133120);
  if (threadIdx.x < 4) xst[threadIdx.x] = 0u;
  __syncthreads();
  const XcdBarrier xb = xcd_barrier_post(p.bar, xst);

  if (PH_MASK & 1)
  {
    constexpr int N0 = 1024, N1 = N0 + TJ_EARLY / 2, N2 = N1 + 64, N3 = N2 + 16, N4 = N3 + 64;
    for (int rep = 0; rep < ((REP_MASK & 1) ? 2 : 1); ++rep)
    for (int it = N4 - 1 - bid; it >= 0; it -= G) {
      if (it < N0) p0_rows(p, it);
      else if (it < N1) p0_transpose(p, it - N0, smem, 0);
      else if (it < N2) p0_weff(p, it - N1, smem);
      else if (it < N3) p0_cbias(p, it - N2, smem);
      else p0_rope(p, it - N3);
    }
  }
  if (p.bar == nullptr) grid.sync();
  xcd_barrier(xb);
  if (PH_MASK & 2) {
    Sched S{0, G, bid};
    EpiProj E{p};
    for (int rep = 0; rep < ((REP_MASK & 2) ? 2 : 1); ++rep)
    gemm_phase(lds, Gemm{p.xb, p.w_in_t, DM, DM, DM, 128, 128}, S, E);
  }
  xcd_barrier(xb);
  if (PH_MASK & 4) for (int rep = 0; rep < ((REP_MASK & 4) ? 2 : 1); ++rep)
  {
    Sched S{2, G, bid};
    EpiCmpHid E{(float*)p.mb};
    gemm_phase(lds, Gemm{p.kvb, p.cw1_t, 1024, 2048, 512, 128, 128}, S, E);
    for (int it = bid; it < 4096; it += G) p2a_pool_item(p, it);
  }
  xcd_barrier(xb);
  if (PH_MASK & 8) {
    Sched S{3, G, bid};
    EpiCmpOut E{p};
    for (int i = 0;; ++i) {
      Unit u;
      if (!S.next(i, u)) break;
      const float* h32 = (const float*)p.mb;
      const float* bias = p.cbias + u.pn * 256;
      for (int e0 = threadIdx.x; e0 < 8192; e0 += 4 * NTHR) {
        f32x4 pv[4][4][2];
#pragma unroll
        for (int q = 0; q < 4; ++q) {
          const int e = e0 + q * NTHR, c = e >> 5, n8 = (e & 31) * 8;
#pragma unroll
          for (int ks = 0; ks < 4; ++ks) {
            const f32x4* sp = (const f32x4*)(h32 + ((size_t)((ks * 32 + u.pm) * 256 + c)) * 256 + n8);
            pv[q][ks][0] = sp[0]; pv[q][ks][1] = sp[1];
          }
        }
#pragma unroll
        for (int q = 0; q < 4; ++q) {
          const int e = e0 + q * NTHR, c = e >> 5, n8 = (e & 31) * 8;
          f32x4 v0 = *(const f32x4*)(bias + n8), v1 = *(const f32x4*)(bias + n8 + 4);
#pragma unroll
          for (int ks = 0; ks < 4; ++ks) { v0 += pv[q][ks][0]; v1 += pv[q][ks][1]; }
#pragma unroll
          for (int j = 0; j < 4; ++j) { v0[j] = gelu_tanh(v0[j]); v1[j] = gelu_tanh(v1[j]); }
          *(u32x4*)(p.hid + ((size_t)u.pm * 256 + c) * 256 + n8) = pack8(v0, v1);
        }
      }
    }
    asm volatile("s_waitcnt vmcnt(0)" ::: "memory");
    __syncthreads();
    gemm_phase(lds, Gemm{p.hid, p.cw2_t, 256, 256, 256, 128, 128}, S, E);
    { Unit u0; const bool has_unit = S.next(0, u0);
      if (G >= 256) {
        if (!has_unit) {
          const int rank = bid - (bid >> 3) - (((bid & 7) > ((bid >> 3) & 7)) ? 1 : 0);
          for (int it = rank; it < (TJ_TOTAL - TJ_EARLY) / 2; it += G - 32) p0_transpose(p, it, smem, TJ_EARLY);
        }
      } else {
        __syncthreads();
        for (int it = bid; it < (TJ_TOTAL - TJ_EARLY) / 2; it += G) p0_transpose(p, it, smem, TJ_EARLY);
      }
    }
  }
  xcd_barrier(xb);
  if (ATTN_PRIO) { if (threadIdx.x >= 256) __builtin_amdgcn_s_setprio(2); }
  if (PH_MASK & 16) for (int rep = 0; rep < ((REP_MASK & 16) ? 2 : 1); ++rep)
  if (G == 256) {
    const int x = bid & 7, j = bid >> 3;
    for (int rd = 0; rd < 4; ++rd) {
      const int idx = rd * 32 + ((rd & 1) ? (31 - j) : j);
      attn_item(p, 2 * x + (idx & 1), 63 - (idx >> 1), smem);
    }
  } else
  for (int rd = 0; rd * G < 1024; ++rd) {
    const int i = rd * G + ((rd & 1) ? (G - 1 - L) : L);
    if (i < 1024) attn_item(p, i & 15, 63 - (i >> 4), smem);
  }
  xcd_barrier(xb);
  if (ATTN_PRIO) __builtin_amdgcn_s_setprio(0);
  if (PH_MASK & 32) {
    Sched S{1, G, bid};
    EpiMerge<0> E0{p};
    EpiMerge<1> E1{p};
    for (int rep = 0; rep < ((REP_MASK & 32) ? 2 : 1); ++rep) {
    gemm_phase(lds, Gemm{p.ob, p.wa_t, 512, 512, 512, 128, 128}, S, E0);
    gemm_phase(lds, Gemm{p.pooled, p.wbe_t, 512, 512, 512, 128, 128}, S, E1);
    }
  }
  xcd_barrier(xb);
  if (PH_MASK & 64) {
    Sched S{1, G, bid};
    EpiResidBf E{p.xb, p.ssq};
    for (int rep = 0; rep < ((REP_MASK & 64) ? 2 : 1); ++rep)
    gemm_phase(lds, Gemm{p.mb, p.wo_t, DM, DM, DM, 128, 128}, S, E);
  }
  xcd_barrier(xb);
  if (PH_MASK & 128) {
    Sched S{0, G, bid};
    EpiFF1 E{p};
    for (int rep = 0; rep < ((REP_MASK & 128) ? 2 : 1); ++rep)
    gemm_phase(lds, Gemm{p.xb, p.w1_t, DM, DM, DM, 128, 128}, S, E);
  }
  xcd_barrier(xb);
#if FUSE_FINAL
  if (PH_MASK & 256) {
    Sched S{1, G, bid};
    EpiFinal E{p.out, p.xb, p.norm_final, p.ssq2, p.bar + XCD_BAR_WORDS};
    gemm_phase(lds, Gemm{p.act, p.w2_t, 64, 64, 4096, (size_t)T_TOK * 128, (size_t)1024 * 128}, S, E);
  }
#else
  if (PH_MASK & 256) {
    Sched S{1, G, bid};
    EpiResid<false> E{p.out, p.out, nullptr, p.ssq2};
    gemm_phase(lds, Gemm{p.act, p.w2_t, 64, 64, 4096, (size_t)T_TOK * 128, (size_t)1024 * 128}, S, E);
  }
  xcd_barrier(xb);
  for (int it = bid; it < 4096; it += G) p10_rows(p, it);
#endif
}

extern "C" void kernel_launch(void* const* d_in, const int* in_sizes, int n_in, void* d_out, int out_size, void* d_ws,
                              size_t ws_size, hipStream_t stream) {
  (void)in_sizes; (void)n_in; (void)out_size; (void)ws_size;
  static int grid_blocks = 0;
  if (!grid_blocks) {
    int dev = 0, cus = 0, per_cu = 0;
    (void)hipGetDevice(&dev);
    (void)hipDeviceGetAttribute(&cus, hipDeviceAttributeMultiprocessorCount, dev);
    (void)hipFuncSetAttribute((const void*)nsa_pool_block_fwd, hipFuncAttributeMaxDynamicSharedMemorySize, LDS_BYTES);
    (void)hipOccupancyMaxActiveBlocksPerMultiprocessor(&per_cu, nsa_pool_block_fwd, NTHR, LDS_BYTES);
    if (per_cu > 1) per_cu = 1;
    if (per_cu < 1) per_cu = 1;
    grid_blocks = cus * per_cu;
  }
  Params p{};
  const float* const* in = (const float* const*)d_in;
  p.x = in[0]; p.norm_mix = in[1]; p.w_in = in[2]; p.pe_k = in[3]; p.pe_v = in[4]; p.ck_w1 = in[5]; p.ck_w2 = in[6];
  p.cv_w1 = in[7]; p.cv_w2 = in[8]; p.w_ba = in[9]; p.pool_w = in[10]; p.pool_scale = in[11]; p.w_bp = in[12];
  p.w_out = in[13]; p.norm_mlp = in[14]; p.w_ff1 = in[15]; p.w_ff2 = in[16]; p.norm_final = in[17];
  p.out = (float*)d_out;
  char* ws = (char*)d_ws;
  size_t off = 0;
  auto take = [&](size_t bytes) { char* r = ws + off; off += (bytes + 255) & ~(size_t)255; return r; };
  const size_t T = T_TOK;
  p.xb = (u16*)take(T * 1024 * 2);
  p.w_in_t = (u16*)take((size_t)NPROJ * 1024 * 2);
  p.wa_t = (u16*)take(1024 * 512 * 2);
  p.wbe_t = (u16*)take(1024 * 512 * 2);
  p.wo_t = (u16*)take(1024 * 1024 * 2);
  p.w1_t = (u16*)take((size_t)4096 * 1024 * 2);
  p.w2_t = (u16*)take((size_t)4096 * 1024 * 2);
  p.cw1_t = (u16*)take(2 * 256 * 2048 * 2);
  p.cw2_t = (u16*)take(2 * 256 * 256 * 2);
  p.rstd0 = (float*)take(T * 4);
  p.cbias = (float*)take(512 * 4);
  p.rope = (float2*)take((size_t)SEQ * 8 * 8);
  p.ssq = (float*)take(T * 16 * 4);
  p.ssq2 = (float*)take(T * 16 * 4);
  p.mb = (u16*)take(T * 1024 * 2);
  char* regionD = ws + off;
  p.qb = (u16*)take(T * 512 * 2);
  p.kvb = (u16*)take((size_t)6 * 16 * SEQ * 64 * 2);
  p.gate = (float*)take(T * 24 * 4);
  p.ub = (u16*)take(T * 512 * 2);
  p.gm = (u16*)take(T * 2048 * 2);
  p.hid = (u16*)take((size_t)2 * 16 * 256 * 256 * 2);
  p.kcmp = (u16*)take(16 * 256 * 64 * 2);
  p.vcmp = (u16*)take(16 * 256 * 64 * 2);
  p.pooled = (u16*)take(T * 512 * 2);
  p.ob = (u16*)take(T * 512 * 2);
  p.bar = (unsigned*)take((XCD_BAR_WORDS + 4096) * 4);
  p.act = (u16*)regionD;
  (void)hipMemsetAsync(p.bar, 0, (XCD_BAR_WORDS + 4096) * 4, stream);
  void* args[] = {&p};
  hipError_t e = hipLaunchCooperativeKernel((void*)nsa_pool_block_fwd, dim3(grid_blocks), dim3(NTHR), args, LDS_BYTES, stream);
  if (e != hipSuccess) fprintf(stderr, "cooperative launch failed: %s (grid %d)\n", hipGetErrorString(e), grid_blocks);
}
```

```cpp
#include <hip/hip_runtime.h>
#include <hip/hip_cooperative_groups.h>
#include <stdint.h>
#include <stdio.h>
namespace cg = cooperative_groups;

#define DI __device__ __forceinline__
#define LAS __attribute__((address_space(3)))
typedef unsigned short u16;
typedef __attribute__((ext_vector_type(8))) short bf16x8;
typedef __attribute__((ext_vector_type(4))) short s16x4;
typedef __attribute__((ext_vector_type(16))) float f32x16;
typedef __attribute__((ext_vector_type(4))) float f32x4;
typedef __attribute__((ext_vector_type(4))) unsigned u32x4;
typedef __attribute__((ext_vector_type(2))) unsigned u32x2;
typedef __attribute__((ext_vector_type(2))) float f32x2;
typedef __attribute__((ext_vector_type(2))) __bf16 bf16x2_t;
typedef LAS const char* lds_cptr;

constexpr int T_TOK = 32768, SEQ = 4096, DM = 1024;
constexpr int NPROJ = 4096;
constexpr int NTHR = 512;
constexpr int LDS_BYTES = 135168;
constexpr float NEGF = -1e30f;
constexpr float QSCALE = 0.125f * 1.4426950408889634f;
#ifndef REP_MASK
#define REP_MASK 0
#endif
#ifndef ATTN_PRIO
#define ATTN_PRIO 0
#endif
#ifndef FUSE_FINAL
#define FUSE_FINAL 1
#endif
#ifndef PH_MASK
#define PH_MASK 0xffff
#endif

struct Params {
  const float *x, *norm_mix, *w_in, *pe_k, *pe_v, *ck_w1, *ck_w2, *cv_w1, *cv_w2, *w_ba, *pool_w, *pool_scale, *w_bp,
      *w_out, *norm_mlp, *w_ff1, *w_ff2, *norm_final;
  float* out;
  u16 *xb, *w_in_t, *wa_t, *wbe_t, *wo_t, *w1_t, *w2_t, *cw1_t, *cw2_t;
  float *rstd0, *cbias;
  float2* rope;
  u16 *qb, *kvb;
  float* gate;
  u16 *ub, *gm, *hid, *kcmp, *vcmp, *pooled, *ob, *mb, *act;
  float *ssq, *ssq2;
  unsigned* bar;
};

DI unsigned pack_bf2(float a, float b) {
  f32x2 v = {a, b};
  bf16x2_t r = __builtin_convertvector(v, bf16x2_t);
  return __builtin_bit_cast(unsigned, r);
}
DI float bf_lo(unsigned u) { return __uint_as_float(u << 16); }
DI float bf_hi(unsigned u) { return __uint_as_float(u & 0xffff0000u); }
DI float sigmoidf_(float v) { return __builtin_amdgcn_rcpf(1.f + __builtin_amdgcn_exp2f(-1.4426950408889634f * v)); }
DI float gelu_tanh(float x) {
  float u = 0.7978845608028654f * (x + 0.044715f * x * x * x);
  float th = 1.f - 2.f / (__expf(2.f * u) + 1.f);
  return 0.5f * x * (1.f + th);
}
DI f32x16 mfma32(bf16x8 a, bf16x8 b, f32x16 c) { return __builtin_amdgcn_mfma_f32_32x32x16_bf16(a, b, c, 0, 0, 0); }
DI int opaque_tid() { int t; asm volatile("v_mov_b32 %0, %1" : "=v"(t) : "v"((int)threadIdx.x)); return t; }
DI f32x16 zero16() { f32x16 z; for (int i = 0; i < 16; ++i) z[i] = 0.f; return z; }
DI s16x4 vtr(lds_cptr p) { return __builtin_amdgcn_ds_read_tr16_b64_v4i16((LAS s16x4*)p); }
DI u32x4 pack8(const f32x4& a, const f32x4& b) {
  u32x4 w = {pack_bf2(a[0], a[1]), pack_bf2(a[2], a[3]), pack_bf2(b[0], b[1]), pack_bf2(b[2], b[3])};
  return w;
}

constexpr int BM = 256, BK = 64, HALF = 128, HTB = HALF * BK * 2;
DI int lds_byte(int r, int c) { const int st = (r >> 4) * 2 + (c >> 5), rr = r & 15, cc = c & 31, ob = rr * 64 + cc * 2; return st * 1024 + (ob ^ (((ob >> 9) & 1) << 5)); }
DI void stage_rc(int b, int& R, int& C) { const int st = b / 1024, sb = b % 1024, swz = sb ^ (((sb >> 9) & 1) << 5); R = (st >> 1) * 16 + swz / 64; C = (st & 1) * 32 + (swz % 64) / 2; }
DI int perm32(int rho) { const int n = rho >> 4, i = rho & 15; return 8 * (i >> 2) + 4 * n + (i & 3); }

struct Unit { int pm, pn, k0; };
struct Gemm { const u16* A; const u16* Bt; int lda, ldb, K; size_t kstepA, kstepB; };

struct Sched {
  int mode, G, bid;
  DI bool next(int i, Unit& u) const {
    u.k0 = 0;
    if (mode == 2) {
      int t;
      if (G >= 256) { if (i > 0 || (bid & 1) != ((bid >> 3) & 1) || (bid >> 1) >= 128) return false; t = bid >> 1; }
      else { t = i * G + bid; if (t >= 128) return false; }
      u.pm = t >> 2; u.pn = u.pm >> 4; u.k0 = (t & 3) * 8; return true;
    }
    if (mode == 3) {
      int t;
      if (G >= 256) { t = bid >> 3; if (i > 0 || (bid & 7) != (t & 7) || t >= 32) return false; }
      else { t = i * G + bid; if (t >= 32) return false; }
      u.pm = t; u.pn = t >> 4; return true;
    }
    const int nN = mode == 0 ? 16 : 4;
    if (G == 256) {
      const int x = bid & 7, j = bid >> 3;
      if (mode == 0) { if (i >= 8) return false; u.pn = (x & 3) * 4 + (j & 3); u.pm = (x >> 2) * 64 + i * 8 + (j >> 2); return true; }
      if (i >= 2) return false; u.pn = j & 3; u.pm = x * 16 + i * 8 + (j >> 2); return true;
    }
    const int t = i * G + bid;
    if (t >= nN * 128) return false;
    u.pn = t % nN; u.pm = t / nN; return true;
  }
};

template <class Epi>
DI void gemm_phase(LAS unsigned char* lds, const Gemm g, const Sched& S, const Epi& E) {
  const int tid = opaque_tid(), wid = __builtin_amdgcn_readfirstlane(tid >> 6), lane = tid & 63, wr = wid >> 2, wc = wid & 3, fr = lane & 15, fq = lane >> 4;
  const int nt = g.K / BK;
  unsigned voffA[2], voffB[2];
#pragma unroll
  for (int i = 0; i < 2; ++i) {
    int R, C; stage_rc(tid * 16 + i * 8192, R, C);
    const int Rb = (R & ~31) + perm32(R & 31);
    voffA[i] = (unsigned)(R * g.lda + C) * 2u; voffB[i] = (unsigned)(Rb * g.ldb + C) * 2u;
  }
  const size_t kstep = g.kstepB, kstepA = g.kstepA;
  const size_t hstepA = (size_t)HALF * g.lda * 2, hstepB = (size_t)HALF * g.ldb * 2;
  const size_t tstepA = 2 * hstepA, tstepB = 2 * hstepB;
  const unsigned ldsw = (unsigned)wid * 1024u;
  const int aoff = lds_byte(wr * 64 + fr, fq * 8), boff = lds_byte(wc * 32 + fr, fq * 8);
#define PG8_SA(b, h) (((b) * 2 + (h)) * HTB)
#define PG8_SB(b, h) ((4 + (b) * 2 + (h)) * HTB)
#define PG8_STAGE(bufoff, gbase, voff) do { _Pragma("unroll") for (int _i = 0; _i < 2; ++_i) \
    __builtin_amdgcn_global_load_lds((const unsigned*)((const char*)(gbase) + (voff)[_i]), (LAS unsigned*)(lds + (bufoff) + ldsw + _i * 8192), 16, 0, 0); } while (0)
#define PG8_LDA(dst, b, h) do { _Pragma("unroll") for (int m = 0; m < 4; ++m) _Pragma("unroll") for (int k = 0; k < 2; ++k) dst[m][k] = *(const LAS bf16x8*)(lds + PG8_SA(b, h) + aoff + m * 2048 + k * 1024); } while (0)
#define PG8_LDB(dst, b, h) do { _Pragma("unroll") for (int n = 0; n < 2; ++n) _Pragma("unroll") for (int k = 0; k < 2; ++k) dst[n][k] = *(const LAS bf16x8*)(lds + PG8_SB(b, h) + boff + n * 2048 + k * 1024); } while (0)
#define PG8_MMA(ai, bj, At, Bt) do { __builtin_amdgcn_s_setprio(1); _Pragma("unroll") for (int m = 0; m < 4; ++m) _Pragma("unroll") for (int n = 0; n < 2; ++n) _Pragma("unroll") for (int k = 0; k < 2; ++k) \
    acc[ai][bj][m][n] = __builtin_amdgcn_mfma_f32_16x16x32_bf16(Bt[n][k], At[m][k], acc[ai][bj][m][n], 0, 0, 0); __builtin_amdgcn_s_setprio(0); } while (0)
#define PG8_WAIT_V(n) asm volatile("s_waitcnt vmcnt(" #n ")" ::: "memory")
#define PG8_WAIT_L(n) asm volatile("s_waitcnt lgkmcnt(" #n ")" ::: "memory")
#define PG8_BAR __builtin_amdgcn_s_barrier()
#define PG8_SCHED __builtin_amdgcn_sched_barrier(0)
  Unit cur, nxt; int ui = 0;
  if (!S.next(0, cur)) return;
  f32x4 acc[2][2][4][2];
#pragma unroll
  for (int a = 0; a < 2; ++a)
#pragma unroll
    for (int b = 0; b < 2; ++b)
#pragma unroll
      for (int m = 0; m < 4; ++m)
#pragma unroll
        for (int n = 0; n < 2; ++n) acc[a][b][m][n] = (f32x4){0.f, 0.f, 0.f, 0.f};
  bf16x8 At[4][2], B0[2][2], B1[2][2];
  const char* cA = (const char*)g.A + (size_t)cur.pm * tstepA + (size_t)cur.k0 * kstepA; const char* cB = (const char*)g.Bt + (size_t)cur.pn * tstepB + (size_t)cur.k0 * kstep;
  PG8_STAGE(PG8_SB(0, 0), cB, voffB); PG8_STAGE(PG8_SA(0, 0), cA, voffA); PG8_STAGE(PG8_SB(0, 1), cB + hstepB, voffB); PG8_STAGE(PG8_SA(0, 1), cA + hstepA, voffA);
  if (wr == 1) PG8_BAR;
  PG8_WAIT_V(4); PG8_BAR;
  PG8_STAGE(PG8_SB(1, 0), cB + kstep, voffB); PG8_STAGE(PG8_SA(1, 0), cA + kstepA, voffA); PG8_STAGE(PG8_SB(1, 1), cB + hstepB + kstep, voffB);
  PG8_WAIT_V(6); PG8_BAR;
  for (;;) {
    const bool has_next = S.next(ui + 1, nxt);
    const char* nA = has_next ? (const char*)g.A + (size_t)nxt.pm * tstepA + (size_t)nxt.k0 * kstepA : cA; const char* nB = has_next ? (const char*)g.Bt + (size_t)nxt.pn * tstepB + (size_t)nxt.k0 * kstep : cB;
    for (int t = 0; t < nt; t += 2) {
      const bool last = (t == nt - 2);
      const char* a1 = cA + (size_t)(t + 1) * kstepA;
      const char* a2 = last ? nA : cA + (size_t)(t + 2) * kstepA; const char* b2 = last ? nB : cB + (size_t)(t + 2) * kstep;
      const char* a3 = a2 + kstepA; const char* b3 = b2 + kstep;
      PG8_LDB(B0, 0, 0); PG8_SCHED; PG8_LDA(At, 0, 0); PG8_STAGE(PG8_SA(1, 1), a1 + hstepA, voffA);
      PG8_WAIT_L(8); PG8_BAR; PG8_WAIT_L(0); PG8_MMA(0, 0, At, B0); PG8_BAR; PG8_SCHED;
      PG8_LDB(B1, 0, 1); PG8_STAGE(PG8_SB(0, 0), b2, voffB);
      PG8_BAR; PG8_WAIT_L(0); PG8_MMA(0, 1, At, B1); PG8_BAR;
      PG8_LDA(At, 0, 1); PG8_STAGE(PG8_SA(0, 0), a2, voffA);
      PG8_BAR; PG8_WAIT_L(0); PG8_MMA(1, 0, At, B0); PG8_BAR; PG8_SCHED;
      PG8_STAGE(PG8_SB(0, 1), b2 + hstepB, voffB);
      PG8_WAIT_V(6); PG8_BAR; PG8_MMA(1, 1, At, B1); PG8_BAR;
      PG8_LDB(B0, 1, 0); PG8_SCHED; PG8_LDA(At, 1, 0); PG8_STAGE(PG8_SA(0, 1), a2 + hstepA, voffA);
      PG8_WAIT_L(8); PG8_BAR; PG8_WAIT_L(0); PG8_MMA(0, 0, At, B0); PG8_BAR; PG8_SCHED;
      PG8_LDB(B1, 1, 1); PG8_STAGE(PG8_SB(1, 0), b3, voffB);
      PG8_BAR; PG8_WAIT_L(0); PG8_MMA(0, 1, At, B1); PG8_BAR;
      PG8_LDA(At, 1, 1); PG8_STAGE(PG8_SA(1, 0), a3, voffA);
      PG8_BAR; PG8_WAIT_L(0); PG8_MMA(1, 0, At, B0); PG8_BAR; PG8_SCHED;
      PG8_STAGE(PG8_SB(1, 1), b3 + hstepB, voffB);
      PG8_WAIT_V(6); PG8_BAR; PG8_MMA(1, 1, At, B1); PG8_BAR;
    }
    E(acc, cur, wr, wc, fr, fq);
    if (!has_next) break;
#pragma unroll
    for (int a = 0; a < 2; ++a)
#pragma unroll
      for (int b = 0; b < 2; ++b)
#pragma unroll
        for (int m = 0; m < 4; ++m)
#pragma unroll
          for (int n = 0; n < 2; ++n) acc[a][b][m][n] = (f32x4){0.f, 0.f, 0.f, 0.f};
    cur = nxt; cA = nA; cB = nB; ++ui;
  }
  PG8_WAIT_V(0);
  if (wr == 0) PG8_BAR;
  PG8_BAR;
#undef PG8_SA
#undef PG8_SB
#undef PG8_STAGE
#undef PG8_LDA
#undef PG8_LDB
#undef PG8_MMA
#undef PG8_WAIT_V
#undef PG8_WAIT_L
#undef PG8_BAR
#undef PG8_SCHED
}

typedef f32x4 (&AccRef)[2][2][4][2];
DI unsigned xb_ld(unsigned* p)              { return __hip_atomic_load(p, __ATOMIC_RELAXED, __HIP_MEMORY_SCOPE_AGENT); }
DI unsigned xb_add(unsigned* p, unsigned v) { return __hip_atomic_fetch_add(p, v, __ATOMIC_RELAXED, __HIP_MEMORY_SCOPE_AGENT); }
#define EPI_ROWS for (int ai = 0; ai < 2; ++ai) _Pragma("unroll") for (int m = 0; m < 4; ++m)
#define EPI_ROW(u) ((u).pm * BM + ai * HALF + wr * 64 + m * 16 + fr)
#define EPI_COL(bj) ((bj) * HALF + wc * 32 + fq * 8)

DI void rope8(f32x4& v0, f32x4& v1, const float2* __restrict__ tab, int pos, int fq) {
  const f32x4* t4 = (const f32x4*)(tab + (size_t)pos * 8);
  const f32x4 c0 = t4[0], c1 = t4[1], c2 = t4[2], c3 = t4[3];
  float pv[8];
#pragma unroll
  for (int j = 0; j < 4; ++j) { pv[j] = __shfl_xor(v0[j], 16); pv[4 + j] = __shfl_xor(v1[j], 16); }
  if (fq < 2) {
    const float sg = fq ? 1.f : -1.f;
    v0[0] = v0[0] * c0[0] + sg * pv[0] * c0[1]; v0[1] = v0[1] * c0[2] + sg * pv[1] * c0[3];
    v0[2] = v0[2] * c1[0] + sg * pv[2] * c1[1]; v0[3] = v0[3] * c1[2] + sg * pv[3] * c1[3];
    v1[0] = v1[0] * c2[0] + sg * pv[4] * c2[1]; v1[1] = v1[1] * c2[2] + sg * pv[5] * c2[3];
    v1[2] = v1[2] * c3[0] + sg * pv[6] * c3[1]; v1[3] = v1[3] * c3[2] + sg * pv[7] * c3[3];
  }
}

DI void rope8t(f32x4& v0, f32x4& v1, const f32x4 (&t)[4], int fq) {
  float pv[8];
#pragma unroll
  for (int j = 0; j < 4; ++j) { pv[j] = __shfl_xor(v0[j], 16); pv[4 + j] = __shfl_xor(v1[j], 16); }
  if (fq < 2) {
    const float sg = fq ? 1.f : -1.f;
    v0[0] = v0[0] * t[0][0] + sg * pv[0] * t[0][1]; v0[1] = v0[1] * t[0][2] + sg * pv[1] * t[0][3];
    v0[2] = v0[2] * t[1][0] + sg * pv[2] * t[1][1]; v0[3] = v0[3] * t[1][2] + sg * pv[3] * t[1][3];
    v1[0] = v1[0] * t[2][0] + sg * pv[4] * t[2][1]; v1[1] = v1[1] * t[2][2] + sg * pv[5] * t[2][3];
    v1[2] = v1[2] * t[3][0] + sg * pv[6] * t[3][1]; v1[3] = v1[3] * t[3][2] + sg * pv[7] * t[3][3];
  }
}

struct EpiProj {
  const Params& p;
  DI void operator()(AccRef acc, const Unit& u, int wr, int wc, int fr, int fq) const {
    const int pn = u.pn;
    const bool roped = ((wc & 1) == 0) && (pn < 2 || pn == 3 || pn == 4);
    float rs8[8];
#pragma unroll
    EPI_ROWS rs8[ai * 4 + m] = p.rstd0[EPI_ROW(u)];
#pragma unroll
    for (int ai = 0; ai < 2; ++ai)
#pragma unroll
    for (int mh = 0; mh < 2; ++mh) {
      f32x4 tabx[2][4];
      if (roped) {
#pragma unroll
        for (int mm = 0; mm < 2; ++mm) {
          const int m = mh * 2 + mm;
          const f32x4* t4 = (const f32x4*)(p.rope + (size_t)(EPI_ROW(u) & (SEQ - 1)) * 8);
          tabx[mm][0] = t4[0]; tabx[mm][1] = t4[1]; tabx[mm][2] = t4[2]; tabx[mm][3] = t4[3];
        }
      }
#pragma unroll
      for (int mm = 0; mm < 2; ++mm) {
        const int m = mh * 2 + mm;
        const f32x4 (&tabm)[4] = tabx[mm];
        const int row = EPI_ROW(u);
        const float rs = rs8[ai * 4 + m];
        const int s = row & (SEQ - 1), b = row >> 12;
#pragma unroll
        for (int bj = 0; bj < 2; ++bj) {
          f32x4 v0 = acc[ai][bj][m][0] * rs, v1 = acc[ai][bj][m][1] * rs;
          const int lc = EPI_COL(bj);
          if (pn < 2) {
            if (roped) rope8t(v0, v1, tabm, fq);
            *(u32x4*)(p.qb + (size_t)row * 512 + pn * 256 + lc) = pack8(v0 * QSCALE, v1 * QSCALE);
          } else if (pn < 5) {
            const int which = (pn - 2) * 2 + bj;
            if ((which == 2 || which == 4) && roped) rope8t(v0, v1, tabm, fq);
            const int g = wc >> 1, d = (wc & 1) * 32 + fq * 8;
            *(u32x4*)(p.kvb + ((size_t)((which * 16 + b * 2 + g) * SEQ + s)) * 64 + d) = pack8(v0, v1);
          } else if (pn < 7) {
            *(u32x4*)(p.ub + (size_t)row * 512 + (pn - 5) * 256 + lc) = pack8(v0, v1);
          } else if (pn < 15) {
#pragma unroll
            for (int j = 0; j < 4; ++j) { v0[j] = sigmoidf_(v0[j]); v1[j] = sigmoidf_(v1[j]); }
            *(u32x4*)(p.gm + (size_t)row * 2048 + (pn - 7) * 256 + lc) = pack8(v0, v1);
          } else {
            if (bj == 0 && wc == 0 && fq < 3) {
#pragma unroll
              for (int j = 0; j < 4; ++j) { v0[j] = sigmoidf_(v0[j]); v1[j] = sigmoidf_(v1[j]); }
              f32x4* gp = (f32x4*)(p.gate + (size_t)row * 24 + fq * 8);
              gp[0] = v0; gp[1] = v1;
            }
          }
        }
      }
    }
  }
};

struct EpiCmpHid {
  float* hid32;
  DI void operator()(AccRef acc, const Unit& u, int wr, int wc, int fr, int fq) const {
    float* base = hid32 + ((size_t)((u.k0 >> 3) * 32 + u.pm) * 256) * 256;
#pragma unroll
    EPI_ROWS {
      const int c = ai * HALF + wr * 64 + m * 16 + fr;
#pragma unroll
      for (int bj = 0; bj < 2; ++bj) {
        f32x4* dp = (f32x4*)(base + (size_t)c * 256 + EPI_COL(bj));
        dp[0] = acc[ai][bj][m][0]; dp[1] = acc[ai][bj][m][1];
      }
    }
  }
};

struct EpiCmpOut {
  const Params& p;
  DI void operator()(AccRef acc, const Unit& u, int wr, int wc, int fr, int fq) const {
    const int kv = u.pm >> 4, bg = u.pm & 15;
    const bool roped = (kv == 0) && (wc == 0);
    u16* dst = (kv ? p.vcmp : p.kcmp) + (size_t)bg * 256 * 64;
#pragma unroll
    for (int ai = 0; ai < 2; ++ai) {
      f32x4 tabx[4][4];
      {
#pragma unroll
        for (int m = 0; m < 4; ++m) {
          const int c = ai * HALF + wr * 64 + m * 16 + fr;
          const f32x4* t4 = (const f32x4*)(p.rope + (size_t)min(16 * c + 31, SEQ - 1) * 8);
          tabx[m][0] = t4[0]; tabx[m][1] = t4[1]; tabx[m][2] = t4[2]; tabx[m][3] = t4[3];
        }
      }
#pragma unroll
      for (int m = 0; m < 4; ++m) {
        const int c = ai * HALF + wr * 64 + m * 16 + fr;
        f32x4 v0 = acc[ai][0][m][0], v1 = acc[ai][0][m][1];
        if (roped) rope8t(v0, v1, tabx[m], fq);
        if (c == 255) { v0 = (f32x4){0.f, 0.f, 0.f, 0.f}; v1 = v0; }
        if (wc < 2) *(u32x4*)(dst + c * 64 + wc * 32 + fq * 8) = pack8(v0, v1);
      }
    }
  }
};

template <int PASS>
struct EpiMerge {
  const Params& p;
  DI void operator()(AccRef acc, const Unit& u, int wr, int wc, int fr, int fq) const {
#pragma unroll
    for (int ai = 0; ai < 2; ++ai) {
      u32x4 gq[4][2], ov[4][2];
#pragma unroll
      for (int m = 0; m < 4; ++m)
#pragma unroll
        for (int bj = 0; bj < 2; ++bj) {
          const int row = EPI_ROW(u), col = u.pn * BM + EPI_COL(bj);
          gq[m][bj] = *(const u32x4*)(p.gm + (size_t)row * 2048 + PASS * 1024 + col);
          if (PASS == 1) ov[m][bj] = *(const u32x4*)(p.mb + (size_t)row * 1024 + col);
        }
#pragma unroll
      for (int m = 0; m < 4; ++m) {
        const int row = EPI_ROW(u);
#pragma unroll
        for (int bj = 0; bj < 2; ++bj) {
          const int col = u.pn * BM + EPI_COL(bj);
          const u32x4 g = gq[m][bj];
          f32x4 v0 = acc[ai][bj][m][0], v1 = acc[ai][bj][m][1];
          v0[0] *= bf_lo(g[0]); v0[1] *= bf_hi(g[0]); v0[2] *= bf_lo(g[1]); v0[3] *= bf_hi(g[1]);
          v1[0] *= bf_lo(g[2]); v1[1] *= bf_hi(g[2]); v1[2] *= bf_lo(g[3]); v1[3] *= bf_hi(g[3]);
          if (PASS == 1) {
            const u32x4 o = ov[m][bj];
            v0[0] += bf_lo(o[0]); v0[1] += bf_hi(o[0]); v0[2] += bf_lo(o[1]); v0[3] += bf_hi(o[1]);
            v1[0] += bf_lo(o[2]); v1[1] += bf_hi(o[2]); v1[2] += bf_lo(o[3]); v1[3] += bf_hi(o[3]);
          }
          *(u32x4*)(p.mb + (size_t)row * 1024 + col) = pack8(v0, v1);
        }
      }
    }
  }
};

template <bool WITH_BF16, bool WITH_F32 = true>
struct EpiResid {
  const float* resid; float* out; u16* outb; float* ssq;
  DI void operator()(AccRef acc, const Unit& u, int wr, int wc, int fr, int fq) const {
#pragma unroll
    for (int ai = 0; ai < 2; ++ai) {
      f32x4 rv[4][2][2];
#pragma unroll
      for (int m = 0; m < 4; ++m)
#pragma unroll
        for (int bj = 0; bj < 2; ++bj) {
          const f32x4* rp = (const f32x4*)(resid + (size_t)EPI_ROW(u) * 1024 + u.pn * BM + EPI_COL(bj));
          rv[m][bj][0] = rp[0]; rv[m][bj][1] = rp[1];
        }
#pragma unroll
      for (int m = 0; m < 4; ++m) {
        const int row = EPI_ROW(u);
        float sq = 0.f;
#pragma unroll
        for (int bj = 0; bj < 2; ++bj) {
          const size_t a = (size_t)row * 1024 + u.pn * BM + EPI_COL(bj);
          const f32x4 v0 = rv[m][bj][0] + acc[ai][bj][m][0], v1 = rv[m][bj][1] + acc[ai][bj][m][1];
          if (WITH_F32) { f32x4* op = (f32x4*)(out + a); op[0] = v0; op[1] = v1; }
          if (WITH_BF16) *(u32x4*)(outb + a) = pack8(v0, v1);
#pragma unroll
          for (int j = 0; j < 4; ++j) sq += v0[j] * v0[j] + v1[j] * v1[j];
        }
        sq += __shfl_xor(sq, 16);
        sq += __shfl_xor(sq, 32);
        if (fq == 0) ssq[(size_t)row * 16 + u.pn * 4 + wc] = sq;
      }
    }
  }
};

struct EpiResidBf {
  u16* xb; float* ssq;
  DI void operator()(AccRef acc, const Unit& u, int wr, int wc, int fr, int fq) const {
#pragma unroll
    for (int ai = 0; ai < 2; ++ai) {
      u32x4 rv[4][2];
#pragma unroll
      for (int m = 0; m < 4; ++m)
#pragma unroll
        for (int bj = 0; bj < 2; ++bj) rv[m][bj] = *(const u32x4*)(xb + (size_t)EPI_ROW(u) * 1024 + u.pn * BM + EPI_COL(bj));
#pragma unroll
      for (int m = 0; m < 4; ++m) {
        const int row = EPI_ROW(u);
        float sq = 0.f;
#pragma unroll
        for (int bj = 0; bj < 2; ++bj) {
          const u32x4 r8 = rv[m][bj];
          f32x4 v0 = acc[ai][bj][m][0], v1 = acc[ai][bj][m][1];
          v0[0] += bf_lo(r8[0]); v0[1] += bf_hi(r8[0]); v0[2] += bf_lo(r8[1]); v0[3] += bf_hi(r8[1]);
          v1[0] += bf_lo(r8[2]); v1[1] += bf_hi(r8[2]); v1[2] += bf_lo(r8[3]); v1[3] += bf_hi(r8[3]);
          *(u32x4*)(xb + (size_t)row * 1024 + u.pn * BM + EPI_COL(bj)) = pack8(v0, v1);
#pragma unroll
          for (int j = 0; j < 4; ++j) sq += v0[j] * v0[j] + v1[j] * v1[j];
        }
        sq += __shfl_xor(sq, 16);
        sq += __shfl_xor(sq, 32);
        if (fq == 0) ssq[(size_t)row * 16 + u.pn * 4 + wc] = sq;
      }
    }
  }
};

struct EpiFinal {
  float* out; const u16* x1b; const float* gfin; float* ssq2; unsigned* cnt;
  DI void operator()(AccRef acc, const Unit& u, int wr, int wc, int fr, int fq) const {
#pragma unroll
    for (int ai = 0; ai < 2; ++ai) {
      u32x4 r8[4][2];
#pragma unroll
      for (int m = 0; m < 4; ++m)
#pragma unroll
        for (int bj = 0; bj < 2; ++bj) r8[m][bj] = *(const u32x4*)(x1b + (size_t)EPI_ROW(u) * 1024 + u.pn * BM + EPI_COL(bj));
#pragma unroll
      for (int m = 0; m < 4; ++m) {
        const int row = EPI_ROW(u);
        float sq = 0.f;
#pragma unroll
        for (int bj = 0; bj < 2; ++bj) {
          const u32x4 r = r8[m][bj];
          acc[ai][bj][m][0] += (f32x4){bf_lo(r[0]), bf_hi(r[0]), bf_lo(r[1]), bf_hi(r[1])};
          acc[ai][bj][m][1] += (f32x4){bf_lo(r[2]), bf_hi(r[2]), bf_lo(r[3]), bf_hi(r[3])};
#pragma unroll
          for (int j = 0; j < 4; ++j) sq += acc[ai][bj][m][0][j] * acc[ai][bj][m][0][j] + acc[ai][bj][m][1][j] * acc[ai][bj][m][1][j];
        }
        sq += __shfl_xor(sq, 16);
        sq += __shfl_xor(sq, 32);
        if (fq == 0) __hip_atomic_store(ssq2 + (size_t)row * 16 + u.pn * 4 + wc, sq, __ATOMIC_RELAXED, __HIP_MEMORY_SCOPE_AGENT);
      }
    }
    asm volatile("s_waitcnt vmcnt(0)" ::: "memory");
    unsigned* c = cnt + (u.pm * 2 + wr) * 16;
    if (fq == 0 && fr == 0) (void)xb_add(c, 1u);
    { unsigned sp = 0; while (xb_ld(c) < 16u) { __builtin_amdgcn_s_sleep(1); if (++sp > (1u << 20)) break; } }
#pragma unroll
    EPI_ROWS {
      const int row = EPI_ROW(u);
      unsigned long long* sp = (unsigned long long*)(ssq2 + (size_t)row * 16 + fq * 4);
      const unsigned long long q0 = __hip_atomic_load(sp, __ATOMIC_RELAXED, __HIP_MEMORY_SCOPE_AGENT);
      const unsigned long long q1 = __hip_atomic_load(sp + 1, __ATOMIC_RELAXED, __HIP_MEMORY_SCOPE_AGENT);
      float ss = (__uint_as_float((unsigned)q0) + __uint_as_float((unsigned)(q0 >> 32))) + (__uint_as_float((unsigned)q1) + __uint_as_float((unsigned)(q1 >> 32)));
      ss += __shfl_xor(ss, 16);
      ss += __shfl_xor(ss, 32);
      const float rs = rsqrtf(ss * (1.f / DM) + 1e-6f);
#pragma unroll
      for (int bj = 0; bj < 2; ++bj) {
        const int col = u.pn * BM + EPI_COL(bj);
        const f32x4* gp = (const f32x4*)(gfin + col);
        f32x4* op = (f32x4*)(out + (size_t)row * 1024 + col);
        op[0] = acc[ai][bj][m][0] * rs * gp[0]; op[1] = acc[ai][bj][m][1] * rs * gp[1];
      }
    }
  }
};

struct EpiFF1 {
  const Params& p;
  DI void operator()(AccRef acc, const Unit& u, int wr, int wc, int fr, int fq) const {
    f32x4 part[8];
#pragma unroll
    EPI_ROWS part[ai * 4 + m] = *(const f32x4*)(p.ssq + (size_t)EPI_ROW(u) * 16 + fq * 4);
    float rs8[8];
#pragma unroll
    for (int r = 0; r < 8; ++r) {
      float ss = (part[r][0] + part[r][1]) + (part[r][2] + part[r][3]);
      ss += __shfl_xor(ss, 16);
      ss += __shfl_xor(ss, 32);
      rs8[r] = rsqrtf(ss * (1.f / DM) + 1e-6f);
    }
#pragma unroll
    EPI_ROWS {
      const int row = EPI_ROW(u);
      const float rs = rs8[ai * 4 + m];
#pragma unroll
      for (int bj = 0; bj < 2; ++bj) {
        f32x4 v0 = acc[ai][bj][m][0] * rs, v1 = acc[ai][bj][m][1] * rs;
#pragma unroll
        for (int j = 0; j < 4; ++j) { const float r0 = fmaxf(v0[j], 0.f), r1 = fmaxf(v1[j], 0.f); v0[j] = r0 * r0; v1[j] = r1 * r1; }
        const int col = u.pn * BM + EPI_COL(bj);
        *(u32x4*)(p.act + ((size_t)(col >> 6) * T_TOK + row) * 64 + (col & 63)) = pack8(v0, v1);
      }
    }
  }
};

DI void p0_rows(const Params& p, int item) {
  const int w = threadIdx.x >> 6, lane = threadIdx.x & 63;
  const int row0 = item * 32 + w * 4;
  float4 v[4][4];
#pragma unroll
  for (int r = 0; r < 4; ++r) {
    const float4* src = (const float4*)(p.x + (size_t)(row0 + r) * DM);
#pragma unroll
    for (int i = 0; i < 4; ++i) v[r][i] = src[lane + 64 * i];
  }
#pragma unroll
  for (int r = 0; r < 4; ++r) {
    float ss = 0.f;
#pragma unroll
    for (int i = 0; i < 4; ++i) ss += v[r][i].x * v[r][i].x + v[r][i].y * v[r][i].y + v[r][i].z * v[r][i].z + v[r][i].w * v[r][i].w;
#pragma unroll
    for (int o = 32; o; o >>= 1) ss += __shfl_xor(ss, o);
    if (lane == 0) p.rstd0[row0 + r] = rsqrtf(ss * (1.f / DM) + 1e-6f);
    u32x2* dst = (u32x2*)(p.xb + (size_t)(row0 + r) * DM);
#pragma unroll
    for (int i = 0; i < 4; ++i) {
      u32x2 o = {pack_bf2(v[r][i].x, v[r][i].y), pack_bf2(v[r][i].z, v[r][i].w)};
      dst[lane + 64 * i] = o;
    }
  }
}

constexpr int TJ_WIN = 1024, TJ_WA = 128, TJ_WO = 256, TJ_W1 = 1024, TJ_W2 = 1024, TJ_C1 = 128, TJ_C2 = 16;
constexpr int TJ_TOTAL = TJ_WIN + TJ_WA + TJ_WO + TJ_W1 + TJ_W2 + 2 * TJ_C1 + 2 * TJ_C2;

constexpr int TJ_EARLY = TJ_WIN + 2 * TJ_C1 + 2 * TJ_C2;
DI void p0_transpose(const Params& p, int item, char* smem, int base) {
  const int half = threadIdx.x >> 8, tid = threadIdx.x & 255;
  int idx = item * 2 + half + base;
  const float* src; u16* dst; const float* scale = nullptr; int K, N, kind = 0;
  if (idx < TJ_WIN) { src = p.w_in; dst = p.w_in_t; scale = p.norm_mix; K = 1024; N = 3864; kind = 1; }
  else if ((idx -= TJ_WIN) < TJ_C1) { src = p.ck_w1; dst = p.cw1_t; K = 2048; N = 256; }
  else if ((idx -= TJ_C1) < TJ_C1) { src = p.cv_w1; dst = p.cw1_t + 256 * 2048; K = 2048; N = 256; }
  else if ((idx -= TJ_C1) < TJ_C2) { src = p.ck_w2; dst = p.cw2_t; K = 256; N = 64; }
  else if ((idx -= TJ_C2) < TJ_C2) { src = p.cv_w2; dst = p.cw2_t + 256 * 256; K = 256; N = 64; }
  else if ((idx -= TJ_C2) < TJ_WA) { src = p.w_ba; dst = p.wa_t; K = 512; N = 1024; }
  else if ((idx -= TJ_WA) < TJ_WO) { src = p.w_out; dst = p.wo_t; K = 1024; N = 1024; }
  else if ((idx -= TJ_WO) < TJ_W1) { src = p.w_ff1; dst = p.w1_t; scale = p.norm_mlp; K = 1024; N = 4096; }
  else { idx -= TJ_W1; src = p.w_ff2; dst = p.w2_t; K = 4096; N = 1024; kind = 2; }
  const int nk = K >> 6;
  const int k0 = (idx % nk) * 64, n0 = (idx / nk) * 64;
  float* tile = (float*)(smem + half * 16640);
  __syncthreads();
#pragma unroll
  for (int i = 0; i < 4; ++i) {
    const int kk = (tid >> 4) + 16 * i, nn = (tid & 15) * 4;
    const int nd = n0 + nn;
    int sc;
    if (kind == 1) sc = nd < 1280 ? nd : (nd < 3840 ? nd + 24 : (nd < 3864 ? nd - 2560 : -1));
    else sc = nd < N ? nd : -1;
    float4 v = make_float4(0.f, 0.f, 0.f, 0.f);
    if (sc >= 0) v = *(const float4*)(src + (size_t)(k0 + kk) * N + sc);
    if (scale) { float s = scale[k0 + kk]; v.x *= s; v.y *= s; v.z *= s; v.w *= s; }
    tile[kk * 65 + nn + 0] = v.x; tile[kk * 65 + nn + 1] = v.y; tile[kk * 65 + nn + 2] = v.z; tile[kk * 65 + nn + 3] = v.w;
  }
  __syncthreads();
  {
    const int n = tid >> 2, kq = (tid & 3) * 16;
    unsigned o[8];
#pragma unroll
    for (int j = 0; j < 8; ++j) o[j] = pack_bf2(tile[(kq + 2 * j) * 65 + n], tile[(kq + 2 * j + 1) * 65 + n]);
    u32x4* d = (kind == 2) ? (u32x4*)(dst + ((size_t)(k0 >> 6) * 1024 + (n0 + n)) * 64 + kq)
                           : (u32x4*)(dst + (size_t)(n0 + n) * K + k0 + kq);
    u32x4 o0 = {o[0], o[1], o[2], o[3]}, o1 = {o[4], o[5], o[6], o[7]};
    d[0] = o0; d[1] = o1;
  }
}

DI void p0_weff(const Params& p, int item, char* smem) {
  const int g = item >> 4, n0 = (item & 15) * 64, tid = threadIdx.x;
  float* pw = (float*)smem;
  float* ws = (float*)(smem + 66048);
  __syncthreads();
  for (int e = tid; e < 128 * 128; e += NTHR) { const int c = e >> 7, d = e & 127; pw[c * 129 + d] = p.pool_w[(size_t)g * 16384 + e] * p.pool_scale[g * 128 + d]; }
  for (int e = tid; e < 128 * 64; e += NTHR) { const int d = e >> 6, n = e & 63; ws[e] = p.w_bp[(size_t)(g * 128 + d) * 1024 + n0 + n]; }
  __syncthreads();
  const int c = tid & 127, nq = (tid >> 7) * 16;
  float a[16];
#pragma unroll
  for (int j = 0; j < 16; ++j) a[j] = 0.f;
  for (int d = 0; d < 128; ++d) {
    const float w = pw[c * 129 + d];
#pragma unroll
    for (int j = 0; j < 16; ++j) a[j] += w * ws[d * 64 + nq + j];
  }
#pragma unroll
  for (int j = 0; j < 16; ++j) p.wbe_t[(size_t)(n0 + nq + j) * 512 + g * 128 + c] = (u16)(pack_bf2(a[j], 0.f) & 0xffffu);
}

DI void p0_cbias(const Params& p, int idx, char* smem) {
  const int kv = idx >> 3, nc = idx & 7, tid = threadIdx.x, n = tid & 31, part = tid >> 5;
  const float* pe = kv ? p.pe_v : p.pe_k;
  const float* w1 = kv ? p.cv_w1 : p.ck_w1;
  float s = 0.f;
  for (int k = part * 128; k < part * 128 + 128; ++k) s += pe[k] * w1[(size_t)k * 256 + nc * 32 + n];
  float* red = (float*)smem;
  __syncthreads();
  red[part * 32 + n] = s;
  __syncthreads();
  if (tid < 32) {
    float t = 0.f;
#pragma unroll
    for (int j = 0; j < 16; ++j) t += red[j * 32 + tid];
    p.cbias[kv * 256 + nc * 32 + tid] = t;
  }
}

DI void p0_rope(const Params& p, int idx) {
  const int e = idx * NTHR + threadIdx.x;
  const int pos = e >> 3, i = e & 7;
  const float inv = powf(500000.0f, -(float)(2 * i) / 16.0f);
  const float ang = (float)pos * inv;
  float sn, cs;
  sincosf(ang, &sn, &cs);
  p.rope[e] = make_float2(cs, sn);
}

DI void p2a_pool_item(const Params& p, int item) {
  const int idx = item * NTHR + threadIdx.x;
  const int t = idx >> 6, ch = (idx & 63) * 8;
  const int grp = ch >> 7, wlen = 2 << grp, s = t & (SEQ - 1);
  const int cnt = min(s + 1, wlen);
  float a[8];
#pragma unroll
  for (int j = 0; j < 8; ++j) a[j] = 0.f;
  const u16* base = p.ub + (size_t)t * 512 + ch;
  u32x4 v[16];
#pragma unroll
  for (int k = 0; k < 16; ++k) { v[k] = (u32x4){0u, 0u, 0u, 0u}; if (k < cnt) v[k] = *(const u32x4*)(base - (size_t)k * 512); }
  const u32x4 cur = v[0];
#pragma unroll
  for (int k = 0; k < 16; ++k) {
#pragma unroll
    for (int j = 0; j < 4; ++j) { a[2 * j] += bf_lo(v[k][j]); a[2 * j + 1] += bf_hi(v[k][j]); }
  }
  const float ic = 1.f / (float)cnt;
  u32x4 o;
#pragma unroll
  for (int j = 0; j < 4; ++j) o[j] = pack_bf2(a[2 * j] * ic - bf_lo(cur[j]), a[2 * j + 1] * ic - bf_hi(cur[j]));
  *(u32x4*)(p.pooled + (size_t)t * 512 + ch) = o;
}

constexpr int AT_P = 65536, AT_S = 98304, AT_M = 131072;
template <int MODE>
DI void attn_tiles(const u16* __restrict__ Kg, const u16* __restrict__ Vg, int j0, int j1, char* smem,
                   const bf16x8 (&qf)[4], float& m, float& l, f32x16 (&O)[2], int lo, int hi, int lo_max, int hi_min,
                   unsigned mlo, unsigned mhi, float inv_l, int tok_l, int tid) {
  const int lane = tid & 63, l31 = lane & 31, h = lane >> 5;
  const int lk = tid >> 3, lc = tid & 7;
  const int kwr = lk * 128 + ((lc ^ ((lk >> 1) & 7)) << 4);
  const int vwr = 16384 + (lc >> 2) * 4096 + lk * 64 + (lc & 3) * 16;
  const int f = (l31 >> 1) & 7;
  const int krd = l31 * 128;
  int kx[4];
#pragma unroll
  for (int ks = 0; ks < 4; ++ks) kx[ks] = ((2 * ks + h) ^ f) << 4;
  const lds_cptr vrd = (lds_cptr)smem + 16384 + ((lane >> 4) & 1) * 32 + (lane & 3) * 8 + (4 * h + ((lane & 15) >> 2)) * 64;
  const int goff = lk * 64 + lc * 8;
  u32x4 rk, rv;
  rk = *(const u32x4*)(Kg + (size_t)j0 * 4096 + goff);
  if (MODE != 0) rv = *(const u32x4*)(Vg + (size_t)j0 * 4096 + goff);
  for (int j = j0; j <= j1; ++j) {
    const int bo = ((j - j0) & 1) * 8192;
    *(u32x4*)(smem + bo + kwr) = rk;
    if (MODE != 0) *(u32x4*)(smem + bo + vwr) = rv;
    __syncthreads();
    if (j < j1) {
      rk = *(const u32x4*)(Kg + (size_t)(j + 1) * 4096 + goff);
      if (MODE != 0) rv = *(const u32x4*)(Vg + (size_t)(j + 1) * 4096 + goff);
    }
    bool bit = true;
    if (MODE == 2) {
      bit = ((j < 32 ? (mlo >> j) : (mhi >> (j - 32))) & 1u) != 0;
      if (__ballot(bit) == 0ull) continue;
    }
    f32x16 s0 = zero16(), s1 = zero16();
#pragma unroll
    for (int ks = 0; ks < 4; ++ks) {
      bf16x8 a0 = *(const bf16x8*)(smem + bo + krd + kx[ks]);
      bf16x8 a1 = *(const bf16x8*)(smem + bo + krd + 4096 + kx[ks]);
      s0 = mfma32(a0, qf[ks], s0);
      s1 = mfma32(a1, qf[ks], s1);
    }
    const bool need_mask = (64 * j < lo_max) || (64 * j + 63 > hi_min);
    const int rlo = lo - 64 * j - 4 * h, span = hi - lo;
    if (need_mask) {
#pragma unroll
      for (int i = 0; i < 16; ++i) {
        const int c0 = 8 * (i >> 2) + (i & 3);
        if ((unsigned)(c0 - rlo) > (unsigned)span || span < 0) s0[i] = NEGF;
        if ((unsigned)(c0 + 32 - rlo) > (unsigned)span || span < 0) s1[i] = NEGF;
      }
    }
    float msub;
    if (MODE == 1) {
      msub = m;
    } else {
      float mx = s0[0];
#pragma unroll
      for (int i = 1; i < 16; ++i) mx = fmaxf(mx, s0[i]);
#pragma unroll
      for (int i = 0; i < 16; ++i) mx = fmaxf(mx, s1[i]);
      mx = fmaxf(mx, __shfl_xor(mx, 32));
      if (MODE == 2) mx = bit ? mx : NEGF;
      const float mn = fmaxf(m, mx);
      const float alpha = __builtin_amdgcn_exp2f(m - mn);
      m = mn;
      l *= alpha;
      if (MODE != 0) {
        if (__ballot(alpha != 1.f) != 0ull) {
#pragma unroll
          for (int i = 0; i < 16; ++i) { O[0][i] *= alpha; O[1][i] *= alpha; }
        }
      }
      msub = (MODE == 2 && !bit) ? 1e30f : mn;
    }
    msub = fmaxf(msub, -1e29f);
    float rs = 0.f;
#pragma unroll
    for (int i = 0; i < 16; ++i) {
      float p0 = __builtin_amdgcn_exp2f(s0[i] - msub), p1 = __builtin_amdgcn_exp2f(s1[i] - msub);
      if (MODE == 1) { p0 *= inv_l; p1 *= inv_l; }
      s0[i] = p0; s1[i] = p1;
      rs += p0 + p1;
    }
    l += rs;
    if (MODE == 0) continue;
    if (MODE == 1) {
      float* ps = (float*)(smem + AT_P) + tok_l * 256 + 64 * j + 4 * h;
#pragma unroll
      for (int gq = 0; gq < 4; ++gq) {
        float4 a, b;
        float t;
        t = s0[4 * gq + 0]; t += __shfl_xor(t, 1); t += __shfl_xor(t, 2); a.x = t;
        t = s0[4 * gq + 1]; t += __shfl_xor(t, 1); t += __shfl_xor(t, 2); a.y = t;
        t = s0[4 * gq + 2]; t += __shfl_xor(t, 1); t += __shfl_xor(t, 2); a.z = t;
        t = s0[4 * gq + 3]; t += __shfl_xor(t, 1); t += __shfl_xor(t, 2); a.w = t;
        t = s1[4 * gq + 0]; t += __shfl_xor(t, 1); t += __shfl_xor(t, 2); b.x = t;
        t = s1[4 * gq + 1]; t += __shfl_xor(t, 1); t += __shfl_xor(t, 2); b.y = t;
        t = s1[4 * gq + 2]; t += __shfl_xor(t, 1); t += __shfl_xor(t, 2); b.z = t;
        t = s1[4 * gq + 3]; t += __shfl_xor(t, 1); t += __shfl_xor(t, 2); b.w = t;
        if ((l31 & 3) == 0) { *(float4*)(ps + 8 * gq) = a; *(float4*)(ps + 32 + 8 * gq) = b; }
      }
    }
#pragma unroll
    for (int s4 = 0; s4 < 4; ++s4) {
      u32x4 pk;
      if (s4 < 2) {
#pragma unroll
        for (int jj = 0; jj < 4; ++jj) pk[jj] = pack_bf2(s0[8 * (s4 & 1) + 2 * jj], s0[8 * (s4 & 1) + 2 * jj + 1]);
      } else {
#pragma unroll
        for (int jj = 0; jj < 4; ++jj) pk[jj] = pack_bf2(s1[8 * (s4 & 1) + 2 * jj], s1[8 * (s4 & 1) + 2 * jj + 1]);
      }
      const bf16x8 pb = __builtin_bit_cast(bf16x8, pk);
#pragma unroll
      for (int dt = 0; dt < 2; ++dt) {
        s16x4 vlo = vtr(vrd + bo + dt * 4096 + s4 * 1024);
        s16x4 vhi = vtr(vrd + bo + dt * 4096 + s4 * 1024 + 512);
        bf16x8 vf = __builtin_shufflevector(vlo, vhi, 0, 1, 2, 3, 4, 5, 6, 7);
        O[dt] = mfma32(vf, pb, O[dt]);
      }
    }
  }
  __syncthreads();
}

template <int MODE>
DI void attn_tiles_pipe(const u16* __restrict__ Kg, const u16* __restrict__ Vg, int j0, int j1, char* smem,
                        const bf16x8 (&qf)[4], float& m, float& l, f32x16 (&O)[2], int lo, int hi, int lo_max, int hi_min,
                        unsigned mlo, unsigned mhi, int tid) {
  const int lane = tid & 63, l31 = lane & 31, h = lane >> 5;
  const int lk = tid >> 3, lc = tid & 7;
  const int kwr = lk * 128 + ((lc ^ ((lk >> 1) & 7)) << 4);
  const int vwr = 16384 + (lc >> 2) * 4096 + lk * 64 + (lc & 3) * 16;
  const int f = (l31 >> 1) & 7;
  const int krd = l31 * 128;
  int kx[4];
#pragma unroll
  for (int ks = 0; ks < 4; ++ks) kx[ks] = ((2 * ks + h) ^ f) << 4;
  const lds_cptr vrd = (lds_cptr)smem + 16384 + ((lane >> 4) & 1) * 32 + (lane & 3) * 8 + (4 * h + ((lane & 15) >> 2)) * 64;
  const int goff = lk * 64 + lc * 8;
  u32x4 rk, rv;
  auto qk_tile = [&](int bufoff, f32x16& d0, f32x16& d1) __attribute__((always_inline)) {
    bf16x8 ka[4], kb[4];
#pragma unroll
    for (int ks = 0; ks < 4; ++ks) { ka[ks] = *(const bf16x8*)(smem + bufoff + krd + kx[ks]); kb[ks] = *(const bf16x8*)(smem + bufoff + krd + 4096 + kx[ks]); }
    d0 = mfma32(ka[0], qf[0], zero16()); d1 = mfma32(kb[0], qf[0], zero16());
#pragma unroll
    for (int ks = 1; ks < 4; ++ks) { d0 = mfma32(ka[ks], qf[ks], d0); d1 = mfma32(kb[ks], qf[ks], d1); }
  };
  auto active = [&](int j) __attribute__((always_inline)) -> bool {
    if (MODE != 2) return true;
    const bool b = ((j < 32 ? (mlo >> j) : (mhi >> (j - 32))) & 1u) != 0;
    return __ballot(b) != 0ull;
  };
  auto step = [&](int j, bool act_c, bool& act_n, f32x16& c0, f32x16& c1, f32x16& n0, f32x16& n1) __attribute__((always_inline)) {
    const int par = (j - j0) & 1;
    const int bo = par * 8192, bn = (par ^ 1) * 8192;
    if (j < j1) *(u32x4*)(smem + bn + kwr) = rk;
    *(u32x4*)(smem + bo + vwr) = rv;
    __syncthreads();
    if (j + 2 <= j1) rk = *(const u32x4*)(Kg + (size_t)(j + 2) * 4096 + goff);
    if (j + 1 <= j1) rv = *(const u32x4*)(Vg + (size_t)(j + 1) * 4096 + goff);
    act_n = false;
    if (j < j1) { act_n = active(j + 1); if (act_n) qk_tile(bn, n0, n1); }
    if (!act_c) return;
    bool bit = true;
    if (MODE == 2) bit = ((j < 32 ? (mlo >> j) : (mhi >> (j - 32))) & 1u) != 0;
    const bool need_mask = (64 * j < lo_max) || (64 * j + 63 > hi_min);
    if (need_mask) {
      const int rlo = lo - 64 * j - 4 * h, span = hi - lo;
#pragma unroll
      for (int i = 0; i < 16; ++i) {
        const int cc = 8 * (i >> 2) + (i & 3);
        if ((unsigned)(cc - rlo) > (unsigned)span || span < 0) c0[i] = NEGF;
        if ((unsigned)(cc + 32 - rlo) > (unsigned)span || span < 0) c1[i] = NEGF;
      }
    }
    float mx = c0[0];
#pragma unroll
    for (int i = 1; i < 16; ++i) mx = fmaxf(mx, c0[i]);
#pragma unroll
    for (int i = 0; i < 16; ++i) mx = fmaxf(mx, c1[i]);
    mx = fmaxf(mx, __shfl_xor(mx, 32));
    if (MODE == 2) mx = bit ? mx : NEGF;
    const float mn = fmaxf(m, mx);
    const float alpha = __builtin_amdgcn_exp2f(m - mn);
    m = mn;
    l *= alpha;
    if (__ballot(alpha != 1.f) != 0ull) {
#pragma unroll
      for (int i = 0; i < 16; ++i) { O[0][i] *= alpha; O[1][i] *= alpha; }
    }
    const float msub = (MODE == 2 && !bit) ? 1e30f : fmaxf(mn, -1e29f);
    bf16x8 vf[4][2];
#pragma unroll
    for (int s4 = 0; s4 < 4; ++s4)
#pragma unroll
      for (int dt = 0; dt < 2; ++dt) {
        s16x4 vlo = vtr(vrd + bo + dt * 4096 + s4 * 1024);
        s16x4 vhi = vtr(vrd + bo + dt * 4096 + s4 * 1024 + 512);
        vf[s4][dt] = __builtin_shufflevector(vlo, vhi, 0, 1, 2, 3, 4, 5, 6, 7);
      }
    float rs = 0.f;
#pragma unroll
    for (int i = 0; i < 16; ++i) {
      const float p0 = __builtin_amdgcn_exp2f(c0[i] - msub), p1 = __builtin_amdgcn_exp2f(c1[i] - msub);
      c0[i] = p0; c1[i] = p1;
      rs += p0 + p1;
    }
    l += rs;
#pragma unroll
    for (int s4 = 0; s4 < 4; ++s4) {
      u32x4 pk;
      if (s4 < 2) {
#pragma unroll
        for (int jj = 0; jj < 4; ++jj) pk[jj] = pack_bf2(c0[8 * (s4 & 1) + 2 * jj], c0[8 * (s4 & 1) + 2 * jj + 1]);
      } else {
#pragma unroll
        for (int jj = 0; jj < 4; ++jj) pk[jj] = pack_bf2(c1[8 * (s4 & 1) + 2 * jj], c1[8 * (s4 & 1) + 2 * jj + 1]);
      }
      const bf16x8 pb = __builtin_bit_cast(bf16x8, pk);
      O[0] = mfma32(vf[s4][0], pb, O[0]);
      O[1] = mfma32(vf[s4][1], pb, O[1]);
    }
  };
  rk = *(const u32x4*)(Kg + (size_t)j0 * 4096 + goff);
  rv = *(const u32x4*)(Vg + (size_t)j0 * 4096 + goff);
  *(u32x4*)(smem + kwr) = rk;
  if (j0 < j1) rk = *(const u32x4*)(Kg + (size_t)(j0 + 1) * 4096 + goff);
  __syncthreads();
  f32x16 a0, a1, b0, b1;
  bool actA = true, actB = false;
  qk_tile(0, a0, a1);
  for (int j = j0; j <= j1; j += 2) {
    step(j, actA, actB, a0, a1, b0, b1);
    if (j + 1 <= j1) step(j + 1, actB, actA, b0, b1, a0, a1);
  }
  __syncthreads();
}

constexpr int RING = 6;
DI void glds16(const u16* g, char* lds) {
  __builtin_amdgcn_global_load_lds((const unsigned*)g, (LAS unsigned*)lds, 16, 0, 0);
}
template <int MODE>
DI void attn_tiles_ring(const u16* __restrict__ Kg, const u16* __restrict__ Vg, int j0, int j1, char* smem,
                        const bf16x8 (&qf)[4], float& m, float& l, f32x16 (&O)[2], int lo, int hi, int lo_max, int hi_min,
                        unsigned mlo, unsigned mhi, int tid) {
  const int lane = tid & 63, l31 = lane & 31, h = lane >> 5;
  const int f = (l31 >> 1) & 7;
  const int krd = l31 * 128;
  int kx[4];
#pragma unroll
  for (int ks = 0; ks < 4; ++ks) kx[ks] = ((2 * ks + h) ^ f) << 4;
  const int vrdo = 8192 + ((lane >> 4) & 1) * 32 + (lane & 3) * 8 + (4 * h + ((lane & 15) >> 2)) * 64;
  const lds_cptr lbase = (lds_cptr)smem;
  const int ksrc = (tid >> 3) * 64 + (((tid & 7) ^ (((tid >> 3) >> 1) & 7)) << 3);
  const int vsrc = ((tid >> 2) & 63) * 64 + (((tid >> 8) * 4 + (tid & 3)) << 3);
  const int dma = tid * 16;
  auto issue = [&](int t, int st) __attribute__((always_inline)) {
    const int tc = t < j1 ? t : j1;
    glds16(Kg + (size_t)tc * 4096 + ksrc, smem + st * 16384 + dma);
    glds16(Vg + (size_t)tc * 4096 + vsrc, smem + st * 16384 + 8192 + dma);
  };
  auto qk_tile = [&](int st, f32x16& d0, f32x16& d1) __attribute__((always_inline)) {
    const char* kb_ = smem + st * 16384;
    bf16x8 ka[4], kb[4];
#pragma unroll
    for (int ks = 0; ks < 4; ++ks) { ka[ks] = *(const bf16x8*)(kb_ + krd + kx[ks]); kb[ks] = *(const bf16x8*)(kb_ + krd + 4096 + kx[ks]); }
    d0 = mfma32(ka[0], qf[0], zero16()); d1 = mfma32(kb[0], qf[0], zero16());
#pragma unroll
    for (int ks = 1; ks < 4; ++ks) { d0 = mfma32(ka[ks], qf[ks], d0); d1 = mfma32(kb[ks], qf[ks], d1); }
  };
  auto active = [&](int j) __attribute__((always_inline)) -> bool {
    if (MODE != 2) return true;
    const bool b = ((j < 32 ? (mlo >> j) : (mhi >> (j - 32))) & 1u) != 0;
    return __ballot(b) != 0ull;
  };
  int st_cur = 0, st_iss = 5;
  auto step = [&](int j, bool act_c, bool& act_n, f32x16& c0, f32x16& c1, f32x16& n0, f32x16& n1) __attribute__((always_inline)) {
    asm volatile("s_waitcnt vmcnt(6)" ::: "memory");
    __builtin_amdgcn_s_barrier();
    issue(j + 5, st_iss);
    const int st_nxt = (st_cur == RING - 1) ? 0 : st_cur + 1;
    act_n = false;
    if (j < j1) { act_n = active(j + 1); if (act_n) qk_tile(st_nxt, n0, n1); }
    if (act_c) {
      bool bit = true;
      if (MODE == 2) bit = ((j < 32 ? (mlo >> j) : (mhi >> (j - 32))) & 1u) != 0;
      const bool need_mask = (64 * j < lo_max) || (64 * j + 63 > hi_min);
      if (need_mask) {
        const int rlo = lo - 64 * j - 4 * h, span = hi - lo;
#pragma unroll
        for (int i = 0; i < 16; ++i) {
          const int cc = 8 * (i >> 2) + (i & 3);
          if ((unsigned)(cc - rlo) > (unsigned)span || span < 0) c0[i] = NEGF;
          if ((unsigned)(cc + 32 - rlo) > (unsigned)span || span < 0) c1[i] = NEGF;
        }
      }
      float mx = c0[0];
#pragma unroll
      for (int i = 1; i < 16; ++i) mx = fmaxf(mx, c0[i]);
#pragma unroll
      for (int i = 0; i < 16; ++i) mx = fmaxf(mx, c1[i]);
      mx = fmaxf(mx, __shfl_xor(mx, 32));
      if (MODE == 2) mx = bit ? mx : NEGF;
      const float mn = fmaxf(m, mx);
      const float alpha = __builtin_amdgcn_exp2f(m - mn);
      m = mn;
      l *= alpha;
      if (__ballot(alpha != 1.f) != 0ull) {
#pragma unroll
        for (int i = 0; i < 16; ++i) { O[0][i] *= alpha; O[1][i] *= alpha; }
      }
      const float msub = (MODE == 2 && !bit) ? 1e30f : fmaxf(mn, -1e29f);
      const lds_cptr vb = lbase + st_cur * 16384 + vrdo;
      bf16x8 vf[4][2];
#pragma unroll
      for (int s4 = 0; s4 < 4; ++s4)
#pragma unroll
        for (int dt = 0; dt < 2; ++dt) {
          s16x4 vlo = vtr(vb + dt * 4096 + s4 * 1024);
          s16x4 vhi = vtr(vb + dt * 4096 + s4 * 1024 + 512);
          vf[s4][dt] = __builtin_shufflevector(vlo, vhi, 0, 1, 2, 3, 4, 5, 6, 7);
        }
      float rs = 0.f;
#pragma unroll
      for (int i = 0; i < 16; ++i) {
        const float p0 = __builtin_amdgcn_exp2f(c0[i] - msub), p1 = __builtin_amdgcn_exp2f(c1[i] - msub);
        c0[i] = p0; c1[i] = p1;
        rs += p0 + p1;
      }
      l += rs;
#pragma unroll
      for (int s4 = 0; s4 < 4; ++s4) {
        u32x4 pk;
        if (s4 < 2) {
#pragma unroll
          for (int jj = 0; jj < 4; ++jj) pk[jj] = pack_bf2(c0[8 * (s4 & 1) + 2 * jj], c0[8 * (s4 & 1) + 2 * jj + 1]);
        } else {
#pragma unroll
          for (int jj = 0; jj < 4; ++jj) pk[jj] = pack_bf2(c1[8 * (s4 & 1) + 2 * jj], c1[8 * (s4 & 1) + 2 * jj + 1]);
        }
        const bf16x8 pb = __builtin_bit_cast(bf16x8, pk);
        O[0] = mfma32(vf[s4][0], pb, O[0]);
        O[1] = mfma32(vf[s4][1], pb, O[1]);
      }
    }
    st_cur = st_nxt;
    st_iss = (st_iss == RING - 1) ? 0 : st_iss + 1;
  };
#pragma unroll
  for (int i = 0; i < 5; ++i) issue(j0 + i, i);
  asm volatile("s_waitcnt vmcnt(8)" ::: "memory");
  __builtin_amdgcn_s_barrier();
  f32x16 a0, a1, b0, b1;
  bool actA = true, actB = false;
  qk_tile(0, a0, a1);
  for (int j = j0; j <= j1; j += 2) {
    step(j, actA, actB, a0, a1, b0, b1);
    if (j + 1 <= j1) step(j + 1, actB, actA, b0, b1, a0, a1);
  }
  asm volatile("s_waitcnt vmcnt(0)" ::: "memory");
  __syncthreads();
}

DI void attn_cmp(const u16* __restrict__ Kc, const u16* __restrict__ Vc, int nct, char* smem, const bf16x8 (&qf)[4],
                 f32x16 (&O)[2], int hi, int hi_min, int tok_l, int tid) {
  const int lane = tid & 63, l31 = lane & 31, h = lane >> 5;
  const int f = (l31 >> 1) & 7;
  const int krd = l31 * 128;
  int kx[4];
#pragma unroll
  for (int ks = 0; ks < 4; ++ks) kx[ks] = ((2 * ks + h) ^ f) << 4;
  const int vrdo = 8192 + ((lane >> 4) & 1) * 32 + (lane & 3) * 8 + (4 * h + ((lane & 15) >> 2)) * 64;
  const lds_cptr lbase = (lds_cptr)smem;
  const int ksrc = (tid >> 3) * 64 + (((tid & 7) ^ (((tid >> 3) >> 1) & 7)) << 3);
  const int vsrc = ((tid >> 2) & 63) * 64 + (((tid >> 8) * 4 + (tid & 3)) << 3);
#pragma unroll
  for (int t = 0; t < 4; ++t) {
    const int tc = t < nct ? t : nct - 1;
    glds16(Kc + (size_t)tc * 4096 + ksrc, smem + t * 16384 + tid * 16);
    glds16(Vc + (size_t)tc * 4096 + vsrc, smem + t * 16384 + 8192 + tid * 16);
  }
  asm volatile("s_waitcnt vmcnt(0)" ::: "memory");
  __syncthreads();
  f32x16 S[4][2];
  float mx = NEGF;
#pragma unroll
  for (int t = 0; t < 4; ++t) {
    if (t < nct) {
      const char* kb_ = smem + t * 16384;
      bf16x8 ka[4], kb[4];
#pragma unroll
      for (int ks = 0; ks < 4; ++ks) { ka[ks] = *(const bf16x8*)(kb_ + krd + kx[ks]); kb[ks] = *(const bf16x8*)(kb_ + krd + 4096 + kx[ks]); }
      S[t][0] = mfma32(ka[0], qf[0], zero16()); S[t][1] = mfma32(kb[0], qf[0], zero16());
#pragma unroll
      for (int ks = 1; ks < 4; ++ks) { S[t][0] = mfma32(ka[ks], qf[ks], S[t][0]); S[t][1] = mfma32(kb[ks], qf[ks], S[t][1]); }
      if (64 * t + 63 > hi_min) {
        const int rhi = hi - 64 * t - 4 * h;
#pragma unroll
        for (int i = 0; i < 16; ++i) {
          const int cc = 8 * (i >> 2) + (i & 3);
          if (cc > rhi) S[t][0][i] = NEGF;
          if (cc + 32 > rhi) S[t][1][i] = NEGF;
        }
      }
#pragma unroll
      for (int i = 0; i < 16; ++i) mx = fmaxf(mx, fmaxf(S[t][0][i], S[t][1][i]));
    }
  }
  mx = fmaxf(mx, __shfl_xor(mx, 32));
  const float msub = fmaxf(mx, -1e29f);
  float ls = 0.f;
#pragma unroll
  for (int t = 0; t < 4; ++t)
    if (t < nct) {
#pragma unroll
      for (int i = 0; i < 16; ++i) {
        S[t][0][i] = __builtin_amdgcn_exp2f(S[t][0][i] - msub); S[t][1][i] = __builtin_amdgcn_exp2f(S[t][1][i] - msub);
        ls += S[t][0][i] + S[t][1][i];
      }
    }
  ls += __shfl_xor(ls, 32);
  const float inv_l = 1.f / fmaxf(ls, 1e-30f);
  O[0] = zero16(); O[1] = zero16();
#pragma unroll
  for (int t = 0; t < 4; ++t)
    if (t < nct) {
      f32x16& s0 = S[t][0];
      f32x16& s1 = S[t][1];
#pragma unroll
      for (int i = 0; i < 16; ++i) { s0[i] *= inv_l; s1[i] *= inv_l; }
      float* ps = (float*)(smem + AT_P) + tok_l * 256 + 64 * t + 4 * h;
#pragma unroll
      for (int gq = 0; gq < 4; ++gq) {
        float4 a, b;
        float u;
        u = s0[4 * gq + 0]; u += __shfl_xor(u, 1); u += __shfl_xor(u, 2); a.x = u;
        u = s0[4 * gq + 1]; u += __shfl_xor(u, 1); u += __shfl_xor(u, 2); a.y = u;
        u = s0[4 * gq + 2]; u += __shfl_xor(u, 1); u += __shfl_xor(u, 2); a.z = u;
        u = s0[4 * gq + 3]; u += __shfl_xor(u, 1); u += __shfl_xor(u, 2); a.w = u;
        u = s1[4 * gq + 0]; u += __shfl_xor(u, 1); u += __shfl_xor(u, 2); b.x = u;
        u = s1[4 * gq + 1]; u += __shfl_xor(u, 1); u += __shfl_xor(u, 2); b.y = u;
        u = s1[4 * gq + 2]; u += __shfl_xor(u, 1); u += __shfl_xor(u, 2); b.z = u;
        u = s1[4 * gq + 3]; u += __shfl_xor(u, 1); u += __shfl_xor(u, 2); b.w = u;
        if ((l31 & 3) == 0) { *(float4*)(ps + 8 * gq) = a; *(float4*)(ps + 32 + 8 * gq) = b; }
      }
      const lds_cptr vb = lbase + t * 16384 + vrdo;
#pragma unroll
      for (int s4 = 0; s4 < 4; ++s4) {
        u32x4 pk;
        if (s4 < 2) {
#pragma unroll
          for (int jj = 0; jj < 4; ++jj) pk[jj] = pack_bf2(s0[8 * (s4 & 1) + 2 * jj], s0[8 * (s4 & 1) + 2 * jj + 1]);
        } else {
#pragma unroll
          for (int jj = 0; jj < 4; ++jj) pk[jj] = pack_bf2(s1[8 * (s4 & 1) + 2 * jj], s1[8 * (s4 & 1) + 2 * jj + 1]);
        }
        const bf16x8 pb = __builtin_bit_cast(bf16x8, pk);
#pragma unroll
        for (int dt = 0; dt < 2; ++dt) {
          s16x4 vlo = vtr(vb + dt * 4096 + s4 * 1024);
          s16x4 vhi = vtr(vb + dt * 4096 + s4 * 1024 + 512);
          bf16x8 vf = __builtin_shufflevector(vlo, vhi, 0, 1, 2, 3, 4, 5, 6, 7);
          O[dt] = mfma32(vf, pb, O[dt]);
        }
      }
    }
  __syncthreads();
}

DI void attn_item(const Params& p, int bg, int qt, char* smem) {
  const int tid = opaque_tid(), lane = tid & 63, w = tid >> 6, l31 = lane & 31, h = lane >> 5;
  const int b = bg >> 1, g = bg & 1;
  const int t0 = qt * 64;
  const int tok_l = w * 8 + (l31 >> 2);
  const int tpos = t0 + tok_l;
  const int r = l31 & 3;
  const size_t tglob = (size_t)b * SEQ + tpos;
  bf16x8 qf[4];
  {
    const u16* qp = p.qb + tglob * 512 + (g * 4 + r) * 64 + h * 8;
#pragma unroll
    for (int ks = 0; ks < 4; ++ks) qf[ks] = *(const bf16x8*)(qp + ks * 16);
  }
  const float g0 = p.gate[tglob * 24 + 0 + g * 4 + r];
  const float g1 = p.gate[tglob * 24 + 8 + g * 4 + r];
  const float g2 = p.gate[tglob * 24 + 16 + g * 4 + r];
  const int cur = t0 >> 6;
  f32x16 O[2];
  float m, l;
  unsigned* stash = (unsigned*)(smem + AT_S) + w * 1024 + lane;
  {
    const u16* Kc = p.kcmp + (size_t)bg * 256 * 64;
    const u16* Vc = p.vcmp + (size_t)bg * 256 * 64;
    const int nct = ((t0 + 32) >> 10) + 1;
    const int hi = (tpos - 31) >> 4;
    const int hi_min = (t0 - 31) >> 4;
    attn_cmp(Kc, Vc, nct, smem, qf, O, hi, hi_min, tok_l, tid);
    const float* Ps = (const float*)(smem + AT_P);
    unsigned long long* Ms = (unsigned long long*)(smem + AT_M);
    const int ncv = nct * 64;
    for (int tl = 0; tl < 8; ++tl) {
      const int tokl = w * 8 + tl;
      const int j = lane;
      const float* pr = Ps + tokl * 256;
      float imp = 0.f;
      if (4 * j < ncv) {
        float4 v = *(const float4*)(pr + 4 * j);
        imp = 2.f * (v.x + v.y + v.z) + v.w;
        if (j > 0) imp += pr[4 * j - 1];
      }
      unsigned key = ((__float_as_uint(imp) & ~63u) | (unsigned)(63 - j)) + 64u;
      if (j > cur) key = (unsigned)(63 - j);
      if (j == 0 || j == cur || j == cur - 1) key = 0xFFFFFF00u | (unsigned)(63 - j);
      unsigned* kl = (unsigned*)(smem + w * 256);
      kl[lane] = key;
      int cnt = 0;
#pragma unroll
      for (int k4 = 0; k4 < 16; ++k4) {
        const u32x4 q = *(const u32x4*)(kl + 4 * k4);
        cnt += (q[0] > key) + (q[1] > key) + (q[2] > key) + (q[3] > key);
      }
      unsigned long long bal = __ballot(cnt < 16);
      if (lane == 0) Ms[tokl] = bal;
    }
  }
  __syncthreads();
  unsigned mlo, mhi;
  {
    const unsigned* Mw = (const unsigned*)(smem + AT_M);
    mlo = Mw[tok_l * 2]; mhi = Mw[tok_l * 2 + 1];
  }
#pragma unroll
  for (int i = 0; i < 8; ++i) { stash[i * 64] = pack_bf2(g0 * O[0][2 * i], g0 * O[0][2 * i + 1]); stash[(8 + i) * 64] = pack_bf2(g0 * O[1][2 * i], g0 * O[1][2 * i + 1]); }
  {
    m = NEGF; l = 0.f;
    O[0] = zero16(); O[1] = zero16();
    attn_tiles_ring<2>(p.kvb + (size_t)(2 * 16 + bg) * SEQ * 64, p.kvb + (size_t)(3 * 16 + bg) * SEQ * 64, 0, cur, smem, qf, m, l, O,
                  0, tpos, 0, t0, mlo, mhi, tid);
    const float lt = l + __shfl_xor(l, 32);
    const float sc = g1 / fmaxf(lt, 1e-30f);
#pragma unroll
    for (int i = 0; i < 8; ++i) {
      const unsigned u0 = stash[i * 64], u1 = stash[(8 + i) * 64];
      stash[i * 64] = pack_bf2(bf_lo(u0) + sc * O[0][2 * i], bf_hi(u0) + sc * O[0][2 * i + 1]);
      stash[(8 + i) * 64] = pack_bf2(bf_lo(u1) + sc * O[1][2 * i], bf_hi(u1) + sc * O[1][2 * i + 1]);
    }
  }
  {
    m = NEGF; l = 0.f;
    O[0] = zero16(); O[1] = zero16();
    const int jlo = max(t0 - 511, 0) >> 6;
    attn_tiles_ring<3>(p.kvb + (size_t)(4 * 16 + bg) * SEQ * 64, p.kvb + (size_t)(5 * 16 + bg) * SEQ * 64, jlo, cur, smem, qf, m, l, O,
                  tpos - 511, tpos, t0 + 63 - 511, t0, 0u, 0u, tid);
    const float lt = l + __shfl_xor(l, 32);
    const float sc = g2 / fmaxf(lt, 1e-30f);
#pragma unroll
    for (int i = 0; i < 8; ++i) {
      const unsigned u0 = stash[i * 64], u1 = stash[(8 + i) * 64];
      O[0][2 * i] = bf_lo(u0) + sc * O[0][2 * i]; O[0][2 * i + 1] = bf_hi(u0) + sc * O[0][2 * i + 1];
      O[1][2 * i] = bf_lo(u1) + sc * O[1][2 * i]; O[1][2 * i + 1] = bf_hi(u1) + sc * O[1][2 * i + 1];
    }
  }
  u16* op = p.ob + tglob * 512 + (g * 4 + r) * 64 + 4 * h;
#pragma unroll
  for (int dt = 0; dt < 2; ++dt)
#pragma unroll
    for (int gq = 0; gq < 4; ++gq) {
      u32x2 o = {pack_bf2(O[dt][4 * gq], O[dt][4 * gq + 1]), pack_bf2(O[dt][4 * gq + 2], O[dt][4 * gq + 3])};
      *(u32x2*)(op + dt * 32 + 8 * gq) = o;
    }
}

DI void p10_rows(const Params& p, int item) {
  const int w = threadIdx.x >> 6, lane = threadIdx.x & 63;
  const int row = item * 8 + w;
  float s = (lane < 16) ? p.ssq2[(size_t)row * 16 + lane] : 0.f;
#pragma unroll
  for (int o = 8; o; o >>= 1) s += __shfl_xor(s, o);
  s = __shfl(s, 0);
  const float rs = rsqrtf(s * (1.f / DM) + 1e-6f);
  float4* o4 = (float4*)(p.out + (size_t)row * DM);
  const float4* g4 = (const float4*)p.norm_final;
#pragma unroll
  for (int i = 0; i < 4; ++i) {
    float4 v = o4[lane + 64 * i], g = g4[lane + 64 * i];
    v.x *= rs * g.x; v.y *= rs * g.y; v.z *= rs * g.z; v.w *= rs * g.w;
    o4[lane + 64 * i] = v;
  }
}


#define XB_TMO      128
#define XB_XCNT(j)  (256  + 64 * (j))
#define XB_XSUB(j)  (1280 + 64 * (j))
#define XB_XGEN(j)  (2304 + 64 * (j))
#define XB_TOP      3328
#define XB_TOPGEN   3392
#define XCD_BAR_WORDS 3456
#define XB_SPIN_CAP (1u << 18)
DI unsigned xb_xcc_id() { return (unsigned)__builtin_amdgcn_s_getreg((3 << 11) | 20) & 0xFu; }
#define XB_SPIN(cond, bar) do { unsigned _sp = 0; while (cond) { __builtin_amdgcn_s_sleep(1); \
    if ((++_sp & 255u) == 0u) { if (xb_ld(&(bar)[XB_TMO])) break; if (_sp > XB_SPIN_CAP) { atomicAdd(&(bar)[XB_TMO], 1u); break; } } } } while (0)
struct XcdBarrier { unsigned* bar; unsigned x; volatile LAS unsigned* st; };
DI XcdBarrier xcd_barrier_post(unsigned* bar, volatile LAS unsigned* st) {
  XcdBarrier b; b.bar = bar; b.x = xb_xcc_id(); b.st = st;
  if (threadIdx.x == 0) (void)xb_add(&bar[XB_XCNT(b.x)], 1u);
  return b;
}
DI void xcd_barrier_complete(unsigned* bar, unsigned x, unsigned& nloc, unsigned& nx) {
  const unsigned G = gridDim.x * gridDim.y * gridDim.z;
  unsigned sum, cnt, mine, sp = 0u;
  for (;;) {
    sum = 0u; cnt = 0u; mine = 0u;
#pragma unroll
    for (unsigned j = 0; j < 16; ++j) { const unsigned c = xb_ld(&bar[XB_XCNT(j)]); sum += c; cnt += (c > 0u) ? 1u : 0u; mine = (j == x) ? c : mine; }
    if (sum == G) break;
    __builtin_amdgcn_s_sleep(1);
    if ((++sp & 255u) == 0u) { if (xb_ld(&bar[XB_TMO])) break; if (sp > XB_SPIN_CAP) { atomicAdd(&bar[XB_TMO], 1u); break; } }
  }
  nloc = mine > 0u ? mine : 1u; nx = cnt > 0u ? cnt : 1u;
}
DI void xcd_barrier(const XcdBarrier& b) {
  asm volatile("s_waitcnt vmcnt(0)" ::: "memory");
  __syncthreads();
  if (threadIdx.x == 0) {
    unsigned* bar = b.bar;
    __builtin_amdgcn_s_waitcnt(0);
    unsigned nloc = b.st[0], nx = b.st[1];
    if (nloc == 0u) { xcd_barrier_complete(bar, b.x, nloc, nx); b.st[0] = nloc; b.st[1] = nx; }
    const unsigned old = xb_add(&bar[XB_XSUB(b.x)], 1u);
    const unsigned gen = old / nloc;
    if (old + 1u == (gen + 1u) * nloc) {
      __builtin_amdgcn_fence(__ATOMIC_RELEASE, "agent");
      asm volatile("s_waitcnt vmcnt(0)" ::: "memory");
      const unsigned og = xb_add(&bar[XB_TOP], 1u);
      const unsigned tg = og / nx;
      if (og + 1u == (tg + 1u) * nx) xb_add(&bar[XB_TOPGEN], 1u);
      else XB_SPIN(xb_ld(&bar[XB_TOPGEN]) == tg, bar);
      __builtin_amdgcn_fence(__ATOMIC_ACQUIRE, "agent");
      xb_add(&bar[XB_XGEN(b.x)], 1u);
      asm volatile("s_waitcnt vmcnt(0)" ::: "memory");
    } else {
      XB_SPIN(xb_ld(&bar[XB_XGEN(b.x)]) == gen, bar);
      __builtin_amdgcn_fence(__ATOMIC_ACQUIRE, "agent");
      asm volatile("s_waitcnt vmcnt(0)" ::: "memory");
    }
  }
  __syncthreads();
}

__global__ void __launch_bounds__(NTHR, 2) nsa_pool_block_fwd(Params p) {
  extern __shared__ __attribute__((aligned(16))) unsigned char shm[];
  char* smem = (char*)shm;
  LAS unsigned char* lds = (LAS unsigned char*)shm;
  cg::grid_group grid = cg::this_grid();
  const int G = gridDim.x;
  const int bid = blockIdx.x;
  const int L = (G % 8 == 0) ? (bid % 8) * (G / 8) + bid / 8 : bid;
  volatile LAS unsigned* xst = (volatile LAS unsigned*)(lds + 133120);
  if (threadIdx.x < 4) xst[threadIdx.x] = 0u;
  __syncthreads();
  const XcdBarrier xb = xcd_barrier_post(p.bar, xst);

  if (PH_MASK & 1)
  {
    constexpr int N0 = 1024, N1 = N0 + TJ_EARLY / 2, N2 = N1 + 64, N3 = N2 + 16, N4 = N3 + 64;
    for (int rep = 0; rep < ((REP_MASK & 1) ? 2 : 1); ++rep)
    for (int it = N4 - 1 - bid; it >= 0; it -= G) {
      if (it < N0) p0_rows(p, it);
      else if (it < N1) p0_transpose(p, it - N0, smem, 0);
      else if (it < N2) p0_weff(p, it - N1, smem);
      else if (it < N3) p0_cbias(p, it - N2, smem);
      else p0_rope(p, it - N3);
    }
  }
  if (p.bar == nullptr) grid.sync();
  xcd_barrier(xb);
  if (PH_MASK & 2) {
    Sched S{0, G, bid};
    EpiProj E{p};
    for (int rep = 0; rep < ((REP_MASK & 2) ? 2 : 1); ++rep)
    gemm_phase(lds, Gemm{p.xb, p.w_in_t, DM, DM, DM, 128, 128}, S, E);
  }
  xcd_barrier(xb);
  if (PH_MASK & 4) for (int rep = 0; rep < ((REP_MASK & 4) ? 2 : 1); ++rep)
  {
    Sched S{2, G, bid};
    EpiCmpHid E{(float*)p.mb};
    gemm_phase(lds, Gemm{p.kvb, p.cw1_t, 1024, 2048, 512, 128, 128}, S, E);
    for (int it = bid; it < 4096; it += G) p2a_pool_item(p, it);
  }
  xcd_barrier(xb);
  if (PH_MASK & 8) {
    Sched S{3, G, bid};
    EpiCmpOut E{p};
    for (int i = 0;; ++i) {
      Unit u;
      if (!S.next(i, u)) break;
      const float* h32 = (const float*)p.mb;
      const float* bias = p.cbias + u.pn * 256;
      for (int e0 = threadIdx.x; e0 < 8192; e0 += 4 * NTHR) {
        f32x4 pv[4][4][2];
#pragma unroll
        for (int q = 0; q < 4; ++q) {
          const int e = e0 + q * NTHR, c = e >> 5, n8 = (e & 31) * 8;
#pragma unroll
          for (int ks = 0; ks < 4; ++ks) {
            const f32x4* sp = (const f32x4*)(h32 + ((size_t)((ks * 32 + u.pm) * 256 + c)) * 256 + n8);
            pv[q][ks][0] = sp[0]; pv[q][ks][1] = sp[1];
          }
        }
#pragma unroll
        for (int q = 0; q < 4; ++q) {
          const int e = e0 + q * NTHR, c = e >> 5, n8 = (e & 31) * 8;
          f32x4 v0 = *(const f32x4*)(bias + n8), v1 = *(const f32x4*)(bias + n8 + 4);
#pragma unroll
          for (int ks = 0; ks < 4; ++ks) { v0 += pv[q][ks][0]; v1 += pv[q][ks][1]; }
#pragma unroll
          for (int j = 0; j < 4; ++j) { v0[j] = gelu_tanh(v0[j]); v1[j] = gelu_tanh(v1[j]); }
          *(u32x4*)(p.hid + ((size_t)u.pm * 256 + c) * 256 + n8) = pack8(v0, v1);
        }
      }
    }
    asm volatile("s_waitcnt vmcnt(0)" ::: "memory");
    __syncthreads();
    gemm_phase(lds, Gemm{p.hid, p.cw2_t, 256, 256, 256, 128, 128}, S, E);
    { Unit u0; const bool has_unit = S.next(0, u0);
      if (G >= 256) {
        if (!has_unit) {
          const int rank = bid - (bid >> 3) - (((bid & 7) > ((bid >> 3) & 7)) ? 1 : 0);
          for (int it = rank; it < (TJ_TOTAL - TJ_EARLY) / 2; it += G - 32) p0_transpose(p, it, smem, TJ_EARLY);
        }
      } else {
        __syncthreads();
        for (int it = bid; it < (TJ_TOTAL - TJ_EARLY) / 2; it += G) p0_transpose(p, it, smem, TJ_EARLY);
      }
    }
  }
  xcd_barrier(xb);
  if (ATTN_PRIO) { if (threadIdx.x >= 256) __builtin_amdgcn_s_setprio(2); }
  if (PH_MASK & 16) for (int rep = 0; rep < ((REP_MASK & 16) ? 2 : 1); ++rep)
  if (G == 256) {
    const int x = bid & 7, j = bid >> 3;
    for (int rd = 0; rd < 4; ++rd) {
      const int idx = rd * 32 + ((rd & 1) ? (31 - j) : j);
      attn_item(p, 2 * x + (idx & 1), 63 - (idx >> 1), smem);
    }
  } else
  for (int rd = 0; rd * G < 1024; ++rd) {
    const int i = rd * G + ((rd & 1) ? (G - 1 - L) : L);
    if (i < 1024) attn_item(p, i & 15, 63 - (i >> 4), smem);
  }
  xcd_barrier(xb);
  if (ATTN_PRIO) __builtin_amdgcn_s_setprio(0);
  if (PH_MASK & 32) {
    Sched S{1, G, bid};
    EpiMerge<0> E0{p};
    EpiMerge<1> E1{p};
    for (int rep = 0; rep < ((REP_MASK & 32) ? 2 : 1); ++rep) {
    gemm_phase(lds, Gemm{p.ob, p.wa_t, 512, 512, 512, 128, 128}, S, E0);
    gemm_phase(lds, Gemm{p.pooled, p.wbe_t, 512, 512, 512, 128, 128}, S, E1);
    }
  }
  xcd_barrier(xb);
  if (PH_MASK & 64) {
    Sched S{1, G, bid};
    EpiResidBf E{p.xb, p.ssq};
    for (int rep = 0; rep < ((REP_MASK & 64) ? 2 : 1); ++rep)
    gemm_phase(lds, Gemm{p.mb, p.wo_t, DM, DM, DM, 128, 128}, S, E);
  }
  xcd_barrier(xb);
  if (PH_MASK & 128) {
    Sched S{0, G, bid};
    EpiFF1 E{p};
    for (int rep = 0; rep < ((REP_MASK & 128) ? 2 : 1); ++rep)
    gemm_phase(lds, Gemm{p.xb, p.w1_t, DM, DM, DM, 128, 128}, S, E);
  }
  xcd_barrier(xb);
#if FUSE_FINAL
  if (PH_MASK & 256) {
    Sched S{1, G, bid};
    EpiFinal E{p.out, p.xb, p.norm_final, p.ssq2, p.bar + XCD_BAR_WORDS};
    gemm_phase(lds, Gemm{p.act, p.w2_t, 64, 64, 4096, (size_t)T_TOK * 128, (size_t)1024 * 128}, S, E);
  }
#else
  if (PH_MASK & 256) {
    Sched S{1, G, bid};
    EpiResid<false> E{p.out, p.out, nullptr, p.ssq2};
    gemm_phase(lds, Gemm{p.act, p.w2_t, 64, 64, 4096, (size_t)T_TOK * 128, (size_t)1024 * 128}, S, E);
  }
  xcd_barrier(xb);
  for (int it = bid; it < 4096; it += G) p10_rows(p, it);
#endif
}

extern "C" void kernel_launch(void* const* d_in, const int* in_sizes, int n_in, void* d_out, int out_size, void* d_ws,
                              size_t ws_size, hipStream_t stream) {
  (void)in_sizes; (void)n_in; (void)out_size; (void)ws_size;
  static int grid_blocks = 0;
  if (!grid_blocks) {
    int dev = 0, cus = 0, per_cu = 0;
    (void)hipGetDevice(&dev);
    (void)hipDeviceGetAttribute(&cus, hipDeviceAttributeMultiprocessorCount, dev);
    (void)hipFuncSetAttribute((const void*)nsa_pool_block_fwd, hipFuncAttributeMaxDynamicSharedMemorySize, LDS_BYTES);
    (void)hipOccupancyMaxActiveBlocksPerMultiprocessor(&per_cu, nsa_pool_block_fwd, NTHR, LDS_BYTES);
    if (per_cu > 1) per_cu = 1;
    if (per_cu < 1) per_cu = 1;
    grid_blocks = cus * per_cu;
  }
  Params p{};
  const float* const* in = (const float* const*)d_in;
  p.x = in[0]; p.norm_mix = in[1]; p.w_in = in[2]; p.pe_k = in[3]; p.pe_v = in[4]; p.ck_w1 = in[5]; p.ck_w2 = in[6];
  p.cv_w1 = in[7]; p.cv_w2 = in[8]; p.w_ba = in[9]; p.pool_w = in[10]; p.pool_scale = in[11]; p.w_bp = in[12];
  p.w_out = in[13]; p.norm_mlp = in[14]; p.w_ff1 = in[15]; p.w_ff2 = in[16]; p.norm_final = in[17];
  p.out = (float*)d_out;
  char* ws = (char*)d_ws;
  size_t off = 0;
  auto take = [&](size_t bytes) { char* r = ws + off; off += (bytes + 255) & ~(size_t)255; return r; };
  const size_t T = T_TOK;
  p.xb = (u16*)take(T * 1024 * 2);
  p.w_in_t = (u16*)take((size_t)NPROJ * 1024 * 2);
  p.wa_t = (u16*)take(1024 * 512 * 2);
  p.wbe_t = (u16*)take(1024 * 512 * 2);
  p.wo_t = (u16*)take(1024 * 1024 * 2);
  p.w1_t = (u16*)take((size_t)4096 * 1024 * 2);
  p.w2_t = (u16*)take((size_t)4096 * 1024 * 2);
  p.cw1_t = (u16*)take(2 * 256 * 2048 * 2);
  p.cw2_t = (u16*)take(2 * 256 * 256 * 2);
  p.rstd0 = (float*)take(T * 4);
  p.cbias = (float*)take(512 * 4);
  p.rope = (float2*)take((size_t)SEQ * 8 * 8);
  p.ssq = (float*)take(T * 16 * 4);
  p.ssq2 = (float*)take(T * 16 * 4);
  p.mb = (u16*)take(T * 1024 * 2);
  char* regionD = ws + off;
  p.qb = (u16*)take(T * 512 * 2);
  p.kvb = (u16*)take((size_t)6 * 16 * SEQ * 64 * 2);
  p.gate = (float*)take(T * 24 * 4);
  p.ub = (u16*)take(T * 512 * 2);
  p.gm = (u16*)take(T * 2048 * 2);
  p.hid = (u16*)take((size_t)2 * 16 * 256 * 256 * 2);
  p.kcmp = (u16*)take(16 * 256 * 64 * 2);
  p.vcmp = (u16*)take(16 * 256 * 64 * 2);
  p.pooled = (u16*)take(T * 512 * 2);
  p.ob = (u16*)take(T * 512 * 2);
  p.bar = (unsigned*)take((XCD_BAR_WORDS + 4096) * 4);
  p.act = (u16*)regionD;
  (void)hipMemsetAsync(p.bar, 0, (XCD_BAR_WORDS + 4096) * 4, stream);
  void* args[] = {&p};
  hipError_t e = hipLaunchCooperativeKernel((void*)nsa_pool_block_fwd, dim3(grid_blocks), dim3(NTHR), args, LDS_BYTES, stream);
  if (e != hipSuccess) fprintf(stderr, "cooperative launch failed: %s (grid %d)\n", hipGetErrorString(e), grid_blocks);
}
```

```cpp
#include <hip/hip_runtime.h>
#include <hip/hip_cooperative_groups.h>
#include <stdint.h>
#include <stdio.h>
namespace cg = cooperative_groups;

#define DI __device__ __forceinline__
#define LAS __attribute__((address_space(3)))
typedef unsigned short u16;
typedef __attribute__((ext_vector_type(8))) short bf16x8;
typedef __attribute__((ext_vector_type(4))) short s16x4;
typedef __attribute__((ext_vector_type(16))) float f32x16;
typedef __attribute__((ext_vector_type(4))) float f32x4;
typedef __attribute__((ext_vector_type(4))) unsigned u32x4;
typedef __attribute__((ext_vector_type(2))) unsigned u32x2;
typedef __attribute__((ext_vector_type(2))) float f32x2;
typedef __attribute__((ext_vector_type(2))) __bf16 bf16x2_t;
typedef LAS const char* lds_cptr;

constexpr int T_TOK = 32768, SEQ = 4096, DM = 1024;
constexpr int NPROJ = 4096;
constexpr int NTHR = 512;
constexpr int LDS_BYTES = 135168;
constexpr float NEGF = -1e30f;
constexpr float QSCALE = 0.125f * 1.4426950408889634f;
#ifndef REP_MASK
#define REP_MASK 0
#endif
#ifndef ATTN_PRIO
#define ATTN_PRIO 0
#endif
#ifndef FUSE_FINAL
#define FUSE_FINAL 1
#endif
#ifndef PH_MASK
#define PH_MASK 0xffff
#endif

struct Params {
  const float *x, *norm_mix, *w_in, *pe_k, *pe_v, *ck_w1, *ck_w2, *cv_w1, *cv_w2, *w_ba, *pool_w, *pool_scale, *w_bp,
      *w_out, *norm_mlp, *w_ff1, *w_ff2, *norm_final;
  float* out;
  u16 *xb, *w_in_t, *wa_t, *wbe_t, *wo_t, *w1_t, *w2_t, *cw1_t, *cw2_t;
  float *rstd0, *cbias;
  float2* rope;
  u16 *qb, *kvb;
  float* gate;
  u16 *ub, *gm, *hid, *kcmp, *vcmp, *pooled, *ob, *mb, *act;
  float *ssq, *ssq2;
  unsigned* bar;
};

DI unsigned pack_bf2(float a, float b) {
  f32x2 v = {a, b};
  bf16x2_t r = __builtin_convertvector(v, bf16x2_t);
  return __builtin_bit_cast(unsigned, r);
}
DI float bf_lo(unsigned u) { return __uint_as_float(u << 16); }
DI float bf_hi(unsigned u) { return __uint_as_float(u & 0xffff0000u); }
DI float sigmoidf_(float v) { return __builtin_amdgcn_rcpf(1.f + __builtin_amdgcn_exp2f(-1.4426950408889634f * v)); }
DI float gelu_tanh(float x) {
  float u = 0.7978845608028654f * (x + 0.044715f * x * x * x);
  float th = 1.f - 2.f / (__expf(2.f * u) + 1.f);
  return 0.5f * x * (1.f + th);
}
DI f32x16 mfma32(bf16x8 a, bf16x8 b, f32x16 c) { return __builtin_amdgcn_mfma_f32_32x32x16_bf16(a, b, c, 0, 0, 0); }
DI int opaque_tid() { int t; asm volatile("v_mov_b32 %0, %1" : "=v"(t) : "v"((int)threadIdx.x)); return t; }
DI f32x16 zero16() { f32x16 z; for (int i = 0; i < 16; ++i) z[i] = 0.f; return z; }
DI s16x4 vtr(lds_cptr p) { return __builtin_amdgcn_ds_read_tr16_b64_v4i16((LAS s16x4*)p); }
DI u32x4 pack8(const f32x4& a, const f32x4& b) {
  u32x4 w = {pack_bf2(a[0], a[1]), pack_bf2(a[2], a[3]), pack_bf2(b[0], b[1]), pack_bf2(b[2], b[3])};
  return w;
}

constexpr int BM = 256, BK = 64, HALF = 128, HTB = HALF * BK * 2;
DI int lds_byte(int r, int c) { const int st = (r >> 4) * 2 + (c >> 5), rr = r & 15, cc = c & 31, ob = rr * 64 + cc * 2; return st * 1024 + (ob ^ (((ob >> 9) & 1) << 5)); }
DI void stage_rc(int b, int& R, int& C) { const int st = b / 1024, sb = b % 1024, swz = sb ^ (((sb >> 9) & 1) << 5); R = (st >> 1) * 16 + swz / 64; C = (st & 1) * 32 + (swz % 64) / 2; }
DI int perm32(int rho) { const int n = rho >> 4, i = rho & 15; return 8 * (i >> 2) + 4 * n + (i & 3); }

struct Unit { int pm, pn, k0; };
struct Gemm { const u16* A; const u16* Bt; int lda, ldb, K; size_t kstepA, kstepB; };

struct Sched {
  int mode, G, bid;
  DI bool next(int i, Unit& u) const {
    u.k0 = 0;
    if (mode == 2) {
      int t;
      if (G >= 256) { if (i > 0 || (bid & 1) != ((bid >> 3) & 1) || (bid >> 1) >= 128) return false; t = bid >> 1; }
      else { t = i * G + bid; if (t >= 128) return false; }
      u.pm = t >> 2; u.pn = u.pm >> 4; u.k0 = (t & 3) * 8; return true;
    }
    if (mode == 3) {
      int t;
      if (G >= 256) { t = bid >> 3; if (i > 0 || (bid & 7) != (t & 7) || t >= 32) return false; }
      else { t = i * G + bid; if (t >= 32) return false; }
      u.pm = t; u.pn = t >> 4; return true;
    }
    const int nN = mode == 0 ? 16 : 4;
    if (G == 256) {
      const int x = bid & 7, j = bid >> 3;
      if (mode == 0) { if (i >= 8) return false; u.pn = (x & 3) * 4 + (j & 3); u.pm = (x >> 2) * 64 + i * 8 + (j >> 2); return true; }
      if (i >= 2) return false; u.pn = j & 3; u.pm = x * 16 + i * 8 + (j >> 2); return true;
    }
    const int t = i * G + bid;
    if (t >= nN * 128) return false;
    u.pn = t % nN; u.pm = t / nN; return true;
  }
};

template <class Epi>
DI void gemm_phase(LAS unsigned char* lds, const Gemm g, const Sched& S, const Epi& E) {
  const int tid = opaque_tid(), wid = __builtin_amdgcn_readfirstlane(tid >> 6), lane = tid & 63, wr = wid >> 2, wc = wid & 3, fr = lane & 15, fq = lane >> 4;
  const int nt = g.K / BK;
  unsigned voffA[2], voffB[2];
#pragma unroll
  for (int i = 0; i < 2; ++i) {
    int R, C; stage_rc(tid * 16 + i * 8192, R, C);
    const int Rb = (R & ~31) + perm32(R & 31);
    voffA[i] = (unsigned)(R * g.lda + C) * 2u; voffB[i] = (unsigned)(Rb * g.ldb + C) * 2u;
  }
  const size_t kstep = g.kstepB, kstepA = g.kstepA;
  const size_t hstepA = (size_t)HALF * g.lda * 2, hstepB = (size_t)HALF * g.ldb * 2;
  const size_t tstepA = 2 * hstepA, tstepB = 2 * hstepB;
  const unsigned ldsw = (unsigned)wid * 1024u;
  const int aoff = lds_byte(wr * 64 + fr, fq * 8), boff = lds_byte(wc * 32 + fr, fq * 8);
#define PG8_SA(b, h) (((b) * 2 + (h)) * HTB)
#define PG8_SB(b, h) ((4 + (b) * 2 + (h)) * HTB)
#define PG8_STAGE(bufoff, gbase, voff) do { _Pragma("unroll") for (int _i = 0; _i < 2; ++_i) \
    __builtin_amdgcn_global_load_lds((const unsigned*)((const char*)(gbase) + (voff)[_i]), (LAS unsigned*)(lds + (bufoff) + ldsw + _i * 8192), 16, 0, 0); } while (0)
#define PG8_LDA(dst, b, h) do { _Pragma("unroll") for (int m = 0; m < 4; ++m) _Pragma("unroll") for (int k = 0; k < 2; ++k) dst[m][k] = *(const LAS bf16x8*)(lds + PG8_SA(b, h) + aoff + m * 2048 + k * 1024); } while (0)
#define PG8_LDB(dst, b, h) do { _Pragma("unroll") for (int n = 0; n < 2; ++n) _Pragma("unroll") for (int k = 0; k < 2; ++k) dst[n][k] = *(const LAS bf16x8*)(lds + PG8_SB(b, h) + boff + n * 2048 + k * 1024); } while (0)
#define PG8_MMA(ai, bj, At, Bt) do { __builtin_amdgcn_s_setprio(1); _Pragma("unroll") for (int m = 0; m < 4; ++m) _Pragma("unroll") for (int n = 0; n < 2; ++n) _Pragma("unroll") for (int k = 0; k < 2; ++k) \
    acc[ai][bj][m][n] = __builtin_amdgcn_mfma_f32_16x16x32_bf16(Bt[n][k], At[m][k], acc[ai][bj][m][n], 0, 0, 0); __builtin_amdgcn_s_setprio(0); } while (0)
#define PG8_WAIT_V(n) asm volatile("s_waitcnt vmcnt(" #n ")" ::: "memory")
#define PG8_WAIT_L(n) asm volatile("s_waitcnt lgkmcnt(" #n ")" ::: "memory")
#define PG8_BAR __builtin_amdgcn_s_barrier()
#define PG8_SCHED __builtin_amdgcn_sched_barrier(0)
  Unit cur, nxt; int ui = 0;
  if (!S.next(0, cur)) return;
  f32x4 acc[2][2][4][2];
#pragma unroll
  for (int a = 0; a < 2; ++a)
#pragma unroll
    for (int b = 0; b < 2; ++b)
#pragma unroll
      for (int m = 0; m < 4; ++m)
#pragma unroll
        for (int n = 0; n < 2; ++n) acc[a][b][m][n] = (f32x4){0.f, 0.f, 0.f, 0.f};
  bf16x8 At[4][2], B0[2][2], B1[2][2];
  const char* cA = (const char*)g.A + (size_t)cur.pm * tstepA + (size_t)cur.k0 * kstepA; const char* cB = (const char*)g.Bt + (size_t)cur.pn * tstepB + (size_t)cur.k0 * kstep;
  PG8_STAGE(PG8_SB(0, 0), cB, voffB); PG8_STAGE(PG8_SA(0, 0), cA, voffA); PG8_STAGE(PG8_SB(0, 1), cB + hstepB, voffB); PG8_STAGE(PG8_SA(0, 1), cA + hstepA, voffA);
  if (wr == 1) PG8_BAR;
  PG8_WAIT_V(4); PG8_BAR;
  PG8_STAGE(PG8_SB(1, 0), cB + kstep, voffB); PG8_STAGE(PG8_SA(1, 0), cA + kstepA, voffA); PG8_STAGE(PG8_SB(1, 1), cB + hstepB + kstep, voffB);
  PG8_WAIT_V(6); PG8_BAR;
  for (;;) {
    const bool has_next = S.next(ui + 1, nxt);
    const char* nA = has_next ? (const char*)g.A + (size_t)nxt.pm * tstepA + (size_t)nxt.k0 * kstepA : cA; const char* nB = has_next ? (const char*)g.Bt + (size_t)nxt.pn * tstepB + (size_t)nxt.k0 * kstep : cB;
    for (int t = 0; t < nt; t += 2) {
      const bool last = (t == nt - 2);
      const char* a1 = cA + (size_t)(t + 1) * kstepA;
      const char* a2 = last ? nA : cA + (size_t)(t + 2) * kstepA; const char* b2 = last ? nB : cB + (size_t)(t + 2) * kstep;
      const char* a3 = a2 + kstepA; const char* b3 = b2 + kstep;
      PG8_LDB(B0, 0, 0); PG8_SCHED; PG8_LDA(At, 0, 0); PG8_STAGE(PG8_SA(1, 1), a1 + hstepA, voffA);
      PG8_WAIT_L(8); PG8_BAR; PG8_WAIT_L(0); PG8_MMA(0, 0, At, B0); PG8_BAR; PG8_SCHED;
      PG8_LDB(B1, 0, 1); PG8_STAGE(PG8_SB(0, 0), b2, voffB);
      PG8_BAR; PG8_WAIT_L(0); PG8_MMA(0, 1, At, B1); PG8_BAR;
      PG8_LDA(At, 0, 1); PG8_STAGE(PG8_SA(0, 0), a2, voffA);
      PG8_BAR; PG8_WAIT_L(0); PG8_MMA(1, 0, At, B0); PG8_BAR; PG8_SCHED;
      PG8_STAGE(PG8_SB(0, 1), b2 + hstepB, voffB);
      PG8_WAIT_V(6); PG8_BAR; PG8_MMA(1, 1, At, B1); PG8_BAR;
      PG8_LDB(B0, 1, 0); PG8_SCHED; PG8_LDA(At, 1, 0); PG8_STAGE(PG8_SA(0, 1), a2 + hstepA, voffA);
      PG8_WAIT_L(8); PG8_BAR; PG8_WAIT_L(0); PG8_MMA(0, 0, At, B0); PG8_BAR; PG8_SCHED;
      PG8_LDB(B1, 1, 1); PG8_STAGE(PG8_SB(1, 0), b3, voffB);
      PG8_BAR; PG8_WAIT_L(0); PG8_MMA(0, 1, At, B1); PG8_BAR;
      PG8_LDA(At, 1, 1); PG8_STAGE(PG8_SA(1, 0), a3, voffA);
      PG8_BAR; PG8_WAIT_L(0); PG8_MMA(1, 0, At, B0); PG8_BAR; PG8_SCHED;
      PG8_STAGE(PG8_SB(1, 1), b3 + hstepB, voffB);
      PG8_WAIT_V(6); PG8_BAR; PG8_MMA(1, 1, At, B1); PG8_BAR;
    }
    E(acc, cur, wr, wc, fr, fq);
    if (!has_next) break;
#pragma unroll
    for (int a = 0; a < 2; ++a)
#pragma unroll
      for (int b = 0; b < 2; ++b)
#pragma unroll
        for (int m = 0; m < 4; ++m)
#pragma unroll
          for (int n = 0; n < 2; ++n) acc[a][b][m][n] = (f32x4){0.f, 0.f, 0.f, 0.f};
    cur = nxt; cA = nA; cB = nB; ++ui;
  }
  PG8_WAIT_V(0);
  if (wr == 0) PG8_BAR;
  PG8_BAR;
#undef PG8_SA
#undef PG8_SB
#undef PG8_STAGE
#undef PG8_LDA
#undef PG8_LDB
#undef PG8_MMA
#undef PG8_WAIT_V
#undef PG8_WAIT_L
#undef PG8_BAR
#undef PG8_SCHED
}

typedef f32x4 (&AccRef)[2][2][4][2];
DI unsigned xb_ld(unsigned* p)              { return __hip_atomic_load(p, __ATOMIC_RELAXED, __HIP_MEMORY_SCOPE_AGENT); }
DI unsigned xb_add(unsigned* p, unsigned v) { return __hip_atomic_fetch_add(p, v, __ATOMIC_RELAXED, __HIP_MEMORY_SCOPE_AGENT); }
#define EPI_ROWS for (int ai = 0; ai < 2; ++ai) _Pragma("unroll") for (int m = 0; m < 4; ++m)
#define EPI_ROW(u) ((u).pm * BM + ai * HALF + wr * 64 + m * 16 + fr)
#define EPI_COL(bj) ((bj) * HALF + wc * 32 + fq * 8)

DI void rope8(f32x4& v0, f32x4& v1, const float2* __restrict__ tab, int pos, int fq) {
  const f32x4* t4 = (const f32x4*)(tab + (size_t)pos * 8);
  const f32x4 c0 = t4[0], c1 = t4[1], c2 = t4[2], c3 = t4[3];
  float pv[8];
#pragma unroll
  for (int j = 0; j < 4; ++j) { pv[j] = __shfl_xor(v0[j], 16); pv[4 + j] = __shfl_xor(v1[j], 16); }
  if (fq < 2) {
    const float sg = fq ? 1.f : -1.f;
    v0[0] = v0[0] * c0[0] + sg * pv[0] * c0[1]; v0[1] = v0[1] * c0[2] + sg * pv[1] * c0[3];
    v0[2] = v0[2] * c1[0] + sg * pv[2] * c1[1]; v0[3] = v0[3] * c1[2] + sg * pv[3] * c1[3];
    v1[0] = v1[0] * c2[0] + sg * pv[4] * c2[1]; v1[1] = v1[1] * c2[2] + sg * pv[5] * c2[3];
    v1[2] = v1[2] * c3[0] + sg * pv[6] * c3[1]; v1[3] = v1[3] * c3[2] + sg * pv[7] * c3[3];
  }
}

DI void rope8t(f32x4& v0, f32x4& v1, const f32x4 (&t)[4], int fq) {
  float pv[8];
#pragma unroll
  for (int j = 0; j < 4; ++j) { pv[j] = __shfl_xor(v0[j], 16); pv[4 + j] = __shfl_xor(v1[j], 16); }
  if (fq < 2) {
    const float sg = fq ? 1.f : -1.f;
    v0[0] = v0[0] * t[0][0] + sg * pv[0] * t[0][1]; v0[1] = v0[1] * t[0][2] + sg * pv[1] * t[0][3];
    v0[2] = v0[2] * t[1][0] + sg * pv[2] * t[1][1]; v0[3] = v0[3] * t[1][2] + sg * pv[3] * t[1][3];
    v1[0] = v1[0] * t[2][0] + sg * pv[4] * t[2][1]; v1[1] = v1[1] * t[2][2] + sg * pv[5] * t[2][3];
    v1[2] = v1[2] * t[3][0] + sg * pv[6] * t[3][1]; v1[3] = v1[3] * t[3][2] + sg * pv[7] * t[3][3];
  }
}

struct EpiProj {
  const Params& p;
  DI void operator()(AccRef acc, const Unit& u, int wr, int wc, int fr, int fq) const {
    const int pn = u.pn;
    const bool roped = ((wc & 1) == 0) && (pn < 2 || pn == 3 || pn == 4);
    float rs8[8];
#pragma unroll
    EPI_ROWS rs8[ai * 4 + m] = p.rstd0[EPI_ROW(u)];
#pragma unroll
    for (int ai = 0; ai < 2; ++ai)
#pragma unroll
    for (int mh = 0; mh < 2; ++mh) {
      f32x4 tabx[2][4];
      if (roped) {
#pragma unroll
        for (int mm = 0; mm < 2; ++mm) {
          const int m = mh * 2 + mm;
          const f32x4* t4 = (const f32x4*)(p.rope + (size_t)(EPI_ROW(u) & (SEQ - 1)) * 8);
          tabx[mm][0] = t4[0]; tabx[mm][1] = t4[1]; tabx[mm][2] = t4[2]; tabx[mm][3] = t4[3];
        }
      }
#pragma unroll
      for (int mm = 0; mm < 2; ++mm) {
        const int m = mh * 2 + mm;
        const f32x4 (&tabm)[4] = tabx[mm];
        const int row = EPI_ROW(u);
        const float rs = rs8[ai * 4 + m];
        const int s = row & (SEQ - 1), b = row >> 12;
#pragma unroll
        for (int bj = 0; bj < 2; ++bj) {
          f32x4 v0 = acc[ai][bj][m][0] * rs, v1 = acc[ai][bj][m][1] * rs;
          const int lc = EPI_COL(bj);
          if (pn < 2) {
            if (roped) rope8t(v0, v1, tabm, fq);
            *(u32x4*)(p.qb + (size_t)row * 512 + pn * 256 + lc) = pack8(v0 * QSCALE, v1 * QSCALE);
          } else if (pn < 5) {
            const int which = (pn - 2) * 2 + bj;
            if ((which == 2 || which == 4) && roped) rope8t(v0, v1, tabm, fq);
            const int g = wc >> 1, d = (wc & 1) * 32 + fq * 8;
            *(u32x4*)(p.kvb + ((size_t)((which * 16 + b * 2 + g) * SEQ + s)) * 64 + d) = pack8(v0, v1);
          } else if (pn < 7) {
            *(u32x4*)(p.ub + (size_t)row * 512 + (pn - 5) * 256 + lc) = pack8(v0, v1);
          } else if (pn < 15) {
#pragma unroll
            for (int j = 0; j < 4; ++j) { v0[j] = sigmoidf_(v0[j]); v1[j] = sigmoidf_(v1[j]); }
            *(u32x4*)(p.gm + (size_t)row * 2048 + (pn - 7) * 256 + lc) = pack8(v0, v1);
          } else {
            if (bj == 0 && wc == 0 && fq < 3) {
#pragma unroll
              for (int j = 0; j < 4; ++j) { v0[j] = sigmoidf_(v0[j]); v1[j] = sigmoidf_(v1[j]); }
              f32x4* gp = (f32x4*)(p.gate + (size_t)row * 24 + fq * 8);
              gp[0] = v0; gp[1] = v1;
            }
          }
        }
      }
    }
  }
};

struct EpiCmpHid {
  float* hid32;
  DI void operator()(AccRef acc, const Unit& u, int wr, int wc, int fr, int fq) const {
    float* base = hid32 + ((size_t)((u.k0 >> 3) * 32 + u.pm) * 256) * 256;
#pragma unroll
    EPI_ROWS {
      const int c = ai * HALF + wr * 64 + m * 16 + fr;
#pragma unroll
      for (int bj = 0; bj < 2; ++bj) {
        f32x4* dp = (f32x4*)(base + (size_t)c * 256 + EPI_COL(bj));
        dp[0] = acc[ai][bj][m][0]; dp[1] = acc[ai][bj][m][1];
      }
    }
  }
};

struct EpiCmpOut {
  const Params& p;
  DI void operator()(AccRef acc, const Unit& u, int wr, int wc, int fr, int fq) const {
    const int kv = u.pm >> 4, bg = u.pm & 15;
    const bool roped = (kv == 0) && (wc == 0);
    u16* dst = (kv ? p.vcmp : p.kcmp) + (size_t)bg * 256 * 64;
#pragma unroll
    for (int ai = 0; ai < 2; ++ai) {
      f32x4 tabx[4][4];
      {
#pragma unroll
        for (int m = 0; m < 4; ++m) {
          const int c = ai * HALF + wr * 64 + m * 16 + fr;
          const f32x4* t4 = (const f32x4*)(p.rope + (size_t)min(16 * c + 31, SEQ - 1) * 8);
          tabx[m][0] = t4[0]; tabx[m][1] = t4[1]; tabx[m][2] = t4[2]; tabx[m][3] = t4[3];
        }
      }
#pragma unroll
      for (int m = 0; m < 4; ++m) {
        const int c = ai * HALF + wr * 64 + m * 16 + fr;
        f32x4 v0 = acc[ai][0][m][0], v1 = acc[ai][0][m][1];
        if (roped) rope8t(v0, v1, tabx[m], fq);
        if (c == 255) { v0 = (f32x4){0.f, 0.f, 0.f, 0.f}; v1 = v0; }
        if (wc < 2) *(u32x4*)(dst + c * 64 + wc * 32 + fq * 8) = pack8(v0, v1);
      }
    }
  }
};

template <int PASS>
struct EpiMerge {
  const Params& p;
  DI void operator()(AccRef acc, const Unit& u, int wr, int wc, int fr, int fq) const {
#pragma unroll
    for (int ai = 0; ai < 2; ++ai) {
      u32x4 gq[4][2], ov[4][2];
#pragma unroll
      for (int m = 0; m < 4; ++m)
#pragma unroll
        for (int bj = 0; bj < 2; ++bj) {
          const int row = EPI_ROW(u), col = u.pn * BM + EPI_COL(bj);
          gq[m][bj] = *(const u32x4*)(p.gm + (size_t)row * 2048 + PASS * 1024 + col);
          if (PASS == 1) ov[m][bj] = *(const u32x4*)(p.mb + (size_t)row * 1024 + col);
        }
#pragma unroll
      for (int m = 0; m < 4; ++m) {
        const int row = EPI_ROW(u);
#pragma unroll
        for (int bj = 0; bj < 2; ++bj) {
          const int col = u.pn * BM + EPI_COL(bj);
          const u32x4 g = gq[m][bj];
          f32x4 v0 = acc[ai][bj][m][0], v1 = acc[ai][bj][m][1];
          v0[0] *= bf_lo(g[0]); v0[1] *= bf_hi(g[0]); v0[2] *= bf_lo(g[1]); v0[3] *= bf_hi(g[1]);
          v1[0] *= bf_lo(g[2]); v1[1] *= bf_hi(g[2]); v1[2] *= bf_lo(g[3]); v1[3] *= bf_hi(g[3]);
          if (PASS == 1) {
            const u32x4 o = ov[m][bj];
            v0[0] += bf_lo(o[0]); v0[1] += bf_hi(o[0]); v0[2] += bf_lo(o[1]); v0[3] += bf_hi(o[1]);
            v1[0] += bf_lo(o[2]); v1[1] += bf_hi(o[2]); v1[2] += bf_lo(o[3]); v1[3] += bf_hi(o[3]);
          }
          *(u32x4*)(p.mb + (size_t)row * 1024 + col) = pack8(v0, v1);
        }
      }
    }
  }
};

template <bool WITH_BF16, bool WITH_F32 = true>
struct EpiResid {
  const float* resid; float* out; u16* outb; float* ssq;
  DI void operator()(AccRef acc, const Unit& u, int wr, int wc, int fr, int fq) const {
#pragma unroll
    for (int ai = 0; ai < 2; ++ai) {
      f32x4 rv[4][2][2];
#pragma unroll
      for (int m = 0; m < 4; ++m)
#pragma unroll
        for (int bj = 0; bj < 2; ++bj) {
          const f32x4* rp = (const f32x4*)(resid + (size_t)EPI_ROW(u) * 1024 + u.pn * BM + EPI_COL(bj));
          rv[m][bj][0] = rp[0]; rv[m][bj][1] = rp[1];
        }
#pragma unroll
      for (int m = 0; m < 4; ++m) {
        const int row = EPI_ROW(u);
        float sq = 0.f;
#pragma unroll
        for (int bj = 0; bj < 2; ++bj) {
          const size_t a = (size_t)row * 1024 + u.pn * BM + EPI_COL(bj);
          const f32x4 v0 = rv[m][bj][0] + acc[ai][bj][m][0], v1 = rv[m][bj][1] + acc[ai][bj][m][1];
          if (WITH_F32) { f32x4* op = (f32x4*)(out + a); op[0] = v0; op[1] = v1; }
          if (WITH_BF16) *(u32x4*)(outb + a) = pack8(v0, v1);
#pragma unroll
          for (int j = 0; j < 4; ++j) sq += v0[j] * v0[j] + v1[j] * v1[j];
        }
        sq += __shfl_xor(sq, 16);
        sq += __shfl_xor(sq, 32);
        if (fq == 0) ssq[(size_t)row * 16 + u.pn * 4 + wc] = sq;
      }
    }
  }
};

struct EpiResidBf {
  u16* xb; float* ssq;
  DI void operator()(AccRef acc, const Unit& u, int wr, int wc, int fr, int fq) const {
#pragma unroll
    for (int ai = 0; ai < 2; ++ai) {
      u32x4 rv[4][2];
#pragma unroll
      for (int m = 0; m < 4; ++m)
#pragma unroll
        for (int bj = 0; bj < 2; ++bj) rv[m][bj] = *(const u32x4*)(xb + (size_t)EPI_ROW(u) * 1024 + u.pn * BM + EPI_COL(bj));
#pragma unroll
      for (int m = 0; m < 4; ++m) {
        const int row = EPI_ROW(u);
        float sq = 0.f;
#pragma unroll
        for (int bj = 0; bj < 2; ++bj) {
          const u32x4 r8 = rv[m][bj];
          f32x4 v0 = acc[ai][bj][m][0], v1 = acc[ai][bj][m][1];
          v0[0] += bf_lo(r8[0]); v0[1] += bf_hi(r8[0]); v0[2] += bf_lo(r8[1]); v0[3] += bf_hi(r8[1]);
          v1[0] += bf_lo(r8[2]); v1[1] += bf_hi(r8[2]); v1[2] += bf_lo(r8[3]); v1[3] += bf_hi(r8[3]);
          *(u32x4*)(xb + (size_t)row * 1024 + u.pn * BM + EPI_COL(bj)) = pack8(v0, v1);
#pragma unroll
          for (int j = 0; j < 4; ++j) sq += v0[j] * v0[j] + v1[j] * v1[j];
        }
        sq += __shfl_xor(sq, 16);
        sq += __shfl_xor(sq, 32);
        if (fq == 0) ssq[(size_t)row * 16 + u.pn * 4 + wc] = sq;
      }
    }
  }
};

struct EpiFinal {
  float* out; const u16* x1b; const float* gfin; float* ssq2; unsigned* cnt;
  DI void operator()(AccRef acc, const Unit& u, int wr, int wc, int fr, int fq) const {
#pragma unroll
    for (int ai = 0; ai < 2; ++ai) {
      u32x4 r8[4][2];
#pragma unroll
      for (int m = 0; m < 4; ++m)
#pragma unroll
        for (int bj = 0; bj < 2; ++bj) r8[m][bj] = *(const u32x4*)(x1b + (size_t)EPI_ROW(u) * 1024 + u.pn * BM + EPI_COL(bj));
#pragma unroll
      for (int m = 0; m < 4; ++m) {
        const int row = EPI_ROW(u);
        float sq = 0.f;
#pragma unroll
        for (int bj = 0; bj < 2; ++bj) {
          const u32x4 r = r8[m][bj];
          acc[ai][bj][m][0] += (f32x4){bf_lo(r[0]), bf_hi(r[0]), bf_lo(r[1]), bf_hi(r[1])};
          acc[ai][bj][m][1] += (f32x4){bf_lo(r[2]), bf_hi(r[2]), bf_lo(r[3]), bf_hi(r[3])};
#pragma unroll
          for (int j = 0; j < 4; ++j) sq += acc[ai][bj][m][0][j] * acc[ai][bj][m][0][j] + acc[ai][bj][m][1][j] * acc[ai][bj][m][1][j];
        }
        sq += __shfl_xor(sq, 16);
        sq += __shfl_xor(sq, 32);
        if (fq == 0) __hip_atomic_store(ssq2 + (size_t)row * 16 + u.pn * 4 + wc, sq, __ATOMIC_RELAXED, __HIP_MEMORY_SCOPE_AGENT);
      }
    }
    asm volatile("s_waitcnt vmcnt(0)" ::: "memory");
    unsigned* c = cnt + (u.pm * 2 + wr) * 16;
    if (fq == 0 && fr == 0) (void)xb_add(c, 1u);
    { unsigned sp = 0; while (xb_ld(c) < 16u) { __builtin_amdgcn_s_sleep(1); if (++sp > (1u << 20)) break; } }
    unsigned long long q0[8], q1[8];
#pragma unroll
    EPI_ROWS {
      unsigned long long* sp = (unsigned long long*)(ssq2 + (size_t)EPI_ROW(u) * 16 + fq * 4);
      q0[ai * 4 + m] = __hip_atomic_load(sp, __ATOMIC_RELAXED, __HIP_MEMORY_SCOPE_AGENT);
      q1[ai * 4 + m] = __hip_atomic_load(sp + 1, __ATOMIC_RELAXED, __HIP_MEMORY_SCOPE_AGENT);
    }
    f32x4 gv[2][2];
#pragma unroll
    for (int bj = 0; bj < 2; ++bj) { const f32x4* gp = (const f32x4*)(gfin + u.pn * BM + EPI_COL(bj)); gv[bj][0] = gp[0]; gv[bj][1] = gp[1]; }
#pragma unroll
    EPI_ROWS {
      const int row = EPI_ROW(u);
      const unsigned long long a0 = q0[ai * 4 + m], a1 = q1[ai * 4 + m];
      float ss = (__uint_as_float((unsigned)a0) + __uint_as_float((unsigned)(a0 >> 32))) + (__uint_as_float((unsigned)a1) + __uint_as_float((unsigned)(a1 >> 32)));
      ss += __shfl_xor(ss, 16);
      ss += __shfl_xor(ss, 32);
      const float rs = rsqrtf(ss * (1.f / DM) + 1e-6f);
#pragma unroll
      for (int bj = 0; bj < 2; ++bj) {
        f32x4* op = (f32x4*)(out + (size_t)row * 1024 + u.pn * BM + EPI_COL(bj));
        op[0] = acc[ai][bj][m][0] * rs * gv[bj][0]; op[1] = acc[ai][bj][m][1] * rs * gv[bj][1];
      }
    }
  }
};

struct EpiFF1 {
  const Params& p;
  DI void operator()(AccRef acc, const Unit& u, int wr, int wc, int fr, int fq) const {
    f32x4 part[8];
#pragma unroll
    EPI_ROWS part[ai * 4 + m] = *(const f32x4*)(p.ssq + (size_t)EPI_ROW(u) * 16 + fq * 4);
    float rs8[8];
#pragma unroll
    for (int r = 0; r < 8; ++r) {
      float ss = (part[r][0] + part[r][1]) + (part[r][2] + part[r][3]);
      ss += __shfl_xor(ss, 16);
      ss += __shfl_xor(ss, 32);
      rs8[r] = rsqrtf(ss * (1.f / DM) + 1e-6f);
    }
#pragma unroll
    EPI_ROWS {
      const int row = EPI_ROW(u);
      const float rs = rs8[ai * 4 + m];
#pragma unroll
      for (int bj = 0; bj < 2; ++bj) {
        f32x4 v0 = acc[ai][bj][m][0] * rs, v1 = acc[ai][bj][m][1] * rs;
#pragma unroll
        for (int j = 0; j < 4; ++j) { const float r0 = fmaxf(v0[j], 0.f), r1 = fmaxf(v1[j], 0.f); v0[j] = r0 * r0; v1[j] = r1 * r1; }
        const int col = u.pn * BM + EPI_COL(bj);
        *(u32x4*)(p.act + ((size_t)(col >> 6) * T_TOK + row) * 64 + (col & 63)) = pack8(v0, v1);
      }
    }
  }
};

DI void p0_rows(const Params& p, int item) {
  const int w = threadIdx.x >> 6, lane = threadIdx.x & 63;
  const int row0 = item * 32 + w * 4;
  float4 v[4][4];
#pragma unroll
  for (int r = 0; r < 4; ++r) {
    const float4* src = (const float4*)(p.x + (size_t)(row0 + r) * DM);
#pragma unroll
    for (int i = 0; i < 4; ++i) v[r][i] = src[lane + 64 * i];
  }
#pragma unroll
  for (int r = 0; r < 4; ++r) {
    float ss = 0.f;
#pragma unroll
    for (int i = 0; i < 4; ++i) ss += v[r][i].x * v[r][i].x + v[r][i].y * v[r][i].y + v[r][i].z * v[r][i].z + v[r][i].w * v[r][i].w;
#pragma unroll
    for (int o = 32; o; o >>= 1) ss += __shfl_xor(ss, o);
    if (lane == 0) p.rstd0[row0 + r] = rsqrtf(ss * (1.f / DM) + 1e-6f);
    u32x2* dst = (u32x2*)(p.xb + (size_t)(row0 + r) * DM);
#pragma unroll
    for (int i = 0; i < 4; ++i) {
      u32x2 o = {pack_bf2(v[r][i].x, v[r][i].y), pack_bf2(v[r][i].z, v[r][i].w)};
      dst[lane + 64 * i] = o;
    }
  }
}

constexpr int TJ_WIN = 1024, TJ_WA = 128, TJ_WO = 256, TJ_W1 = 1024, TJ_W2 = 1024, TJ_C1 = 128, TJ_C2 = 16;
constexpr int TJ_TOTAL = TJ_WIN + TJ_WA + TJ_WO + TJ_W1 + TJ_W2 + 2 * TJ_C1 + 2 * TJ_C2;

constexpr int TJ_EARLY = TJ_WIN + 2 * TJ_C1 + 2 * TJ_C2;
DI void p0_transpose(const Params& p, int item, char* smem, int base) {
  const int half = threadIdx.x >> 8, tid = threadIdx.x & 255;
  int idx = item * 2 + half + base;
  const float* src; u16* dst; const float* scale = nullptr; int K, N, kind = 0;
  if (idx < TJ_WIN) { src = p.w_in; dst = p.w_in_t; scale = p.norm_mix; K = 1024; N = 3864; kind = 1; }
  else if ((idx -= TJ_WIN) < TJ_C1) { src = p.ck_w1; dst = p.cw1_t; K = 2048; N = 256; }
  else if ((idx -= TJ_C1) < TJ_C1) { src = p.cv_w1; dst = p.cw1_t + 256 * 2048; K = 2048; N = 256; }
  else if ((idx -= TJ_C1) < TJ_C2) { src = p.ck_w2; dst = p.cw2_t; K = 256; N = 64; }
  else if ((idx -= TJ_C2) < TJ_C2) { src = p.cv_w2; dst = p.cw2_t + 256 * 256; K = 256; N = 64; }
  else if ((idx -= TJ_C2) < TJ_WA) { src = p.w_ba; dst = p.wa_t; K = 512; N = 1024; }
  else if ((idx -= TJ_WA) < TJ_WO) { src = p.w_out; dst = p.wo_t; K = 1024; N = 1024; }
  else if ((idx -= TJ_WO) < TJ_W1) { src = p.w_ff1; dst = p.w1_t; scale = p.norm_mlp; K = 1024; N = 4096; }
  else { idx -= TJ_W1; src = p.w_ff2; dst = p.w2_t; K = 4096; N = 1024; kind = 2; }
  const int nk = K >> 6;
  const int k0 = (idx % nk) * 64, n0 = (idx / nk) * 64;
  float* tile = (float*)(smem + half * 16640);
  __syncthreads();
#pragma unroll
  for (int i = 0; i < 4; ++i) {
    const int kk = (tid >> 4) + 16 * i, nn = (tid & 15) * 4;
    const int nd = n0 + nn;
    int sc;
    if (kind == 1) sc = nd < 1280 ? nd : (nd < 3840 ? nd + 24 : (nd < 3864 ? nd - 2560 : -1));
    else sc = nd < N ? nd : -1;
    float4 v = make_float4(0.f, 0.f, 0.f, 0.f);
    if (sc >= 0) v = *(const float4*)(src + (size_t)(k0 + kk) * N + sc);
    if (scale) { float s = scale[k0 + kk]; v.x *= s; v.y *= s; v.z *= s; v.w *= s; }
    tile[kk * 65 + nn + 0] = v.x; tile[kk * 65 + nn + 1] = v.y; tile[kk * 65 + nn + 2] = v.z; tile[kk * 65 + nn + 3] = v.w;
  }
  __syncthreads();
  {
    const int n = tid >> 2, kq = (tid & 3) * 16;
    unsigned o[8];
#pragma unroll
    for (int j = 0; j < 8; ++j) o[j] = pack_bf2(tile[(kq + 2 * j) * 65 + n], tile[(kq + 2 * j + 1) * 65 + n]);
    u32x4* d = (kind == 2) ? (u32x4*)(dst + ((size_t)(k0 >> 6) * 1024 + (n0 + n)) * 64 + kq)
                           : (u32x4*)(dst + (size_t)(n0 + n) * K + k0 + kq);
    u32x4 o0 = {o[0], o[1], o[2], o[3]}, o1 = {o[4], o[5], o[6], o[7]};
    d[0] = o0; d[1] = o1;
  }
}

DI void p0_weff(const Params& p, int item, char* smem) {
  const int g = item >> 4, n0 = (item & 15) * 64, tid = threadIdx.x;
  float* pw = (float*)smem;
  float* ws = (float*)(smem + 66048);
  __syncthreads();
  for (int e = tid; e < 128 * 128; e += NTHR) { const int c = e >> 7, d = e & 127; pw[c * 129 + d] = p.pool_w[(size_t)g * 16384 + e] * p.pool_scale[g * 128 + d]; }
  for (int e = tid; e < 128 * 64; e += NTHR) { const int d = e >> 6, n = e & 63; ws[e] = p.w_bp[(size_t)(g * 128 + d) * 1024 + n0 + n]; }
  __syncthreads();
  const int c = tid & 127, nq = (tid >> 7) * 16;
  float a[16];
#pragma unroll
  for (int j = 0; j < 16; ++j) a[j] = 0.f;
  for (int d = 0; d < 128; ++d) {
    const float w = pw[c * 129 + d];
#pragma unroll
    for (int j = 0; j < 16; ++j) a[j] += w * ws[d * 64 + nq + j];
  }
#pragma unroll
  for (int j = 0; j < 16; ++j) p.wbe_t[(size_t)(n0 + nq + j) * 512 + g * 128 + c] = (u16)(pack_bf2(a[j], 0.f) & 0xffffu);
}

DI void p0_cbias(const Params& p, int idx, char* smem) {
  const int kv = idx >> 3, nc = idx & 7, tid = threadIdx.x, n = tid & 31, part = tid >> 5;
  const float* pe = kv ? p.pe_v : p.pe_k;
  const float* w1 = kv ? p.cv_w1 : p.ck_w1;
  float s = 0.f;
  for (int k = part * 128; k < part * 128 + 128; ++k) s += pe[k] * w1[(size_t)k * 256 + nc * 32 + n];
  float* red = (float*)smem;
  __syncthreads();
  red[part * 32 + n] = s;
  __syncthreads();
  if (tid < 32) {
    float t = 0.f;
#pragma unroll
    for (int j = 0; j < 16; ++j) t += red[j * 32 + tid];
    p.cbias[kv * 256 + nc * 32 + tid] = t;
  }
}

DI void p0_rope(const Params& p, int idx) {
  const int e = idx * NTHR + threadIdx.x;
  const int pos = e >> 3, i = e & 7;
  const float inv = powf(500000.0f, -(float)(2 * i) / 16.0f);
  const float ang = (float)pos * inv;
  float sn, cs;
  sincosf(ang, &sn, &cs);
  p.rope[e] = make_float2(cs, sn);
}

DI void p2a_pool_item(const Params& p, int item) {
  const int idx = item * NTHR + threadIdx.x;
  const int t = idx >> 6, ch = (idx & 63) * 8;
  const int grp = ch >> 7, wlen = 2 << grp, s = t & (SEQ - 1);
  const int cnt = min(s + 1, wlen);
  float a[8];
#pragma unroll
  for (int j = 0; j < 8; ++j) a[j] = 0.f;
  const u16* base = p.ub + (size_t)t * 512 + ch;
  u32x4 v[16];
#pragma unroll
  for (int k = 0; k < 16; ++k) { v[k] = (u32x4){0u, 0u, 0u, 0u}; if (k < cnt) v[k] = *(const u32x4*)(base - (size_t)k * 512); }
  const u32x4 cur = v[0];
#pragma unroll
  for (int k = 0; k < 16; ++k) {
#pragma unroll
    for (int j = 0; j < 4; ++j) { a[2 * j] += bf_lo(v[k][j]); a[2 * j + 1] += bf_hi(v[k][j]); }
  }
  const float ic = 1.f / (float)cnt;
  u32x4 o;
#pragma unroll
  for (int j = 0; j < 4; ++j) o[j] = pack_bf2(a[2 * j] * ic - bf_lo(cur[j]), a[2 * j + 1] * ic - bf_hi(cur[j]));
  *(u32x4*)(p.pooled + (size_t)t * 512 + ch) = o;
}

constexpr int AT_P = 65536, AT_S = 98304, AT_M = 131072;
template <int MODE>
DI void attn_tiles(const u16* __restrict__ Kg, const u16* __restrict__ Vg, int j0, int j1, char* smem,
                   const bf16x8 (&qf)[4], float& m, float& l, f32x16 (&O)[2], int lo, int hi, int lo_max, int hi_min,
                   unsigned mlo, unsigned mhi, float inv_l, int tok_l, int tid) {
  const int lane = tid & 63, l31 = lane & 31, h = lane >> 5;
  const int lk = tid >> 3, lc = tid & 7;
  const int kwr = lk * 128 + ((lc ^ ((lk >> 1) & 7)) << 4);
  const int vwr = 16384 + (lc >> 2) * 4096 + lk * 64 + (lc & 3) * 16;
  const int f = (l31 >> 1) & 7;
  const int krd = l31 * 128;
  int kx[4];
#pragma unroll
  for (int ks = 0; ks < 4; ++ks) kx[ks] = ((2 * ks + h) ^ f) << 4;
  const lds_cptr vrd = (lds_cptr)smem + 16384 + ((lane >> 4) & 1) * 32 + (lane & 3) * 8 + (4 * h + ((lane & 15) >> 2)) * 64;
  const int goff = lk * 64 + lc * 8;
  u32x4 rk, rv;
  rk = *(const u32x4*)(Kg + (size_t)j0 * 4096 + goff);
  if (MODE != 0) rv = *(const u32x4*)(Vg + (size_t)j0 * 4096 + goff);
  for (int j = j0; j <= j1; ++j) {
    const int bo = ((j - j0) & 1) * 8192;
    *(u32x4*)(smem + bo + kwr) = rk;
    if (MODE != 0) *(u32x4*)(smem + bo + vwr) = rv;
    __syncthreads();
    if (j < j1) {
      rk = *(const u32x4*)(Kg + (size_t)(j + 1) * 4096 + goff);
      if (MODE != 0) rv = *(const u32x4*)(Vg + (size_t)(j + 1) * 4096 + goff);
    }
    bool bit = true;
    if (MODE == 2) {
      bit = ((j < 32 ? (mlo >> j) : (mhi >> (j - 32))) & 1u) != 0;
      if (__ballot(bit) == 0ull) continue;
    }
    f32x16 s0 = zero16(), s1 = zero16();
#pragma unroll
    for (int ks = 0; ks < 4; ++ks) {
      bf16x8 a0 = *(const bf16x8*)(smem + bo + krd + kx[ks]);
      bf16x8 a1 = *(const bf16x8*)(smem + bo + krd + 4096 + kx[ks]);
      s0 = mfma32(a0, qf[ks], s0);
      s1 = mfma32(a1, qf[ks], s1);
    }
    const bool need_mask = (64 * j < lo_max) || (64 * j + 63 > hi_min);
    const int rlo = lo - 64 * j - 4 * h, span = hi - lo;
    if (need_mask) {
#pragma unroll
      for (int i = 0; i < 16; ++i) {
        const int c0 = 8 * (i >> 2) + (i & 3);
        if ((unsigned)(c0 - rlo) > (unsigned)span || span < 0) s0[i] = NEGF;
        if ((unsigned)(c0 + 32 - rlo) > (unsigned)span || span < 0) s1[i] = NEGF;
      }
    }
    float msub;
    if (MODE == 1) {
      msub = m;
    } else {
      float mx = s0[0];
#pragma unroll
      for (int i = 1; i < 16; ++i) mx = fmaxf(mx, s0[i]);
#pragma unroll
      for (int i = 0; i < 16; ++i) mx = fmaxf(mx, s1[i]);
      mx = fmaxf(mx, __shfl_xor(mx, 32));
      if (MODE == 2) mx = bit ? mx : NEGF;
      const float mn = fmaxf(m, mx);
      const float alpha = __builtin_amdgcn_exp2f(m - mn);
      m = mn;
      l *= alpha;
      if (MODE != 0) {
        if (__ballot(alpha != 1.f) != 0ull) {
#pragma unroll
          for (int i = 0; i < 16; ++i) { O[0][i] *= alpha; O[1][i] *= alpha; }
        }
      }
      msub = (MODE == 2 && !bit) ? 1e30f : mn;
    }
    msub = fmaxf(msub, -1e29f);
    float rs = 0.f;
#pragma unroll
    for (int i = 0; i < 16; ++i) {
      float p0 = __builtin_amdgcn_exp2f(s0[i] - msub), p1 = __builtin_amdgcn_exp2f(s1[i] - msub);
      if (MODE == 1) { p0 *= inv_l; p1 *= inv_l; }
      s0[i] = p0; s1[i] = p1;
      rs += p0 + p1;
    }
    l += rs;
    if (MODE == 0) continue;
    if (MODE == 1) {
      float* ps = (float*)(smem + AT_P) + tok_l * 256 + 64 * j + 4 * h;
#pragma unroll
      for (int gq = 0; gq < 4; ++gq) {
        float4 a, b;
        float t;
        t = s0[4 * gq + 0]; t += __shfl_xor(t, 1); t += __shfl_xor(t, 2); a.x = t;
        t = s0[4 * gq + 1]; t += __shfl_xor(t, 1); t += __shfl_xor(t, 2); a.y = t;
        t = s0[4 * gq + 2]; t += __shfl_xor(t, 1); t += __shfl_xor(t, 2); a.z = t;
        t = s0[4 * gq + 3]; t += __shfl_xor(t, 1); t += __shfl_xor(t, 2); a.w = t;
        t = s1[4 * gq + 0]; t += __shfl_xor(t, 1); t += __shfl_xor(t, 2); b.x = t;
        t = s1[4 * gq + 1]; t += __shfl_xor(t, 1); t += __shfl_xor(t, 2); b.y = t;
        t = s1[4 * gq + 2]; t += __shfl_xor(t, 1); t += __shfl_xor(t, 2); b.z = t;
        t = s1[4 * gq + 3]; t += __shfl_xor(t, 1); t += __shfl_xor(t, 2); b.w = t;
        if ((l31 & 3) == 0) { *(float4*)(ps + 8 * gq) = a; *(float4*)(ps + 32 + 8 * gq) = b; }
      }
    }
#pragma unroll
    for (int s4 = 0; s4 < 4; ++s4) {
      u32x4 pk;
      if (s4 < 2) {
#pragma unroll
        for (int jj = 0; jj < 4; ++jj) pk[jj] = pack_bf2(s0[8 * (s4 & 1) + 2 * jj], s0[8 * (s4 & 1) + 2 * jj + 1]);
      } else {
#pragma unroll
        for (int jj = 0; jj < 4; ++jj) pk[jj] = pack_bf2(s1[8 * (s4 & 1) + 2 * jj], s1[8 * (s4 & 1) + 2 * jj + 1]);
      }
      const bf16x8 pb = __builtin_bit_cast(bf16x8, pk);
#pragma unroll
      for (int dt = 0; dt < 2; ++dt) {
        s16x4 vlo = vtr(vrd + bo + dt * 4096 + s4 * 1024);
        s16x4 vhi = vtr(vrd + bo + dt * 4096 + s4 * 1024 + 512);
        bf16x8 vf = __builtin_shufflevector(vlo, vhi, 0, 1, 2, 3, 4, 5, 6, 7);
        O[dt] = mfma32(vf, pb, O[dt]);
      }
    }
  }
  __syncthreads();
}

template <int MODE>
DI void attn_tiles_pipe(const u16* __restrict__ Kg, const u16* __restrict__ Vg, int j0, int j1, char* smem,
                        const bf16x8 (&qf)[4], float& m, float& l, f32x16 (&O)[2], int lo, int hi, int lo_max, int hi_min,
                        unsigned mlo, unsigned mhi, int tid) {
  const int lane = tid & 63, l31 = lane & 31, h = lane >> 5;
  const int lk = tid >> 3, lc = tid & 7;
  const int kwr = lk * 128 + ((lc ^ ((lk >> 1) & 7)) << 4);
  const int vwr = 16384 + (lc >> 2) * 4096 + lk * 64 + (lc & 3) * 16;
  const int f = (l31 >> 1) & 7;
  const int krd = l31 * 128;
  int kx[4];
#pragma unroll
  for (int ks = 0; ks < 4; ++ks) kx[ks] = ((2 * ks + h) ^ f) << 4;
  const lds_cptr vrd = (lds_cptr)smem + 16384 + ((lane >> 4) & 1) * 32 + (lane & 3) * 8 + (4 * h + ((lane & 15) >> 2)) * 64;
  const int goff = lk * 64 + lc * 8;
  u32x4 rk, rv;
  auto qk_tile = [&](int bufoff, f32x16& d0, f32x16& d1) __attribute__((always_inline)) {
    bf16x8 ka[4], kb[4];
#pragma unroll
    for (int ks = 0; ks < 4; ++ks) { ka[ks] = *(const bf16x8*)(smem + bufoff + krd + kx[ks]); kb[ks] = *(const bf16x8*)(smem + bufoff + krd + 4096 + kx[ks]); }
    d0 = mfma32(ka[0], qf[0], zero16()); d1 = mfma32(kb[0], qf[0], zero16());
#pragma unroll
    for (int ks = 1; ks < 4; ++ks) { d0 = mfma32(ka[ks], qf[ks], d0); d1 = mfma32(kb[ks], qf[ks], d1); }
  };
  auto active = [&](int j) __attribute__((always_inline)) -> bool {
    if (MODE != 2) return true;
    const bool b = ((j < 32 ? (mlo >> j) : (mhi >> (j - 32))) & 1u) != 0;
    return __ballot(b) != 0ull;
  };
  auto step = [&](int j, bool act_c, bool& act_n, f32x16& c0, f32x16& c1, f32x16& n0, f32x16& n1) __attribute__((always_inline)) {
    const int par = (j - j0) & 1;
    const int bo = par * 8192, bn = (par ^ 1) * 8192;
    if (j < j1) *(u32x4*)(smem + bn + kwr) = rk;
    *(u32x4*)(smem + bo + vwr) = rv;
    __syncthreads();
    if (j + 2 <= j1) rk = *(const u32x4*)(Kg + (size_t)(j + 2) * 4096 + goff);
    if (j + 1 <= j1) rv = *(const u32x4*)(Vg + (size_t)(j + 1) * 4096 + goff);
    act_n = false;
    if (j < j1) { act_n = active(j + 1); if (act_n) qk_tile(bn, n0, n1); }
    if (!act_c) return;
    bool bit = true;
    if (MODE == 2) bit = ((j < 32 ? (mlo >> j) : (mhi >> (j - 32))) & 1u) != 0;
    const bool need_mask = (64 * j < lo_max) || (64 * j + 63 > hi_min);
    if (need_mask) {
      const int rlo = lo - 64 * j - 4 * h, span = hi - lo;
#pragma unroll
      for (int i = 0; i < 16; ++i) {
        const int cc = 8 * (i >> 2) + (i & 3);
        if ((unsigned)(cc - rlo) > (unsigned)span || span < 0) c0[i] = NEGF;
        if ((unsigned)(cc + 32 - rlo) > (unsigned)span || span < 0) c1[i] = NEGF;
      }
    }
    float mx = c0[0];
#pragma unroll
    for (int i = 1; i < 16; ++i) mx = fmaxf(mx, c0[i]);
#pragma unroll
    for (int i = 0; i < 16; ++i) mx = fmaxf(mx, c1[i]);
    mx = fmaxf(mx, __shfl_xor(mx, 32));
    if (MODE == 2) mx = bit ? mx : NEGF;
    const float mn = fmaxf(m, mx);
    const float alpha = __builtin_amdgcn_exp2f(m - mn);
    m = mn;
    l *= alpha;
    if (__ballot(alpha != 1.f) != 0ull) {
#pragma unroll
      for (int i = 0; i < 16; ++i) { O[0][i] *= alpha; O[1][i] *= alpha; }
    }
    const float msub = (MODE == 2 && !bit) ? 1e30f : fmaxf(mn, -1e29f);
    bf16x8 vf[4][2];
#pragma unroll
    for (int s4 = 0; s4 < 4; ++s4)
#pragma unroll
      for (int dt = 0; dt < 2; ++dt) {
        s16x4 vlo = vtr(vrd + bo + dt * 4096 + s4 * 1024);
        s16x4 vhi = vtr(vrd + bo + dt * 4096 + s4 * 1024 + 512);
        vf[s4][dt] = __builtin_shufflevector(vlo, vhi, 0, 1, 2, 3, 4, 5, 6, 7);
      }
    float rs = 0.f;
#pragma unroll
    for (int i = 0; i < 16; ++i) {
      const float p0 = __builtin_amdgcn_exp2f(c0[i] - msub), p1 = __builtin_amdgcn_exp2f(c1[i] - msub);
      c0[i] = p0; c1[i] = p1;
      rs += p0 + p1;
    }
    l += rs;
#pragma unroll
    for (int s4 = 0; s4 < 4; ++s4) {
      u32x4 pk;
      if (s4 < 2) {
#pragma unroll
        for (int jj = 0; jj < 4; ++jj) pk[jj] = pack_bf2(c0[8 * (s4 & 1) + 2 * jj], c0[8 * (s4 & 1) + 2 * jj + 1]);
      } else {
#pragma unroll
        for (int jj = 0; jj < 4; ++jj) pk[jj] = pack_bf2(c1[8 * (s4 & 1) + 2 * jj], c1[8 * (s4 & 1) + 2 * jj + 1]);
      }
      const bf16x8 pb = __builtin_bit_cast(bf16x8, pk);
      O[0] = mfma32(vf[s4][0], pb, O[0]);
      O[1] = mfma32(vf[s4][1], pb, O[1]);
    }
  };
  rk = *(const u32x4*)(Kg + (size_t)j0 * 4096 + goff);
  rv = *(const u32x4*)(Vg + (size_t)j0 * 4096 + goff);
  *(u32x4*)(smem + kwr) = rk;
  if (j0 < j1) rk = *(const u32x4*)(Kg + (size_t)(j0 + 1) * 4096 + goff);
  __syncthreads();
  f32x16 a0, a1, b0, b1;
  bool actA = true, actB = false;
  qk_tile(0, a0, a1);
  for (int j = j0; j <= j1; j += 2) {
    step(j, actA, actB, a0, a1, b0, b1);
    if (j + 1 <= j1) step(j + 1, actB, actA, b0, b1, a0, a1);
  }
  __syncthreads();
}

constexpr int RING = 6;
DI void glds16(const u16* g, char* lds) {
  __builtin_amdgcn_global_load_lds((const unsigned*)g, (LAS unsigned*)lds, 16, 0, 0);
}
template <int MODE>
DI void attn_tiles_ring(const u16* __restrict__ Kg, const u16* __restrict__ Vg, int j0, int j1, char* smem,
                        const bf16x8 (&qf)[4], float& m, float& l, f32x16 (&O)[2], int lo, int hi, int lo_max, int hi_min,
                        unsigned mlo, unsigned mhi, int tid) {
  const int lane = tid & 63, l31 = lane & 31, h = lane >> 5;
  const int f = (l31 >> 1) & 7;
  const int krd = l31 * 128;
  int kx[4];
#pragma unroll
  for (int ks = 0; ks < 4; ++ks) kx[ks] = ((2 * ks + h) ^ f) << 4;
  const int vrdo = 8192 + ((lane >> 4) & 1) * 32 + (lane & 3) * 8 + (4 * h + ((lane & 15) >> 2)) * 64;
  const lds_cptr lbase = (lds_cptr)smem;
  const int ksrc = (tid >> 3) * 64 + (((tid & 7) ^ (((tid >> 3) >> 1) & 7)) << 3);
  const int vsrc = ((tid >> 2) & 63) * 64 + (((tid >> 8) * 4 + (tid & 3)) << 3);
  const int dma = tid * 16;
  auto issue = [&](int t, int st) __attribute__((always_inline)) {
    const int tc = t < j1 ? t : j1;
    glds16(Kg + (size_t)tc * 4096 + ksrc, smem + st * 16384 + dma);
    glds16(Vg + (size_t)tc * 4096 + vsrc, smem + st * 16384 + 8192 + dma);
  };
  auto qk_tile = [&](int st, f32x16& d0, f32x16& d1) __attribute__((always_inline)) {
    const char* kb_ = smem + st * 16384;
    bf16x8 ka[4], kb[4];
#pragma unroll
    for (int ks = 0; ks < 4; ++ks) { ka[ks] = *(const bf16x8*)(kb_ + krd + kx[ks]); kb[ks] = *(const bf16x8*)(kb_ + krd + 4096 + kx[ks]); }
    d0 = mfma32(ka[0], qf[0], zero16()); d1 = mfma32(kb[0], qf[0], zero16());
#pragma unroll
    for (int ks = 1; ks < 4; ++ks) { d0 = mfma32(ka[ks], qf[ks], d0); d1 = mfma32(kb[ks], qf[ks], d1); }
  };
  auto active = [&](int j) __attribute__((always_inline)) -> bool {
    if (MODE != 2) return true;
    const bool b = ((j < 32 ? (mlo >> j) : (mhi >> (j - 32))) & 1u) != 0;
    return __ballot(b) != 0ull;
  };
  int st_cur = 0, st_iss = 5;
  auto step = [&](int j, bool act_c, bool& act_n, f32x16& c0, f32x16& c1, f32x16& n0, f32x16& n1) __attribute__((always_inline)) {
    asm volatile("s_waitcnt vmcnt(6)" ::: "memory");
    __builtin_amdgcn_s_barrier();
    issue(j + 5, st_iss);
    const int st_nxt = (st_cur == RING - 1) ? 0 : st_cur + 1;
    act_n = false;
    if (j < j1) { act_n = active(j + 1); if (act_n) qk_tile(st_nxt, n0, n1); }
    if (act_c) {
      bool bit = true;
      if (MODE == 2) bit = ((j < 32 ? (mlo >> j) : (mhi >> (j - 32))) & 1u) != 0;
      const bool need_mask = (64 * j < lo_max) || (64 * j + 63 > hi_min);
      if (need_mask) {
        const int rlo = lo - 64 * j - 4 * h, span = hi - lo;
#pragma unroll
        for (int i = 0; i < 16; ++i) {
          const int cc = 8 * (i >> 2) + (i & 3);
          if ((unsigned)(cc - rlo) > (unsigned)span || span < 0) c0[i] = NEGF;
          if ((unsigned)(cc + 32 - rlo) > (unsigned)span || span < 0) c1[i] = NEGF;
        }
      }
      float mx = c0[0];
#pragma unroll
      for (int i = 1; i < 16; ++i) mx = fmaxf(mx, c0[i]);
#pragma unroll
      for (int i = 0; i < 16; ++i) mx = fmaxf(mx, c1[i]);
      mx = fmaxf(mx, __shfl_xor(mx, 32));
      if (MODE == 2) mx = bit ? mx : NEGF;
      const float mn = fmaxf(m, mx);
      const float alpha = __builtin_amdgcn_exp2f(m - mn);
      m = mn;
      l *= alpha;
      if (__ballot(alpha != 1.f) != 0ull) {
#pragma unroll
        for (int i = 0; i < 16; ++i) { O[0][i] *= alpha; O[1][i] *= alpha; }
      }
      const float msub = (MODE == 2 && !bit) ? 1e30f : fmaxf(mn, -1e29f);
      const lds_cptr vb = lbase + st_cur * 16384 + vrdo;
      bf16x8 vf[4][2];
#pragma unroll
      for (int s4 = 0; s4 < 4; ++s4)
#pragma unroll
        for (int dt = 0; dt < 2; ++dt) {
          s16x4 vlo = vtr(vb + dt * 4096 + s4 * 1024);
          s16x4 vhi = vtr(vb + dt * 4096 + s4 * 1024 + 512);
          vf[s4][dt] = __builtin_shufflevector(vlo, vhi, 0, 1, 2, 3, 4, 5, 6, 7);
        }
      float rs = 0.f;
#pragma unroll
      for (int i = 0; i < 16; ++i) {
        const float p0 = __builtin_amdgcn_exp2f(c0[i] - msub), p1 = __builtin_amdgcn_exp2f(c1[i] - msub);
        c0[i] = p0; c1[i] = p1;
        rs += p0 + p1;
      }
      l += rs;
#pragma unroll
      for (int s4 = 0; s4 < 4; ++s4) {
        u32x4 pk;
        if (s4 < 2) {
#pragma unroll
          for (int jj = 0; jj < 4; ++jj) pk[jj] = pack_bf2(c0[8 * (s4 & 1) + 2 * jj], c0[8 * (s4 & 1) + 2 * jj + 1]);
        } else {
#pragma unroll
          for (int jj = 0; jj < 4; ++jj) pk[jj] = pack_bf2(c1[8 * (s4 & 1) + 2 * jj], c1[8 * (s4 & 1) + 2 * jj + 1]);
        }
        const bf16x8 pb = __builtin_bit_cast(bf16x8, pk);
        O[0] = mfma32(vf[s4][0], pb, O[0]);
        O[1] = mfma32(vf[s4][1], pb, O[1]);
      }
    }
    st_cur = st_nxt;
    st_iss = (st_iss == RING - 1) ? 0 : st_iss + 1;
  };
#pragma unroll
  for (int i = 0; i < 5; ++i) issue(j0 + i, i);
  asm volatile("s_waitcnt vmcnt(8)" ::: "memory");
  __builtin_amdgcn_s_barrier();
  f32x16 a0, a1, b0, b1;
  bool actA = true, actB = false;
  qk_tile(0, a0, a1);
  for (int j = j0; j <= j1; j += 2) {
    step(j, actA, actB, a0, a1, b0, b1);
    if (j + 1 <= j1) step(j + 1, actB, actA, b0, b1, a0, a1);
  }
  asm volatile("s_waitcnt vmcnt(0)" ::: "memory");
  __syncthreads();
}

DI void attn_cmp(const u16* __restrict__ Kc, const u16* __restrict__ Vc, int nct, char* smem, const bf16x8 (&qf)[4],
                 f32x16 (&O)[2], int hi, int hi_min, int tok_l, int tid) {
  const int lane = tid & 63, l31 = lane & 31, h = lane >> 5;
  const int f = (l31 >> 1) & 7;
  const int krd = l31 * 128;
  int kx[4];
#pragma unroll
  for (int ks = 0; ks < 4; ++ks) kx[ks] = ((2 * ks + h) ^ f) << 4;
  const int vrdo = 8192 + ((lane >> 4) & 1) * 32 + (lane & 3) * 8 + (4 * h + ((lane & 15) >> 2)) * 64;
  const lds_cptr lbase = (lds_cptr)smem;
  const int ksrc = (tid >> 3) * 64 + (((tid & 7) ^ (((tid >> 3) >> 1) & 7)) << 3);
  const int vsrc = ((tid >> 2) & 63) * 64 + (((tid >> 8) * 4 + (tid & 3)) << 3);
#pragma unroll
  for (int t = 0; t < 4; ++t) {
    const int tc = t < nct ? t : nct - 1;
    glds16(Kc + (size_t)tc * 4096 + ksrc, smem + t * 16384 + tid * 16);
    glds16(Vc + (size_t)tc * 4096 + vsrc, smem + t * 16384 + 8192 + tid * 16);
  }
  asm volatile("s_waitcnt vmcnt(0)" ::: "memory");
  __syncthreads();
  f32x16 S[4][2];
  float mx = NEGF;
#pragma unroll
  for (int t = 0; t < 4; ++t) {
    if (t < nct) {
      const char* kb_ = smem + t * 16384;
      bf16x8 ka[4], kb[4];
#pragma unroll
      for (int ks = 0; ks < 4; ++ks) { ka[ks] = *(const bf16x8*)(kb_ + krd + kx[ks]); kb[ks] = *(const bf16x8*)(kb_ + krd + 4096 + kx[ks]); }
      S[t][0] = mfma32(ka[0], qf[0], zero16()); S[t][1] = mfma32(kb[0], qf[0], zero16());
#pragma unroll
      for (int ks = 1; ks < 4; ++ks) { S[t][0] = mfma32(ka[ks], qf[ks], S[t][0]); S[t][1] = mfma32(kb[ks], qf[ks], S[t][1]); }
      if (64 * t + 63 > hi_min) {
        const int rhi = hi - 64 * t - 4 * h;
#pragma unroll
        for (int i = 0; i < 16; ++i) {
          const int cc = 8 * (i >> 2) + (i & 3);
          if (cc > rhi) S[t][0][i] = NEGF;
          if (cc + 32 > rhi) S[t][1][i] = NEGF;
        }
      }
#pragma unroll
      for (int i = 0; i < 16; ++i) mx = fmaxf(mx, fmaxf(S[t][0][i], S[t][1][i]));
    }
  }
  mx = fmaxf(mx, __shfl_xor(mx, 32));
  const float msub = fmaxf(mx, -1e29f);
  float ls = 0.f;
#pragma unroll
  for (int t = 0; t < 4; ++t)
    if (t < nct) {
#pragma unroll
      for (int i = 0; i < 16; ++i) {
        S[t][0][i] = __builtin_amdgcn_exp2f(S[t][0][i] - msub); S[t][1][i] = __builtin_amdgcn_exp2f(S[t][1][i] - msub);
        ls += S[t][0][i] + S[t][1][i];
      }
    }
  ls += __shfl_xor(ls, 32);
  const float inv_l = 1.f / fmaxf(ls, 1e-30f);
  O[0] = zero16(); O[1] = zero16();
#pragma unroll
  for (int t = 0; t < 4; ++t)
    if (t < nct) {
      f32x16& s0 = S[t][0];
      f32x16& s1 = S[t][1];
#pragma unroll
      for (int i = 0; i < 16; ++i) { s0[i] *= inv_l; s1[i] *= inv_l; }
      float* ps = (float*)(smem + AT_P) + tok_l * 256 + 64 * t + 4 * h;
#pragma unroll
      for (int gq = 0; gq < 4; ++gq) {
        float4 a, b;
        float u;
        u = s0[4 * gq + 0]; u += __shfl_xor(u, 1); u += __shfl_xor(u, 2); a.x = u;
        u = s0[4 * gq + 1]; u += __shfl_xor(u, 1); u += __shfl_xor(u, 2); a.y = u;
        u = s0[4 * gq + 2]; u += __shfl_xor(u, 1); u += __shfl_xor(u, 2); a.z = u;
        u = s0[4 * gq + 3]; u += __shfl_xor(u, 1); u += __shfl_xor(u, 2); a.w = u;
        u = s1[4 * gq + 0]; u += __shfl_xor(u, 1); u += __shfl_xor(u, 2); b.x = u;
        u = s1[4 * gq + 1]; u += __shfl_xor(u, 1); u += __shfl_xor(u, 2); b.y = u;
        u = s1[4 * gq + 2]; u += __shfl_xor(u, 1); u += __shfl_xor(u, 2); b.z = u;
        u = s1[4 * gq + 3]; u += __shfl_xor(u, 1); u += __shfl_xor(u, 2); b.w = u;
        if ((l31 & 3) == 0) { *(float4*)(ps + 8 * gq) = a; *(float4*)(ps + 32 + 8 * gq) = b; }
      }
      const lds_cptr vb = lbase + t * 16384 + vrdo;
#pragma unroll
      for (int s4 = 0; s4 < 4; ++s4) {
        u32x4 pk;
        if (s4 < 2) {
#pragma unroll
          for (int jj = 0; jj < 4; ++jj) pk[jj] = pack_bf2(s0[8 * (s4 & 1) + 2 * jj], s0[8 * (s4 & 1) + 2 * jj + 1]);
        } else {
#pragma unroll
          for (int jj = 0; jj < 4; ++jj) pk[jj] = pack_bf2(s1[8 * (s4 & 1) + 2 * jj], s1[8 * (s4 & 1) + 2 * jj + 1]);
        }
        const bf16x8 pb = __builtin_bit_cast(bf16x8, pk);
#pragma unroll
        for (int dt = 0; dt < 2; ++dt) {
          s16x4 vlo = vtr(vb + dt * 4096 + s4 * 1024);
          s16x4 vhi = vtr(vb + dt * 4096 + s4 * 1024 + 512);
          bf16x8 vf = __builtin_shufflevector(vlo, vhi, 0, 1, 2, 3, 4, 5, 6, 7);
          O[dt] = mfma32(vf, pb, O[dt]);
        }
      }
    }
  __syncthreads();
}

DI void attn_item(const Params& p, int bg, int qt, char* smem) {
  const int tid = opaque_tid(), lane = tid & 63, w = tid >> 6, l31 = lane & 31, h = lane >> 5;
  const int b = bg >> 1, g = bg & 1;
  const int t0 = qt * 64;
  const int tok_l = w * 8 + (l31 >> 2);
  const int tpos = t0 + tok_l;
  const int r = l31 & 3;
  const size_t tglob = (size_t)b * SEQ + tpos;
  bf16x8 qf[4];
  {
    const u16* qp = p.qb + tglob * 512 + (g * 4 + r) * 64 + h * 8;
#pragma unroll
    for (int ks = 0; ks < 4; ++ks) qf[ks] = *(const bf16x8*)(qp + ks * 16);
  }
  const float g0 = p.gate[tglob * 24 + 0 + g * 4 + r];
  const float g1 = p.gate[tglob * 24 + 8 + g * 4 + r];
  const float g2 = p.gate[tglob * 24 + 16 + g * 4 + r];
  const int cur = t0 >> 6;
  f32x16 O[2];
  float m, l;
  unsigned* stash = (unsigned*)(smem + AT_S) + w * 1024 + lane;
  {
    const u16* Kc = p.kcmp + (size_t)bg * 256 * 64;
    const u16* Vc = p.vcmp + (size_t)bg * 256 * 64;
    const int nct = ((t0 + 32) >> 10) + 1;
    const int hi = (tpos - 31) >> 4;
    const int hi_min = (t0 - 31) >> 4;
    attn_cmp(Kc, Vc, nct, smem, qf, O, hi, hi_min, tok_l, tid);
    const float* Ps = (const float*)(smem + AT_P);
    unsigned long long* Ms = (unsigned long long*)(smem + AT_M);
    const int ncv = nct * 64;
    for (int tl = 0; tl < 8; ++tl) {
      const int tokl = w * 8 + tl;
      const int j = lane;
      const float* pr = Ps + tokl * 256;
      float imp = 0.f;
      if (4 * j < ncv) {
        float4 v = *(const float4*)(pr + 4 * j);
        imp = 2.f * (v.x + v.y + v.z) + v.w;
        if (j > 0) imp += pr[4 * j - 1];
      }
      unsigned key = ((__float_as_uint(imp) & ~63u) | (unsigned)(63 - j)) + 64u;
      if (j > cur) key = (unsigned)(63 - j);
      if (j == 0 || j == cur || j == cur - 1) key = 0xFFFFFF00u | (unsigned)(63 - j);
      unsigned* kl = (unsigned*)(smem + w * 256);
      kl[lane] = key;
      int cnt = 0;
#pragma unroll
      for (int k4 = 0; k4 < 16; ++k4) {
        const u32x4 q = *(const u32x4*)(kl + 4 * k4);
        cnt += (q[0] > key) + (q[1] > key) + (q[2] > key) + (q[3] > key);
      }
      unsigned long long bal = __ballot(cnt < 16);
      if (lane == 0) Ms[tokl] = bal;
    }
  }
  __syncthreads();
  unsigned mlo, mhi;
  {
    const unsigned* Mw = (const unsigned*)(smem + AT_M);
    mlo = Mw[tok_l * 2]; mhi = Mw[tok_l * 2 + 1];
  }
#pragma unroll
  for (int i = 0; i < 8; ++i) { stash[i * 64] = pack_bf2(g0 * O[0][2 * i], g0 * O[0][2 * i + 1]); stash[(8 + i) * 64] = pack_bf2(g0 * O[1][2 * i], g0 * O[1][2 * i + 1]); }
  {
    m = NEGF; l = 0.f;
    O[0] = zero16(); O[1] = zero16();
    attn_tiles_ring<2>(p.kvb + (size_t)(2 * 16 + bg) * SEQ * 64, p.kvb + (size_t)(3 * 16 + bg) * SEQ * 64, 0, cur, smem, qf, m, l, O,
                  0, tpos, 0, t0, mlo, mhi, tid);
    const float lt = l + __shfl_xor(l, 32);
    const float sc = g1 / fmaxf(lt, 1e-30f);
#pragma unroll
    for (int i = 0; i < 8; ++i) {
      const unsigned u0 = stash[i * 64], u1 = stash[(8 + i) * 64];
      stash[i * 64] = pack_bf2(bf_lo(u0) + sc * O[0][2 * i], bf_hi(u0) + sc * O[0][2 * i + 1]);
      stash[(8 + i) * 64] = pack_bf2(bf_lo(u1) + sc * O[1][2 * i], bf_hi(u1) + sc * O[1][2 * i + 1]);
    }
  }
  {
    m = NEGF; l = 0.f;
    O[0] = zero16(); O[1] = zero16();
    const int jlo = max(t0 - 511, 0) >> 6;
    attn_tiles_ring<3>(p.kvb + (size_t)(4 * 16 + bg) * SEQ * 64, p.kvb + (size_t)(5 * 16 + bg) * SEQ * 64, jlo, cur, smem, qf, m, l, O,
                  tpos - 511, tpos, t0 + 63 - 511, t0, 0u, 0u, tid);
    const float lt = l + __shfl_xor(l, 32);
    const float sc = g2 / fmaxf(lt, 1e-30f);
#pragma unroll
    for (int i = 0; i < 8; ++i) {
      const unsigned u0 = stash[i * 64], u1 = stash[(8 + i) * 64];
      O[0][2 * i] = bf_lo(u0) + sc * O[0][2 * i]; O[0][2 * i + 1] = bf_hi(u0) + sc * O[0][2 * i + 1];
      O[1][2 * i] = bf_lo(u1) + sc * O[1][2 * i]; O[1][2 * i + 1] = bf_hi(u1) + sc * O[1][2 * i + 1];
    }
  }
  u16* op = p.ob + tglob * 512 + (g * 4 + r) * 64 + 4 * h;
#pragma unroll
  for (int dt = 0; dt < 2; ++dt)
#pragma unroll
    for (int gq = 0; gq < 4; ++gq) {
      u32x2 o = {pack_bf2(O[dt][4 * gq], O[dt][4 * gq + 1]), pack_bf2(O[dt][4 * gq + 2], O[dt][4 * gq + 3])};
      *(u32x2*)(op + dt * 32 + 8 * gq) = o;
    }
}

DI void p10_rows(const Params& p, int item) {
  const int w = threadIdx.x >> 6, lane = threadIdx.x & 63;
  const int row = item * 8 + w;
  float s = (lane < 16) ? p.ssq2[(size_t)row * 16 + lane] : 0.f;
#pragma unroll
  for (int o = 8; o; o >>= 1) s += __shfl_xor(s, o);
  s = __shfl(s, 0);
  const float rs = rsqrtf(s * (1.f / DM) + 1e-6f);
  float4* o4 = (float4*)(p.out + (size_t)row * DM);
  const float4* g4 = (const float4*)p.norm_final;
#pragma unroll
  for (int i = 0; i < 4; ++i) {
    float4 v = o4[lane + 64 * i], g = g4[lane + 64 * i];
    v.x *= rs * g.x; v.y *= rs * g.y; v.z *= rs * g.z; v.w *= rs * g.w;
    o4[lane + 64 * i] = v;
  }
}


#define XB_TMO      128
#define XB_XCNT(j)  (256  + 64 * (j))
#define XB_XSUB(j)  (1280 + 64 * (j))
#define XB_XGEN(j)  (2304 + 64 * (j))
#define XB_TOP      3328
#define XB_TOPGEN   3392
#define XCD_BAR_WORDS 3456
#define XB_SPIN_CAP (1u << 18)
DI unsigned xb_xcc_id() { return (unsigned)__builtin_amdgcn_s_getreg((3 << 11) | 20) & 0xFu; }
#define XB_SPIN(cond, bar) do { unsigned _sp = 0; while (cond) { __builtin_amdgcn_s_sleep(1); \
    if ((++_sp & 255u) == 0u) { if (xb_ld(&(bar)[XB_TMO])) break; if (_sp > XB_SPIN_CAP) { atomicAdd(&(bar)[XB_TMO], 1u); break; } } } } while (0)
struct XcdBarrier { unsigned* bar; unsigned x; volatile LAS unsigned* st; };
DI XcdBarrier xcd_barrier_post(unsigned* bar, volatile LAS unsigned* st) {
  XcdBarrier b; b.bar = bar; b.x = xb_xcc_id(); b.st = st;
  if (threadIdx.x == 0) (void)xb_add(&bar[XB_XCNT(b.x)], 1u);
  return b;
}
DI void xcd_barrier_complete(unsigned* bar, unsigned x, unsigned& nloc, unsigned& nx) {
  const unsigned G = gridDim.x * gridDim.y * gridDim.z;
  unsigned sum, cnt, mine, sp = 0u;
  for (;;) {
    sum = 0u; cnt = 0u; mine = 0u;
#pragma unroll
    for (unsigned j = 0; j < 16; ++j) { const unsigned c = xb_ld(&bar[XB_XCNT(j)]); sum += c; cnt += (c > 0u) ? 1u : 0u; mine = (j == x) ? c : mine; }
    if (sum == G) break;
    __builtin_amdgcn_s_sleep(1);
    if ((++sp & 255u) == 0u) { if (xb_ld(&bar[XB_TMO])) break; if (sp > XB_SPIN_CAP) { atomicAdd(&bar[XB_TMO], 1u); break; } }
  }
  nloc = mine > 0u ? mine : 1u; nx = cnt > 0u ? cnt : 1u;
}
DI void xcd_barrier(const XcdBarrier& b) {
  asm volatile("s_waitcnt vmcnt(0)" ::: "memory");
  __syncthreads();
  if (threadIdx.x == 0) {
    unsigned* bar = b.bar;
    __builtin_amdgcn_s_waitcnt(0);
    unsigned nloc = b.st[0], nx = b.st[1];
    if (nloc == 0u) { xcd_barrier_complete(bar, b.x, nloc, nx); b.st[0] = nloc; b.st[1] = nx; }
    const unsigned old = xb_add(&bar[XB_XSUB(b.x)], 1u);
    const unsigned gen = old / nloc;
    if (old + 1u == (gen + 1u) * nloc) {
      __builtin_amdgcn_fence(__ATOMIC_RELEASE, "agent");
      asm volatile("s_waitcnt vmcnt(0)" ::: "memory");
      const unsigned og = xb_add(&bar[XB_TOP], 1u);
      const unsigned tg = og / nx;
      if (og + 1u == (tg + 1u) * nx) xb_add(&bar[XB_TOPGEN], 1u);
      else XB_SPIN(xb_ld(&bar[XB_TOPGEN]) == tg, bar);
      __builtin_amdgcn_fence(__ATOMIC_ACQUIRE, "agent");
      xb_add(&bar[XB_XGEN(b.x)], 1u);
      asm volatile("s_waitcnt vmcnt(0)" ::: "memory");
    } else {
      XB_SPIN(xb_ld(&bar[XB_XGEN(b.x)]) == gen, bar);
      __builtin_amdgcn_fence(__ATOMIC_ACQUIRE, "agent");
      asm volatile("s_waitcnt vmcnt(0)" ::: "memory");
    }
  }
  __syncthreads();
}

__global__ void __launch_bounds__(NTHR, 2) nsa_pool_block_fwd(Params p) {
  extern __shared__ __attribute__((aligned(16))) unsigned char shm[];
  char* smem = (char*)shm;
  LAS unsigned char* lds = (LAS unsigned char*)shm;
  cg::grid_group grid = cg::this_grid();
  const int G = gridDim.x;
  const int bid = blockIdx.x;
  const int L = (G % 8 == 0) ? (bid % 8) * (G / 8) + bid / 8 : bid;
  volatile LAS unsigned* xst = (volatile LAS unsigned*)(lds + 133120);
  if (threadIdx.x < 4) xst[threadIdx.x] = 0u;
  __syncthreads();
  const XcdBarrier xb = xcd_barrier_post(p.bar, xst);

  if (PH_MASK & 1)
  {
    constexpr int N0 = 1024, N1 = N0 + TJ_EARLY / 2, N2 = N1 + 64, N3 = N2 + 16, N4 = N3 + 64;
    for (int rep = 0; rep < ((REP_MASK & 1) ? 2 : 1); ++rep)
    for (int it = N4 - 1 - bid; it >= 0; it -= G) {
      if (it < N0) p0_rows(p, it);
      else if (it < N1) p0_transpose(p, it - N0, smem, 0);
      else if (it < N2) p0_weff(p, it - N1, smem);
      else if (it < N3) p0_cbias(p, it - N2, smem);
      else p0_rope(p, it - N3);
    }
  }
  if (p.bar == nullptr) grid.sync();
  xcd_barrier(xb);
  if (PH_MASK & 2) {
    Sched S{0, G, bid};
    EpiProj E{p};
    for (int rep = 0; rep < ((REP_MASK & 2) ? 2 : 1); ++rep)
    gemm_phase(lds, Gemm{p.xb, p.w_in_t, DM, DM, DM, 128, 128}, S, E);
  }
  xcd_barrier(xb);
  if (PH_MASK & 4) for (int rep = 0; rep < ((REP_MASK & 4) ? 2 : 1); ++rep)
  {
    Sched S{2, G, bid};
    EpiCmpHid E{(float*)p.mb};
    gemm_phase(lds, Gemm{p.kvb, p.cw1_t, 1024, 2048, 512, 128, 128}, S, E);
    for (int it = bid; it < 4096; it += G) p2a_pool_item(p, it);
  }
  xcd_barrier(xb);
  if (PH_MASK & 8) {
    Sched S{3, G, bid};
    EpiCmpOut E{p};
    for (int i = 0;; ++i) {
      Unit u;
      if (!S.next(i, u)) break;
      const float* h32 = (const float*)p.mb;
      const float* bias = p.cbias + u.pn * 256;
      for (int e0 = threadIdx.x; e0 < 8192; e0 += 4 * NTHR) {
        f32x4 pv[4][4][2];
#pragma unroll
        for (int q = 0; q < 4; ++q) {
          const int e = e0 + q * NTHR, c = e >> 5, n8 = (e & 31) * 8;
#pragma unroll
          for (int ks = 0; ks < 4; ++ks) {
            const f32x4* sp = (const f32x4*)(h32 + ((size_t)((ks * 32 + u.pm) * 256 + c)) * 256 + n8);
            pv[q][ks][0] = sp[0]; pv[q][ks][1] = sp[1];
          }
        }
#pragma unroll
        for (int q = 0; q < 4; ++q) {
          const int e = e0 + q * NTHR, c = e >> 5, n8 = (e & 31) * 8;
          f32x4 v0 = *(const f32x4*)(bias + n8), v1 = *(const f32x4*)(bias + n8 + 4);
#pragma unroll
          for (int ks = 0; ks < 4; ++ks) { v0 += pv[q][ks][0]; v1 += pv[q][ks][1]; }
#pragma unroll
          for (int j = 0; j < 4; ++j) { v0[j] = gelu_tanh(v0[j]); v1[j] = gelu_tanh(v1[j]); }
          *(u32x4*)(p.hid + ((size_t)u.pm * 256 + c) * 256 + n8) = pack8(v0, v1);
        }
      }
    }
    asm volatile("s_waitcnt vmcnt(0)" ::: "memory");
    __syncthreads();
    gemm_phase(lds, Gemm{p.hid, p.cw2_t, 256, 256, 256, 128, 128}, S, E);
    { Unit u0; const bool has_unit = S.next(0, u0);
      if (G >= 256) {
        if (!has_unit) {
          const int rank = bid - (bid >> 3) - (((bid & 7) > ((bid >> 3) & 7)) ? 1 : 0);
          for (int it = rank; it < (TJ_TOTAL - TJ_EARLY) / 2; it += G - 32) p0_transpose(p, it, smem, TJ_EARLY);
        }
      } else {
        __syncthreads();
        for (int it = bid; it < (TJ_TOTAL - TJ_EARLY) / 2; it += G) p0_transpose(p, it, smem, TJ_EARLY);
      }
    }
  }
  xcd_barrier(xb);
  if (ATTN_PRIO) { if (threadIdx.x >= 256) __builtin_amdgcn_s_setprio(2); }
  if (PH_MASK & 16) for (int rep = 0; rep < ((REP_MASK & 16) ? 2 : 1); ++rep)
  if (G == 256) {
    const int x = bid & 7, j = bid >> 3;
    for (int rd = 0; rd < 4; ++rd) {
      const int idx = rd * 32 + ((rd & 1) ? (31 - j) : j);
      attn_item(p, 2 * x + (idx & 1), 63 - (idx >> 1), smem);
    }
  } else
  for (int rd = 0; rd * G < 1024; ++rd) {
    const int i = rd * G + ((rd & 1) ? (G - 1 - L) : L);
    if (i < 1024) attn_item(p, i & 15, 63 - (i >> 4), smem);
  }
  xcd_barrier(xb);
  if (ATTN_PRIO) __builtin_amdgcn_s_setprio(0);
  if (PH_MASK & 32) {
    Sched S{1, G, bid};
    EpiMerge<0> E0{p};
    EpiMerge<1> E1{p};
    for (int rep = 0; rep < ((REP_MASK & 32) ? 2 : 1); ++rep) {
    gemm_phase(lds, Gemm{p.ob, p.wa_t, 512, 512, 512, 128, 128}, S, E0);
    gemm_phase(lds, Gemm{p.pooled, p.wbe_t, 512, 512, 512, 128, 128}, S, E1);
    }
  }
  xcd_barrier(xb);
  if (PH_MASK & 64) {
    Sched S{1, G, bid};
    EpiResidBf E{p.xb, p.ssq};
    for (int rep = 0; rep < ((REP_MASK & 64) ? 2 : 1); ++rep)
    gemm_phase(lds, Gemm{p.mb, p.wo_t, DM, DM, DM, 128, 128}, S, E);
  }
  xcd_barrier(xb);
  if (PH_MASK & 128) {
    Sched S{0, G, bid};
    EpiFF1 E{p};
    for (int rep = 0; rep < ((REP_MASK & 128) ? 2 : 1); ++rep)
    gemm_phase(lds, Gemm{p.xb, p.w1_t, DM, DM, DM, 128, 128}, S, E);
  }
  xcd_barrier(xb);
#if FUSE_FINAL
  if (PH_MASK & 256) {
    Sched S{1, G, bid};
    EpiFinal E{p.out, p.xb, p.norm_final, p.ssq2, p.bar + XCD_BAR_WORDS};
    gemm_phase(lds, Gemm{p.act, p.w2_t, 64, 64, 4096, (size_t)T_TOK * 128, (size_t)1024 * 128}, S, E);
  }
#else
  if (PH_MASK & 256) {
    Sched S{1, G, bid};
    EpiResid<false> E{p.out, p.out, nullptr, p.ssq2};
    gemm_phase(lds, Gemm{p.act, p.w2_t, 64, 64, 4096, (size_t)T_TOK * 128, (size_t)1024 * 128}, S, E);
  }
  xcd_barrier(xb);
  for (int it = bid; it < 4096; it += G) p10_rows(p, it);
#endif
}

extern "C" void kernel_launch(void* const* d_in, const int* in_sizes, int n_in, void* d_out, int out_size, void* d_ws,
                              size_t ws_size, hipStream_t stream) {
  (void)in_sizes; (void)n_in; (void)out_size; (void)ws_size;
  static int grid_blocks = 0;
  if (!grid_blocks) {
    int dev = 0, cus = 0, per_cu = 0;
    (void)hipGetDevice(&dev);
    (void)hipDeviceGetAttribute(&cus, hipDeviceAttributeMultiprocessorCount, dev);
    (void)hipFuncSetAttribute((const void*)nsa_pool_block_fwd, hipFuncAttributeMaxDynamicSharedMemorySize, LDS_BYTES);
    (void)hipOccupancyMaxActiveBlocksPerMultiprocessor(&per_cu, nsa_pool_block_fwd, NTHR, LDS_BYTES);
    if (per_cu > 1) per_cu = 1;
    if (per_cu < 1) per_cu = 1;
    grid_blocks = cus * per_cu;
  }
  Params p{};
  const float* const* in = (const float* const*)d_in;
  p.x = in[0]; p.norm_mix = in[1]; p.w_in = in[2]; p.pe_k = in[3]; p.pe_v = in[4]; p.ck_w1 = in[5]; p.ck_w2 = in[6];
  p.cv_w1 = in[7]; p.cv_w2 = in[8]; p.w_ba = in[9]; p.pool_w = in[10]; p.pool_scale = in[11]; p.w_bp = in[12];
  p.w_out = in[13]; p.norm_mlp = in[14]; p.w_ff1 = in[15]; p.w_ff2 = in[16]; p.norm_final = in[17];
  p.out = (float*)d_out;
  char* ws = (char*)d_ws;
  size_t off = 0;
  auto take = [&](size_t bytes) { char* r = ws + off; off += (bytes + 255) & ~(size_t)255; return r; };
  const size_t T = T_TOK;
  p.xb = (u16*)take(T * 1024 * 2);
  p.w_in_t = (u16*)take((size_t)NPROJ * 1024 * 2);
  p.wa_t = (u16*)take(1024 * 512 * 2);
  p.wbe_t = (u16*)take(1024 * 512 * 2);
  p.wo_t = (u16*)take(1024 * 1024 * 2);
  p.w1_t = (u16*)take((size_t)4096 * 1024 * 2);
  p.w2_t = (u16*)take((size_t)4096 * 1024 * 2);
  p.cw1_t = (u16*)take(2 * 256 * 2048 * 2);
  p.cw2_t = (u16*)take(2 * 256 * 256 * 2);
  p.rstd0 = (float*)take(T * 4);
  p.cbias = (float*)take(512 * 4);
  p.rope = (float2*)take((size_t)SEQ * 8 * 8);
  p.ssq = (float*)take(T * 16 * 4);
  p.ssq2 = (float*)take(T * 16 * 4);
  p.mb = (u16*)take(T * 1024 * 2);
  char* regionD = ws + off;
  p.qb = (u16*)take(T * 512 * 2);
  p.kvb = (u16*)take((size_t)6 * 16 * SEQ * 64 * 2);
  p.gate = (float*)take(T * 24 * 4);
  p.ub = (u16*)take(T * 512 * 2);
  p.gm = (u16*)take(T * 2048 * 2);
  p.hid = (u16*)take((size_t)2 * 16 * 256 * 256 * 2);
  p.kcmp = (u16*)take(16 * 256 * 64 * 2);
  p.vcmp = (u16*)take(16 * 256 * 64 * 2);
  p.pooled = (u16*)take(T * 512 * 2);
  p.ob = (u16*)take(T * 512 * 2);
  p.bar = (unsigned*)take((XCD_BAR_WORDS + 4096) * 4);
  p.act = (u16*)regionD;
  (void)hipMemsetAsync(p.bar, 0, (XCD_BAR_WORDS + 4096) * 4, stream);
  void* args[] = {&p};
  hipError_t e = hipLaunchCooperativeKernel((void*)nsa_pool_block_fwd, dim3(grid_blocks), dim3(NTHR), args, LDS_BYTES, stream);
  if (e != hipSuccess) fprintf(stderr, "cooperative launch failed: %s (grid %d)\n", hipGetErrorString(e), grid_blocks);
}
```

```cpp
#include <hip/hip_runtime.h>
#include <hip/hip_cooperative_groups.h>
#include <stdint.h>
#include <stdio.h>
namespace cg = cooperative_groups;

#define DI __device__ __forceinline__
#define LAS __attribute__((address_space(3)))
typedef unsigned short u16;
typedef __attribute__((ext_vector_type(8))) short bf16x8;
typedef __attribute__((ext_vector_type(4))) short s16x4;
typedef __attribute__((ext_vector_type(16))) float f32x16;
typedef __attribute__((ext_vector_type(4))) float f32x4;
typedef __attribute__((ext_vector_type(4))) unsigned u32x4;
typedef __attribute__((ext_vector_type(2))) unsigned u32x2;
typedef __attribute__((ext_vector_type(2))) float f32x2;
typedef __attribute__((ext_vector_type(2))) __bf16 bf16x2_t;
typedef LAS const char* lds_cptr;

constexpr int T_TOK = 32768, SEQ = 4096, DM = 1024;
constexpr int NPROJ = 4096;
constexpr int NTHR = 512;
constexpr int LDS_BYTES = 135168;
constexpr float NEGF = -1e30f;
constexpr float QSCALE = 0.125f * 1.4426950408889634f;
#ifndef REP_MASK
#define REP_MASK 0
#endif
#ifndef ATTN_PRIO
#define ATTN_PRIO 0
#endif
#ifndef FUSE_FINAL
#define FUSE_FINAL 1
#endif
#ifndef PH_MASK
#define PH_MASK 0xffff
#endif

struct Params {
  const float *x, *norm_mix, *w_in, *pe_k, *pe_v, *ck_w1, *ck_w2, *cv_w1, *cv_w2, *w_ba, *pool_w, *pool_scale, *w_bp,
      *w_out, *norm_mlp, *w_ff1, *w_ff2, *norm_final;
  float* out;
  u16 *xb, *w_in_t, *wa_t, *wbe_t, *wo_t, *w1_t, *w2_t, *cw1_t, *cw2_t;
  float *rstd0, *cbias;
  float2* rope;
  u16 *qb, *kvb;
  float* gate;
  u16 *ub, *gm, *hid, *kcmp, *vcmp, *pooled, *ob, *mb, *act;
  float *ssq, *ssq2;
  unsigned* bar;
};

DI unsigned pack_bf2(float a, float b) {
  f32x2 v = {a, b};
  bf16x2_t r = __builtin_convertvector(v, bf16x2_t);
  return __builtin_bit_cast(unsigned, r);
}
DI float bf_lo(unsigned u) { return __uint_as_float(u << 16); }
DI float bf_hi(unsigned u) { return __uint_as_float(u & 0xffff0000u); }
DI float sigmoidf_(float v) { return __builtin_amdgcn_rcpf(1.f + __builtin_amdgcn_exp2f(-1.4426950408889634f * v)); }
DI float gelu_tanh(float x) {
  float u = 0.7978845608028654f * (x + 0.044715f * x * x * x);
  float th = 1.f - 2.f / (__expf(2.f * u) + 1.f);
  return 0.5f * x * (1.f + th);
}
DI f32x16 mfma32(bf16x8 a, bf16x8 b, f32x16 c) { return __builtin_amdgcn_mfma_f32_32x32x16_bf16(a, b, c, 0, 0, 0); }
DI int opaque_tid() { int t; asm volatile("v_mov_b32 %0, %1" : "=v"(t) : "v"((int)threadIdx.x)); return t; }
DI f32x16 zero16() { f32x16 z; for (int i = 0; i < 16; ++i) z[i] = 0.f; return z; }
DI s16x4 vtr(lds_cptr p) { return __builtin_amdgcn_ds_read_tr16_b64_v4i16((LAS s16x4*)p); }
DI u32x4 pack8(const f32x4& a, const f32x4& b) {
  u32x4 w = {pack_bf2(a[0], a[1]), pack_bf2(a[2], a[3]), pack_bf2(b[0], b[1]), pack_bf2(b[2], b[3])};
  return w;
}

constexpr int BM = 256, BK = 64, HALF = 128, HTB = HALF * BK * 2;
DI int lds_byte(int r, int c) { const int st = (r >> 4) * 2 + (c >> 5), rr = r & 15, cc = c & 31, ob = rr * 64 + cc * 2; return st * 1024 + (ob ^ (((ob >> 9) & 1) << 5)); }
DI void stage_rc(int b, int& R, int& C) { const int st = b / 1024, sb = b % 1024, swz = sb ^ (((sb >> 9) & 1) << 5); R = (st >> 1) * 16 + swz / 64; C = (st & 1) * 32 + (swz % 64) / 2; }
DI int perm32(int rho) { const int n = rho >> 4, i = rho & 15; return 8 * (i >> 2) + 4 * n + (i & 3); }

struct Unit { int pm, pn, k0; };
struct Gemm { const u16* A; const u16* Bt; int lda, ldb, K; size_t kstepA, kstepB; };

struct Sched {
  int mode, G, bid;
  DI bool next(int i, Unit& u) const {
    u.k0 = 0;
    if (mode == 2) {
      int t;
      if (G >= 256) { if (i > 0 || (bid & 1) != ((bid >> 3) & 1) || (bid >> 1) >= 128) return false; t = bid >> 1; }
      else { t = i * G + bid; if (t >= 128) return false; }
      u.pm = t >> 2; u.pn = u.pm >> 4; u.k0 = (t & 3) * 8; return true;
    }
    if (mode == 3) {
      int t;
      if (G >= 256) { t = bid >> 3; if (i > 0 || (bid & 7) != (t & 7) || t >= 32) return false; }
      else { t = i * G + bid; if (t >= 32) return false; }
      u.pm = t; u.pn = t >> 4; return true;
    }
    const int nN = mode == 0 ? 16 : 4;
    if (G == 256) {
      const int x = bid & 7, j = bid >> 3;
      if (mode == 0) { if (i >= 8) return false; u.pn = (x & 3) * 4 + (j & 3); u.pm = (x >> 2) * 64 + i * 8 + (j >> 2); return true; }
      if (i >= 2) return false; u.pn = j & 3; u.pm = x * 16 + i * 8 + (j >> 2); return true;
    }
    const int t = i * G + bid;
    if (t >= nN * 128) return false;
    u.pn = t % nN; u.pm = t / nN; return true;
  }
};

template <class Epi>
DI void gemm_phase(LAS unsigned char* lds, const Gemm g, const Sched& S, const Epi& E) {
  const int tid = opaque_tid(), wid = __builtin_amdgcn_readfirstlane(tid >> 6), lane = tid & 63, wr = wid >> 2, wc = wid & 3, fr = lane & 15, fq = lane >> 4;
  const int nt = g.K / BK;
  unsigned voffA[2], voffB[2];
#pragma unroll
  for (int i = 0; i < 2; ++i) {
    int R, C; stage_rc(tid * 16 + i * 8192, R, C);
    const int Rb = (R & ~31) + perm32(R & 31);
    voffA[i] = (unsigned)(R * g.lda + C) * 2u; voffB[i] = (unsigned)(Rb * g.ldb + C) * 2u;
  }
  const size_t kstep = g.kstepB, kstepA = g.kstepA;
  const size_t hstepA = (size_t)HALF * g.lda * 2, hstepB = (size_t)HALF * g.ldb * 2;
  const size_t tstepA = 2 * hstepA, tstepB = 2 * hstepB;
  const unsigned ldsw = (unsigned)wid * 1024u;
  const int aoff = lds_byte(wr * 64 + fr, fq * 8), boff = lds_byte(wc * 32 + fr, fq * 8);
#define PG8_SA(b, h) (((b) * 2 + (h)) * HTB)
#define PG8_SB(b, h) ((4 + (b) * 2 + (h)) * HTB)
#define PG8_STAGE(bufoff, gbase, voff) do { _Pragma("unroll") for (int _i = 0; _i < 2; ++_i) \
    __builtin_amdgcn_global_load_lds((const unsigned*)((const char*)(gbase) + (voff)[_i]), (LAS unsigned*)(lds + (bufoff) + ldsw + _i * 8192), 16, 0, 0); } while (0)
#define PG8_LDA(dst, b, h) do { _Pragma("unroll") for (int m = 0; m < 4; ++m) _Pragma("unroll") for (int k = 0; k < 2; ++k) dst[m][k] = *(const LAS bf16x8*)(lds + PG8_SA(b, h) + aoff + m * 2048 + k * 1024); } while (0)
#define PG8_LDB(dst, b, h) do { _Pragma("unroll") for (int n = 0; n < 2; ++n) _Pragma("unroll") for (int k = 0; k < 2; ++k) dst[n][k] = *(const LAS bf16x8*)(lds + PG8_SB(b, h) + boff + n * 2048 + k * 1024); } while (0)
#define PG8_MMA(ai, bj, At, Bt) do { __builtin_amdgcn_s_setprio(1); _Pragma("unroll") for (int m = 0; m < 4; ++m) _Pragma("unroll") for (int n = 0; n < 2; ++n) _Pragma("unroll") for (int k = 0; k < 2; ++k) \
    acc[ai][bj][m][n] = __builtin_amdgcn_mfma_f32_16x16x32_bf16(Bt[n][k], At[m][k], acc[ai][bj][m][n], 0, 0, 0); __builtin_amdgcn_s_setprio(0); } while (0)
#define PG8_WAIT_V(n) asm volatile("s_waitcnt vmcnt(" #n ")" ::: "memory")
#define PG8_WAIT_L(n) asm volatile("s_waitcnt lgkmcnt(" #n ")" ::: "memory")
#define PG8_BAR __builtin_amdgcn_s_barrier()
#define PG8_SCHED __builtin_amdgcn_sched_barrier(0)
  Unit cur, nxt; int ui = 0;
  if (!S.next(0, cur)) return;
  f32x4 acc[2][2][4][2];
#pragma unroll
  for (int a = 0; a < 2; ++a)
#pragma unroll
    for (int b = 0; b < 2; ++b)
#pragma unroll
      for (int m = 0; m < 4; ++m)
#pragma unroll
        for (int n = 0; n < 2; ++n) acc[a][b][m][n] = (f32x4){0.f, 0.f, 0.f, 0.f};
  bf16x8 At[4][2], B0[2][2], B1[2][2];
  const char* cA = (const char*)g.A + (size_t)cur.pm * tstepA + (size_t)cur.k0 * kstepA; const char* cB = (const char*)g.Bt + (size_t)cur.pn * tstepB + (size_t)cur.k0 * kstep;
  PG8_STAGE(PG8_SB(0, 0), cB, voffB); PG8_STAGE(PG8_SA(0, 0), cA, voffA); PG8_STAGE(PG8_SB(0, 1), cB + hstepB, voffB); PG8_STAGE(PG8_SA(0, 1), cA + hstepA, voffA);
  if (wr == 1) PG8_BAR;
  PG8_WAIT_V(4); PG8_BAR;
  PG8_STAGE(PG8_SB(1, 0), cB + kstep, voffB); PG8_STAGE(PG8_SA(1, 0), cA + kstepA, voffA); PG8_STAGE(PG8_SB(1, 1), cB + hstepB + kstep, voffB);
  PG8_WAIT_V(6); PG8_BAR;
  for (;;) {
    const bool has_next = S.next(ui + 1, nxt);
    const char* nA = has_next ? (const char*)g.A + (size_t)nxt.pm * tstepA + (size_t)nxt.k0 * kstepA : cA; const char* nB = has_next ? (const char*)g.Bt + (size_t)nxt.pn * tstepB + (size_t)nxt.k0 * kstep : cB;
    for (int t = 0; t < nt; t += 2) {
      const bool last = (t == nt - 2);
      const char* a1 = cA + (size_t)(t + 1) * kstepA;
      const char* a2 = last ? nA : cA + (size_t)(t + 2) * kstepA; const char* b2 = last ? nB : cB + (size_t)(t + 2) * kstep;
      const char* a3 = a2 + kstepA; const char* b3 = b2 + kstep;
      PG8_LDB(B0, 0, 0); PG8_SCHED; PG8_LDA(At, 0, 0); PG8_STAGE(PG8_SA(1, 1), a1 + hstepA, voffA);
      PG8_WAIT_L(8); PG8_BAR; PG8_WAIT_L(0); PG8_MMA(0, 0, At, B0); PG8_BAR; PG8_SCHED;
      PG8_LDB(B1, 0, 1); PG8_STAGE(PG8_SB(0, 0), b2, voffB);
      PG8_BAR; PG8_WAIT_L(0); PG8_MMA(0, 1, At, B1); PG8_BAR;
      PG8_LDA(At, 0, 1); PG8_STAGE(PG8_SA(0, 0), a2, voffA);
      PG8_BAR; PG8_WAIT_L(0); PG8_MMA(1, 0, At, B0); PG8_BAR; PG8_SCHED;
      PG8_STAGE(PG8_SB(0, 1), b2 + hstepB, voffB);
      PG8_WAIT_V(6); PG8_BAR; PG8_MMA(1, 1, At, B1); PG8_BAR;
      PG8_LDB(B0, 1, 0); PG8_SCHED; PG8_LDA(At, 1, 0); PG8_STAGE(PG8_SA(0, 1), a2 + hstepA, voffA);
      PG8_WAIT_L(8); PG8_BAR; PG8_WAIT_L(0); PG8_MMA(0, 0, At, B0); PG8_BAR; PG8_SCHED;
      PG8_LDB(B1, 1, 1); PG8_STAGE(PG8_SB(1, 0), b3, voffB);
      PG8_BAR; PG8_WAIT_L(0); PG8_MMA(0, 1, At, B1); PG8_BAR;
      PG8_LDA(At, 1, 1); PG8_STAGE(PG8_SA(1, 0), a3, voffA);
      PG8_BAR; PG8_WAIT_L(0); PG8_MMA(1, 0, At, B0); PG8_BAR; PG8_SCHED;
      PG8_STAGE(PG8_SB(1, 1), b3 + hstepB, voffB);
      PG8_WAIT_V(6); PG8_BAR; PG8_MMA(1, 1, At, B1); PG8_BAR;
    }
    E(acc, cur, wr, wc, fr, fq);
    if (!has_next) break;
#pragma unroll
    for (int a = 0; a < 2; ++a)
#pragma unroll
      for (int b = 0; b < 2; ++b)
#pragma unroll
        for (int m = 0; m < 4; ++m)
#pragma unroll
          for (int n = 0; n < 2; ++n) acc[a][b][m][n] = (f32x4){0.f, 0.f, 0.f, 0.f};
    cur = nxt; cA = nA; cB = nB; ++ui;
  }
  PG8_WAIT_V(0);
  if (wr == 0) PG8_BAR;
  PG8_BAR;
#undef PG8_SA
#undef PG8_SB
#undef PG8_STAGE
#undef PG8_LDA
#undef PG8_LDB
#undef PG8_MMA
#undef PG8_WAIT_V
#undef PG8_WAIT_L
#undef PG8_BAR
#undef PG8_SCHED
}

typedef f32x4 (&AccRef)[2][2][4][2];
DI unsigned xb_ld(unsigned* p)              { return __hip_atomic_load(p, __ATOMIC_RELAXED, __HIP_MEMORY_SCOPE_AGENT); }
DI unsigned xb_add(unsigned* p, unsigned v) { return __hip_atomic_fetch_add(p, v, __ATOMIC_RELAXED, __HIP_MEMORY_SCOPE_AGENT); }
#define EPI_ROWS for (int ai = 0; ai < 2; ++ai) _Pragma("unroll") for (int m = 0; m < 4; ++m)
#define EPI_ROW(u) ((u).pm * BM + ai * HALF + wr * 64 + m * 16 + fr)
#define EPI_COL(bj) ((bj) * HALF + wc * 32 + fq * 8)

DI void rope8(f32x4& v0, f32x4& v1, const float2* __restrict__ tab, int pos, int fq) {
  const f32x4* t4 = (const f32x4*)(tab + (size_t)pos * 8);
  const f32x4 c0 = t4[0], c1 = t4[1], c2 = t4[2], c3 = t4[3];
  float pv[8];
#pragma unroll
  for (int j = 0; j < 4; ++j) { pv[j] = __shfl_xor(v0[j], 16); pv[4 + j] = __shfl_xor(v1[j], 16); }
  if (fq < 2) {
    const float sg = fq ? 1.f : -1.f;
    v0[0] = v0[0] * c0[0] + sg * pv[0] * c0[1]; v0[1] = v0[1] * c0[2] + sg * pv[1] * c0[3];
    v0[2] = v0[2] * c1[0] + sg * pv[2] * c1[1]; v0[3] = v0[3] * c1[2] + sg * pv[3] * c1[3];
    v1[0] = v1[0] * c2[0] + sg * pv[4] * c2[1]; v1[1] = v1[1] * c2[2] + sg * pv[5] * c2[3];
    v1[2] = v1[2] * c3[0] + sg * pv[6] * c3[1]; v1[3] = v1[3] * c3[2] + sg * pv[7] * c3[3];
  }
}

DI void rope8t(f32x4& v0, f32x4& v1, const f32x4 (&t)[4], int fq) {
  float pv[8];
#pragma unroll
  for (int j = 0; j < 4; ++j) { pv[j] = __shfl_xor(v0[j], 16); pv[4 + j] = __shfl_xor(v1[j], 16); }
  if (fq < 2) {
    const float sg = fq ? 1.f : -1.f;
    v0[0] = v0[0] * t[0][0] + sg * pv[0] * t[0][1]; v0[1] = v0[1] * t[0][2] + sg * pv[1] * t[0][3];
    v0[2] = v0[2] * t[1][0] + sg * pv[2] * t[1][1]; v0[3] = v0[3] * t[1][2] + sg * pv[3] * t[1][3];
    v1[0] = v1[0] * t[2][0] + sg * pv[4] * t[2][1]; v1[1] = v1[1] * t[2][2] + sg * pv[5] * t[2][3];
    v1[2] = v1[2] * t[3][0] + sg * pv[6] * t[3][1]; v1[3] = v1[3] * t[3][2] + sg * pv[7] * t[3][3];
  }
}

struct EpiProj {
  const Params& p;
  DI void operator()(AccRef acc, const Unit& u, int wr, int wc, int fr, int fq) const {
    const int pn = u.pn;
    const bool roped = ((wc & 1) == 0) && (pn < 2 || pn == 3 || pn == 4);
    float rs8[8];
#pragma unroll
    EPI_ROWS rs8[ai * 4 + m] = p.rstd0[EPI_ROW(u)];
#pragma unroll
    for (int ai = 0; ai < 2; ++ai)
#pragma unroll
    for (int mh = 0; mh < 2; ++mh) {
      f32x4 tabx[2][4];
      if (roped) {
#pragma unroll
        for (int mm = 0; mm < 2; ++mm) {
          const int m = mh * 2 + mm;
          const f32x4* t4 = (const f32x4*)(p.rope + (size_t)(EPI_ROW(u) & (SEQ - 1)) * 8);
          tabx[mm][0] = t4[0]; tabx[mm][1] = t4[1]; tabx[mm][2] = t4[2]; tabx[mm][3] = t4[3];
        }
      }
#pragma unroll
      for (int mm = 0; mm < 2; ++mm) {
        const int m = mh * 2 + mm;
        const f32x4 (&tabm)[4] = tabx[mm];
        const int row = EPI_ROW(u);
        const float rs = rs8[ai * 4 + m];
        const int s = row & (SEQ - 1), b = row >> 12;
#pragma unroll
        for (int bj = 0; bj < 2; ++bj) {
          f32x4 v0 = acc[ai][bj][m][0] * rs, v1 = acc[ai][bj][m][1] * rs;
          const int lc = EPI_COL(bj);
          if (pn < 2) {
            if (roped) rope8t(v0, v1, tabm, fq);
            *(u32x4*)(p.qb + (size_t)row * 512 + pn * 256 + lc) = pack8(v0 * QSCALE, v1 * QSCALE);
          } else if (pn < 5) {
            const int which = (pn - 2) * 2 + bj;
            if ((which == 2 || which == 4) && roped) rope8t(v0, v1, tabm, fq);
            const int g = wc >> 1, d = (wc & 1) * 32 + fq * 8;
            *(u32x4*)(p.kvb + ((size_t)((which * 16 + b * 2 + g) * SEQ + s)) * 64 + d) = pack8(v0, v1);
          } else if (pn < 7) {
            *(u32x4*)(p.ub + (size_t)row * 512 + (pn - 5) * 256 + lc) = pack8(v0, v1);
          } else if (pn < 15) {
#pragma unroll
            for (int j = 0; j < 4; ++j) { v0[j] = sigmoidf_(v0[j]); v1[j] = sigmoidf_(v1[j]); }
            *(u32x4*)(p.gm + (size_t)row * 2048 + (pn - 7) * 256 + lc) = pack8(v0, v1);
          } else {
            if (bj == 0 && wc == 0 && fq < 3) {
#pragma unroll
              for (int j = 0; j < 4; ++j) { v0[j] = sigmoidf_(v0[j]); v1[j] = sigmoidf_(v1[j]); }
              f32x4* gp = (f32x4*)(p.gate + (size_t)row * 24 + fq * 8);
              gp[0] = v0; gp[1] = v1;
            }
          }
        }
      }
    }
  }
};

struct EpiCmpHid {
  float* hid32;
  DI void operator()(AccRef acc, const Unit& u, int wr, int wc, int fr, int fq) const {
    float* base = hid32 + ((size_t)((u.k0 >> 3) * 32 + u.pm) * 256) * 256;
#pragma unroll
    EPI_ROWS {
      const int c = ai * HALF + wr * 64 + m * 16 + fr;
#pragma unroll
      for (int bj = 0; bj < 2; ++bj) {
        f32x4* dp = (f32x4*)(base + (size_t)c * 256 + EPI_COL(bj));
        dp[0] = acc[ai][bj][m][0]; dp[1] = acc[ai][bj][m][1];
      }
    }
  }
};

struct EpiCmpOut {
  const Params& p;
  DI void operator()(AccRef acc, const Unit& u, int wr, int wc, int fr, int fq) const {
    const int kv = u.pm >> 4, bg = u.pm & 15;
    const bool roped = (kv == 0) && (wc == 0);
    u16* dst = (kv ? p.vcmp : p.kcmp) + (size_t)bg * 256 * 64;
#pragma unroll
    for (int ai = 0; ai < 2; ++ai) {
      f32x4 tabx[4][4];
      {
#pragma unroll
        for (int m = 0; m < 4; ++m) {
          const int c = ai * HALF + wr * 64 + m * 16 + fr;
          const f32x4* t4 = (const f32x4*)(p.rope + (size_t)min(16 * c + 31, SEQ - 1) * 8);
          tabx[m][0] = t4[0]; tabx[m][1] = t4[1]; tabx[m][2] = t4[2]; tabx[m][3] = t4[3];
        }
      }
#pragma unroll
      for (int m = 0; m < 4; ++m) {
        const int c = ai * HALF + wr * 64 + m * 16 + fr;
        f32x4 v0 = acc[ai][0][m][0], v1 = acc[ai][0][m][1];
        if (roped) rope8t(v0, v1, tabx[m], fq);
        if (c == 255) { v0 = (f32x4){0.f, 0.f, 0.f, 0.f}; v1 = v0; }
        if (wc < 2) *(u32x4*)(dst + c * 64 + wc * 32 + fq * 8) = pack8(v0, v1);
      }
    }
  }
};

template <int PASS>
struct EpiMerge {
  const Params& p;
  DI void operator()(AccRef acc, const Unit& u, int wr, int wc, int fr, int fq) const {
#pragma unroll
    for (int ai = 0; ai < 2; ++ai) {
      u32x4 gq[4][2], ov[4][2];
#pragma unroll
      for (int m = 0; m < 4; ++m)
#pragma unroll
        for (int bj = 0; bj < 2; ++bj) {
          const int row = EPI_ROW(u), col = u.pn * BM + EPI_COL(bj);
          gq[m][bj] = *(const u32x4*)(p.gm + (size_t)row * 2048 + PASS * 1024 + col);
          if (PASS == 1) ov[m][bj] = *(const u32x4*)(p.mb + (size_t)row * 1024 + col);
        }
#pragma unroll
      for (int m = 0; m < 4; ++m) {
        const int row = EPI_ROW(u);
#pragma unroll
        for (int bj = 0; bj < 2; ++bj) {
          const int col = u.pn * BM + EPI_COL(bj);
          const u32x4 g = gq[m][bj];
          f32x4 v0 = acc[ai][bj][m][0], v1 = acc[ai][bj][m][1];
          v0[0] *= bf_lo(g[0]); v0[1] *= bf_hi(g[0]); v0[2] *= bf_lo(g[1]); v0[3] *= bf_hi(g[1]);
          v1[0] *= bf_lo(g[2]); v1[1] *= bf_hi(g[2]); v1[2] *= bf_lo(g[3]); v1[3] *= bf_hi(g[3]);
          if (PASS == 1) {
            const u32x4 o = ov[m][bj];
            v0[0] += bf_lo(o[0]); v0[1] += bf_hi(o[0]); v0[2] += bf_lo(o[1]); v0[3] += bf_hi(o[1]);
            v1[0] += bf_lo(o[2]); v1[1] += bf_hi(o[2]); v1[2] += bf_lo(o[3]); v1[3] += bf_hi(o[3]);
          }
          *(u32x4*)(p.mb + (size_t)row * 1024 + col) = pack8(v0, v1);
        }
      }
    }
  }
};

template <bool WITH_BF16, bool WITH_F32 = true>
struct EpiResid {
  const float* resid; float* out; u16* outb; float* ssq;
  DI void operator()(AccRef acc, const Unit& u, int wr, int wc, int fr, int fq) const {
#pragma unroll
    for (int ai = 0; ai < 2; ++ai) {
      f32x4 rv[4][2][2];
#pragma unroll
      for (int m = 0; m < 4; ++m)
#pragma unroll
        for (int bj = 0; bj < 2; ++bj) {
          const f32x4* rp = (const f32x4*)(resid + (size_t)EPI_ROW(u) * 1024 + u.pn * BM + EPI_COL(bj));
          rv[m][bj][0] = rp[0]; rv[m][bj][1] = rp[1];
        }
#pragma unroll
      for (int m = 0; m < 4; ++m) {
        const int row = EPI_ROW(u);
        float sq = 0.f;
#pragma unroll
        for (int bj = 0; bj < 2; ++bj) {
          const size_t a = (size_t)row * 1024 + u.pn * BM + EPI_COL(bj);
          const f32x4 v0 = rv[m][bj][0] + acc[ai][bj][m][0], v1 = rv[m][bj][1] + acc[ai][bj][m][1];
          if (WITH_F32) { f32x4* op = (f32x4*)(out + a); op[0] = v0; op[1] = v1; }
          if (WITH_BF16) *(u32x4*)(outb + a) = pack8(v0, v1);
#pragma unroll
          for (int j = 0; j < 4; ++j) sq += v0[j] * v0[j] + v1[j] * v1[j];
        }
        sq += __shfl_xor(sq, 16);
        sq += __shfl_xor(sq, 32);
        if (fq == 0) ssq[(size_t)row * 16 + u.pn * 4 + wc] = sq;
      }
    }
  }
};

struct EpiResidBf {
  u16* xb; float* ssq;
  DI void operator()(AccRef acc, const Unit& u, int wr, int wc, int fr, int fq) const {
#pragma unroll
    for (int ai = 0; ai < 2; ++ai) {
      u32x4 rv[4][2];
#pragma unroll
      for (int m = 0; m < 4; ++m)
#pragma unroll
        for (int bj = 0; bj < 2; ++bj) rv[m][bj] = *(const u32x4*)(xb + (size_t)EPI_ROW(u) * 1024 + u.pn * BM + EPI_COL(bj));
#pragma unroll
      for (int m = 0; m < 4; ++m) {
        const int row = EPI_ROW(u);
        float sq = 0.f;
#pragma unroll
        for (int bj = 0; bj < 2; ++bj) {
          const u32x4 r8 = rv[m][bj];
          f32x4 v0 = acc[ai][bj][m][0], v1 = acc[ai][bj][m][1];
          v0[0] += bf_lo(r8[0]); v0[1] += bf_hi(r8[0]); v0[2] += bf_lo(r8[1]); v0[3] += bf_hi(r8[1]);
          v1[0] += bf_lo(r8[2]); v1[1] += bf_hi(r8[2]); v1[2] += bf_lo(r8[3]); v1[3] += bf_hi(r8[3]);
          *(u32x4*)(xb + (size_t)row * 1024 + u.pn * BM + EPI_COL(bj)) = pack8(v0, v1);
#pragma unroll
          for (int j = 0; j < 4; ++j) sq += v0[j] * v0[j] + v1[j] * v1[j];
        }
        sq += __shfl_xor(sq, 16);
        sq += __shfl_xor(sq, 32);
        if (fq == 0) ssq[(size_t)row * 16 + u.pn * 4 + wc] = sq;
      }
    }
  }
};

struct EpiFinal {
  float* out; const u16* x1b; const float* gfin; float* ssq2; unsigned* cnt;
  DI void operator()(AccRef acc, const Unit& u, int wr, int wc, int fr, int fq) const {
#pragma unroll
    for (int ai = 0; ai < 2; ++ai) {
      u32x4 r8[4][2];
#pragma unroll
      for (int m = 0; m < 4; ++m)
#pragma unroll
        for (int bj = 0; bj < 2; ++bj) r8[m][bj] = *(const u32x4*)(x1b + (size_t)EPI_ROW(u) * 1024 + u.pn * BM + EPI_COL(bj));
#pragma unroll
      for (int m = 0; m < 4; ++m) {
        const int row = EPI_ROW(u);
        float sq = 0.f;
#pragma unroll
        for (int bj = 0; bj < 2; ++bj) {
          const u32x4 r = r8[m][bj];
          acc[ai][bj][m][0] += (f32x4){bf_lo(r[0]), bf_hi(r[0]), bf_lo(r[1]), bf_hi(r[1])};
          acc[ai][bj][m][1] += (f32x4){bf_lo(r[2]), bf_hi(r[2]), bf_lo(r[3]), bf_hi(r[3])};
#pragma unroll
          for (int j = 0; j < 4; ++j) sq += acc[ai][bj][m][0][j] * acc[ai][bj][m][0][j] + acc[ai][bj][m][1][j] * acc[ai][bj][m][1][j];
        }
        sq += __shfl_xor(sq, 16);
        sq += __shfl_xor(sq, 32);
        if (fq == 0) __hip_atomic_store(ssq2 + (size_t)row * 16 + u.pn * 4 + wc, sq, __ATOMIC_RELAXED, __HIP_MEMORY_SCOPE_AGENT);
      }
    }
    asm volatile("s_waitcnt vmcnt(0)" ::: "memory");
    unsigned* c = cnt + (u.pm * 2 + wr) * 16;
    if (fq == 0 && fr == 0) (void)xb_add(c, 1u);
    { unsigned sp = 0; while (xb_ld(c) < 16u) { __builtin_amdgcn_s_sleep(1); if (++sp > (1u << 20)) break; } }
    unsigned long long q0[8], q1[8];
#pragma unroll
    EPI_ROWS {
      unsigned long long* sp = (unsigned long long*)(ssq2 + (size_t)EPI_ROW(u) * 16 + fq * 4);
      q0[ai * 4 + m] = __hip_atomic_load(sp, __ATOMIC_RELAXED, __HIP_MEMORY_SCOPE_AGENT);
      q1[ai * 4 + m] = __hip_atomic_load(sp + 1, __ATOMIC_RELAXED, __HIP_MEMORY_SCOPE_AGENT);
    }
    f32x4 gv[2][2];
#pragma unroll
    for (int bj = 0; bj < 2; ++bj) { const f32x4* gp = (const f32x4*)(gfin + u.pn * BM + EPI_COL(bj)); gv[bj][0] = gp[0]; gv[bj][1] = gp[1]; }
#pragma unroll
    EPI_ROWS {
      const int row = EPI_ROW(u);
      const unsigned long long a0 = q0[ai * 4 + m], a1 = q1[ai * 4 + m];
      float ss = (__uint_as_float((unsigned)a0) + __uint_as_float((unsigned)(a0 >> 32))) + (__uint_as_float((unsigned)a1) + __uint_as_float((unsigned)(a1 >> 32)));
      ss += __shfl_xor(ss, 16);
      ss += __shfl_xor(ss, 32);
      const float rs = rsqrtf(ss * (1.f / DM) + 1e-6f);
#pragma unroll
      for (int bj = 0; bj < 2; ++bj) {
        f32x4* op = (f32x4*)(out + (size_t)row * 1024 + u.pn * BM + EPI_COL(bj));
        __builtin_nontemporal_store(acc[ai][bj][m][0] * rs * gv[bj][0], op);
        __builtin_nontemporal_store(acc[ai][bj][m][1] * rs * gv[bj][1], op + 1);
      }
    }
  }
};

struct EpiFF1 {
  const Params& p;
  DI void operator()(AccRef acc, const Unit& u, int wr, int wc, int fr, int fq) const {
    f32x4 part[8];
#pragma unroll
    EPI_ROWS part[ai * 4 + m] = *(const f32x4*)(p.ssq + (size_t)EPI_ROW(u) * 16 + fq * 4);
    float rs8[8];
#pragma unroll
    for (int r = 0; r < 8; ++r) {
      float ss = (part[r][0] + part[r][1]) + (part[r][2] + part[r][3]);
      ss += __shfl_xor(ss, 16);
      ss += __shfl_xor(ss, 32);
      rs8[r] = rsqrtf(ss * (1.f / DM) + 1e-6f);
    }
#pragma unroll
    EPI_ROWS {
      const int row = EPI_ROW(u);
      const float rs = rs8[ai * 4 + m];
#pragma unroll
      for (int bj = 0; bj < 2; ++bj) {
        f32x4 v0 = acc[ai][bj][m][0] * rs, v1 = acc[ai][bj][m][1] * rs;
#pragma unroll
        for (int j = 0; j < 4; ++j) { const float r0 = fmaxf(v0[j], 0.f), r1 = fmaxf(v1[j], 0.f); v0[j] = r0 * r0; v1[j] = r1 * r1; }
        const int col = u.pn * BM + EPI_COL(bj);
        *(u32x4*)(p.act + ((size_t)(col >> 6) * T_TOK + row) * 64 + (col & 63)) = pack8(v0, v1);
      }
    }
  }
};

DI void p0_rows(const Params& p, int item) {
  const int w = threadIdx.x >> 6, lane = threadIdx.x & 63;
  const int row0 = item * 32 + w * 4;
  f32x4 v[4][4];
#pragma unroll
  for (int r = 0; r < 4; ++r) {
    const f32x4* src = (const f32x4*)(p.x + (size_t)(row0 + r) * DM);
#pragma unroll
    for (int i = 0; i < 4; ++i) v[r][i] = __builtin_nontemporal_load(src + lane + 64 * i);
  }
#pragma unroll
  for (int r = 0; r < 4; ++r) {
    float ss = 0.f;
#pragma unroll
    for (int i = 0; i < 4; ++i) ss += v[r][i][0] * v[r][i][0] + v[r][i][1] * v[r][i][1] + v[r][i][2] * v[r][i][2] + v[r][i][3] * v[r][i][3];
#pragma unroll
    for (int o = 32; o; o >>= 1) ss += __shfl_xor(ss, o);
    if (lane == 0) p.rstd0[row0 + r] = rsqrtf(ss * (1.f / DM) + 1e-6f);
    u32x2* dst = (u32x2*)(p.xb + (size_t)(row0 + r) * DM);
#pragma unroll
    for (int i = 0; i < 4; ++i) {
      u32x2 o = {pack_bf2(v[r][i][0], v[r][i][1]), pack_bf2(v[r][i][2], v[r][i][3])};
      dst[lane + 64 * i] = o;
    }
  }
}

constexpr int TJ_WIN = 1024, TJ_WA = 128, TJ_WO = 256, TJ_W1 = 1024, TJ_W2 = 1024, TJ_C1 = 128, TJ_C2 = 16;
constexpr int TJ_TOTAL = TJ_WIN + TJ_WA + TJ_WO + TJ_W1 + TJ_W2 + 2 * TJ_C1 + 2 * TJ_C2;

constexpr int TJ_EARLY = TJ_WIN + 2 * TJ_C1 + 2 * TJ_C2;
DI void p0_transpose(const Params& p, int item, char* smem, int base) {
  const int half = threadIdx.x >> 8, tid = threadIdx.x & 255;
  int idx = item * 2 + half + base;
  const float* src; u16* dst; const float* scale = nullptr; int K, N, kind = 0;
  if (idx < TJ_WIN) { src = p.w_in; dst = p.w_in_t; scale = p.norm_mix; K = 1024; N = 3864; kind = 1; }
  else if ((idx -= TJ_WIN) < TJ_C1) { src = p.ck_w1; dst = p.cw1_t; K = 2048; N = 256; }
  else if ((idx -= TJ_C1) < TJ_C1) { src = p.cv_w1; dst = p.cw1_t + 256 * 2048; K = 2048; N = 256; }
  else if ((idx -= TJ_C1) < TJ_C2) { src = p.ck_w2; dst = p.cw2_t; K = 256; N = 64; }
  else if ((idx -= TJ_C2) < TJ_C2) { src = p.cv_w2; dst = p.cw2_t + 256 * 256; K = 256; N = 64; }
  else if ((idx -= TJ_C2) < TJ_WA) { src = p.w_ba; dst = p.wa_t; K = 512; N = 1024; }
  else if ((idx -= TJ_WA) < TJ_WO) { src = p.w_out; dst = p.wo_t; K = 1024; N = 1024; }
  else if ((idx -= TJ_WO) < TJ_W1) { src = p.w_ff1; dst = p.w1_t; scale = p.norm_mlp; K = 1024; N = 4096; }
  else { idx -= TJ_W1; src = p.w_ff2; dst = p.w2_t; K = 4096; N = 1024; kind = 2; }
  const int nk = K >> 6;
  const int k0 = (idx % nk) * 64, n0 = (idx / nk) * 64;
  float* tile = (float*)(smem + half * 16640);
  __syncthreads();
#pragma unroll
  for (int i = 0; i < 4; ++i) {
    const int kk = (tid >> 4) + 16 * i, nn = (tid & 15) * 4;
    const int nd = n0 + nn;
    int sc;
    if (kind == 1) sc = nd < 1280 ? nd : (nd < 3840 ? nd + 24 : (nd < 3864 ? nd - 2560 : -1));
    else sc = nd < N ? nd : -1;
    float4 v = make_float4(0.f, 0.f, 0.f, 0.f);
    if (sc >= 0) v = *(const float4*)(src + (size_t)(k0 + kk) * N + sc);
    if (scale) { float s = scale[k0 + kk]; v.x *= s; v.y *= s; v.z *= s; v.w *= s; }
    tile[kk * 65 + nn + 0] = v.x; tile[kk * 65 + nn + 1] = v.y; tile[kk * 65 + nn + 2] = v.z; tile[kk * 65 + nn + 3] = v.w;
  }
  __syncthreads();
  {
    const int n = tid >> 2, kq = (tid & 3) * 16;
    unsigned o[8];
#pragma unroll
    for (int j = 0; j < 8; ++j) o[j] = pack_bf2(tile[(kq + 2 * j) * 65 + n], tile[(kq + 2 * j + 1) * 65 + n]);
    u32x4* d = (kind == 2) ? (u32x4*)(dst + ((size_t)(k0 >> 6) * 1024 + (n0 + n)) * 64 + kq)
                           : (u32x4*)(dst + (size_t)(n0 + n) * K + k0 + kq);
    u32x4 o0 = {o[0], o[1], o[2], o[3]}, o1 = {o[4], o[5], o[6], o[7]};
    d[0] = o0; d[1] = o1;
  }
}

DI void p0_weff(const Params& p, int item, char* smem) {
  const int g = item >> 4, n0 = (item & 15) * 64, tid = threadIdx.x;
  float* pw = (float*)smem;
  float* ws = (float*)(smem + 66048);
  __syncthreads();
  for (int e = tid; e < 128 * 128; e += NTHR) { const int c = e >> 7, d = e & 127; pw[c * 129 + d] = p.pool_w[(size_t)g * 16384 + e] * p.pool_scale[g * 128 + d]; }
  for (int e = tid; e < 128 * 64; e += NTHR) { const int d = e >> 6, n = e & 63; ws[e] = p.w_bp[(size_t)(g * 128 + d) * 1024 + n0 + n]; }
  __syncthreads();
  const int c = tid & 127, nq = (tid >> 7) * 16;
  float a[16];
#pragma unroll
  for (int j = 0; j < 16; ++j) a[j] = 0.f;
  for (int d = 0; d < 128; ++d) {
    const float w = pw[c * 129 + d];
#pragma unroll
    for (int j = 0; j < 16; ++j) a[j] += w * ws[d * 64 + nq + j];
  }
#pragma unroll
  for (int j = 0; j < 16; ++j) p.wbe_t[(size_t)(n0 + nq + j) * 512 + g * 128 + c] = (u16)(pack_bf2(a[j], 0.f) & 0xffffu);
}

DI void p0_cbias(const Params& p, int idx, char* smem) {
  const int kv = idx >> 3, nc = idx & 7, tid = threadIdx.x, n = tid & 31, part = tid >> 5;
  const float* pe = kv ? p.pe_v : p.pe_k;
  const float* w1 = kv ? p.cv_w1 : p.ck_w1;
  float s = 0.f;
  for (int k = part * 128; k < part * 128 + 128; ++k) s += pe[k] * w1[(size_t)k * 256 + nc * 32 + n];
  float* red = (float*)smem;
  __syncthreads();
  red[part * 32 + n] = s;
  __syncthreads();
  if (tid < 32) {
    float t = 0.f;
#pragma unroll
    for (int j = 0; j < 16; ++j) t += red[j * 32 + tid];
    p.cbias[kv * 256 + nc * 32 + tid] = t;
  }
}

DI void p0_rope(const Params& p, int idx) {
  const int e = idx * NTHR + threadIdx.x;
  const int pos = e >> 3, i = e & 7;
  const float inv = powf(500000.0f, -(float)(2 * i) / 16.0f);
  const float ang = (float)pos * inv;
  float sn, cs;
  sincosf(ang, &sn, &cs);
  p.rope[e] = make_float2(cs, sn);
}

DI void p2a_pool_item(const Params& p, int item) {
  const int idx = item * NTHR + threadIdx.x;
  const int t = idx >> 6, ch = (idx & 63) * 8;
  const int grp = ch >> 7, wlen = 2 << grp, s = t & (SEQ - 1);
  const int cnt = min(s + 1, wlen);
  float a[8];
#pragma unroll
  for (int j = 0; j < 8; ++j) a[j] = 0.f;
  const u16* base = p.ub + (size_t)t * 512 + ch;
  u32x4 v[16];
#pragma unroll
  for (int k = 0; k < 16; ++k) { v[k] = (u32x4){0u, 0u, 0u, 0u}; if (k < cnt) v[k] = *(const u32x4*)(base - (size_t)k * 512); }
  const u32x4 cur = v[0];
#pragma unroll
  for (int k = 0; k < 16; ++k) {
#pragma unroll
    for (int j = 0; j < 4; ++j) { a[2 * j] += bf_lo(v[k][j]); a[2 * j + 1] += bf_hi(v[k][j]); }
  }
  const float ic = 1.f / (float)cnt;
  u32x4 o;
#pragma unroll
  for (int j = 0; j < 4; ++j) o[j] = pack_bf2(a[2 * j] * ic - bf_lo(cur[j]), a[2 * j + 1] * ic - bf_hi(cur[j]));
  *(u32x4*)(p.pooled + (size_t)t * 512 + ch) = o;
}

constexpr int AT_P = 65536, AT_S = 98304, AT_M = 131072;
template <int MODE>
DI void attn_tiles(const u16* __restrict__ Kg, const u16* __restrict__ Vg, int j0, int j1, char* smem,
                   const bf16x8 (&qf)[4], float& m, float& l, f32x16 (&O)[2], int lo, int hi, int lo_max, int hi_min,
                   unsigned mlo, unsigned mhi, float inv_l, int tok_l, int tid) {
  const int lane = tid & 63, l31 = lane & 31, h = lane >> 5;
  const int lk = tid >> 3, lc = tid & 7;
  const int kwr = lk * 128 + ((lc ^ ((lk >> 1) & 7)) << 4);
  const int vwr = 16384 + (lc >> 2) * 4096 + lk * 64 + (lc & 3) * 16;
  const int f = (l31 >> 1) & 7;
  const int krd = l31 * 128;
  int kx[4];
#pragma unroll
  for (int ks = 0; ks < 4; ++ks) kx[ks] = ((2 * ks + h) ^ f) << 4;
  const lds_cptr vrd = (lds_cptr)smem + 16384 + ((lane >> 4) & 1) * 32 + (lane & 3) * 8 + (4 * h + ((lane & 15) >> 2)) * 64;
  const int goff = lk * 64 + lc * 8;
  u32x4 rk, rv;
  rk = *(const u32x4*)(Kg + (size_t)j0 * 4096 + goff);
  if (MODE != 0) rv = *(const u32x4*)(Vg + (size_t)j0 * 4096 + goff);
  for (int j = j0; j <= j1; ++j) {
    const int bo = ((j - j0) & 1) * 8192;
    *(u32x4*)(smem + bo + kwr) = rk;
    if (MODE != 0) *(u32x4*)(smem + bo + vwr) = rv;
    __syncthreads();
    if (j < j1) {
      rk = *(const u32x4*)(Kg + (size_t)(j + 1) * 4096 + goff);
      if (MODE != 0) rv = *(const u32x4*)(Vg + (size_t)(j + 1) * 4096 + goff);
    }
    bool bit = true;
    if (MODE == 2) {
      bit = ((j < 32 ? (mlo >> j) : (mhi >> (j - 32))) & 1u) != 0;
      if (__ballot(bit) == 0ull) continue;
    }
    f32x16 s0 = zero16(), s1 = zero16();
#pragma unroll
    for (int ks = 0; ks < 4; ++ks) {
      bf16x8 a0 = *(const bf16x8*)(smem + bo + krd + kx[ks]);
      bf16x8 a1 = *(const bf16x8*)(smem + bo + krd + 4096 + kx[ks]);
      s0 = mfma32(a0, qf[ks], s0);
      s1 = mfma32(a1, qf[ks], s1);
    }
    const bool need_mask = (64 * j < lo_max) || (64 * j + 63 > hi_min);
    const int rlo = lo - 64 * j - 4 * h, span = hi - lo;
    if (need_mask) {
#pragma unroll
      for (int i = 0; i < 16; ++i) {
        const int c0 = 8 * (i >> 2) + (i & 3);
        if ((unsigned)(c0 - rlo) > (unsigned)span || span < 0) s0[i] = NEGF;
        if ((unsigned)(c0 + 32 - rlo) > (unsigned)span || span < 0) s1[i] = NEGF;
      }
    }
    float msub;
    if (MODE == 1) {
      msub = m;
    } else {
      float mx = s0[0];
#pragma unroll
      for (int i = 1; i < 16; ++i) mx = fmaxf(mx, s0[i]);
#pragma unroll
      for (int i = 0; i < 16; ++i) mx = fmaxf(mx, s1[i]);
      mx = fmaxf(mx, __shfl_xor(mx, 32));
      if (MODE == 2) mx = bit ? mx : NEGF;
      const float mn = fmaxf(m, mx);
      const float alpha = __builtin_amdgcn_exp2f(m - mn);
      m = mn;
      l *= alpha;
      if (MODE != 0) {
        if (__ballot(alpha != 1.f) != 0ull) {
#pragma unroll
          for (int i = 0; i < 16; ++i) { O[0][i] *= alpha; O[1][i] *= alpha; }
        }
      }
      msub = (MODE == 2 && !bit) ? 1e30f : mn;
    }
    msub = fmaxf(msub, -1e29f);
    float rs = 0.f;
#pragma unroll
    for (int i = 0; i < 16; ++i) {
      float p0 = __builtin_amdgcn_exp2f(s0[i] - msub), p1 = __builtin_amdgcn_exp2f(s1[i] - msub);
      if (MODE == 1) { p0 *= inv_l; p1 *= inv_l; }
      s0[i] = p0; s1[i] = p1;
      rs += p0 + p1;
    }
    l += rs;
    if (MODE == 0) continue;
    if (MODE == 1) {
      float* ps = (float*)(smem + AT_P) + tok_l * 256 + 64 * j + 4 * h;
#pragma unroll
      for (int gq = 0; gq < 4; ++gq) {
        float4 a, b;
        float t;
        t = s0[4 * gq + 0]; t += __shfl_xor(t, 1); t += __shfl_xor(t, 2); a.x = t;
        t = s0[4 * gq + 1]; t += __shfl_xor(t, 1); t += __shfl_xor(t, 2); a.y = t;
        t = s0[4 * gq + 2]; t += __shfl_xor(t, 1); t += __shfl_xor(t, 2); a.z = t;
        t = s0[4 * gq + 3]; t += __shfl_xor(t, 1); t += __shfl_xor(t, 2); a.w = t;
        t = s1[4 * gq + 0]; t += __shfl_xor(t, 1); t += __shfl_xor(t, 2); b.x = t;
        t = s1[4 * gq + 1]; t += __shfl_xor(t, 1); t += __shfl_xor(t, 2); b.y = t;
        t = s1[4 * gq + 2]; t += __shfl_xor(t, 1); t += __shfl_xor(t, 2); b.z = t;
        t = s1[4 * gq + 3]; t += __shfl_xor(t, 1); t += __shfl_xor(t, 2); b.w = t;
        if ((l31 & 3) == 0) { *(float4*)(ps + 8 * gq) = a; *(float4*)(ps + 32 + 8 * gq) = b; }
      }
    }
#pragma unroll
    for (int s4 = 0; s4 < 4; ++s4) {
      u32x4 pk;
      if (s4 < 2) {
#pragma unroll
        for (int jj = 0; jj < 4; ++jj) pk[jj] = pack_bf2(s0[8 * (s4 & 1) + 2 * jj], s0[8 * (s4 & 1) + 2 * jj + 1]);
      } else {
#pragma unroll
        for (int jj = 0; jj < 4; ++jj) pk[jj] = pack_bf2(s1[8 * (s4 & 1) + 2 * jj], s1[8 * (s4 & 1) + 2 * jj + 1]);
      }
      const bf16x8 pb = __builtin_bit_cast(bf16x8, pk);
#pragma unroll
      for (int dt = 0; dt < 2; ++dt) {
        s16x4 vlo = vtr(vrd + bo + dt * 4096 + s4 * 1024);
        s16x4 vhi = vtr(vrd + bo + dt * 4096 + s4 * 1024 + 512);
        bf16x8 vf = __builtin_shufflevector(vlo, vhi, 0, 1, 2, 3, 4, 5, 6, 7);
        O[dt] = mfma32(vf, pb, O[dt]);
      }
    }
  }
  __syncthreads();
}

template <int MODE>
DI void attn_tiles_pipe(const u16* __restrict__ Kg, const u16* __restrict__ Vg, int j0, int j1, char* smem,
                        const bf16x8 (&qf)[4], float& m, float& l, f32x16 (&O)[2], int lo, int hi, int lo_max, int hi_min,
                        unsigned mlo, unsigned mhi, int tid) {
  const int lane = tid & 63, l31 = lane & 31, h = lane >> 5;
  const int lk = tid >> 3, lc = tid & 7;
  const int kwr = lk * 128 + ((lc ^ ((lk >> 1) & 7)) << 4);
  const int vwr = 16384 + (lc >> 2) * 4096 + lk * 64 + (lc & 3) * 16;
  const int f = (l31 >> 1) & 7;
  const int krd = l31 * 128;
  int kx[4];
#pragma unroll
  for (int ks = 0; ks < 4; ++ks) kx[ks] = ((2 * ks + h) ^ f) << 4;
  const lds_cptr vrd = (lds_cptr)smem + 16384 + ((lane >> 4) & 1) * 32 + (lane & 3) * 8 + (4 * h + ((lane & 15) >> 2)) * 64;
  const int goff = lk * 64 + lc * 8;
  u32x4 rk, rv;
  auto qk_tile = [&](int bufoff, f32x16& d0, f32x16& d1) __attribute__((always_inline)) {
    bf16x8 ka[4], kb[4];
#pragma unroll
    for (int ks = 0; ks < 4; ++ks) { ka[ks] = *(const bf16x8*)(smem + bufoff + krd + kx[ks]); kb[ks] = *(const bf16x8*)(smem + bufoff + krd + 4096 + kx[ks]); }
    d0 = mfma32(ka[0], qf[0], zero16()); d1 = mfma32(kb[0], qf[0], zero16());
#pragma unroll
    for (int ks = 1; ks < 4; ++ks) { d0 = mfma32(ka[ks], qf[ks], d0); d1 = mfma32(kb[ks], qf[ks], d1); }
  };
  auto active = [&](int j) __attribute__((always_inline)) -> bool {
    if (MODE != 2) return true;
    const bool b = ((j < 32 ? (mlo >> j) : (mhi >> (j - 32))) & 1u) != 0;
    return __ballot(b) != 0ull;
  };
  auto step = [&](int j, bool act_c, bool& act_n, f32x16& c0, f32x16& c1, f32x16& n0, f32x16& n1) __attribute__((always_inline)) {
    const int par = (j - j0) & 1;
    const int bo = par * 8192, bn = (par ^ 1) * 8192;
    if (j < j1) *(u32x4*)(smem + bn + kwr) = rk;
    *(u32x4*)(smem + bo + vwr) = rv;
    __syncthreads();
    if (j + 2 <= j1) rk = *(const u32x4*)(Kg + (size_t)(j + 2) * 4096 + goff);
    if (j + 1 <= j1) rv = *(const u32x4*)(Vg + (size_t)(j + 1) * 4096 + goff);
    act_n = false;
    if (j < j1) { act_n = active(j + 1); if (act_n) qk_tile(bn, n0, n1); }
    if (!act_c) return;
    bool bit = true;
    if (MODE == 2) bit = ((j < 32 ? (mlo >> j) : (mhi >> (j - 32))) & 1u) != 0;
    const bool need_mask = (64 * j < lo_max) || (64 * j + 63 > hi_min);
    if (need_mask) {
      const int rlo = lo - 64 * j - 4 * h, span = hi - lo;
#pragma unroll
      for (int i = 0; i < 16; ++i) {
        const int cc = 8 * (i >> 2) + (i & 3);
        if ((unsigned)(cc - rlo) > (unsigned)span || span < 0) c0[i] = NEGF;
        if ((unsigned)(cc + 32 - rlo) > (unsigned)span || span < 0) c1[i] = NEGF;
      }
    }
    float mx = c0[0];
#pragma unroll
    for (int i = 1; i < 16; ++i) mx = fmaxf(mx, c0[i]);
#pragma unroll
    for (int i = 0; i < 16; ++i) mx = fmaxf(mx, c1[i]);
    mx = fmaxf(mx, __shfl_xor(mx, 32));
    if (MODE == 2) mx = bit ? mx : NEGF;
    const float mn = fmaxf(m, mx);
    const float alpha = __builtin_amdgcn_exp2f(m - mn);
    m = mn;
    l *= alpha;
    if (__ballot(alpha != 1.f) != 0ull) {
#pragma unroll
      for (int i = 0; i < 16; ++i) { O[0][i] *= alpha; O[1][i] *= alpha; }
    }
    const float msub = (MODE == 2 && !bit) ? 1e30f : fmaxf(mn, -1e29f);
    bf16x8 vf[4][2];
#pragma unroll
    for (int s4 = 0; s4 < 4; ++s4)
#pragma unroll
      for (int dt = 0; dt < 2; ++dt) {
        s16x4 vlo = vtr(vrd + bo + dt * 4096 + s4 * 1024);
        s16x4 vhi = vtr(vrd + bo + dt * 4096 + s4 * 1024 + 512);
        vf[s4][dt] = __builtin_shufflevector(vlo, vhi, 0, 1, 2, 3, 4, 5, 6, 7);
      }
    float rs = 0.f;
#pragma unroll
    for (int i = 0; i < 16; ++i) {
      const float p0 = __builtin_amdgcn_exp2f(c0[i] - msub), p1 = __builtin_amdgcn_exp2f(c1[i] - msub);
      c0[i] = p0; c1[i] = p1;
      rs += p0 + p1;
    }
    l += rs;
#pragma unroll
    for (int s4 = 0; s4 < 4; ++s4) {
      u32x4 pk;
      if (s4 < 2) {
#pragma unroll
        for (int jj = 0; jj < 4; ++jj) pk[jj] = pack_bf2(c0[8 * (s4 & 1) + 2 * jj], c0[8 * (s4 & 1) + 2 * jj + 1]);
      } else {
#pragma unroll
        for (int jj = 0; jj < 4; ++jj) pk[jj] = pack_bf2(c1[8 * (s4 & 1) + 2 * jj], c1[8 * (s4 & 1) + 2 * jj + 1]);
      }
      const bf16x8 pb = __builtin_bit_cast(bf16x8, pk);
      O[0] = mfma32(vf[s4][0], pb, O[0]);
      O[1] = mfma32(vf[s4][1], pb, O[1]);
    }
  };
  rk = *(const u32x4*)(Kg + (size_t)j0 * 4096 + goff);
  rv = *(const u32x4*)(Vg + (size_t)j0 * 4096 + goff);
  *(u32x4*)(smem + kwr) = rk;
  if (j0 < j1) rk = *(const u32x4*)(Kg + (size_t)(j0 + 1) * 4096 + goff);
  __syncthreads();
  f32x16 a0, a1, b0, b1;
  bool actA = true, actB = false;
  qk_tile(0, a0, a1);
  for (int j = j0; j <= j1; j += 2) {
    step(j, actA, actB, a0, a1, b0, b1);
    if (j + 1 <= j1) step(j + 1, actB, actA, b0, b1, a0, a1);
  }
  __syncthreads();
}

constexpr int RING = 6;
DI void glds16(const u16* g, char* lds) {
  __builtin_amdgcn_global_load_lds((const unsigned*)g, (LAS unsigned*)lds, 16, 0, 0);
}
template <int MODE>
DI void attn_tiles_ring(const u16* __restrict__ Kg, const u16* __restrict__ Vg, int j0, int j1, char* smem,
                        const bf16x8 (&qf)[4], float& m, float& l, f32x16 (&O)[2], int lo, int hi, int lo_max, int hi_min,
                        unsigned mlo, unsigned mhi, int tid) {
  const int lane = tid & 63, l31 = lane & 31, h = lane >> 5;
  const int f = (l31 >> 1) & 7;
  const int krd = l31 * 128;
  int kx[4];
#pragma unroll
  for (int ks = 0; ks < 4; ++ks) kx[ks] = ((2 * ks + h) ^ f) << 4;
  const int vrdo = 8192 + ((lane >> 4) & 1) * 32 + (lane & 3) * 8 + (4 * h + ((lane & 15) >> 2)) * 64;
  const lds_cptr lbase = (lds_cptr)smem;
  const int ksrc = (tid >> 3) * 64 + (((tid & 7) ^ (((tid >> 3) >> 1) & 7)) << 3);
  const int vsrc = ((tid >> 2) & 63) * 64 + (((tid >> 8) * 4 + (tid & 3)) << 3);
  const int dma = tid * 16;
  auto issue = [&](int t, int st) __attribute__((always_inline)) {
    const int tc = t < j1 ? t : j1;
    glds16(Kg + (size_t)tc * 4096 + ksrc, smem + st * 16384 + dma);
    glds16(Vg + (size_t)tc * 4096 + vsrc, smem + st * 16384 + 8192 + dma);
  };
  auto qk_tile = [&](int st, f32x16& d0, f32x16& d1) __attribute__((always_inline)) {
    const char* kb_ = smem + st * 16384;
    bf16x8 ka[4], kb[4];
#pragma unroll
    for (int ks = 0; ks < 4; ++ks) { ka[ks] = *(const bf16x8*)(kb_ + krd + kx[ks]); kb[ks] = *(const bf16x8*)(kb_ + krd + 4096 + kx[ks]); }
    d0 = mfma32(ka[0], qf[0], zero16()); d1 = mfma32(kb[0], qf[0], zero16());
#pragma unroll
    for (int ks = 1; ks < 4; ++ks) { d0 = mfma32(ka[ks], qf[ks], d0); d1 = mfma32(kb[ks], qf[ks], d1); }
  };
  auto active = [&](int j) __attribute__((always_inline)) -> bool {
    if (MODE != 2) return true;
    const bool b = ((j < 32 ? (mlo >> j) : (mhi >> (j - 32))) & 1u) != 0;
    return __ballot(b) != 0ull;
  };
  int st_cur = 0, st_iss = 5;
  auto step = [&](int j, bool act_c, bool& act_n, f32x16& c0, f32x16& c1, f32x16& n0, f32x16& n1) __attribute__((always_inline)) {
    asm volatile("s_waitcnt vmcnt(6)" ::: "memory");
    __builtin_amdgcn_s_barrier();
    issue(j + 5, st_iss);
    const int st_nxt = (st_cur == RING - 1) ? 0 : st_cur + 1;
    act_n = false;
    if (j < j1) { act_n = active(j + 1); if (act_n) qk_tile(st_nxt, n0, n1); }
    if (act_c) {
      bool bit = true;
      if (MODE == 2) bit = ((j < 32 ? (mlo >> j) : (mhi >> (j - 32))) & 1u) != 0;
      const bool need_mask = (64 * j < lo_max) || (64 * j + 63 > hi_min);
      if (need_mask) {
        const int rlo = lo - 64 * j - 4 * h, span = hi - lo;
#pragma unroll
        for (int i = 0; i < 16; ++i) {
          const int cc = 8 * (i >> 2) + (i & 3);
          if ((unsigned)(cc - rlo) > (unsigned)span || span < 0) c0[i] = NEGF;
          if ((unsigned)(cc + 32 - rlo) > (unsigned)span || span < 0) c1[i] = NEGF;
        }
      }
      float mx = c0[0];
#pragma unroll
      for (int i = 1; i < 16; ++i) mx = fmaxf(mx, c0[i]);
#pragma unroll
      for (int i = 0; i < 16; ++i) mx = fmaxf(mx, c1[i]);
      mx = fmaxf(mx, __shfl_xor(mx, 32));
      if (MODE == 2) mx = bit ? mx : NEGF;
      const float mn = fmaxf(m, mx);
      const float alpha = __builtin_amdgcn_exp2f(m - mn);
      m = mn;
      l *= alpha;
      if (__ballot(alpha != 1.f) != 0ull) {
#pragma unroll
        for (int i = 0; i < 16; ++i) { O[0][i] *= alpha; O[1][i] *= alpha; }
      }
      const float msub = (MODE == 2 && !bit) ? 1e30f : fmaxf(mn, -1e29f);
      const lds_cptr vb = lbase + st_cur * 16384 + vrdo;
      bf16x8 vf[4][2];
#pragma unroll
      for (int s4 = 0; s4 < 4; ++s4)
#pragma unroll
        for (int dt = 0; dt < 2; ++dt) {
          s16x4 vlo = vtr(vb + dt * 4096 + s4 * 1024);
          s16x4 vhi = vtr(vb + dt * 4096 + s4 * 1024 + 512);
          vf[s4][dt] = __builtin_shufflevector(vlo, vhi, 0, 1, 2, 3, 4, 5, 6, 7);
        }
      float rs = 0.f;
#pragma unroll
      for (int i = 0; i < 16; ++i) {
        const float p0 = __builtin_amdgcn_exp2f(c0[i] - msub), p1 = __builtin_amdgcn_exp2f(c1[i] - msub);
        c0[i] = p0; c1[i] = p1;
        rs += p0 + p1;
      }
      l += rs;
#pragma unroll
      for (int s4 = 0; s4 < 4; ++s4) {
        u32x4 pk;
        if (s4 < 2) {
#pragma unroll
          for (int jj = 0; jj < 4; ++jj) pk[jj] = pack_bf2(c0[8 * (s4 & 1) + 2 * jj], c0[8 * (s4 & 1) + 2 * jj + 1]);
        } else {
#pragma unroll
          for (int jj = 0; jj < 4; ++jj) pk[jj] = pack_bf2(c1[8 * (s4 & 1) + 2 * jj], c1[8 * (s4 & 1) + 2 * jj + 1]);
        }
        const bf16x8 pb = __builtin_bit_cast(bf16x8, pk);
        O[0] = mfma32(vf[s4][0], pb, O[0]);
        O[1] = mfma32(vf[s4][1], pb, O[1]);
      }
    }
    st_cur = st_nxt;
    st_iss = (st_iss == RING - 1) ? 0 : st_iss + 1;
  };
#pragma unroll
  for (int i = 0; i < 5; ++i) issue(j0 + i, i);
  asm volatile("s_waitcnt vmcnt(8)" ::: "memory");
  __builtin_amdgcn_s_barrier();
  f32x16 a0, a1, b0, b1;
  bool actA = true, actB = false;
  qk_tile(0, a0, a1);
  for (int j = j0; j <= j1; j += 2) {
    step(j, actA, actB, a0, a1, b0, b1);
    if (j + 1 <= j1) step(j + 1, actB, actA, b0, b1, a0, a1);
  }
  asm volatile("s_waitcnt vmcnt(0)" ::: "memory");
  __syncthreads();
}

DI void attn_cmp(const u16* __restrict__ Kc, const u16* __restrict__ Vc, int nct, char* smem, const bf16x8 (&qf)[4],
                 f32x16 (&O)[2], int hi, int hi_min, int tok_l, int tid) {
  const int lane = tid & 63, l31 = lane & 31, h = lane >> 5;
  const int f = (l31 >> 1) & 7;
  const int krd = l31 * 128;
  int kx[4];
#pragma unroll
  for (int ks = 0; ks < 4; ++ks) kx[ks] = ((2 * ks + h) ^ f) << 4;
  const int vrdo = 8192 + ((lane >> 4) & 1) * 32 + (lane & 3) * 8 + (4 * h + ((lane & 15) >> 2)) * 64;
  const lds_cptr lbase = (lds_cptr)smem;
  const int ksrc = (tid >> 3) * 64 + (((tid & 7) ^ (((tid >> 3) >> 1) & 7)) << 3);
  const int vsrc = ((tid >> 2) & 63) * 64 + (((tid >> 8) * 4 + (tid & 3)) << 3);
#pragma unroll
  for (int t = 0; t < 4; ++t) {
    const int tc = t < nct ? t : nct - 1;
    glds16(Kc + (size_t)tc * 4096 + ksrc, smem + t * 16384 + tid * 16);
    glds16(Vc + (size_t)tc * 4096 + vsrc, smem + t * 16384 + 8192 + tid * 16);
  }
  asm volatile("s_waitcnt vmcnt(0)" ::: "memory");
  __syncthreads();
  f32x16 S[4][2];
  float mx = NEGF;
#pragma unroll
  for (int t = 0; t < 4; ++t) {
    if (t < nct) {
      const char* kb_ = smem + t * 16384;
      bf16x8 ka[4], kb[4];
#pragma unroll
      for (int ks = 0; ks < 4; ++ks) { ka[ks] = *(const bf16x8*)(kb_ + krd + kx[ks]); kb[ks] = *(const bf16x8*)(kb_ + krd + 4096 + kx[ks]); }
      S[t][0] = mfma32(ka[0], qf[0], zero16()); S[t][1] = mfma32(kb[0], qf[0], zero16());
#pragma unroll
      for (int ks = 1; ks < 4; ++ks) { S[t][0] = mfma32(ka[ks], qf[ks], S[t][0]); S[t][1] = mfma32(kb[ks], qf[ks], S[t][1]); }
      if (64 * t + 63 > hi_min) {
        const int rhi = hi - 64 * t - 4 * h;
#pragma unroll
        for (int i = 0; i < 16; ++i) {
          const int cc = 8 * (i >> 2) + (i & 3);
          if (cc > rhi) S[t][0][i] = NEGF;
          if (cc + 32 > rhi) S[t][1][i] = NEGF;
        }
      }
#pragma unroll
      for (int i = 0; i < 16; ++i) mx = fmaxf(mx, fmaxf(S[t][0][i], S[t][1][i]));
    }
  }
  mx = fmaxf(mx, __shfl_xor(mx, 32));
  const float msub = fmaxf(mx, -1e29f);
  float ls = 0.f;
#pragma unroll
  for (int t = 0; t < 4; ++t)
    if (t < nct) {
#pragma unroll
      for (int i = 0; i < 16; ++i) {
        S[t][0][i] = __builtin_amdgcn_exp2f(S[t][0][i] - msub); S[t][1][i] = __builtin_amdgcn_exp2f(S[t][1][i] - msub);
        ls += S[t][0][i] + S[t][1][i];
      }
    }
  ls += __shfl_xor(ls, 32);
  const float inv_l = 1.f / fmaxf(ls, 1e-30f);
  O[0] = zero16(); O[1] = zero16();
#pragma unroll
  for (int t = 0; t < 4; ++t)
    if (t < nct) {
      f32x16& s0 = S[t][0];
      f32x16& s1 = S[t][1];
#pragma unroll
      for (int i = 0; i < 16; ++i) { s0[i] *= inv_l; s1[i] *= inv_l; }
      float* ps = (float*)(smem + AT_P) + tok_l * 256 + 64 * t + 4 * h;
#pragma unroll
      for (int gq = 0; gq < 4; ++gq) {
        float4 a, b;
        float u;
        u = s0[4 * gq + 0]; u += __shfl_xor(u, 1); u += __shfl_xor(u, 2); a.x = u;
        u = s0[4 * gq + 1]; u += __shfl_xor(u, 1); u += __shfl_xor(u, 2); a.y = u;
        u = s0[4 * gq + 2]; u += __shfl_xor(u, 1); u += __shfl_xor(u, 2); a.z = u;
        u = s0[4 * gq + 3]; u += __shfl_xor(u, 1); u += __shfl_xor(u, 2); a.w = u;
        u = s1[4 * gq + 0]; u += __shfl_xor(u, 1); u += __shfl_xor(u, 2); b.x = u;
        u = s1[4 * gq + 1]; u += __shfl_xor(u, 1); u += __shfl_xor(u, 2); b.y = u;
        u = s1[4 * gq + 2]; u += __shfl_xor(u, 1); u += __shfl_xor(u, 2); b.z = u;
        u = s1[4 * gq + 3]; u += __shfl_xor(u, 1); u += __shfl_xor(u, 2); b.w = u;
        if ((l31 & 3) == 0) { *(float4*)(ps + 8 * gq) = a; *(float4*)(ps + 32 + 8 * gq) = b; }
      }
      const lds_cptr vb = lbase + t * 16384 + vrdo;
#pragma unroll
      for (int s4 = 0; s4 < 4; ++s4) {
        u32x4 pk;
        if (s4 < 2) {
#pragma unroll
          for (int jj = 0; jj < 4; ++jj) pk[jj] = pack_bf2(s0[8 * (s4 & 1) + 2 * jj], s0[8 * (s4 & 1) + 2 * jj + 1]);
        } else {
#pragma unroll
          for (int jj = 0; jj < 4; ++jj) pk[jj] = pack_bf2(s1[8 * (s4 & 1) + 2 * jj], s1[8 * (s4 & 1) + 2 * jj + 1]);
        }
        const bf16x8 pb = __builtin_bit_cast(bf16x8, pk);
#pragma unroll
        for (int dt = 0; dt < 2; ++dt) {
          s16x4 vlo = vtr(vb + dt * 4096 + s4 * 1024);
          s16x4 vhi = vtr(vb + dt * 4096 + s4 * 1024 + 512);
          bf16x8 vf = __builtin_shufflevector(vlo, vhi, 0, 1, 2, 3, 4, 5, 6, 7);
          O[dt] = mfma32(vf, pb, O[dt]);
        }
      }
    }
  __syncthreads();
}

DI void attn_item(const Params& p, int bg, int qt, char* smem) {
  const int tid = opaque_tid(), lane = tid & 63, w = tid >> 6, l31 = lane & 31, h = lane >> 5;
  const int b = bg >> 1, g = bg & 1;
  const int t0 = qt * 64;
  const int tok_l = w * 8 + (l31 >> 2);
  const int tpos = t0 + tok_l;
  const int r = l31 & 3;
  const size_t tglob = (size_t)b * SEQ + tpos;
  bf16x8 qf[4];
  {
    const u16* qp = p.qb + tglob * 512 + (g * 4 + r) * 64 + h * 8;
#pragma unroll
    for (int ks = 0; ks < 4; ++ks) qf[ks] = *(const bf16x8*)(qp + ks * 16);
  }
  const float g0 = p.gate[tglob * 24 + 0 + g * 4 + r];
  const float g1 = p.gate[tglob * 24 + 8 + g * 4 + r];
  const float g2 = p.gate[tglob * 24 + 16 + g * 4 + r];
  const int cur = t0 >> 6;
  f32x16 O[2];
  float m, l;
  unsigned* stash = (unsigned*)(smem + AT_S) + w * 1024 + lane;
  {
    const u16* Kc = p.kcmp + (size_t)bg * 256 * 64;
    const u16* Vc = p.vcmp + (size_t)bg * 256 * 64;
    const int nct = ((t0 + 32) >> 10) + 1;
    const int hi = (tpos - 31) >> 4;
    const int hi_min = (t0 - 31) >> 4;
    attn_cmp(Kc, Vc, nct, smem, qf, O, hi, hi_min, tok_l, tid);
    const float* Ps = (const float*)(smem + AT_P);
    unsigned long long* Ms = (unsigned long long*)(smem + AT_M);
    const int ncv = nct * 64;
    for (int tl = 0; tl < 8; ++tl) {
      const int tokl = w * 8 + tl;
      const int j = lane;
      const float* pr = Ps + tokl * 256;
      float imp = 0.f;
      if (4 * j < ncv) {
        float4 v = *(const float4*)(pr + 4 * j);
        imp = 2.f * (v.x + v.y + v.z) + v.w;
        if (j > 0) imp += pr[4 * j - 1];
      }
      unsigned key = ((__float_as_uint(imp) & ~63u) | (unsigned)(63 - j)) + 64u;
      if (j > cur) key = (unsigned)(63 - j);
      if (j == 0 || j == cur || j == cur - 1) key = 0xFFFFFF00u | (unsigned)(63 - j);
      unsigned* kl = (unsigned*)(smem + w * 256);
      kl[lane] = key;
      int cnt = 0;
#pragma unroll
      for (int k4 = 0; k4 < 16; ++k4) {
        const u32x4 q = *(const u32x4*)(kl + 4 * k4);
        cnt += (q[0] > key) + (q[1] > key) + (q[2] > key) + (q[3] > key);
      }
      unsigned long long bal = __ballot(cnt < 16);
      if (lane == 0) Ms[tokl] = bal;
    }
  }
  __syncthreads();
  unsigned mlo, mhi;
  {
    const unsigned* Mw = (const unsigned*)(smem + AT_M);
    mlo = Mw[tok_l * 2]; mhi = Mw[tok_l * 2 + 1];
  }
#pragma unroll
  for (int i = 0; i < 8; ++i) { stash[i * 64] = pack_bf2(g0 * O[0][2 * i], g0 * O[0][2 * i + 1]); stash[(8 + i) * 64] = pack_bf2(g0 * O[1][2 * i], g0 * O[1][2 * i + 1]); }
  {
    m = NEGF; l = 0.f;
    O[0] = zero16(); O[1] = zero16();
    attn_tiles_ring<2>(p.kvb + (size_t)(2 * 16 + bg) * SEQ * 64, p.kvb + (size_t)(3 * 16 + bg) * SEQ * 64, 0, cur, smem, qf, m, l, O,
                  0, tpos, 0, t0, mlo, mhi, tid);
    const float lt = l + __shfl_xor(l, 32);
    const float sc = g1 / fmaxf(lt, 1e-30f);
#pragma unroll
    for (int i = 0; i < 8; ++i) {
      const unsigned u0 = stash[i * 64], u1 = stash[(8 + i) * 64];
      stash[i * 64] = pack_bf2(bf_lo(u0) + sc * O[0][2 * i], bf_hi(u0) + sc * O[0][2 * i + 1]);
      stash[(8 + i) * 64] = pack_bf2(bf_lo(u1) + sc * O[1][2 * i], bf_hi(u1) + sc * O[1][2 * i + 1]);
    }
  }
  {
    m = NEGF; l = 0.f;
    O[0] = zero16(); O[1] = zero16();
    const int jlo = max(t0 - 511, 0) >> 6;
    attn_tiles_ring<3>(p.kvb + (size_t)(4 * 16 + bg) * SEQ * 64, p.kvb + (size_t)(5 * 16 + bg) * SEQ * 64, jlo, cur, smem, qf, m, l, O,
                  tpos - 511, tpos, t0 + 63 - 511, t0, 0u, 0u, tid);
    const float lt = l + __shfl_xor(l, 32);
    const float sc = g2 / fmaxf(lt, 1e-30f);
#pragma unroll
    for (int i = 0; i < 8; ++i) {
      const unsigned u0 = stash[i * 64], u1 = stash[(8 + i) * 64];
      O[0][2 * i] = bf_lo(u0) + sc * O[0][2 * i]; O[0][2 * i + 1] = bf_hi(u0) + sc * O[0][2 * i + 1];
      O[1][2 * i] = bf_lo(u1) + sc * O[1][2 * i]; O[1][2 * i + 1] = bf_hi(u1) + sc * O[1][2 * i + 1];
    }
  }
  u16* op = p.ob + tglob * 512 + (g * 4 + r) * 64 + 4 * h;
#pragma unroll
  for (int dt = 0; dt < 2; ++dt)
#pragma unroll
    for (int gq = 0; gq < 4; ++gq) {
      u32x2 o = {pack_bf2(O[dt][4 * gq], O[dt][4 * gq + 1]), pack_bf2(O[dt][4 * gq + 2], O[dt][4 * gq + 3])};
      *(u32x2*)(op + dt * 32 + 8 * gq) = o;
    }
}

DI void p10_rows(const Params& p, int item) {
  const int w = threadIdx.x >> 6, lane = threadIdx.x & 63;
  const int row = item * 8 + w;
  float s = (lane < 16) ? p.ssq2[(size_t)row * 16 + lane] : 0.f;
#pragma unroll
  for (int o = 8; o; o >>= 1) s += __shfl_xor(s, o);
  s = __shfl(s, 0);
  const float rs = rsqrtf(s * (1.f / DM) + 1e-6f);
  float4* o4 = (float4*)(p.out + (size_t)row * DM);
  const float4* g4 = (const float4*)p.norm_final;
#pragma unroll
  for (int i = 0; i < 4; ++i) {
    float4 v = o4[lane + 64 * i], g = g4[lane + 64 * i];
    v.x *= rs * g.x; v.y *= rs * g.y; v.z *= rs * g.z; v.w *= rs * g.w;
    o4[lane + 64 * i] = v;
  }
}


#define XB_TMO      128
#define XB_XCNT(j)  (256  + 64 * (j))
#define XB_XSUB(j)  (1280 + 64 * (j))
#define XB_XGEN(j)  (2304 + 64 * (j))
#define XB_TOP      3328
#define XB_TOPGEN   3392
#define XCD_BAR_WORDS 3456
#define XB_SPIN_CAP (1u << 18)
DI unsigned xb_xcc_id() { return (unsigned)__builtin_amdgcn_s_getreg((3 << 11) | 20) & 0xFu; }
#define XB_SPIN(cond, bar) do { unsigned _sp = 0; while (cond) { __builtin_amdgcn_s_sleep(1); \
    if ((++_sp & 255u) == 0u) { if (xb_ld(&(bar)[XB_TMO])) break; if (_sp > XB_SPIN_CAP) { atomicAdd(&(bar)[XB_TMO], 1u); break; } } } } while (0)
struct XcdBarrier { unsigned* bar; unsigned x; volatile LAS unsigned* st; };
DI XcdBarrier xcd_barrier_post(unsigned* bar, volatile LAS unsigned* st) {
  XcdBarrier b; b.bar = bar; b.x = xb_xcc_id(); b.st = st;
  if (threadIdx.x == 0) (void)xb_add(&bar[XB_XCNT(b.x)], 1u);
  return b;
}
DI void xcd_barrier_complete(unsigned* bar, unsigned x, unsigned& nloc, unsigned& nx) {
  const unsigned G = gridDim.x * gridDim.y * gridDim.z;
  unsigned sum, cnt, mine, sp = 0u;
  for (;;) {
    sum = 0u; cnt = 0u; mine = 0u;
#pragma unroll
    for (unsigned j = 0; j < 16; ++j) { const unsigned c = xb_ld(&bar[XB_XCNT(j)]); sum += c; cnt += (c > 0u) ? 1u : 0u; mine = (j == x) ? c : mine; }
    if (sum == G) break;
    __builtin_amdgcn_s_sleep(1);
    if ((++sp & 255u) == 0u) { if (xb_ld(&bar[XB_TMO])) break; if (sp > XB_SPIN_CAP) { atomicAdd(&bar[XB_TMO], 1u); break; } }
  }
  nloc = mine > 0u ? mine : 1u; nx = cnt > 0u ? cnt : 1u;
}
DI void xcd_barrier(const XcdBarrier& b) {
  asm volatile("s_waitcnt vmcnt(0)" ::: "memory");
  __syncthreads();
  if (threadIdx.x == 0) {
    unsigned* bar = b.bar;
    __builtin_amdgcn_s_waitcnt(0);
    unsigned nloc = b.st[0], nx = b.st[1];
    if (nloc == 0u) { xcd_barrier_complete(bar, b.x, nloc, nx); b.st[0] = nloc; b.st[1] = nx; }
    const unsigned old = xb_add(&bar[XB_XSUB(b.x)], 1u);
    const unsigned gen = old / nloc;
    if (old + 1u == (gen + 1u) * nloc) {
      __builtin_amdgcn_fence(__ATOMIC_RELEASE, "agent");
      asm volatile("s_waitcnt vmcnt(0)" ::: "memory");
      const unsigned og = xb_add(&bar[XB_TOP], 1u);
      const unsigned tg = og / nx;
      if (og + 1u == (tg + 1u) * nx) xb_add(&bar[XB_TOPGEN], 1u);
      else XB_SPIN(xb_ld(&bar[XB_TOPGEN]) == tg, bar);
      __builtin_amdgcn_fence(__ATOMIC_ACQUIRE, "agent");
      xb_add(&bar[XB_XGEN(b.x)], 1u);
      asm volatile("s_waitcnt vmcnt(0)" ::: "memory");
    } else {
      XB_SPIN(xb_ld(&bar[XB_XGEN(b.x)]) == gen, bar);
      __builtin_amdgcn_fence(__ATOMIC_ACQUIRE, "agent");
      asm volatile("s_waitcnt vmcnt(0)" ::: "memory");
    }
  }
  __syncthreads();
}

__global__ void __launch_bounds__(NTHR, 2) nsa_pool_block_fwd(Params p) {
  extern __shared__ __attribute__((aligned(16))) unsigned char shm[];
  char* smem = (char*)shm;
  LAS unsigned char* lds = (LAS unsigned char*)shm;
  cg::grid_group grid = cg::this_grid();
  const int G = gridDim.x;
  const int bid = blockIdx.x;
  const int L = (G % 8 == 0) ? (bid % 8) * (G / 8) + bid / 8 : bid;
  volatile LAS unsigned* xst = (volatile LAS unsigned*)(lds + 133120);
  if (threadIdx.x < 4) xst[threadIdx.x] = 0u;
  __syncthreads();
  const XcdBarrier xb = xcd_barrier_post(p.bar, xst);

  if (PH_MASK & 1)
  {
    constexpr int N0 = 1024, N1 = N0 + TJ_EARLY / 2, N2 = N1 + 64, N3 = N2 + 16, N4 = N3 + 64;
    for (int rep = 0; rep < ((REP_MASK & 1) ? 2 : 1); ++rep)
    for (int it = N4 - 1 - bid; it >= 0; it -= G) {
      if (it < N0) p0_rows(p, it);
      else if (it < N1) p0_transpose(p, it - N0, smem, 0);
      else if (it < N2) p0_weff(p, it - N1, smem);
      else if (it < N3) p0_cbias(p, it - N2, smem);
      else p0_rope(p, it - N3);
    }
  }
  if (p.bar == nullptr) grid.sync();
  xcd_barrier(xb);
  if (PH_MASK & 2) {
    Sched S{0, G, bid};
    EpiProj E{p};
    for (int rep = 0; rep < ((REP_MASK & 2) ? 2 : 1); ++rep)
    gemm_phase(lds, Gemm{p.xb, p.w_in_t, DM, DM, DM, 128, 128}, S, E);
  }
  xcd_barrier(xb);
  if (PH_MASK & 4) for (int rep = 0; rep < ((REP_MASK & 4) ? 2 : 1); ++rep)
  {
    Sched S{2, G, bid};
    EpiCmpHid E{(float*)p.mb};
    gemm_phase(lds, Gemm{p.kvb, p.cw1_t, 1024, 2048, 512, 128, 128}, S, E);
    for (int it = bid; it < 4096; it += G) p2a_pool_item(p, it);
  }
  xcd_barrier(xb);
  if (PH_MASK & 8) {
    Sched S{3, G, bid};
    EpiCmpOut E{p};
    for (int i = 0;; ++i) {
      Unit u;
      if (!S.next(i, u)) break;
      const float* h32 = (const float*)p.mb;
      const float* bias = p.cbias + u.pn * 256;
      for (int e0 = threadIdx.x; e0 < 8192; e0 += 4 * NTHR) {
        f32x4 pv[4][4][2];
#pragma unroll
        for (int q = 0; q < 4; ++q) {
          const int e = e0 + q * NTHR, c = e >> 5, n8 = (e & 31) * 8;
#pragma unroll
          for (int ks = 0; ks < 4; ++ks) {
            const f32x4* sp = (const f32x4*)(h32 + ((size_t)((ks * 32 + u.pm) * 256 + c)) * 256 + n8);
            pv[q][ks][0] = sp[0]; pv[q][ks][1] = sp[1];
          }
        }
#pragma unroll
        for (int q = 0; q < 4; ++q) {
          const int e = e0 + q * NTHR, c = e >> 5, n8 = (e & 31) * 8;
          f32x4 v0 = *(const f32x4*)(bias + n8), v1 = *(const f32x4*)(bias + n8 + 4);
#pragma unroll
          for (int ks = 0; ks < 4; ++ks) { v0 += pv[q][ks][0]; v1 += pv[q][ks][1]; }
#pragma unroll
          for (int j = 0; j < 4; ++j) { v0[j] = gelu_tanh(v0[j]); v1[j] = gelu_tanh(v1[j]); }
          *(u32x4*)(p.hid + ((size_t)u.pm * 256 + c) * 256 + n8) = pack8(v0, v1);
        }
      }
    }
    asm volatile("s_waitcnt vmcnt(0)" ::: "memory");
    __syncthreads();
    gemm_phase(lds, Gemm{p.hid, p.cw2_t, 256, 256, 256, 128, 128}, S, E);
    { Unit u0; const bool has_unit = S.next(0, u0);
      if (G >= 256) {
        if (!has_unit) {
          const int rank = bid - (bid >> 3) - (((bid & 7) > ((bid >> 3) & 7)) ? 1 : 0);
          for (int it = rank; it < (TJ_TOTAL - TJ_EARLY) / 2; it += G - 32) p0_transpose(p, it, smem, TJ_EARLY);
        }
      } else {
        __syncthreads();
        for (int it = bid; it < (TJ_TOTAL - TJ_EARLY) / 2; it += G) p0_transpose(p, it, smem, TJ_EARLY);
      }
    }
  }
  xcd_barrier(xb);
  if (ATTN_PRIO) { if (threadIdx.x >= 256) __builtin_amdgcn_s_setprio(2); }
  if (PH_MASK & 16) for (int rep = 0; rep < ((REP_MASK & 16) ? 2 : 1); ++rep)
  if (G == 256) {
    const int x = bid & 7, j = bid >> 3;
    for (int rd = 0; rd < 4; ++rd) {
      const int idx = rd * 32 + ((rd & 1) ? (31 - j) : j);
      attn_item(p, 2 * x + (idx & 1), 63 - (idx >> 1), smem);
    }
  } else
  for (int rd = 0; rd * G < 1024; ++rd) {
    const int i = rd * G + ((rd & 1) ? (G - 1 - L) : L);
    if (i < 1024) attn_item(p, i & 15, 63 - (i >> 4), smem);
  }
  xcd_barrier(xb);
  if (ATTN_PRIO) __builtin_amdgcn_s_setprio(0);
  if (PH_MASK & 32) {
    Sched S{1, G, bid};
    EpiMerge<0> E0{p};
    EpiMerge<1> E1{p};
    for (int rep = 0; rep < ((REP_MASK & 32) ? 2 : 1); ++rep) {
    gemm_phase(lds, Gemm{p.ob, p.wa_t, 512, 512, 512, 128, 128}, S, E0);
    gemm_phase(lds, Gemm{p.pooled, p.wbe_t, 512, 512, 512, 128, 128}, S, E1);
    }
  }
  xcd_barrier(xb);
  if (PH_MASK & 64) {
    Sched S{1, G, bid};
    EpiResidBf E{p.xb, p.ssq};
    for (int rep = 0; rep < ((REP_MASK & 64) ? 2 : 1); ++rep)
    gemm_phase(lds, Gemm{p.mb, p.wo_t, DM, DM, DM, 128, 128}, S, E);
  }
  xcd_barrier(xb);
  if (PH_MASK & 128) {
    Sched S{0, G, bid};
    EpiFF1 E{p};
    for (int rep = 0; rep < ((REP_MASK & 128) ? 2 : 1); ++rep)
    gemm_phase(lds, Gemm{p.xb, p.w1_t, DM, DM, DM, 128, 128}, S, E);
  }
  xcd_barrier(xb);
#if FUSE_FINAL
  if (PH_MASK & 256) {
    Sched S{1, G, bid};
    EpiFinal E{p.out, p.xb, p.norm_final, p.ssq2, p.bar + XCD_BAR_WORDS};
    gemm_phase(lds, Gemm{p.act, p.w2_t, 64, 64, 4096, (size_t)T_TOK * 128, (size_t)1024 * 128}, S, E);
  }
#else
  if (PH_MASK & 256) {
    Sched S{1, G, bid};
    EpiResid<false> E{p.out, p.out, nullptr, p.ssq2};
    gemm_phase(lds, Gemm{p.act, p.w2_t, 64, 64, 4096, (size_t)T_TOK * 128, (size_t)1024 * 128}, S, E);
  }
  xcd_barrier(xb);
  for (int it = bid; it < 4096; it += G) p10_rows(p, it);
#endif
}

extern "C" void kernel_launch(void* const* d_in, const int* in_sizes, int n_in, void* d_out, int out_size, void* d_ws,
                              size_t ws_size, hipStream_t stream) {
  (void)in_sizes; (void)n_in; (void)out_size; (void)ws_size;
  static int grid_blocks = 0;
  if (!grid_blocks) {
    int dev = 0, cus = 0, per_cu = 0;
    (void)hipGetDevice(&dev);
    (void)hipDeviceGetAttribute(&cus, hipDeviceAttributeMultiprocessorCount, dev);
    (void)hipFuncSetAttribute((const void*)nsa_pool_block_fwd, hipFuncAttributeMaxDynamicSharedMemorySize, LDS_BYTES);
    (void)hipOccupancyMaxActiveBlocksPerMultiprocessor(&per_cu, nsa_pool_block_fwd, NTHR, LDS_BYTES);
    if (per_cu > 1) per_cu = 1;
    if (per_cu < 1) per_cu = 1;
    grid_blocks = cus * per_cu;
  }
  Params p{};
  const float* const* in = (const float* const*)d_in;
  p.x = in[0]; p.norm_mix = in[1]; p.w_in = in[2]; p.pe_k = in[3]; p.pe_v = in[4]; p.ck_w1 = in[5]; p.ck_w2 = in[6];
  p.cv_w1 = in[7]; p.cv_w2 = in[8]; p.w_ba = in[9]; p.pool_w = in[10]; p.pool_scale = in[11]; p.w_bp = in[12];
  p.w_out = in[13]; p.norm_mlp = in[14]; p.w_ff1 = in[15]; p.w_ff2 = in[16]; p.norm_final = in[17];
  p.out = (float*)d_out;
  char* ws = (char*)d_ws;
  size_t off = 0;
  auto take = [&](size_t bytes) { char* r = ws + off; off += (bytes + 255) & ~(size_t)255; return r; };
  const size_t T = T_TOK;
  p.xb = (u16*)take(T * 1024 * 2);
  p.w_in_t = (u16*)take((size_t)NPROJ * 1024 * 2);
  p.wa_t = (u16*)take(1024 * 512 * 2);
  p.wbe_t = (u16*)take(1024 * 512 * 2);
  p.wo_t = (u16*)take(1024 * 1024 * 2);
  p.w1_t = (u16*)take((size_t)4096 * 1024 * 2);
  p.w2_t = (u16*)take((size_t)4096 * 1024 * 2);
  p.cw1_t = (u16*)take(2 * 256 * 2048 * 2);
  p.cw2_t = (u16*)take(2 * 256 * 256 * 2);
  p.rstd0 = (float*)take(T * 4);
  p.cbias = (float*)take(512 * 4);
  p.rope = (float2*)take((size_t)SEQ * 8 * 8);
  p.ssq = (float*)take(T * 16 * 4);
  p.ssq2 = (float*)take(T * 16 * 4);
  p.mb = (u16*)take(T * 1024 * 2);
  char* regionD = ws + off;
  p.qb = (u16*)take(T * 512 * 2);
  p.kvb = (u16*)take((size_t)6 * 16 * SEQ * 64 * 2);
  p.gate = (float*)take(T * 24 * 4);
  p.ub = (u16*)take(T * 512 * 2);
  p.gm = (u16*)take(T * 2048 * 2);
  p.hid = (u16*)take((size_t)2 * 16 * 256 * 256 * 2);
  p.kcmp = (u16*)take(16 * 256 * 64 * 2);
  p.vcmp = (u16*)take(16 * 256 * 64 * 2);
  p.pooled = (u16*)take(T * 512 * 2);
  p.ob = (u16*)take(T * 512 * 2);
  p.bar = (unsigned*)take((XCD_BAR_WORDS + 4096) * 4);
  p.act = (u16*)regionD;
  (void)hipMemsetAsync(p.bar, 0, (XCD_BAR_WORDS + 4096) * 4, stream);
  void* args[] = {&p};
  hipError_t e = hipLaunchCooperativeKernel((void*)nsa_pool_block_fwd, dim3(grid_blocks), dim3(NTHR), args, LDS_BYTES, stream);
  if (e != hipSuccess) fprintf(stderr, "cooperative launch failed: %s (grid %d)\n", hipGetErrorString(e), grid_blocks);
}
```

```cpp
#include <hip/hip_runtime.h>
#include <hip/hip_cooperative_groups.h>
#include <stdint.h>
#include <stdio.h>
namespace cg = cooperative_groups;

#define DI __device__ __forceinline__
#define LAS __attribute__((address_space(3)))
typedef unsigned short u16;
typedef __attribute__((ext_vector_type(8))) short bf16x8;
typedef __attribute__((ext_vector_type(4))) short s16x4;
typedef __attribute__((ext_vector_type(16))) float f32x16;
typedef __attribute__((ext_vector_type(4))) float f32x4;
typedef __attribute__((ext_vector_type(4))) unsigned u32x4;
typedef __attribute__((ext_vector_type(2))) unsigned u32x2;
typedef __attribute__((ext_vector_type(2))) float f32x2;
typedef __attribute__((ext_vector_type(2))) __bf16 bf16x2_t;
typedef LAS const char* lds_cptr;

constexpr int T_TOK = 32768, SEQ = 4096, DM = 1024;
constexpr int NPROJ = 4096;
constexpr int NTHR = 512;
constexpr int LDS_BYTES = 135168;
constexpr float NEGF = -1e30f;
constexpr float QSCALE = 0.125f * 1.4426950408889634f;
#ifndef REP_MASK
#define REP_MASK 0
#endif
#ifndef ATTN_PRIO
#define ATTN_PRIO 0
#endif
#ifndef FUSE_FINAL
#define FUSE_FINAL 1
#endif
#ifndef PH_MASK
#define PH_MASK 0xffff
#endif

struct Params {
  const float *x, *norm_mix, *w_in, *pe_k, *pe_v, *ck_w1, *ck_w2, *cv_w1, *cv_w2, *w_ba, *pool_w, *pool_scale, *w_bp,
      *w_out, *norm_mlp, *w_ff1, *w_ff2, *norm_final;
  float* out;
  u16 *xb, *w_in_t, *wa_t, *wbe_t, *wo_t, *w1_t, *w2_t, *cw1_t, *cw2_t;
  float *rstd0, *cbias;
  float2* rope;
  u16 *qb, *kvb;
  float* gate;
  u16 *ub, *gm, *hid, *kcmp, *vcmp, *pooled, *ob, *mb, *act;
  float *ssq, *ssq2;
  unsigned* bar;
};

DI unsigned pack_bf2(float a, float b) {
  f32x2 v = {a, b};
  bf16x2_t r = __builtin_convertvector(v, bf16x2_t);
  return __builtin_bit_cast(unsigned, r);
}
DI float bf_lo(unsigned u) { return __uint_as_float(u << 16); }
DI float bf_hi(unsigned u) { return __uint_as_float(u & 0xffff0000u); }
DI float sigmoidf_(float v) { return __builtin_amdgcn_rcpf(1.f + __builtin_amdgcn_exp2f(-1.4426950408889634f * v)); }
DI float gelu_tanh(float x) {
  float u = 0.7978845608028654f * (x + 0.044715f * x * x * x);
  float th = 1.f - 2.f / (__expf(2.f * u) + 1.f);
  return 0.5f * x * (1.f + th);
}
DI f32x16 mfma32(bf16x8 a, bf16x8 b, f32x16 c) { return __builtin_amdgcn_mfma_f32_32x32x16_bf16(a, b, c, 0, 0, 0); }
DI int opaque_tid() { int t; asm volatile("v_mov_b32 %0, %1" : "=v"(t) : "v"((int)threadIdx.x)); return t; }
DI f32x16 zero16() { f32x16 z; for (int i = 0; i < 16; ++i) z[i] = 0.f; return z; }
DI s16x4 vtr(lds_cptr p) { return __builtin_amdgcn_ds_read_tr16_b64_v4i16((LAS s16x4*)p); }
DI u32x4 pack8(const f32x4& a, const f32x4& b) {
  u32x4 w = {pack_bf2(a[0], a[1]), pack_bf2(a[2], a[3]), pack_bf2(b[0], b[1]), pack_bf2(b[2], b[3])};
  return w;
}

constexpr int BM = 256, BK = 64, HALF = 128, HTB = HALF * BK * 2;
DI int lds_byte(int r, int c) { const int st = (r >> 4) * 2 + (c >> 5), rr = r & 15, cc = c & 31, ob = rr * 64 + cc * 2; return st * 1024 + (ob ^ (((ob >> 9) & 1) << 5)); }
DI void stage_rc(int b, int& R, int& C) { const int st = b / 1024, sb = b % 1024, swz = sb ^ (((sb >> 9) & 1) << 5); R = (st >> 1) * 16 + swz / 64; C = (st & 1) * 32 + (swz % 64) / 2; }
DI int perm32(int rho) { const int n = rho >> 4, i = rho & 15; return 8 * (i >> 2) + 4 * n + (i & 3); }

struct Unit { int pm, pn, k0; };
struct Gemm { const u16* A; const u16* Bt; int lda, ldb, K; size_t kstepA, kstepB; };

struct Sched {
  int mode, G, bid;
  DI bool next(int i, Unit& u) const {
    u.k0 = 0;
    if (mode == 2) {
      int t;
      if (G >= 256) { if (i > 0 || (bid & 1) != ((bid >> 3) & 1) || (bid >> 1) >= 128) return false; t = bid >> 1; }
      else { t = i * G + bid; if (t >= 128) return false; }
      u.pm = t >> 2; u.pn = u.pm >> 4; u.k0 = (t & 3) * 8; return true;
    }
    if (mode == 3) {
      int t;
      if (G >= 256) { t = bid >> 3; if (i > 0 || (bid & 7) != (t & 7) || t >= 32) return false; }
      else { t = i * G + bid; if (t >= 32) return false; }
      u.pm = t; u.pn = t >> 4; return true;
    }
    const int nN = mode == 0 ? 16 : 4;
    if (G == 256) {
      const int x = bid & 7, j = bid >> 3;
      if (mode == 0) { if (i >= 8) return false; u.pn = (x & 3) * 4 + (j & 3); u.pm = (x >> 2) * 64 + i * 8 + (j >> 2); return true; }
      if (i >= 2) return false; u.pn = j & 3; u.pm = x * 16 + i * 8 + (j >> 2); return true;
    }
    const int t = i * G + bid;
    if (t >= nN * 128) return false;
    u.pn = t % nN; u.pm = t / nN; return true;
  }
};

template <class Epi>
DI void gemm_phase(LAS unsigned char* lds, const Gemm g, const Sched& S, const Epi& E) {
  const int tid = opaque_tid(), wid = __builtin_amdgcn_readfirstlane(tid >> 6), lane = tid & 63, wr = wid >> 2, wc = wid & 3, fr = lane & 15, fq = lane >> 4;
  const int nt = g.K / BK;
  unsigned voffA[2], voffB[2];
#pragma unroll
  for (int i = 0; i < 2; ++i) {
    int R, C; stage_rc(tid * 16 + i * 8192, R, C);
    const int Rb = (R & ~31) + perm32(R & 31);
    voffA[i] = (unsigned)(R * g.lda + C) * 2u; voffB[i] = (unsigned)(Rb * g.ldb + C) * 2u;
  }
  const size_t kstep = g.kstepB, kstepA = g.kstepA;
  const size_t hstepA = (size_t)HALF * g.lda * 2, hstepB = (size_t)HALF * g.ldb * 2;
  const size_t tstepA = 2 * hstepA, tstepB = 2 * hstepB;
  const unsigned ldsw = (unsigned)wid * 1024u;
  const int aoff = lds_byte(wr * 64 + fr, fq * 8), boff = lds_byte(wc * 32 + fr, fq * 8);
#define PG8_SA(b, h) (((b) * 2 + (h)) * HTB)
#define PG8_SB(b, h) ((4 + (b) * 2 + (h)) * HTB)
#define PG8_STAGE(bufoff, gbase, voff) do { _Pragma("unroll") for (int _i = 0; _i < 2; ++_i) \
    __builtin_amdgcn_global_load_lds((const unsigned*)((const char*)(gbase) + (voff)[_i]), (LAS unsigned*)(lds + (bufoff) + ldsw + _i * 8192), 16, 0, 0); } while (0)
#define PG8_LDA(dst, b, h) do { _Pragma("unroll") for (int m = 0; m < 4; ++m) _Pragma("unroll") for (int k = 0; k < 2; ++k) dst[m][k] = *(const LAS bf16x8*)(lds + PG8_SA(b, h) + aoff + m * 2048 + k * 1024); } while (0)
#define PG8_LDB(dst, b, h) do { _Pragma("unroll") for (int n = 0; n < 2; ++n) _Pragma("unroll") for (int k = 0; k < 2; ++k) dst[n][k] = *(const LAS bf16x8*)(lds + PG8_SB(b, h) + boff + n * 2048 + k * 1024); } while (0)
#define PG8_MMA(ai, bj, At, Bt) do { __builtin_amdgcn_s_setprio(1); _Pragma("unroll") for (int m = 0; m < 4; ++m) _Pragma("unroll") for (int n = 0; n < 2; ++n) _Pragma("unroll") for (int k = 0; k < 2; ++k) \
    acc[ai][bj][m][n] = __builtin_amdgcn_mfma_f32_16x16x32_bf16(Bt[n][k], At[m][k], acc[ai][bj][m][n], 0, 0, 0); __builtin_amdgcn_s_setprio(0); } while (0)
#define PG8_WAIT_V(n) asm volatile("s_waitcnt vmcnt(" #n ")" ::: "memory")
#define PG8_WAIT_L(n) asm volatile("s_waitcnt lgkmcnt(" #n ")" ::: "memory")
#define PG8_BAR __builtin_amdgcn_s_barrier()
#define PG8_SCHED __builtin_amdgcn_sched_barrier(0)
  Unit cur, nxt; int ui = 0;
  if (!S.next(0, cur)) return;
  f32x4 acc[2][2][4][2];
#pragma unroll
  for (int a = 0; a < 2; ++a)
#pragma unroll
    for (int b = 0; b < 2; ++b)
#pragma unroll
      for (int m = 0; m < 4; ++m)
#pragma unroll
        for (int n = 0; n < 2; ++n) acc[a][b][m][n] = (f32x4){0.f, 0.f, 0.f, 0.f};
  bf16x8 At[4][2], B0[2][2], B1[2][2];
  const char* cA = (const char*)g.A + (size_t)cur.pm * tstepA + (size_t)cur.k0 * kstepA; const char* cB = (const char*)g.Bt + (size_t)cur.pn * tstepB + (size_t)cur.k0 * kstep;
  PG8_STAGE(PG8_SB(0, 0), cB, voffB); PG8_STAGE(PG8_SA(0, 0), cA, voffA); PG8_STAGE(PG8_SB(0, 1), cB + hstepB, voffB); PG8_STAGE(PG8_SA(0, 1), cA + hstepA, voffA);
  if (wr == 1) PG8_BAR;
  PG8_WAIT_V(4); PG8_BAR;
  PG8_STAGE(PG8_SB(1, 0), cB + kstep, voffB); PG8_STAGE(PG8_SA(1, 0), cA + kstepA, voffA); PG8_STAGE(PG8_SB(1, 1), cB + hstepB + kstep, voffB);
  PG8_WAIT_V(6); PG8_BAR;
  for (;;) {
    const bool has_next = S.next(ui + 1, nxt);
    const char* nA = has_next ? (const char*)g.A + (size_t)nxt.pm * tstepA + (size_t)nxt.k0 * kstepA : cA; const char* nB = has_next ? (const char*)g.Bt + (size_t)nxt.pn * tstepB + (size_t)nxt.k0 * kstep : cB;
    for (int t = 0; t < nt; t += 2) {
      const bool last = (t == nt - 2);
      const char* a1 = cA + (size_t)(t + 1) * kstepA;
      const char* a2 = last ? nA : cA + (size_t)(t + 2) * kstepA; const char* b2 = last ? nB : cB + (size_t)(t + 2) * kstep;
      const char* a3 = a2 + kstepA; const char* b3 = b2 + kstep;
      PG8_LDB(B0, 0, 0); PG8_SCHED; PG8_LDA(At, 0, 0); PG8_STAGE(PG8_SA(1, 1), a1 + hstepA, voffA);
      PG8_WAIT_L(8); PG8_BAR; PG8_WAIT_L(0); PG8_MMA(0, 0, At, B0); PG8_BAR; PG8_SCHED;
      PG8_LDB(B1, 0, 1); PG8_STAGE(PG8_SB(0, 0), b2, voffB);
      PG8_BAR; PG8_WAIT_L(0); PG8_MMA(0, 1, At, B1); PG8_BAR;
      PG8_LDA(At, 0, 1); PG8_STAGE(PG8_SA(0, 0), a2, voffA);
      PG8_BAR; PG8_WAIT_L(0); PG8_MMA(1, 0, At, B0); PG8_BAR; PG8_SCHED;
      PG8_STAGE(PG8_SB(0, 1), b2 + hstepB, voffB);
      PG8_WAIT_V(6); PG8_BAR; PG8_MMA(1, 1, At, B1); PG8_BAR;
      PG8_LDB(B0, 1, 0); PG8_SCHED; PG8_LDA(At, 1, 0); PG8_STAGE(PG8_SA(0, 1), a2 + hstepA, voffA);
      PG8_WAIT_L(8); PG8_BAR; PG8_WAIT_L(0); PG8_MMA(0, 0, At, B0); PG8_BAR; PG8_SCHED;
      PG8_LDB(B1, 1, 1); PG8_STAGE(PG8_SB(1, 0), b3, voffB);
      PG8_BAR; PG8_WAIT_L(0); PG8_MMA(0, 1, At, B1); PG8_BAR;
      PG8_LDA(At, 1, 1); PG8_STAGE(PG8_SA(1, 0), a3, voffA);
      PG8_BAR; PG8_WAIT_L(0); PG8_MMA(1, 0, At, B0); PG8_BAR; PG8_SCHED;
      PG8_STAGE(PG8_SB(1, 1), b3 + hstepB, voffB);
      PG8_WAIT_V(6); PG8_BAR; PG8_MMA(1, 1, At, B1); PG8_BAR;
    }
    E(acc, cur, wr, wc, fr, fq);
    if (!has_next) break;
#pragma unroll
    for (int a = 0; a < 2; ++a)
#pragma unroll
      for (int b = 0; b < 2; ++b)
#pragma unroll
        for (int m = 0; m < 4; ++m)
#pragma unroll
          for (int n = 0; n < 2; ++n) acc[a][b][m][n] = (f32x4){0.f, 0.f, 0.f, 0.f};
    cur = nxt; cA = nA; cB = nB; ++ui;
  }
  PG8_WAIT_V(0);
  if (wr == 0) PG8_BAR;
  PG8_BAR;
#undef PG8_SA
#undef PG8_SB
#undef PG8_STAGE
#undef PG8_LDA
#undef PG8_LDB
#undef PG8_MMA
#undef PG8_WAIT_V
#undef PG8_WAIT_L
#undef PG8_BAR
#undef PG8_SCHED
}

typedef f32x4 (&AccRef)[2][2][4][2];
DI unsigned xb_ld(unsigned* p)              { return __hip_atomic_load(p, __ATOMIC_RELAXED, __HIP_MEMORY_SCOPE_AGENT); }
DI unsigned xb_add(unsigned* p, unsigned v) { return __hip_atomic_fetch_add(p, v, __ATOMIC_RELAXED, __HIP_MEMORY_SCOPE_AGENT); }
#define EPI_ROWS for (int ai = 0; ai < 2; ++ai) _Pragma("unroll") for (int m = 0; m < 4; ++m)
#define EPI_ROW(u) ((u).pm * BM + ai * HALF + wr * 64 + m * 16 + fr)
#define EPI_COL(bj) ((bj) * HALF + wc * 32 + fq * 8)

DI void rope8(f32x4& v0, f32x4& v1, const float2* __restrict__ tab, int pos, int fq) {
  const f32x4* t4 = (const f32x4*)(tab + (size_t)pos * 8);
  const f32x4 c0 = t4[0], c1 = t4[1], c2 = t4[2], c3 = t4[3];
  float pv[8];
#pragma unroll
  for (int j = 0; j < 4; ++j) { pv[j] = __shfl_xor(v0[j], 16); pv[4 + j] = __shfl_xor(v1[j], 16); }
  if (fq < 2) {
    const float sg = fq ? 1.f : -1.f;
    v0[0] = v0[0] * c0[0] + sg * pv[0] * c0[1]; v0[1] = v0[1] * c0[2] + sg * pv[1] * c0[3];
    v0[2] = v0[2] * c1[0] + sg * pv[2] * c1[1]; v0[3] = v0[3] * c1[2] + sg * pv[3] * c1[3];
    v1[0] = v1[0] * c2[0] + sg * pv[4] * c2[1]; v1[1] = v1[1] * c2[2] + sg * pv[5] * c2[3];
    v1[2] = v1[2] * c3[0] + sg * pv[6] * c3[1]; v1[3] = v1[3] * c3[2] + sg * pv[7] * c3[3];
  }
}

DI void rope8t(f32x4& v0, f32x4& v1, const f32x4 (&t)[4], int fq) {
  float pv[8];
#pragma unroll
  for (int j = 0; j < 4; ++j) { pv[j] = __shfl_xor(v0[j], 16); pv[4 + j] = __shfl_xor(v1[j], 16); }
  if (fq < 2) {
    const float sg = fq ? 1.f : -1.f;
    v0[0] = v0[0] * t[0][0] + sg * pv[0] * t[0][1]; v0[1] = v0[1] * t[0][2] + sg * pv[1] * t[0][3];
    v0[2] = v0[2] * t[1][0] + sg * pv[2] * t[1][1]; v0[3] = v0[3] * t[1][2] + sg * pv[3] * t[1][3];
    v1[0] = v1[0] * t[2][0] + sg * pv[4] * t[2][1]; v1[1] = v1[1] * t[2][2] + sg * pv[5] * t[2][3];
    v1[2] = v1[2] * t[3][0] + sg * pv[6] * t[3][1]; v1[3] = v1[3] * t[3][2] + sg * pv[7] * t[3][3];
  }
}

struct EpiProj {
  const Params& p;
  DI void operator()(AccRef acc, const Unit& u, int wr, int wc, int fr, int fq) const {
    const int pn = u.pn;
    const bool roped = ((wc & 1) == 0) && (pn < 2 || pn == 3 || pn == 4);
    float rs8[8];
#pragma unroll
    EPI_ROWS rs8[ai * 4 + m] = p.rstd0[EPI_ROW(u)];
#pragma unroll
    for (int ai = 0; ai < 2; ++ai)
#pragma unroll
    for (int mh = 0; mh < 2; ++mh) {
      f32x4 tabx[2][4];
      if (roped) {
#pragma unroll
        for (int mm = 0; mm < 2; ++mm) {
          const int m = mh * 2 + mm;
          const f32x4* t4 = (const f32x4*)(p.rope + (size_t)(EPI_ROW(u) & (SEQ - 1)) * 8);
          tabx[mm][0] = t4[0]; tabx[mm][1] = t4[1]; tabx[mm][2] = t4[2]; tabx[mm][3] = t4[3];
        }
      }
#pragma unroll
      for (int mm = 0; mm < 2; ++mm) {
        const int m = mh * 2 + mm;
        const f32x4 (&tabm)[4] = tabx[mm];
        const int row = EPI_ROW(u);
        const float rs = rs8[ai * 4 + m];
        const int s = row & (SEQ - 1), b = row >> 12;
#pragma unroll
        for (int bj = 0; bj < 2; ++bj) {
          f32x4 v0 = acc[ai][bj][m][0] * rs, v1 = acc[ai][bj][m][1] * rs;
          const int lc = EPI_COL(bj);
          if (pn < 2) {
            if (roped) rope8t(v0, v1, tabm, fq);
            *(u32x4*)(p.qb + (size_t)row * 512 + pn * 256 + lc) = pack8(v0 * QSCALE, v1 * QSCALE);
          } else if (pn < 5) {
            const int which = (pn - 2) * 2 + bj;
            if ((which == 2 || which == 4) && roped) rope8t(v0, v1, tabm, fq);
            const int g = wc >> 1, d = (wc & 1) * 32 + fq * 8;
            *(u32x4*)(p.kvb + ((size_t)((which * 16 + b * 2 + g) * SEQ + s)) * 64 + d) = pack8(v0, v1);
          } else if (pn < 7) {
            *(u32x4*)(p.ub + (size_t)row * 512 + (pn - 5) * 256 + lc) = pack8(v0, v1);
          } else if (pn < 15) {
#pragma unroll
            for (int j = 0; j < 4; ++j) { v0[j] = sigmoidf_(v0[j]); v1[j] = sigmoidf_(v1[j]); }
            __builtin_nontemporal_store(pack8(v0, v1), (u32x4*)(p.gm + (size_t)row * 2048 + (pn - 7) * 256 + lc));
          } else {
            if (bj == 0 && wc == 0 && fq < 3) {
#pragma unroll
              for (int j = 0; j < 4; ++j) { v0[j] = sigmoidf_(v0[j]); v1[j] = sigmoidf_(v1[j]); }
              f32x4* gp = (f32x4*)(p.gate + (size_t)row * 24 + fq * 8);
              gp[0] = v0; gp[1] = v1;
            }
          }
        }
      }
    }
  }
};

struct EpiCmpHid {
  float* hid32;
  DI void operator()(AccRef acc, const Unit& u, int wr, int wc, int fr, int fq) const {
    float* base = hid32 + ((size_t)((u.k0 >> 3) * 32 + u.pm) * 256) * 256;
#pragma unroll
    EPI_ROWS {
      const int c = ai * HALF + wr * 64 + m * 16 + fr;
#pragma unroll
      for (int bj = 0; bj < 2; ++bj) {
        f32x4* dp = (f32x4*)(base + (size_t)c * 256 + EPI_COL(bj));
        dp[0] = acc[ai][bj][m][0]; dp[1] = acc[ai][bj][m][1];
      }
    }
  }
};

struct EpiCmpOut {
  const Params& p;
  DI void operator()(AccRef acc, const Unit& u, int wr, int wc, int fr, int fq) const {
    const int kv = u.pm >> 4, bg = u.pm & 15;
    const bool roped = (kv == 0) && (wc == 0);
    u16* dst = (kv ? p.vcmp : p.kcmp) + (size_t)bg * 256 * 64;
#pragma unroll
    for (int ai = 0; ai < 2; ++ai) {
      f32x4 tabx[4][4];
      {
#pragma unroll
        for (int m = 0; m < 4; ++m) {
          const int c = ai * HALF + wr * 64 + m * 16 + fr;
          const f32x4* t4 = (const f32x4*)(p.rope + (size_t)min(16 * c + 31, SEQ - 1) * 8);
          tabx[m][0] = t4[0]; tabx[m][1] = t4[1]; tabx[m][2] = t4[2]; tabx[m][3] = t4[3];
        }
      }
#pragma unroll
      for (int m = 0; m < 4; ++m) {
        const int c = ai * HALF + wr * 64 + m * 16 + fr;
        f32x4 v0 = acc[ai][0][m][0], v1 = acc[ai][0][m][1];
        if (roped) rope8t(v0, v1, tabx[m], fq);
        if (c == 255) { v0 = (f32x4){0.f, 0.f, 0.f, 0.f}; v1 = v0; }
        if (wc < 2) *(u32x4*)(dst + c * 64 + wc * 32 + fq * 8) = pack8(v0, v1);
      }
    }
  }
};

template <int PASS>
struct EpiMerge {
  const Params& p;
  DI void operator()(AccRef acc, const Unit& u, int wr, int wc, int fr, int fq) const {
#pragma unroll
    for (int ai = 0; ai < 2; ++ai) {
      u32x4 gq[4][2], ov[4][2];
#pragma unroll
      for (int m = 0; m < 4; ++m)
#pragma unroll
        for (int bj = 0; bj < 2; ++bj) {
          const int row = EPI_ROW(u), col = u.pn * BM + EPI_COL(bj);
          gq[m][bj] = *(const u32x4*)(p.gm + (size_t)row * 2048 + PASS * 1024 + col);
          if (PASS == 1) ov[m][bj] = *(const u32x4*)(p.mb + (size_t)row * 1024 + col);
        }
#pragma unroll
      for (int m = 0; m < 4; ++m) {
        const int row = EPI_ROW(u);
#pragma unroll
        for (int bj = 0; bj < 2; ++bj) {
          const int col = u.pn * BM + EPI_COL(bj);
          const u32x4 g = gq[m][bj];
          f32x4 v0 = acc[ai][bj][m][0], v1 = acc[ai][bj][m][1];
          v0[0] *= bf_lo(g[0]); v0[1] *= bf_hi(g[0]); v0[2] *= bf_lo(g[1]); v0[3] *= bf_hi(g[1]);
          v1[0] *= bf_lo(g[2]); v1[1] *= bf_hi(g[2]); v1[2] *= bf_lo(g[3]); v1[3] *= bf_hi(g[3]);
          if (PASS == 1) {
            const u32x4 o = ov[m][bj];
            v0[0] += bf_lo(o[0]); v0[1] += bf_hi(o[0]); v0[2] += bf_lo(o[1]); v0[3] += bf_hi(o[1]);
            v1[0] += bf_lo(o[2]); v1[1] += bf_hi(o[2]); v1[2] += bf_lo(o[3]); v1[3] += bf_hi(o[3]);
          }
          *(u32x4*)(p.mb + (size_t)row * 1024 + col) = pack8(v0, v1);
        }
      }
    }
  }
};

template <bool WITH_BF16, bool WITH_F32 = true>
struct EpiResid {
  const float* resid; float* out; u16* outb; float* ssq;
  DI void operator()(AccRef acc, const Unit& u, int wr, int wc, int fr, int fq) const {
#pragma unroll
    for (int ai = 0; ai < 2; ++ai) {
      f32x4 rv[4][2][2];
#pragma unroll
      for (int m = 0; m < 4; ++m)
#pragma unroll
        for (int bj = 0; bj < 2; ++bj) {
          const f32x4* rp = (const f32x4*)(resid + (size_t)EPI_ROW(u) * 1024 + u.pn * BM + EPI_COL(bj));
          rv[m][bj][0] = rp[0]; rv[m][bj][1] = rp[1];
        }
#pragma unroll
      for (int m = 0; m < 4; ++m) {
        const int row = EPI_ROW(u);
        float sq = 0.f;
#pragma unroll
        for (int bj = 0; bj < 2; ++bj) {
          const size_t a = (size_t)row * 1024 + u.pn * BM + EPI_COL(bj);
          const f32x4 v0 = rv[m][bj][0] + acc[ai][bj][m][0], v1 = rv[m][bj][1] + acc[ai][bj][m][1];
          if (WITH_F32) { f32x4* op = (f32x4*)(out + a); op[0] = v0; op[1] = v1; }
          if (WITH_BF16) *(u32x4*)(outb + a) = pack8(v0, v1);
#pragma unroll
          for (int j = 0; j < 4; ++j) sq += v0[j] * v0[j] + v1[j] * v1[j];
        }
        sq += __shfl_xor(sq, 16);
        sq += __shfl_xor(sq, 32);
        if (fq == 0) ssq[(size_t)row * 16 + u.pn * 4 + wc] = sq;
      }
    }
  }
};

struct EpiResidBf {
  u16* xb; float* ssq;
  DI void operator()(AccRef acc, const Unit& u, int wr, int wc, int fr, int fq) const {
#pragma unroll
    for (int ai = 0; ai < 2; ++ai) {
      u32x4 rv[4][2];
#pragma unroll
      for (int m = 0; m < 4; ++m)
#pragma unroll
        for (int bj = 0; bj < 2; ++bj) rv[m][bj] = *(const u32x4*)(xb + (size_t)EPI_ROW(u) * 1024 + u.pn * BM + EPI_COL(bj));
#pragma unroll
      for (int m = 0; m < 4; ++m) {
        const int row = EPI_ROW(u);
        float sq = 0.f;
#pragma unroll
        for (int bj = 0; bj < 2; ++bj) {
          const u32x4 r8 = rv[m][bj];
          f32x4 v0 = acc[ai][bj][m][0], v1 = acc[ai][bj][m][1];
          v0[0] += bf_lo(r8[0]); v0[1] += bf_hi(r8[0]); v0[2] += bf_lo(r8[1]); v0[3] += bf_hi(r8[1]);
          v1[0] += bf_lo(r8[2]); v1[1] += bf_hi(r8[2]); v1[2] += bf_lo(r8[3]); v1[3] += bf_hi(r8[3]);
          *(u32x4*)(xb + (size_t)row * 1024 + u.pn * BM + EPI_COL(bj)) = pack8(v0, v1);
#pragma unroll
          for (int j = 0; j < 4; ++j) sq += v0[j] * v0[j] + v1[j] * v1[j];
        }
        sq += __shfl_xor(sq, 16);
        sq += __shfl_xor(sq, 32);
        if (fq == 0) ssq[(size_t)row * 16 + u.pn * 4 + wc] = sq;
      }
    }
  }
};

struct EpiFinal {
  float* out; const u16* x1b; const float* gfin; float* ssq2; unsigned* cnt;
  DI void operator()(AccRef acc, const Unit& u, int wr, int wc, int fr, int fq) const {
#pragma unroll
    for (int ai = 0; ai < 2; ++ai) {
      u32x4 r8[4][2];
#pragma unroll
      for (int m = 0; m < 4; ++m)
#pragma unroll
        for (int bj = 0; bj < 2; ++bj) r8[m][bj] = *(const u32x4*)(x1b + (size_t)EPI_ROW(u) * 1024 + u.pn * BM + EPI_COL(bj));
#pragma unroll
      for (int m = 0; m < 4; ++m) {
        const int row = EPI_ROW(u);
        float sq = 0.f;
#pragma unroll
        for (int bj = 0; bj < 2; ++bj) {
          const u32x4 r = r8[m][bj];
          acc[ai][bj][m][0] += (f32x4){bf_lo(r[0]), bf_hi(r[0]), bf_lo(r[1]), bf_hi(r[1])};
          acc[ai][bj][m][1] += (f32x4){bf_lo(r[2]), bf_hi(r[2]), bf_lo(r[3]), bf_hi(r[3])};
#pragma unroll
          for (int j = 0; j < 4; ++j) sq += acc[ai][bj][m][0][j] * acc[ai][bj][m][0][j] + acc[ai][bj][m][1][j] * acc[ai][bj][m][1][j];
        }
        sq += __shfl_xor(sq, 16);
        sq += __shfl_xor(sq, 32);
        if (fq == 0) __hip_atomic_store(ssq2 + (size_t)row * 16 + u.pn * 4 + wc, sq, __ATOMIC_RELAXED, __HIP_MEMORY_SCOPE_AGENT);
      }
    }
    asm volatile("s_waitcnt vmcnt(0)" ::: "memory");
    unsigned* c = cnt + (u.pm * 2 + wr) * 16;
    if (fq == 0 && fr == 0) (void)xb_add(c, 1u);
    { unsigned sp = 0; while (xb_ld(c) < 16u) { __builtin_amdgcn_s_sleep(1); if (++sp > (1u << 20)) break; } }
    unsigned long long q0[8], q1[8];
#pragma unroll
    EPI_ROWS {
      unsigned long long* sp = (unsigned long long*)(ssq2 + (size_t)EPI_ROW(u) * 16 + fq * 4);
      q0[ai * 4 + m] = __hip_atomic_load(sp, __ATOMIC_RELAXED, __HIP_MEMORY_SCOPE_AGENT);
      q1[ai * 4 + m] = __hip_atomic_load(sp + 1, __ATOMIC_RELAXED, __HIP_MEMORY_SCOPE_AGENT);
    }
    f32x4 gv[2][2];
#pragma unroll
    for (int bj = 0; bj < 2; ++bj) { const f32x4* gp = (const f32x4*)(gfin + u.pn * BM + EPI_COL(bj)); gv[bj][0] = gp[0]; gv[bj][1] = gp[1]; }
#pragma unroll
    EPI_ROWS {
      const int row = EPI_ROW(u);
      const unsigned long long a0 = q0[ai * 4 + m], a1 = q1[ai * 4 + m];
      float ss = (__uint_as_float((unsigned)a0) + __uint_as_float((unsigned)(a0 >> 32))) + (__uint_as_float((unsigned)a1) + __uint_as_float((unsigned)(a1 >> 32)));
      ss += __shfl_xor(ss, 16);
      ss += __shfl_xor(ss, 32);
      const float rs = rsqrtf(ss * (1.f / DM) + 1e-6f);
#pragma unroll
      for (int bj = 0; bj < 2; ++bj) {
        f32x4* op = (f32x4*)(out + (size_t)row * 1024 + u.pn * BM + EPI_COL(bj));
        __builtin_nontemporal_store(acc[ai][bj][m][0] * rs * gv[bj][0], op);
        __builtin_nontemporal_store(acc[ai][bj][m][1] * rs * gv[bj][1], op + 1);
      }
    }
  }
};

struct EpiFF1 {
  const Params& p;
  DI void operator()(AccRef acc, const Unit& u, int wr, int wc, int fr, int fq) const {
    f32x4 part[8];
#pragma unroll
    EPI_ROWS part[ai * 4 + m] = *(const f32x4*)(p.ssq + (size_t)EPI_ROW(u) * 16 + fq * 4);
    float rs8[8];
#pragma unroll
    for (int r = 0; r < 8; ++r) {
      float ss = (part[r][0] + part[r][1]) + (part[r][2] + part[r][3]);
      ss += __shfl_xor(ss, 16);
      ss += __shfl_xor(ss, 32);
      rs8[r] = rsqrtf(ss * (1.f / DM) + 1e-6f);
    }
#pragma unroll
    EPI_ROWS {
      const int row = EPI_ROW(u);
      const float rs = rs8[ai * 4 + m];
#pragma unroll
      for (int bj = 0; bj < 2; ++bj) {
        f32x4 v0 = acc[ai][bj][m][0] * rs, v1 = acc[ai][bj][m][1] * rs;
#pragma unroll
        for (int j = 0; j < 4; ++j) { const float r0 = fmaxf(v0[j], 0.f), r1 = fmaxf(v1[j], 0.f); v0[j] = r0 * r0; v1[j] = r1 * r1; }
        const int col = u.pn * BM + EPI_COL(bj);
        __builtin_nontemporal_store(pack8(v0, v1), (u32x4*)(p.act + ((size_t)(col >> 6) * T_TOK + row) * 64 + (col & 63)));
      }
    }
  }
};

DI void p0_rows(const Params& p, int item) {
  const int w = threadIdx.x >> 6, lane = threadIdx.x & 63;
  const int row0 = item * 32 + w * 4;
  f32x4 v[4][4];
#pragma unroll
  for (int r = 0; r < 4; ++r) {
    const f32x4* src = (const f32x4*)(p.x + (size_t)(row0 + r) * DM);
#pragma unroll
    for (int i = 0; i < 4; ++i) v[r][i] = __builtin_nontemporal_load(src + lane + 64 * i);
  }
#pragma unroll
  for (int r = 0; r < 4; ++r) {
    float ss = 0.f;
#pragma unroll
    for (int i = 0; i < 4; ++i) ss += v[r][i][0] * v[r][i][0] + v[r][i][1] * v[r][i][1] + v[r][i][2] * v[r][i][2] + v[r][i][3] * v[r][i][3];
#pragma unroll
    for (int o = 32; o; o >>= 1) ss += __shfl_xor(ss, o);
    if (lane == 0) p.rstd0[row0 + r] = rsqrtf(ss * (1.f / DM) + 1e-6f);
    u32x2* dst = (u32x2*)(p.xb + (size_t)(row0 + r) * DM);
#pragma unroll
    for (int i = 0; i < 4; ++i) {
      u32x2 o = {pack_bf2(v[r][i][0], v[r][i][1]), pack_bf2(v[r][i][2], v[r][i][3])};
      dst[lane + 64 * i] = o;
    }
  }
}

constexpr int TJ_WIN = 1024, TJ_WA = 128, TJ_WO = 256, TJ_W1 = 1024, TJ_W2 = 1024, TJ_C1 = 128, TJ_C2 = 16;
constexpr int TJ_TOTAL = TJ_WIN + TJ_WA + TJ_WO + TJ_W1 + TJ_W2 + 2 * TJ_C1 + 2 * TJ_C2;

constexpr int TJ_EARLY = TJ_WIN + 2 * TJ_C1 + 2 * TJ_C2;
DI void p0_transpose(const Params& p, int item, char* smem, int base) {
  const int half = threadIdx.x >> 8, tid = threadIdx.x & 255;
  int idx = item * 2 + half + base;
  const float* src; u16* dst; const float* scale = nullptr; int K, N, kind = 0;
  if (idx < TJ_WIN) { src = p.w_in; dst = p.w_in_t; scale = p.norm_mix; K = 1024; N = 3864; kind = 1; }
  else if ((idx -= TJ_WIN) < TJ_C1) { src = p.ck_w1; dst = p.cw1_t; K = 2048; N = 256; }
  else if ((idx -= TJ_C1) < TJ_C1) { src = p.cv_w1; dst = p.cw1_t + 256 * 2048; K = 2048; N = 256; }
  else if ((idx -= TJ_C1) < TJ_C2) { src = p.ck_w2; dst = p.cw2_t; K = 256; N = 64; }
  else if ((idx -= TJ_C2) < TJ_C2) { src = p.cv_w2; dst = p.cw2_t + 256 * 256; K = 256; N = 64; }
  else if ((idx -= TJ_C2) < TJ_WA) { src = p.w_ba; dst = p.wa_t; K = 512; N = 1024; }
  else if ((idx -= TJ_WA) < TJ_WO) { src = p.w_out; dst = p.wo_t; K = 1024; N = 1024; }
  else if ((idx -= TJ_WO) < TJ_W1) { src = p.w_ff1; dst = p.w1_t; scale = p.norm_mlp; K = 1024; N = 4096; }
  else { idx -= TJ_W1; src = p.w_ff2; dst = p.w2_t; K = 4096; N = 1024; kind = 2; }
  const int nk = K >> 6;
  const int k0 = (idx % nk) * 64, n0 = (idx / nk) * 64;
  float* tile = (float*)(smem + half * 16640);
  __syncthreads();
#pragma unroll
  for (int i = 0; i < 4; ++i) {
    const int kk = (tid >> 4) + 16 * i, nn = (tid & 15) * 4;
    const int nd = n0 + nn;
    int sc;
    if (kind == 1) sc = nd < 1280 ? nd : (nd < 3840 ? nd + 24 : (nd < 3864 ? nd - 2560 : -1));
    else sc = nd < N ? nd : -1;
    float4 v = make_float4(0.f, 0.f, 0.f, 0.f);
    if (sc >= 0) v = *(const float4*)(src + (size_t)(k0 + kk) * N + sc);
    if (scale) { float s = scale[k0 + kk]; v.x *= s; v.y *= s; v.z *= s; v.w *= s; }
    tile[kk * 65 + nn + 0] = v.x; tile[kk * 65 + nn + 1] = v.y; tile[kk * 65 + nn + 2] = v.z; tile[kk * 65 + nn + 3] = v.w;
  }
  __syncthreads();
  {
    const int n = tid >> 2, kq = (tid & 3) * 16;
    unsigned o[8];
#pragma unroll
    for (int j = 0; j < 8; ++j) o[j] = pack_bf2(tile[(kq + 2 * j) * 65 + n], tile[(kq + 2 * j + 1) * 65 + n]);
    u32x4* d = (kind == 2) ? (u32x4*)(dst + ((size_t)(k0 >> 6) * 1024 + (n0 + n)) * 64 + kq)
                           : (u32x4*)(dst + (size_t)(n0 + n) * K + k0 + kq);
    u32x4 o0 = {o[0], o[1], o[2], o[3]}, o1 = {o[4], o[5], o[6], o[7]};
    d[0] = o0; d[1] = o1;
  }
}

DI void p0_weff(const Params& p, int item, char* smem) {
  const int g = item >> 4, n0 = (item & 15) * 64, tid = threadIdx.x;
  float* pw = (float*)smem;
  float* ws = (float*)(smem + 66048);
  __syncthreads();
  for (int e = tid; e < 128 * 128; e += NTHR) { const int c = e >> 7, d = e & 127; pw[c * 129 + d] = p.pool_w[(size_t)g * 16384 + e] * p.pool_scale[g * 128 + d]; }
  for (int e = tid; e < 128 * 64; e += NTHR) { const int d = e >> 6, n = e & 63; ws[e] = p.w_bp[(size_t)(g * 128 + d) * 1024 + n0 + n]; }
  __syncthreads();
  const int c = tid & 127, nq = (tid >> 7) * 16;
  float a[16];
#pragma unroll
  for (int j = 0; j < 16; ++j) a[j] = 0.f;
  for (int d = 0; d < 128; ++d) {
    const float w = pw[c * 129 + d];
#pragma unroll
    for (int j = 0; j < 16; ++j) a[j] += w * ws[d * 64 + nq + j];
  }
#pragma unroll
  for (int j = 0; j < 16; ++j) p.wbe_t[(size_t)(n0 + nq + j) * 512 + g * 128 + c] = (u16)(pack_bf2(a[j], 0.f) & 0xffffu);
}

DI void p0_cbias(const Params& p, int idx, char* smem) {
  const int kv = idx >> 3, nc = idx & 7, tid = threadIdx.x, n = tid & 31, part = tid >> 5;
  const float* pe = kv ? p.pe_v : p.pe_k;
  const float* w1 = kv ? p.cv_w1 : p.ck_w1;
  float s = 0.f;
  for (int k = part * 128; k < part * 128 + 128; ++k) s += pe[k] * w1[(size_t)k * 256 + nc * 32 + n];
  float* red = (float*)smem;
  __syncthreads();
  red[part * 32 + n] = s;
  __syncthreads();
  if (tid < 32) {
    float t = 0.f;
#pragma unroll
    for (int j = 0; j < 16; ++j) t += red[j * 32 + tid];
    p.cbias[kv * 256 + nc * 32 + tid] = t;
  }
}

DI void p0_rope(const Params& p, int idx) {
  const int e = idx * NTHR + threadIdx.x;
  const int pos = e >> 3, i = e & 7;
  const float inv = powf(500000.0f, -(float)(2 * i) / 16.0f);
  const float ang = (float)pos * inv;
  float sn, cs;
  sincosf(ang, &sn, &cs);
  p.rope[e] = make_float2(cs, sn);
}

DI void p2a_pool_item(const Params& p, int item) {
  const int idx = item * NTHR + threadIdx.x;
  const int t = idx >> 6, ch = (idx & 63) * 8;
  const int grp = ch >> 7, wlen = 2 << grp, s = t & (SEQ - 1);
  const int cnt = min(s + 1, wlen);
  float a[8];
#pragma unroll
  for (int j = 0; j < 8; ++j) a[j] = 0.f;
  const u16* base = p.ub + (size_t)t * 512 + ch;
  u32x4 v[16];
#pragma unroll
  for (int k = 0; k < 16; ++k) { v[k] = (u32x4){0u, 0u, 0u, 0u}; if (k < cnt) v[k] = *(const u32x4*)(base - (size_t)k * 512); }
  const u32x4 cur = v[0];
#pragma unroll
  for (int k = 0; k < 16; ++k) {
#pragma unroll
    for (int j = 0; j < 4; ++j) { a[2 * j] += bf_lo(v[k][j]); a[2 * j + 1] += bf_hi(v[k][j]); }
  }
  const float ic = 1.f / (float)cnt;
  u32x4 o;
#pragma unroll
  for (int j = 0; j < 4; ++j) o[j] = pack_bf2(a[2 * j] * ic - bf_lo(cur[j]), a[2 * j + 1] * ic - bf_hi(cur[j]));
  *(u32x4*)(p.pooled + (size_t)t * 512 + ch) = o;
}

constexpr int AT_P = 65536, AT_S = 98304, AT_M = 131072;
template <int MODE>
DI void attn_tiles(const u16* __restrict__ Kg, const u16* __restrict__ Vg, int j0, int j1, char* smem,
                   const bf16x8 (&qf)[4], float& m, float& l, f32x16 (&O)[2], int lo, int hi, int lo_max, int hi_min,
                   unsigned mlo, unsigned mhi, float inv_l, int tok_l, int tid) {
  const int lane = tid & 63, l31 = lane & 31, h = lane >> 5;
  const int lk = tid >> 3, lc = tid & 7;
  const int kwr = lk * 128 + ((lc ^ ((lk >> 1) & 7)) << 4);
  const int vwr = 16384 + (lc >> 2) * 4096 + lk * 64 + (lc & 3) * 16;
  const int f = (l31 >> 1) & 7;
  const int krd = l31 * 128;
  int kx[4];
#pragma unroll
  for (int ks = 0; ks < 4; ++ks) kx[ks] = ((2 * ks + h) ^ f) << 4;
  const lds_cptr vrd = (lds_cptr)smem + 16384 + ((lane >> 4) & 1) * 32 + (lane & 3) * 8 + (4 * h + ((lane & 15) >> 2)) * 64;
  const int goff = lk * 64 + lc * 8;
  u32x4 rk, rv;
  rk = *(const u32x4*)(Kg + (size_t)j0 * 4096 + goff);
  if (MODE != 0) rv = *(const u32x4*)(Vg + (size_t)j0 * 4096 + goff);
  for (int j = j0; j <= j1; ++j) {
    const int bo = ((j - j0) & 1) * 8192;
    *(u32x4*)(smem + bo + kwr) = rk;
    if (MODE != 0) *(u32x4*)(smem + bo + vwr) = rv;
    __syncthreads();
    if (j < j1) {
      rk = *(const u32x4*)(Kg + (size_t)(j + 1) * 4096 + goff);
      if (MODE != 0) rv = *(const u32x4*)(Vg + (size_t)(j + 1) * 4096 + goff);
    }
    bool bit = true;
    if (MODE == 2) {
      bit = ((j < 32 ? (mlo >> j) : (mhi >> (j - 32))) & 1u) != 0;
      if (__ballot(bit) == 0ull) continue;
    }
    f32x16 s0 = zero16(), s1 = zero16();
#pragma unroll
    for (int ks = 0; ks < 4; ++ks) {
      bf16x8 a0 = *(const bf16x8*)(smem + bo + krd + kx[ks]);
      bf16x8 a1 = *(const bf16x8*)(smem + bo + krd + 4096 + kx[ks]);
      s0 = mfma32(a0, qf[ks], s0);
      s1 = mfma32(a1, qf[ks], s1);
    }
    const bool need_mask = (64 * j < lo_max) || (64 * j + 63 > hi_min);
    const int rlo = lo - 64 * j - 4 * h, span = hi - lo;
    if (need_mask) {
#pragma unroll
      for (int i = 0; i < 16; ++i) {
        const int c0 = 8 * (i >> 2) + (i & 3);
        if ((unsigned)(c0 - rlo) > (unsigned)span || span < 0) s0[i] = NEGF;
        if ((unsigned)(c0 + 32 - rlo) > (unsigned)span || span < 0) s1[i] = NEGF;
      }
    }
    float msub;
    if (MODE == 1) {
      msub = m;
    } else {
      float mx = s0[0];
#pragma unroll
      for (int i = 1; i < 16; ++i) mx = fmaxf(mx, s0[i]);
#pragma unroll
      for (int i = 0; i < 16; ++i) mx = fmaxf(mx, s1[i]);
      mx = fmaxf(mx, __shfl_xor(mx, 32));
      if (MODE == 2) mx = bit ? mx : NEGF;
      const float mn = fmaxf(m, mx);
      const float alpha = __builtin_amdgcn_exp2f(m - mn);
      m = mn;
      l *= alpha;
      if (MODE != 0) {
        if (__ballot(alpha != 1.f) != 0ull) {
#pragma unroll
          for (int i = 0; i < 16; ++i) { O[0][i] *= alpha; O[1][i] *= alpha; }
        }
      }
      msub = (MODE == 2 && !bit) ? 1e30f : mn;
    }
    msub = fmaxf(msub, -1e29f);
    float rs = 0.f;
#pragma unroll
    for (int i = 0; i < 16; ++i) {
      float p0 = __builtin_amdgcn_exp2f(s0[i] - msub), p1 = __builtin_amdgcn_exp2f(s1[i] - msub);
      if (MODE == 1) { p0 *= inv_l; p1 *= inv_l; }
      s0[i] = p0; s1[i] = p1;
      rs += p0 + p1;
    }
    l += rs;
    if (MODE == 0) continue;
    if (MODE == 1) {
      float* ps = (float*)(smem + AT_P) + tok_l * 256 + 64 * j + 4 * h;
#pragma unroll
      for (int gq = 0; gq < 4; ++gq) {
        float4 a, b;
        float t;
        t = s0[4 * gq + 0]; t += __shfl_xor(t, 1); t += __shfl_xor(t, 2); a.x = t;
        t = s0[4 * gq + 1]; t += __shfl_xor(t, 1); t += __shfl_xor(t, 2); a.y = t;
        t = s0[4 * gq + 2]; t += __shfl_xor(t, 1); t += __shfl_xor(t, 2); a.z = t;
        t = s0[4 * gq + 3]; t += __shfl_xor(t, 1); t += __shfl_xor(t, 2); a.w = t;
        t = s1[4 * gq + 0]; t += __shfl_xor(t, 1); t += __shfl_xor(t, 2); b.x = t;
        t = s1[4 * gq + 1]; t += __shfl_xor(t, 1); t += __shfl_xor(t, 2); b.y = t;
        t = s1[4 * gq + 2]; t += __shfl_xor(t, 1); t += __shfl_xor(t, 2); b.z = t;
        t = s1[4 * gq + 3]; t += __shfl_xor(t, 1); t += __shfl_xor(t, 2); b.w = t;
        if ((l31 & 3) == 0) { *(float4*)(ps + 8 * gq) = a; *(float4*)(ps + 32 + 8 * gq) = b; }
      }
    }
#pragma unroll
    for (int s4 = 0; s4 < 4; ++s4) {
      u32x4 pk;
      if (s4 < 2) {
#pragma unroll
        for (int jj = 0; jj < 4; ++jj) pk[jj] = pack_bf2(s0[8 * (s4 & 1) + 2 * jj], s0[8 * (s4 & 1) + 2 * jj + 1]);
      } else {
#pragma unroll
        for (int jj = 0; jj < 4; ++jj) pk[jj] = pack_bf2(s1[8 * (s4 & 1) + 2 * jj], s1[8 * (s4 & 1) + 2 * jj + 1]);
      }
      const bf16x8 pb = __builtin_bit_cast(bf16x8, pk);
#pragma unroll
      for (int dt = 0; dt < 2; ++dt) {
        s16x4 vlo = vtr(vrd + bo + dt * 4096 + s4 * 1024);
        s16x4 vhi = vtr(vrd + bo + dt * 4096 + s4 * 1024 + 512);
        bf16x8 vf = __builtin_shufflevector(vlo, vhi, 0, 1, 2, 3, 4, 5, 6, 7);
        O[dt] = mfma32(vf, pb, O[dt]);
      }
    }
  }
  __syncthreads();
}

template <int MODE>
DI void attn_tiles_pipe(const u16* __restrict__ Kg, const u16* __restrict__ Vg, int j0, int j1, char* smem,
                        const bf16x8 (&qf)[4], float& m, float& l, f32x16 (&O)[2], int lo, int hi, int lo_max, int hi_min,
                        unsigned mlo, unsigned mhi, int tid) {
  const int lane = tid & 63, l31 = lane & 31, h = lane >> 5;
  const int lk = tid >> 3, lc = tid & 7;
  const int kwr = lk * 128 + ((lc ^ ((lk >> 1) & 7)) << 4);
  const int vwr = 16384 + (lc >> 2) * 4096 + lk * 64 + (lc & 3) * 16;
  const int f = (l31 >> 1) & 7;
  const int krd = l31 * 128;
  int kx[4];
#pragma unroll
  for (int ks = 0; ks < 4; ++ks) kx[ks] = ((2 * ks + h) ^ f) << 4;
  const lds_cptr vrd = (lds_cptr)smem + 16384 + ((lane >> 4) & 1) * 32 + (lane & 3) * 8 + (4 * h + ((lane & 15) >> 2)) * 64;
  const int goff = lk * 64 + lc * 8;
  u32x4 rk, rv;
  auto qk_tile = [&](int bufoff, f32x16& d0, f32x16& d1) __attribute__((always_inline)) {
    bf16x8 ka[4], kb[4];
#pragma unroll
    for (int ks = 0; ks < 4; ++ks) { ka[ks] = *(const bf16x8*)(smem + bufoff + krd + kx[ks]); kb[ks] = *(const bf16x8*)(smem + bufoff + krd + 4096 + kx[ks]); }
    d0 = mfma32(ka[0], qf[0], zero16()); d1 = mfma32(kb[0], qf[0], zero16());
#pragma unroll
    for (int ks = 1; ks < 4; ++ks) { d0 = mfma32(ka[ks], qf[ks], d0); d1 = mfma32(kb[ks], qf[ks], d1); }
  };
  auto active = [&](int j) __attribute__((always_inline)) -> bool {
    if (MODE != 2) return true;
    const bool b = ((j < 32 ? (mlo >> j) : (mhi >> (j - 32))) & 1u) != 0;
    return __ballot(b) != 0ull;
  };
  auto step = [&](int j, bool act_c, bool& act_n, f32x16& c0, f32x16& c1, f32x16& n0, f32x16& n1) __attribute__((always_inline)) {
    const int par = (j - j0) & 1;
    const int bo = par * 8192, bn = (par ^ 1) * 8192;
    if (j < j1) *(u32x4*)(smem + bn + kwr) = rk;
    *(u32x4*)(smem + bo + vwr) = rv;
    __syncthreads();
    if (j + 2 <= j1) rk = *(const u32x4*)(Kg + (size_t)(j + 2) * 4096 + goff);
    if (j + 1 <= j1) rv = *(const u32x4*)(Vg + (size_t)(j + 1) * 4096 + goff);
    act_n = false;
    if (j < j1) { act_n = active(j + 1); if (act_n) qk_tile(bn, n0, n1); }
    if (!act_c) return;
    bool bit = true;
    if (MODE == 2) bit = ((j < 32 ? (mlo >> j) : (mhi >> (j - 32))) & 1u) != 0;
    const bool need_mask = (64 * j < lo_max) || (64 * j + 63 > hi_min);
    if (need_mask) {
      const int rlo = lo - 64 * j - 4 * h, span = hi - lo;
#pragma unroll
      for (int i = 0; i < 16; ++i) {
        const int cc = 8 * (i >> 2) + (i & 3);
        if ((unsigned)(cc - rlo) > (unsigned)span || span < 0) c0[i] = NEGF;
        if ((unsigned)(cc + 32 - rlo) > (unsigned)span || span < 0) c1[i] = NEGF;
      }
    }
    float mx = c0[0];
#pragma unroll
    for (int i = 1; i < 16; ++i) mx = fmaxf(mx, c0[i]);
#pragma unroll
    for (int i = 0; i < 16; ++i) mx = fmaxf(mx, c1[i]);
    mx = fmaxf(mx, __shfl_xor(mx, 32));
    if (MODE == 2) mx = bit ? mx : NEGF;
    const float mn = fmaxf(m, mx);
    const float alpha = __builtin_amdgcn_exp2f(m - mn);
    m = mn;
    l *= alpha;
    if (__ballot(alpha != 1.f) != 0ull) {
#pragma unroll
      for (int i = 0; i < 16; ++i) { O[0][i] *= alpha; O[1][i] *= alpha; }
    }
    const float msub = (MODE == 2 && !bit) ? 1e30f : fmaxf(mn, -1e29f);
    bf16x8 vf[4][2];
#pragma unroll
    for (int s4 = 0; s4 < 4; ++s4)
#pragma unroll
      for (int dt = 0; dt < 2; ++dt) {
        s16x4 vlo = vtr(vrd + bo + dt * 4096 + s4 * 1024);
        s16x4 vhi = vtr(vrd + bo + dt * 4096 + s4 * 1024 + 512);
        vf[s4][dt] = __builtin_shufflevector(vlo, vhi, 0, 1, 2, 3, 4, 5, 6, 7);
      }
    float rs = 0.f;
#pragma unroll
    for (int i = 0; i < 16; ++i) {
      const float p0 = __builtin_amdgcn_exp2f(c0[i] - msub), p1 = __builtin_amdgcn_exp2f(c1[i] - msub);
      c0[i] = p0; c1[i] = p1;
      rs += p0 + p1;
    }
    l += rs;
#pragma unroll
    for (int s4 = 0; s4 < 4; ++s4) {
      u32x4 pk;
      if (s4 < 2) {
#pragma unroll
        for (int jj = 0; jj < 4; ++jj) pk[jj] = pack_bf2(c0[8 * (s4 & 1) + 2 * jj], c0[8 * (s4 & 1) + 2 * jj + 1]);
      } else {
#pragma unroll
        for (int jj = 0; jj < 4; ++jj) pk[jj] = pack_bf2(c1[8 * (s4 & 1) + 2 * jj], c1[8 * (s4 & 1) + 2 * jj + 1]);
      }
      const bf16x8 pb = __builtin_bit_cast(bf16x8, pk);
      O[0] = mfma32(vf[s4][0], pb, O[0]);
      O[1] = mfma32(vf[s4][1], pb, O[1]);
    }
  };
  rk = *(const u32x4*)(Kg + (size_t)j0 * 4096 + goff);
  rv = *(const u32x4*)(Vg + (size_t)j0 * 4096 + goff);
  *(u32x4*)(smem + kwr) = rk;
  if (j0 < j1) rk = *(const u32x4*)(Kg + (size_t)(j0 + 1) * 4096 + goff);
  __syncthreads();
  f32x16 a0, a1, b0, b1;
  bool actA = true, actB = false;
  qk_tile(0, a0, a1);
  for (int j = j0; j <= j1; j += 2) {
    step(j, actA, actB, a0, a1, b0, b1);
    if (j + 1 <= j1) step(j + 1, actB, actA, b0, b1, a0, a1);
  }
  __syncthreads();
}

constexpr int RING = 6;
DI void glds16(const u16* g, char* lds) {
  __builtin_amdgcn_global_load_lds((const unsigned*)g, (LAS unsigned*)lds, 16, 0, 0);
}
template <int MODE>
DI void attn_tiles_ring(const u16* __restrict__ Kg, const u16* __restrict__ Vg, int j0, int j1, char* smem,
                        const bf16x8 (&qf)[4], float& m, float& l, f32x16 (&O)[2], int lo, int hi, int lo_max, int hi_min,
                        unsigned mlo, unsigned mhi, int tid) {
  const int lane = tid & 63, l31 = lane & 31, h = lane >> 5;
  const int f = (l31 >> 1) & 7;
  const int krd = l31 * 128;
  int kx[4];
#pragma unroll
  for (int ks = 0; ks < 4; ++ks) kx[ks] = ((2 * ks + h) ^ f) << 4;
  const int vrdo = 8192 + ((lane >> 4) & 1) * 32 + (lane & 3) * 8 + (4 * h + ((lane & 15) >> 2)) * 64;
  const lds_cptr lbase = (lds_cptr)smem;
  const int ksrc = (tid >> 3) * 64 + (((tid & 7) ^ (((tid >> 3) >> 1) & 7)) << 3);
  const int vsrc = ((tid >> 2) & 63) * 64 + (((tid >> 8) * 4 + (tid & 3)) << 3);
  const int dma = tid * 16;
  auto issue = [&](int t, int st) __attribute__((always_inline)) {
    const int tc = t < j1 ? t : j1;
    glds16(Kg + (size_t)tc * 4096 + ksrc, smem + st * 16384 + dma);
    glds16(Vg + (size_t)tc * 4096 + vsrc, smem + st * 16384 + 8192 + dma);
  };
  auto qk_tile = [&](int st, f32x16& d0, f32x16& d1) __attribute__((always_inline)) {
    const char* kb_ = smem + st * 16384;
    bf16x8 ka[4], kb[4];
#pragma unroll
    for (int ks = 0; ks < 4; ++ks) { ka[ks] = *(const bf16x8*)(kb_ + krd + kx[ks]); kb[ks] = *(const bf16x8*)(kb_ + krd + 4096 + kx[ks]); }
    d0 = mfma32(ka[0], qf[0], zero16()); d1 = mfma32(kb[0], qf[0], zero16());
#pragma unroll
    for (int ks = 1; ks < 4; ++ks) { d0 = mfma32(ka[ks], qf[ks], d0); d1 = mfma32(kb[ks], qf[ks], d1); }
  };
  auto active = [&](int j) __attribute__((always_inline)) -> bool {
    if (MODE != 2) return true;
    const bool b = ((j < 32 ? (mlo >> j) : (mhi >> (j - 32))) & 1u) != 0;
    return __ballot(b) != 0ull;
  };
  int st_cur = 0, st_iss = 5;
  auto step = [&](int j, bool act_c, bool& act_n, f32x16& c0, f32x16& c1, f32x16& n0, f32x16& n1) __attribute__((always_inline)) {
    asm volatile("s_waitcnt vmcnt(6)" ::: "memory");
    __builtin_amdgcn_s_barrier();
    issue(j + 5, st_iss);
    const int st_nxt = (st_cur == RING - 1) ? 0 : st_cur + 1;
    act_n = false;
    if (j < j1) { act_n = active(j + 1); if (act_n) qk_tile(st_nxt, n0, n1); }
    if (act_c) {
      bool bit = true;
      if (MODE == 2) bit = ((j < 32 ? (mlo >> j) : (mhi >> (j - 32))) & 1u) != 0;
      const bool need_mask = (64 * j < lo_max) || (64 * j + 63 > hi_min);
      if (need_mask) {
        const int rlo = lo - 64 * j - 4 * h, span = hi - lo;
#pragma unroll
        for (int i = 0; i < 16; ++i) {
          const int cc = 8 * (i >> 2) + (i & 3);
          if ((unsigned)(cc - rlo) > (unsigned)span || span < 0) c0[i] = NEGF;
          if ((unsigned)(cc + 32 - rlo) > (unsigned)span || span < 0) c1[i] = NEGF;
        }
      }
      float mx = c0[0];
#pragma unroll
      for (int i = 1; i < 16; ++i) mx = fmaxf(mx, c0[i]);
#pragma unroll
      for (int i = 0; i < 16; ++i) mx = fmaxf(mx, c1[i]);
      mx = fmaxf(mx, __shfl_xor(mx, 32));
      if (MODE == 2) mx = bit ? mx : NEGF;
      const float mn = fmaxf(m, mx);
      const float alpha = __builtin_amdgcn_exp2f(m - mn);
      m = mn;
      l *= alpha;
      if (__ballot(alpha != 1.f) != 0ull) {
#pragma unroll
        for (int i = 0; i < 16; ++i) { O[0][i] *= alpha; O[1][i] *= alpha; }
      }
      const float msub = (MODE == 2 && !bit) ? 1e30f : fmaxf(mn, -1e29f);
      const lds_cptr vb = lbase + st_cur * 16384 + vrdo;
      bf16x8 vf[4][2];
#pragma unroll
      for (int s4 = 0; s4 < 4; ++s4)
#pragma unroll
        for (int dt = 0; dt < 2; ++dt) {
          s16x4 vlo = vtr(vb + dt * 4096 + s4 * 1024);
          s16x4 vhi = vtr(vb + dt * 4096 + s4 * 1024 + 512);
          vf[s4][dt] = __builtin_shufflevector(vlo, vhi, 0, 1, 2, 3, 4, 5, 6, 7);
        }
      float rs = 0.f;
#pragma unroll
      for (int i = 0; i < 16; ++i) {
        const float p0 = __builtin_amdgcn_exp2f(c0[i] - msub), p1 = __builtin_amdgcn_exp2f(c1[i] - msub);
        c0[i] = p0; c1[i] = p1;
        rs += p0 + p1;
      }
      l += rs;
#pragma unroll
      for (int s4 = 0; s4 < 4; ++s4) {
        u32x4 pk;
        if (s4 < 2) {
#pragma unroll
          for (int jj = 0; jj < 4; ++jj) pk[jj] = pack_bf2(c0[8 * (s4 & 1) + 2 * jj], c0[8 * (s4 & 1) + 2 * jj + 1]);
        } else {
#pragma unroll
          for (int jj = 0; jj < 4; ++jj) pk[jj] = pack_bf2(c1[8 * (s4 & 1) + 2 * jj], c1[8 * (s4 & 1) + 2 * jj + 1]);
        }
        const bf16x8 pb = __builtin_bit_cast(bf16x8, pk);
        O[0] = mfma32(vf[s4][0], pb, O[0]);
        O[1] = mfma32(vf[s4][1], pb, O[1]);
      }
    }
    st_cur = st_nxt;
    st_iss = (st_iss == RING - 1) ? 0 : st_iss + 1;
  };
#pragma unroll
  for (int i = 0; i < 5; ++i) issue(j0 + i, i);
  asm volatile("s_waitcnt vmcnt(8)" ::: "memory");
  __builtin_amdgcn_s_barrier();
  f32x16 a0, a1, b0, b1;
  bool actA = true, actB = false;
  qk_tile(0, a0, a1);
  for (int j = j0; j <= j1; j += 2) {
    step(j, actA, actB, a0, a1, b0, b1);
    if (j + 1 <= j1) step(j + 1, actB, actA, b0, b1, a0, a1);
  }
  asm volatile("s_waitcnt vmcnt(0)" ::: "memory");
  __syncthreads();
}

DI void attn_cmp(const u16* __restrict__ Kc, const u16* __restrict__ Vc, int nct, char* smem, const bf16x8 (&qf)[4],
                 f32x16 (&O)[2], int hi, int hi_min, int tok_l, int tid) {
  const int lane = tid & 63, l31 = lane & 31, h = lane >> 5;
  const int f = (l31 >> 1) & 7;
  const int krd = l31 * 128;
  int kx[4];
#pragma unroll
  for (int ks = 0; ks < 4; ++ks) kx[ks] = ((2 * ks + h) ^ f) << 4;
  const int vrdo = 8192 + ((lane >> 4) & 1) * 32 + (lane & 3) * 8 + (4 * h + ((lane & 15) >> 2)) * 64;
  const lds_cptr lbase = (lds_cptr)smem;
  const int ksrc = (tid >> 3) * 64 + (((tid & 7) ^ (((tid >> 3) >> 1) & 7)) << 3);
  const int vsrc = ((tid >> 2) & 63) * 64 + (((tid >> 8) * 4 + (tid & 3)) << 3);
#pragma unroll
  for (int t = 0; t < 4; ++t) {
    const int tc = t < nct ? t : nct - 1;
    glds16(Kc + (size_t)tc * 4096 + ksrc, smem + t * 16384 + tid * 16);
    glds16(Vc + (size_t)tc * 4096 + vsrc, smem + t * 16384 + 8192 + tid * 16);
  }
  asm volatile("s_waitcnt vmcnt(0)" ::: "memory");
  __syncthreads();
  f32x16 S[4][2];
  float mx = NEGF;
#pragma unroll
  for (int t = 0; t < 4; ++t) {
    if (t < nct) {
      const char* kb_ = smem + t * 16384;
      bf16x8 ka[4], kb[4];
#pragma unroll
      for (int ks = 0; ks < 4; ++ks) { ka[ks] = *(const bf16x8*)(kb_ + krd + kx[ks]); kb[ks] = *(const bf16x8*)(kb_ + krd + 4096 + kx[ks]); }
      S[t][0] = mfma32(ka[0], qf[0], zero16()); S[t][1] = mfma32(kb[0], qf[0], zero16());
#pragma unroll
      for (int ks = 1; ks < 4; ++ks) { S[t][0] = mfma32(ka[ks], qf[ks], S[t][0]); S[t][1] = mfma32(kb[ks], qf[ks], S[t][1]); }
      if (64 * t + 63 > hi_min) {
        const int rhi = hi - 64 * t - 4 * h;
#pragma unroll
        for (int i = 0; i < 16; ++i) {
          const int cc = 8 * (i >> 2) + (i & 3);
          if (cc > rhi) S[t][0][i] = NEGF;
          if (cc + 32 > rhi) S[t][1][i] = NEGF;
        }
      }
#pragma unroll
      for (int i = 0; i < 16; ++i) mx = fmaxf(mx, fmaxf(S[t][0][i], S[t][1][i]));
    }
  }
  mx = fmaxf(mx, __shfl_xor(mx, 32));
  const float msub = fmaxf(mx, -1e29f);
  float ls = 0.f;
#pragma unroll
  for (int t = 0; t < 4; ++t)
    if (t < nct) {
#pragma unroll
      for (int i = 0; i < 16; ++i) {
        S[t][0][i] = __builtin_amdgcn_exp2f(S[t][0][i] - msub); S[t][1][i] = __builtin_amdgcn_exp2f(S[t][1][i] - msub);
        ls += S[t][0][i] + S[t][1][i];
      }
    }
  ls += __shfl_xor(ls, 32);
  const float inv_l = 1.f / fmaxf(ls, 1e-30f);
  O[0] = zero16(); O[1] = zero16();
#pragma unroll
  for (int t = 0; t < 4; ++t)
    if (t < nct) {
      f32x16& s0 = S[t][0];
      f32x16& s1 = S[t][1];
#pragma unroll
      for (int i = 0; i < 16; ++i) { s0[i] *= inv_l; s1[i] *= inv_l; }
      float* ps = (float*)(smem + AT_P) + tok_l * 256 + 64 * t + 4 * h;
#pragma unroll
      for (int gq = 0; gq < 4; ++gq) {
        float4 a, b;
        float u;
        u = s0[4 * gq + 0]; u += __shfl_xor(u, 1); u += __shfl_xor(u, 2); a.x = u;
        u = s0[4 * gq + 1]; u += __shfl_xor(u, 1); u += __shfl_xor(u, 2); a.y = u;
        u = s0[4 * gq + 2]; u += __shfl_xor(u, 1); u += __shfl_xor(u, 2); a.z = u;
        u = s0[4 * gq + 3]; u += __shfl_xor(u, 1); u += __shfl_xor(u, 2); a.w = u;
        u = s1[4 * gq + 0]; u += __shfl_xor(u, 1); u += __shfl_xor(u, 2); b.x = u;
        u = s1[4 * gq + 1]; u += __shfl_xor(u, 1); u += __shfl_xor(u, 2); b.y = u;
        u = s1[4 * gq + 2]; u += __shfl_xor(u, 1); u += __shfl_xor(u, 2); b.z = u;
        u = s1[4 * gq + 3]; u += __shfl_xor(u, 1); u += __shfl_xor(u, 2); b.w = u;
        if ((l31 & 3) == 0) { *(float4*)(ps + 8 * gq) = a; *(float4*)(ps + 32 + 8 * gq) = b; }
      }
      const lds_cptr vb = lbase + t * 16384 + vrdo;
#pragma unroll
      for (int s4 = 0; s4 < 4; ++s4) {
        u32x4 pk;
        if (s4 < 2) {
#pragma unroll
          for (int jj = 0; jj < 4; ++jj) pk[jj] = pack_bf2(s0[8 * (s4 & 1) + 2 * jj], s0[8 * (s4 & 1) + 2 * jj + 1]);
        } else {
#pragma unroll
          for (int jj = 0; jj < 4; ++jj) pk[jj] = pack_bf2(s1[8 * (s4 & 1) + 2 * jj], s1[8 * (s4 & 1) + 2 * jj + 1]);
        }
        const bf16x8 pb = __builtin_bit_cast(bf16x8, pk);
#pragma unroll
        for (int dt = 0; dt < 2; ++dt) {
          s16x4 vlo = vtr(vb + dt * 4096 + s4 * 1024);
          s16x4 vhi = vtr(vb + dt * 4096 + s4 * 1024 + 512);
          bf16x8 vf = __builtin_shufflevector(vlo, vhi, 0, 1, 2, 3, 4, 5, 6, 7);
          O[dt] = mfma32(vf, pb, O[dt]);
        }
      }
    }
  __syncthreads();
}

DI void attn_item(const Params& p, int bg, int qt, char* smem) {
  const int tid = opaque_tid(), lane = tid & 63, w = tid >> 6, l31 = lane & 31, h = lane >> 5;
  const int b = bg >> 1, g = bg & 1;
  const int t0 = qt * 64;
  const int tok_l = w * 8 + (l31 >> 2);
  const int tpos = t0 + tok_l;
  const int r = l31 & 3;
  const size_t tglob = (size_t)b * SEQ + tpos;
  bf16x8 qf[4];
  {
    const u16* qp = p.qb + tglob * 512 + (g * 4 + r) * 64 + h * 8;
#pragma unroll
    for (int ks = 0; ks < 4; ++ks) qf[ks] = *(const bf16x8*)(qp + ks * 16);
  }
  const float g0 = p.gate[tglob * 24 + 0 + g * 4 + r];
  const float g1 = p.gate[tglob * 24 + 8 + g * 4 + r];
  const float g2 = p.gate[tglob * 24 + 16 + g * 4 + r];
  const int cur = t0 >> 6;
  f32x16 O[2];
  float m, l;
  unsigned* stash = (unsigned*)(smem + AT_S) + w * 1024 + lane;
  {
    const u16* Kc = p.kcmp + (size_t)bg * 256 * 64;
    const u16* Vc = p.vcmp + (size_t)bg * 256 * 64;
    const int nct = ((t0 + 32) >> 10) + 1;
    const int hi = (tpos - 31) >> 4;
    const int hi_min = (t0 - 31) >> 4;
    attn_cmp(Kc, Vc, nct, smem, qf, O, hi, hi_min, tok_l, tid);
    const float* Ps = (const float*)(smem + AT_P);
    unsigned long long* Ms = (unsigned long long*)(smem + AT_M);
    const int ncv = nct * 64;
    for (int tl = 0; tl < 8; ++tl) {
      const int tokl = w * 8 + tl;
      const int j = lane;
      const float* pr = Ps + tokl * 256;
      float imp = 0.f;
      if (4 * j < ncv) {
        float4 v = *(const float4*)(pr + 4 * j);
        imp = 2.f * (v.x + v.y + v.z) + v.w;
        if (j > 0) imp += pr[4 * j - 1];
      }
      unsigned key = ((__float_as_uint(imp) & ~63u) | (unsigned)(63 - j)) + 64u;
      if (j > cur) key = (unsigned)(63 - j);
      if (j == 0 || j == cur || j == cur - 1) key = 0xFFFFFF00u | (unsigned)(63 - j);
      unsigned* kl = (unsigned*)(smem + w * 256);
      kl[lane] = key;
      int cnt = 0;
#pragma unroll
      for (int k4 = 0; k4 < 16; ++k4) {
        const u32x4 q = *(const u32x4*)(kl + 4 * k4);
        cnt += (q[0] > key) + (q[1] > key) + (q[2] > key) + (q[3] > key);
      }
      unsigned long long bal = __ballot(cnt < 16);
      if (lane == 0) Ms[tokl] = bal;
    }
  }
  __syncthreads();
  unsigned mlo, mhi;
  {
    const unsigned* Mw = (const unsigned*)(smem + AT_M);
    mlo = Mw[tok_l * 2]; mhi = Mw[tok_l * 2 + 1];
  }
#pragma unroll
  for (int i = 0; i < 8; ++i) { stash[i * 64] = pack_bf2(g0 * O[0][2 * i], g0 * O[0][2 * i + 1]); stash[(8 + i) * 64] = pack_bf2(g0 * O[1][2 * i], g0 * O[1][2 * i + 1]); }
  {
    m = NEGF; l = 0.f;
    O[0] = zero16(); O[1] = zero16();
    attn_tiles_ring<2>(p.kvb + (size_t)(2 * 16 + bg) * SEQ * 64, p.kvb + (size_t)(3 * 16 + bg) * SEQ * 64, 0, cur, smem, qf, m, l, O,
                  0, tpos, 0, t0, mlo, mhi, tid);
    const float lt = l + __shfl_xor(l, 32);
    const float sc = g1 / fmaxf(lt, 1e-30f);
#pragma unroll
    for (int i = 0; i < 8; ++i) {
      const unsigned u0 = stash[i * 64], u1 = stash[(8 + i) * 64];
      stash[i * 64] = pack_bf2(bf_lo(u0) + sc * O[0][2 * i], bf_hi(u0) + sc * O[0][2 * i + 1]);
      stash[(8 + i) * 64] = pack_bf2(bf_lo(u1) + sc * O[1][2 * i], bf_hi(u1) + sc * O[1][2 * i + 1]);
    }
  }
  {
    m = NEGF; l = 0.f;
    O[0] = zero16(); O[1] = zero16();
    const int jlo = max(t0 - 511, 0) >> 6;
    attn_tiles_ring<3>(p.kvb + (size_t)(4 * 16 + bg) * SEQ * 64, p.kvb + (size_t)(5 * 16 + bg) * SEQ * 64, jlo, cur, smem, qf, m, l, O,
                  tpos - 511, tpos, t0 + 63 - 511, t0, 0u, 0u, tid);
    const float lt = l + __shfl_xor(l, 32);
    const float sc = g2 / fmaxf(lt, 1e-30f);
#pragma unroll
    for (int i = 0; i < 8; ++i) {
      const unsigned u0 = stash[i * 64], u1 = stash[(8 + i) * 64];
      O[0][2 * i] = bf_lo(u0) + sc * O[0][2 * i]; O[0][2 * i + 1] = bf_hi(u0) + sc * O[0][2 * i + 1];
      O[1][2 * i] = bf_lo(u1) + sc * O[1][2 * i]; O[1][2 * i + 1] = bf_hi(u1) + sc * O[1][2 * i + 1];
    }
  }
  u16* op = p.ob + tglob * 512 + (g * 4 + r) * 64 + 4 * h;
#pragma unroll
  for (int dt = 0; dt < 2; ++dt)
#pragma unroll
    for (int gq = 0; gq < 4; ++gq) {
      u32x2 o = {pack_bf2(O[dt][4 * gq], O[dt][4 * gq + 1]), pack_bf2(O[dt][4 * gq + 2], O[dt][4 * gq + 3])};
      *(u32x2*)(op + dt * 32 + 8 * gq) = o;
    }
}

DI void p10_rows(const Params& p, int item) {
  const int w = threadIdx.x >> 6, lane = threadIdx.x & 63;
  const int row = item * 8 + w;
  float s = (lane < 16) ? p.ssq2[(size_t)row * 16 + lane] : 0.f;
#pragma unroll
  for (int o = 8; o; o >>= 1) s += __shfl_xor(s, o);
  s = __shfl(s, 0);
  const float rs = rsqrtf(s * (1.f / DM) + 1e-6f);
  float4* o4 = (float4*)(p.out + (size_t)row * DM);
  const float4* g4 = (const float4*)p.norm_final;
#pragma unroll
  for (int i = 0; i < 4; ++i) {
    float4 v = o4[lane + 64 * i], g = g4[lane + 64 * i];
    v.x *= rs * g.x; v.y *= rs * g.y; v.z *= rs * g.z; v.w *= rs * g.w;
    o4[lane + 64 * i] = v;
  }
}


#define XB_TMO      128
#define XB_XCNT(j)  (256  + 64 * (j))
#define XB_XSUB(j)  (1280 + 64 * (j))
#define XB_XGEN(j)  (2304 + 64 * (j))
#define XB_TOP      3328
#define XB_TOPGEN   3392
#define XCD_BAR_WORDS 3456
#define XB_SPIN_CAP (1u << 18)
DI unsigned xb_xcc_id() { return (unsigned)__builtin_amdgcn_s_getreg((3 << 11) | 20) & 0xFu; }
#define XB_SPIN(cond, bar) do { unsigned _sp = 0; while (cond) { __builtin_amdgcn_s_sleep(1); \
    if ((++_sp & 255u) == 0u) { if (xb_ld(&(bar)[XB_TMO])) break; if (_sp > XB_SPIN_CAP) { atomicAdd(&(bar)[XB_TMO], 1u); break; } } } } while (0)
struct XcdBarrier { unsigned* bar; unsigned x; volatile LAS unsigned* st; };
DI XcdBarrier xcd_barrier_post(unsigned* bar, volatile LAS unsigned* st) {
  XcdBarrier b; b.bar = bar; b.x = xb_xcc_id(); b.st = st;
  if (threadIdx.x == 0) (void)xb_add(&bar[XB_XCNT(b.x)], 1u);
  return b;
}
DI void xcd_barrier_complete(unsigned* bar, unsigned x, unsigned& nloc, unsigned& nx) {
  const unsigned G = gridDim.x * gridDim.y * gridDim.z;
  unsigned sum, cnt, mine, sp = 0u;
  for (;;) {
    sum = 0u; cnt = 0u; mine = 0u;
#pragma unroll
    for (unsigned j = 0; j < 16; ++j) { const unsigned c = xb_ld(&bar[XB_XCNT(j)]); sum += c; cnt += (c > 0u) ? 1u : 0u; mine = (j == x) ? c : mine; }
    if (sum == G) break;
    __builtin_amdgcn_s_sleep(1);
    if ((++sp & 255u) == 0u) { if (xb_ld(&bar[XB_TMO])) break; if (sp > XB_SPIN_CAP) { atomicAdd(&bar[XB_TMO], 1u); break; } }
  }
  nloc = mine > 0u ? mine : 1u; nx = cnt > 0u ? cnt : 1u;
}
DI void xcd_barrier(const XcdBarrier& b) {
  asm volatile("s_waitcnt vmcnt(0)" ::: "memory");
  __syncthreads();
  if (threadIdx.x == 0) {
    unsigned* bar = b.bar;
    __builtin_amdgcn_s_waitcnt(0);
    unsigned nloc = b.st[0], nx = b.st[1];
    if (nloc == 0u) { xcd_barrier_complete(bar, b.x, nloc, nx); b.st[0] = nloc; b.st[1] = nx; }
    const unsigned old = xb_add(&bar[XB_XSUB(b.x)], 1u);
    const unsigned gen = old / nloc;
    if (old + 1u == (gen + 1u) * nloc) {
      __builtin_amdgcn_fence(__ATOMIC_RELEASE, "agent");
      asm volatile("s_waitcnt vmcnt(0)" ::: "memory");
      const unsigned og = xb_add(&bar[XB_TOP], 1u);
      const unsigned tg = og / nx;
      if (og + 1u == (tg + 1u) * nx) xb_add(&bar[XB_TOPGEN], 1u);
      else XB_SPIN(xb_ld(&bar[XB_TOPGEN]) == tg, bar);
      __builtin_amdgcn_fence(__ATOMIC_ACQUIRE, "agent");
      xb_add(&bar[XB_XGEN(b.x)], 1u);
      asm volatile("s_waitcnt vmcnt(0)" ::: "memory");
    } else {
      XB_SPIN(xb_ld(&bar[XB_XGEN(b.x)]) == gen, bar);
      __builtin_amdgcn_fence(__ATOMIC_ACQUIRE, "agent");
      asm volatile("s_waitcnt vmcnt(0)" ::: "memory");
    }
  }
  __syncthreads();
}

__global__ void __launch_bounds__(NTHR, 2) nsa_pool_block_fwd(Params p) {
  extern __shared__ __attribute__((aligned(16))) unsigned char shm[];
  char* smem = (char*)shm;
  LAS unsigned char* lds = (LAS unsigned char*)shm;
  cg::grid_group grid = cg::this_grid();
  const int G = gridDim.x;
  const int bid = blockIdx.x;
  const int L = (G % 8 == 0) ? (bid % 8) * (G / 8) + bid / 8 : bid;
  volatile LAS unsigned* xst = (volatile LAS unsigned*)(lds + 133120);
  if (threadIdx.x < 4) xst[threadIdx.x] = 0u;
  __syncthreads();
  const XcdBarrier xb = xcd_barrier_post(p.bar, xst);

  if (PH_MASK & 1)
  {
    constexpr int N0 = 1024, N1 = N0 + TJ_EARLY / 2, N2 = N1 + 64, N3 = N2 + 16, N4 = N3 + 64;
    for (int rep = 0; rep < ((REP_MASK & 1) ? 2 : 1); ++rep)
    for (int it = N4 - 1 - bid; it >= 0; it -= G) {
      if (it < N0) p0_rows(p, it);
      else if (it < N1) p0_transpose(p, it - N0, smem, 0);
      else if (it < N2) p0_weff(p, it - N1, smem);
      else if (it < N3) p0_cbias(p, it - N2, smem);
      else p0_rope(p, it - N3);
    }
  }
  if (p.bar == nullptr) grid.sync();
  xcd_barrier(xb);
  if (PH_MASK & 2) {
    Sched S{0, G, bid};
    EpiProj E{p};
    for (int rep = 0; rep < ((REP_MASK & 2) ? 2 : 1); ++rep)
    gemm_phase(lds, Gemm{p.xb, p.w_in_t, DM, DM, DM, 128, 128}, S, E);
  }
  xcd_barrier(xb);
  if (PH_MASK & 4) for (int rep = 0; rep < ((REP_MASK & 4) ? 2 : 1); ++rep)
  {
    Sched S{2, G, bid};
    EpiCmpHid E{(float*)p.mb};
    gemm_phase(lds, Gemm{p.kvb, p.cw1_t, 1024, 2048, 512, 128, 128}, S, E);
    for (int it = bid; it < 4096; it += G) p2a_pool_item(p, it);
  }
  xcd_barrier(xb);
  if (PH_MASK & 8) {
    Sched S{3, G, bid};
    EpiCmpOut E{p};
    for (int i = 0;; ++i) {
      Unit u;
      if (!S.next(i, u)) break;
      const float* h32 = (const float*)p.mb;
      const float* bias = p.cbias + u.pn * 256;
      for (int e0 = threadIdx.x; e0 < 8192; e0 += 4 * NTHR) {
        f32x4 pv[4][4][2];
#pragma unroll
        for (int q = 0; q < 4; ++q) {
          const int e = e0 + q * NTHR, c = e >> 5, n8 = (e & 31) * 8;
#pragma unroll
          for (int ks = 0; ks < 4; ++ks) {
            const f32x4* sp = (const f32x4*)(h32 + ((size_t)((ks * 32 + u.pm) * 256 + c)) * 256 + n8);
            pv[q][ks][0] = sp[0]; pv[q][ks][1] = sp[1];
          }
        }
#pragma unroll
        for (int q = 0; q < 4; ++q) {
          const int e = e0 + q * NTHR, c = e >> 5, n8 = (e & 31) * 8;
          f32x4 v0 = *(const f32x4*)(bias + n8), v1 = *(const f32x4*)(bias + n8 + 4);
#pragma unroll
          for (int ks = 0; ks < 4; ++ks) { v0 += pv[q][ks][0]; v1 += pv[q][ks][1]; }
#pragma unroll
          for (int j = 0; j < 4; ++j) { v0[j] = gelu_tanh(v0[j]); v1[j] = gelu_tanh(v1[j]); }
          *(u32x4*)(p.hid + ((size_t)u.pm * 256 + c) * 256 + n8) = pack8(v0, v1);
        }
      }
    }
    asm volatile("s_waitcnt vmcnt(0)" ::: "memory");
    __syncthreads();
    gemm_phase(lds, Gemm{p.hid, p.cw2_t, 256, 256, 256, 128, 128}, S, E);
    { Unit u0; const bool has_unit = S.next(0, u0);
      if (G >= 256) {
        if (!has_unit) {
          const int rank = bid - (bid >> 3) - (((bid & 7) > ((bid >> 3) & 7)) ? 1 : 0);
          for (int it = rank; it < (TJ_TOTAL - TJ_EARLY) / 2; it += G - 32) p0_transpose(p, it, smem, TJ_EARLY);
        }
      } else {
        __syncthreads();
        for (int it = bid; it < (TJ_TOTAL - TJ_EARLY) / 2; it += G) p0_transpose(p, it, smem, TJ_EARLY);
      }
    }
  }
  xcd_barrier(xb);
  if (ATTN_PRIO) { if (threadIdx.x >= 256) __builtin_amdgcn_s_setprio(2); }
  if (PH_MASK & 16) for (int rep = 0; rep < ((REP_MASK & 16) ? 2 : 1); ++rep)
  if (G == 256) {
    const int x = bid & 7, j = bid >> 3;
    for (int rd = 0; rd < 4; ++rd) {
      const int idx = rd * 32 + ((rd & 1) ? (31 - j) : j);
      attn_item(p, 2 * x + (idx & 1), 63 - (idx >> 1), smem);
    }
  } else
  for (int rd = 0; rd * G < 1024; ++rd) {
    const int i = rd * G + ((rd & 1) ? (G - 1 - L) : L);
    if (i < 1024) attn_item(p, i & 15, 63 - (i >> 4), smem);
  }
  xcd_barrier(xb);
  if (ATTN_PRIO) __builtin_amdgcn_s_setprio(0);
  if (PH_MASK & 32) {
    Sched S{1, G, bid};
    EpiMerge<0> E0{p};
    EpiMerge<1> E1{p};
    for (int rep = 0; rep < ((REP_MASK & 32) ? 2 : 1); ++rep) {
    gemm_phase(lds, Gemm{p.ob, p.wa_t, 512, 512, 512, 128, 128}, S, E0);
    gemm_phase(lds, Gemm{p.pooled, p.wbe_t, 512, 512, 512, 128, 128}, S, E1);
    }
  }
  xcd_barrier(xb);
  if (PH_MASK & 64) {
    Sched S{1, G, bid};
    EpiResidBf E{p.xb, p.ssq};
    for (int rep = 0; rep < ((REP_MASK & 64) ? 2 : 1); ++rep)
    gemm_phase(lds, Gemm{p.mb, p.wo_t, DM, DM, DM, 128, 128}, S, E);
  }
  xcd_barrier(xb);
  if (PH_MASK & 128) {
    Sched S{0, G, bid};
    EpiFF1 E{p};
    for (int rep = 0; rep < ((REP_MASK & 128) ? 2 : 1); ++rep)
    gemm_phase(lds, Gemm{p.xb, p.w1_t, DM, DM, DM, 128, 128}, S, E);
  }
  xcd_barrier(xb);
#if FUSE_FINAL
  if (PH_MASK & 256) {
    Sched S{1, G, bid};
    EpiFinal E{p.out, p.xb, p.norm_final, p.ssq2, p.bar + XCD_BAR_WORDS};
    gemm_phase(lds, Gemm{p.act, p.w2_t, 64, 64, 4096, (size_t)T_TOK * 128, (size_t)1024 * 128}, S, E);
  }
#else
  if (PH_MASK & 256) {
    Sched S{1, G, bid};
    EpiResid<false> E{p.out, p.out, nullptr, p.ssq2};
    gemm_phase(lds, Gemm{p.act, p.w2_t, 64, 64, 4096, (size_t)T_TOK * 128, (size_t)1024 * 128}, S, E);
  }
  xcd_barrier(xb);
  for (int it = bid; it < 4096; it += G) p10_rows(p, it);
#endif
}

extern "C" void kernel_launch(void* const* d_in, const int* in_sizes, int n_in, void* d_out, int out_size, void* d_ws,
                              size_t ws_size, hipStream_t stream) {
  (void)in_sizes; (void)n_in; (void)out_size; (void)ws_size;
  static int grid_blocks = 0;
  if (!grid_blocks) {
    int dev = 0, cus = 0, per_cu = 0;
    (void)hipGetDevice(&dev);
    (void)hipDeviceGetAttribute(&cus, hipDeviceAttributeMultiprocessorCount, dev);
    (void)hipFuncSetAttribute((const void*)nsa_pool_block_fwd, hipFuncAttributeMaxDynamicSharedMemorySize, LDS_BYTES);
    (void)hipOccupancyMaxActiveBlocksPerMultiprocessor(&per_cu, nsa_pool_block_fwd, NTHR, LDS_BYTES);
    if (per_cu > 1) per_cu = 1;
    if (per_cu < 1) per_cu = 1;
    grid_blocks = cus * per_cu;
  }
  Params p{};
  const float* const* in = (const float* const*)d_in;
  p.x = in[0]; p.norm_mix = in[1]; p.w_in = in[2]; p.pe_k = in[3]; p.pe_v = in[4]; p.ck_w1 = in[5]; p.ck_w2 = in[6];
  p.cv_w1 = in[7]; p.cv_w2 = in[8]; p.w_ba = in[9]; p.pool_w = in[10]; p.pool_scale = in[11]; p.w_bp = in[12];
  p.w_out = in[13]; p.norm_mlp = in[14]; p.w_ff1 = in[15]; p.w_ff2 = in[16]; p.norm_final = in[17];
  p.out = (float*)d_out;
  char* ws = (char*)d_ws;
  size_t off = 0;
  auto take = [&](size_t bytes) { char* r = ws + off; off += (bytes + 255) & ~(size_t)255; return r; };
  const size_t T = T_TOK;
  p.xb = (u16*)take(T * 1024 * 2);
  p.w_in_t = (u16*)take((size_t)NPROJ * 1024 * 2);
  p.wa_t = (u16*)take(1024 * 512 * 2);
  p.wbe_t = (u16*)take(1024 * 512 * 2);
  p.wo_t = (u16*)take(1024 * 1024 * 2);
  p.w1_t = (u16*)take((size_t)4096 * 1024 * 2);
  p.w2_t = (u16*)take((size_t)4096 * 1024 * 2);
  p.cw1_t = (u16*)take(2 * 256 * 2048 * 2);
  p.cw2_t = (u16*)take(2 * 256 * 256 * 2);
  p.rstd0 = (float*)take(T * 4);
  p.cbias = (float*)take(512 * 4);
  p.rope = (float2*)take((size_t)SEQ * 8 * 8);
  p.ssq = (float*)take(T * 16 * 4);
  p.ssq2 = (float*)take(T * 16 * 4);
  p.mb = (u16*)take(T * 1024 * 2);
  char* regionD = ws + off;
  p.qb = (u16*)take(T * 512 * 2);
  p.kvb = (u16*)take((size_t)6 * 16 * SEQ * 64 * 2);
  p.gate = (float*)take(T * 24 * 4);
  p.ub = (u16*)take(T * 512 * 2);
  p.gm = (u16*)take(T * 2048 * 2);
  p.hid = (u16*)take((size_t)2 * 16 * 256 * 256 * 2);
  p.kcmp = (u16*)take(16 * 256 * 64 * 2);
  p.vcmp = (u16*)take(16 * 256 * 64 * 2);
  p.pooled = (u16*)take(T * 512 * 2);
  p.ob = (u16*)take(T * 512 * 2);
  p.bar = (unsigned*)take((XCD_BAR_WORDS + 4096) * 4);
  p.act = (u16*)regionD;
  (void)hipMemsetAsync(p.bar, 0, (XCD_BAR_WORDS + 4096) * 4, stream);
  void* args[] = {&p};
  hipError_t e = hipLaunchCooperativeKernel((void*)nsa_pool_block_fwd, dim3(grid_blocks), dim3(NTHR), args, LDS_BYTES, stream);
  if (e != hipSuccess) fprintf(stderr, "cooperative launch failed: %s (grid %d)\n", hipGetErrorString(e), grid_blocks);
}
```

```cpp
#include <hip/hip_runtime.h>
#include <hip/hip_cooperative_groups.h>
#include <stdint.h>
#include <stdio.h>
namespace cg = cooperative_groups;

#define DI __device__ __forceinline__
#define LAS __attribute__((address_space(3)))
typedef unsigned short u16;
typedef __attribute__((ext_vector_type(8))) short bf16x8;
typedef __attribute__((ext_vector_type(4))) short s16x4;
typedef __attribute__((ext_vector_type(16))) float f32x16;
typedef __attribute__((ext_vector_type(4))) float f32x4;
typedef __attribute__((ext_vector_type(4))) unsigned u32x4;
typedef __attribute__((ext_vector_type(2))) unsigned u32x2;
typedef __attribute__((ext_vector_type(2))) float f32x2;
typedef __attribute__((ext_vector_type(2))) __bf16 bf16x2_t;
typedef LAS const char* lds_cptr;

constexpr int T_TOK = 32768, SEQ = 4096, DM = 1024;
constexpr int NPROJ = 4096;
constexpr int NTHR = 512;
constexpr int LDS_BYTES = 135168;
constexpr float NEGF = -1e30f;
constexpr float QSCALE = 0.125f * 1.4426950408889634f;
#ifndef REP_MASK
#define REP_MASK 0
#endif
#ifndef ATTN_PRIO
#define ATTN_PRIO 0
#endif
#ifndef FUSE_FINAL
#define FUSE_FINAL 1
#endif
#ifndef PH_MASK
#define PH_MASK 0xffff
#endif

struct Params {
  const float *x, *norm_mix, *w_in, *pe_k, *pe_v, *ck_w1, *ck_w2, *cv_w1, *cv_w2, *w_ba, *pool_w, *pool_scale, *w_bp,
      *w_out, *norm_mlp, *w_ff1, *w_ff2, *norm_final;
  float* out;
  u16 *xb, *w_in_t, *wa_t, *wbe_t, *wo_t, *w1_t, *w2_t, *cw1_t, *cw2_t;
  float *rstd0, *cbias;
  float2* rope;
  u16 *qb, *kvb;
  float* gate;
  u16 *ub, *gm, *hid, *kcmp, *vcmp, *pooled, *ob, *mb, *act;
  float *ssq, *ssq2;
  unsigned* bar;
};

DI unsigned pack_bf2(float a, float b) {
  f32x2 v = {a, b};
  bf16x2_t r = __builtin_convertvector(v, bf16x2_t);
  return __builtin_bit_cast(unsigned, r);
}
DI float bf_lo(unsigned u) { return __uint_as_float(u << 16); }
DI float bf_hi(unsigned u) { return __uint_as_float(u & 0xffff0000u); }
DI float sigmoidf_(float v) { return __builtin_amdgcn_rcpf(1.f + __builtin_amdgcn_exp2f(-1.4426950408889634f * v)); }
DI float gelu_tanh(float x) {
  float u = 0.7978845608028654f * (x + 0.044715f * x * x * x);
  float th = 1.f - 2.f / (__expf(2.f * u) + 1.f);
  return 0.5f * x * (1.f + th);
}
DI f32x16 mfma32(bf16x8 a, bf16x8 b, f32x16 c) { return __builtin_amdgcn_mfma_f32_32x32x16_bf16(a, b, c, 0, 0, 0); }
DI int opaque_tid() { int t; asm volatile("v_mov_b32 %0, %1" : "=v"(t) : "v"((int)threadIdx.x)); return t; }
DI f32x16 zero16() { f32x16 z; for (int i = 0; i < 16; ++i) z[i] = 0.f; return z; }
DI s16x4 vtr(lds_cptr p) { return __builtin_amdgcn_ds_read_tr16_b64_v4i16((LAS s16x4*)p); }
DI u32x4 pack8(const f32x4& a, const f32x4& b) {
  u32x4 w = {pack_bf2(a[0], a[1]), pack_bf2(a[2], a[3]), pack_bf2(b[0], b[1]), pack_bf2(b[2], b[3])};
  return w;
}

constexpr int BM = 256, BK = 64, HALF = 128, HTB = HALF * BK * 2;
DI int lds_byte(int r, int c) { const int st = (r >> 4) * 2 + (c >> 5), rr = r & 15, cc = c & 31, ob = rr * 64 + cc * 2; return st * 1024 + (ob ^ (((ob >> 9) & 1) << 5)); }
DI void stage_rc(int b, int& R, int& C) { const int st = b / 1024, sb = b % 1024, swz = sb ^ (((sb >> 9) & 1) << 5); R = (st >> 1) * 16 + swz / 64; C = (st & 1) * 32 + (swz % 64) / 2; }
DI int perm32(int rho) { const int n = rho >> 4, i = rho & 15; return 8 * (i >> 2) + 4 * n + (i & 3); }

struct Unit { int pm, pn, k0; };
struct Gemm { const u16* A; const u16* Bt; int lda, ldb, K; size_t kstepA, kstepB; };

struct Sched {
  int mode, G, bid;
  DI bool next(int i, Unit& u) const {
    u.k0 = 0;
    if (mode == 2) {
      int t;
      if (G >= 256) { if (i > 0 || (bid & 1) != ((bid >> 3) & 1) || (bid >> 1) >= 128) return false; t = bid >> 1; }
      else { t = i * G + bid; if (t >= 128) return false; }
      u.pm = t >> 2; u.pn = u.pm >> 4; u.k0 = (t & 3) * 8; return true;
    }
    if (mode == 3) {
      int t;
      if (G >= 256) { t = bid >> 3; if (i > 0 || (bid & 7) != (t & 7) || t >= 32) return false; }
      else { t = i * G + bid; if (t >= 32) return false; }
      u.pm = t; u.pn = t >> 4; return true;
    }
    const int nN = mode == 0 ? 16 : 4;
    if (G == 256) {
      const int x = bid & 7, j = bid >> 3;
      if (mode == 0) { if (i >= 8) return false; u.pn = (x & 3) * 4 + (j & 3); u.pm = (x >> 2) * 64 + i * 8 + (j >> 2); return true; }
      if (i >= 2) return false; u.pn = j & 3; u.pm = x * 16 + i * 8 + (j >> 2); return true;
    }
    const int t = i * G + bid;
    if (t >= nN * 128) return false;
    u.pn = t % nN; u.pm = t / nN; return true;
  }
};

template <class Epi>
DI void gemm_phase(LAS unsigned char* lds, const Gemm g, const Sched& S, const Epi& E) {
  const int tid = opaque_tid(), wid = __builtin_amdgcn_readfirstlane(tid >> 6), lane = tid & 63, wr = wid >> 2, wc = wid & 3, fr = lane & 15, fq = lane >> 4;
  const int nt = g.K / BK;
  unsigned voffA[2], voffB[2];
#pragma unroll
  for (int i = 0; i < 2; ++i) {
    int R, C; stage_rc(tid * 16 + i * 8192, R, C);
    const int Rb = (R & ~31) + perm32(R & 31);
    voffA[i] = (unsigned)(R * g.lda + C) * 2u; voffB[i] = (unsigned)(Rb * g.ldb + C) * 2u;
  }
  const size_t kstep = g.kstepB, kstepA = g.kstepA;
  const size_t hstepA = (size_t)HALF * g.lda * 2, hstepB = (size_t)HALF * g.ldb * 2;
  const size_t tstepA = 2 * hstepA, tstepB = 2 * hstepB;
  const unsigned ldsw = (unsigned)wid * 1024u;
  const int aoff = lds_byte(wr * 64 + fr, fq * 8), boff = lds_byte(wc * 32 + fr, fq * 8);
#define PG8_SA(b, h) (((b) * 2 + (h)) * HTB)
#define PG8_SB(b, h) ((4 + (b) * 2 + (h)) * HTB)
#define PG8_STAGE(bufoff, gbase, voff) do { _Pragma("unroll") for (int _i = 0; _i < 2; ++_i) \
    __builtin_amdgcn_global_load_lds((const unsigned*)((const char*)(gbase) + (voff)[_i]), (LAS unsigned*)(lds + (bufoff) + ldsw + _i * 8192), 16, 0, 0); } while (0)
#define PG8_LDA(dst, b, h) do { _Pragma("unroll") for (int m = 0; m < 4; ++m) _Pragma("unroll") for (int k = 0; k < 2; ++k) dst[m][k] = *(const LAS bf16x8*)(lds + PG8_SA(b, h) + aoff + m * 2048 + k * 1024); } while (0)
#define PG8_LDB(dst, b, h) do { _Pragma("unroll") for (int n = 0; n < 2; ++n) _Pragma("unroll") for (int k = 0; k < 2; ++k) dst[n][k] = *(const LAS bf16x8*)(lds + PG8_SB(b, h) + boff + n * 2048 + k * 1024); } while (0)
#define PG8_MMA(ai, bj, At, Bt) do { __builtin_amdgcn_s_setprio(1); _Pragma("unroll") for (int m = 0; m < 4; ++m) _Pragma("unroll") for (int n = 0; n < 2; ++n) _Pragma("unroll") for (int k = 0; k < 2; ++k) \
    acc[ai][bj][m][n] = __builtin_amdgcn_mfma_f32_16x16x32_bf16(Bt[n][k], At[m][k], acc[ai][bj][m][n], 0, 0, 0); __builtin_amdgcn_s_setprio(0); } while (0)
#define PG8_WAIT_V(n) asm volatile("s_waitcnt vmcnt(" #n ")" ::: "memory")
#define PG8_WAIT_L(n) asm volatile("s_waitcnt lgkmcnt(" #n ")" ::: "memory")
#define PG8_BAR __builtin_amdgcn_s_barrier()
#define PG8_SCHED __builtin_amdgcn_sched_barrier(0)
  Unit cur, nxt; int ui = 0;
  if (!S.next(0, cur)) return;
  f32x4 acc[2][2][4][2];
#pragma unroll
  for (int a = 0; a < 2; ++a)
#pragma unroll
    for (int b = 0; b < 2; ++b)
#pragma unroll
      for (int m = 0; m < 4; ++m)
#pragma unroll
        for (int n = 0; n < 2; ++n) acc[a][b][m][n] = (f32x4){0.f, 0.f, 0.f, 0.f};
  bf16x8 At[4][2], B0[2][2], B1[2][2];
  const char* cA = (const char*)g.A + (size_t)cur.pm * tstepA + (size_t)cur.k0 * kstepA; const char* cB = (const char*)g.Bt + (size_t)cur.pn * tstepB + (size_t)cur.k0 * kstep;
  PG8_STAGE(PG8_SB(0, 0), cB, voffB); PG8_STAGE(PG8_SA(0, 0), cA, voffA); PG8_STAGE(PG8_SB(0, 1), cB + hstepB, voffB); PG8_STAGE(PG8_SA(0, 1), cA + hstepA, voffA);
  if (wr == 1) PG8_BAR;
  PG8_WAIT_V(4); PG8_BAR;
  PG8_STAGE(PG8_SB(1, 0), cB + kstep, voffB); PG8_STAGE(PG8_SA(1, 0), cA + kstepA, voffA); PG8_STAGE(PG8_SB(1, 1), cB + hstepB + kstep, voffB);
  PG8_WAIT_V(6); PG8_BAR;
  for (;;) {
    const bool has_next = S.next(ui + 1, nxt);
    const char* nA = has_next ? (const char*)g.A + (size_t)nxt.pm * tstepA + (size_t)nxt.k0 * kstepA : cA; const char* nB = has_next ? (const char*)g.Bt + (size_t)nxt.pn * tstepB + (size_t)nxt.k0 * kstep : cB;
    for (int t = 0; t < nt; t += 2) {
      const bool last = (t == nt - 2);
      const char* a1 = cA + (size_t)(t + 1) * kstepA;
      const char* a2 = last ? nA : cA + (size_t)(t + 2) * kstepA; const char* b2 = last ? nB : cB + (size_t)(t + 2) * kstep;
      const char* a3 = a2 + kstepA; const char* b3 = b2 + kstep;
      PG8_LDB(B0, 0, 0); PG8_SCHED; PG8_LDA(At, 0, 0); PG8_STAGE(PG8_SA(1, 1), a1 + hstepA, voffA);
      PG8_WAIT_L(8); PG8_BAR; PG8_WAIT_L(0); PG8_MMA(0, 0, At, B0); PG8_BAR; PG8_SCHED;
      PG8_LDB(B1, 0, 1); PG8_STAGE(PG8_SB(0, 0), b2, voffB);
      PG8_BAR; PG8_WAIT_L(0); PG8_MMA(0, 1, At, B1); PG8_BAR;
      PG8_LDA(At, 0, 1); PG8_STAGE(PG8_SA(0, 0), a2, voffA);
      PG8_BAR; PG8_WAIT_L(0); PG8_MMA(1, 0, At, B0); PG8_BAR; PG8_SCHED;
      PG8_STAGE(PG8_SB(0, 1), b2 + hstepB, voffB);
      PG8_WAIT_V(6); PG8_BAR; PG8_MMA(1, 1, At, B1); PG8_BAR;
      PG8_LDB(B0, 1, 0); PG8_SCHED; PG8_LDA(At, 1, 0); PG8_STAGE(PG8_SA(0, 1), a2 + hstepA, voffA);
      PG8_WAIT_L(8); PG8_BAR; PG8_WAIT_L(0); PG8_MMA(0, 0, At, B0); PG8_BAR; PG8_SCHED;
      PG8_LDB(B1, 1, 1); PG8_STAGE(PG8_SB(1, 0), b3, voffB);
      PG8_BAR; PG8_WAIT_L(0); PG8_MMA(0, 1, At, B1); PG8_BAR;
      PG8_LDA(At, 1, 1); PG8_STAGE(PG8_SA(1, 0), a3, voffA);
      PG8_BAR; PG8_WAIT_L(0); PG8_MMA(1, 0, At, B0); PG8_BAR; PG8_SCHED;
      PG8_STAGE(PG8_SB(1, 1), b3 + hstepB, voffB);
      PG8_WAIT_V(6); PG8_BAR; PG8_MMA(1, 1, At, B1); PG8_BAR;
    }
    E(acc, cur, wr, wc, fr, fq);
    if (!has_next) break;
#pragma unroll
    for (int a = 0; a < 2; ++a)
#pragma unroll
      for (int b = 0; b < 2; ++b)
#pragma unroll
        for (int m = 0; m < 4; ++m)
#pragma unroll
          for (int n = 0; n < 2; ++n) acc[a][b][m][n] = (f32x4){0.f, 0.f, 0.f, 0.f};
    cur = nxt; cA = nA; cB = nB; ++ui;
  }
  PG8_WAIT_V(0);
  if (wr == 0) PG8_BAR;
  PG8_BAR;
#undef PG8_SA
#undef PG8_SB
#undef PG8_STAGE
#undef PG8_LDA
#undef PG8_LDB
#undef PG8_MMA
#undef PG8_WAIT_V
#undef PG8_WAIT_L
#undef PG8_BAR
#undef PG8_SCHED
}

typedef f32x4 (&AccRef)[2][2][4][2];
DI unsigned xb_ld(unsigned* p)              { return __hip_atomic_load(p, __ATOMIC_RELAXED, __HIP_MEMORY_SCOPE_AGENT); }
DI unsigned xb_add(unsigned* p, unsigned v) { return __hip_atomic_fetch_add(p, v, __ATOMIC_RELAXED, __HIP_MEMORY_SCOPE_AGENT); }
#define EPI_ROWS for (int ai = 0; ai < 2; ++ai) _Pragma("unroll") for (int m = 0; m < 4; ++m)
#define EPI_ROW(u) ((u).pm * BM + ai * HALF + wr * 64 + m * 16 + fr)
#define EPI_COL(bj) ((bj) * HALF + wc * 32 + fq * 8)

DI void rope8(f32x4& v0, f32x4& v1, const float2* __restrict__ tab, int pos, int fq) {
  const f32x4* t4 = (const f32x4*)(tab + (size_t)pos * 8);
  const f32x4 c0 = t4[0], c1 = t4[1], c2 = t4[2], c3 = t4[3];
  float pv[8];
#pragma unroll
  for (int j = 0; j < 4; ++j) { pv[j] = __shfl_xor(v0[j], 16); pv[4 + j] = __shfl_xor(v1[j], 16); }
  if (fq < 2) {
    const float sg = fq ? 1.f : -1.f;
    v0[0] = v0[0] * c0[0] + sg * pv[0] * c0[1]; v0[1] = v0[1] * c0[2] + sg * pv[1] * c0[3];
    v0[2] = v0[2] * c1[0] + sg * pv[2] * c1[1]; v0[3] = v0[3] * c1[2] + sg * pv[3] * c1[3];
    v1[0] = v1[0] * c2[0] + sg * pv[4] * c2[1]; v1[1] = v1[1] * c2[2] + sg * pv[5] * c2[3];
    v1[2] = v1[2] * c3[0] + sg * pv[6] * c3[1]; v1[3] = v1[3] * c3[2] + sg * pv[7] * c3[3];
  }
}

DI void rope8t(f32x4& v0, f32x4& v1, const f32x4 (&t)[4], int fq) {
  float pv[8];
#pragma unroll
  for (int j = 0; j < 4; ++j) { pv[j] = __shfl_xor(v0[j], 16); pv[4 + j] = __shfl_xor(v1[j], 16); }
  if (fq < 2) {
    const float sg = fq ? 1.f : -1.f;
    v0[0] = v0[0] * t[0][0] + sg * pv[0] * t[0][1]; v0[1] = v0[1] * t[0][2] + sg * pv[1] * t[0][3];
    v0[2] = v0[2] * t[1][0] + sg * pv[2] * t[1][1]; v0[3] = v0[3] * t[1][2] + sg * pv[3] * t[1][3];
    v1[0] = v1[0] * t[2][0] + sg * pv[4] * t[2][1]; v1[1] = v1[1] * t[2][2] + sg * pv[5] * t[2][3];
    v1[2] = v1[2] * t[3][0] + sg * pv[6] * t[3][1]; v1[3] = v1[3] * t[3][2] + sg * pv[7] * t[3][3];
  }
}

struct EpiProj {
  const Params& p;
  DI void operator()(AccRef acc, const Unit& u, int wr, int wc, int fr, int fq) const {
    const int pn = u.pn;
    const bool roped = ((wc & 1) == 0) && (pn < 2 || pn == 3 || pn == 4);
    float rs8[8];
#pragma unroll
    EPI_ROWS rs8[ai * 4 + m] = p.rstd0[EPI_ROW(u)];
#pragma unroll
    for (int ai = 0; ai < 2; ++ai)
#pragma unroll
    for (int mh = 0; mh < 2; ++mh) {
      f32x4 tabx[2][4];
      if (roped) {
#pragma unroll
        for (int mm = 0; mm < 2; ++mm) {
          const int m = mh * 2 + mm;
          const f32x4* t4 = (const f32x4*)(p.rope + (size_t)(EPI_ROW(u) & (SEQ - 1)) * 8);
          tabx[mm][0] = t4[0]; tabx[mm][1] = t4[1]; tabx[mm][2] = t4[2]; tabx[mm][3] = t4[3];
        }
      }
#pragma unroll
      for (int mm = 0; mm < 2; ++mm) {
        const int m = mh * 2 + mm;
        const f32x4 (&tabm)[4] = tabx[mm];
        const int row = EPI_ROW(u);
        const float rs = rs8[ai * 4 + m];
        const int s = row & (SEQ - 1), b = row >> 12;
#pragma unroll
        for (int bj = 0; bj < 2; ++bj) {
          f32x4 v0 = acc[ai][bj][m][0] * rs, v1 = acc[ai][bj][m][1] * rs;
          const int lc = EPI_COL(bj);
          if (pn < 2) {
            if (roped) rope8t(v0, v1, tabm, fq);
            *(u32x4*)(p.qb + (size_t)row * 512 + pn * 256 + lc) = pack8(v0 * QSCALE, v1 * QSCALE);
          } else if (pn < 5) {
            const int which = (pn - 2) * 2 + bj;
            if ((which == 2 || which == 4) && roped) rope8t(v0, v1, tabm, fq);
            const int g = wc >> 1, d = (wc & 1) * 32 + fq * 8;
            *(u32x4*)(p.kvb + ((size_t)((which * 16 + b * 2 + g) * SEQ + s)) * 64 + d) = pack8(v0, v1);
          } else if (pn < 7) {
            *(u32x4*)(p.ub + (size_t)row * 512 + (pn - 5) * 256 + lc) = pack8(v0, v1);
          } else if (pn < 15) {
#pragma unroll
            for (int j = 0; j < 4; ++j) { v0[j] = sigmoidf_(v0[j]); v1[j] = sigmoidf_(v1[j]); }
            __builtin_nontemporal_store(pack8(v0, v1), (u32x4*)(p.gm + (size_t)row * 2048 + (pn - 7) * 256 + lc));
          } else {
            if (bj == 0 && wc == 0 && fq < 3) {
#pragma unroll
              for (int j = 0; j < 4; ++j) { v0[j] = sigmoidf_(v0[j]); v1[j] = sigmoidf_(v1[j]); }
              f32x4* gp = (f32x4*)(p.gate + (size_t)row * 24 + fq * 8);
              gp[0] = v0; gp[1] = v1;
            }
          }
        }
      }
    }
  }
};

struct EpiCmpHid {
  float* hid32;
  DI void operator()(AccRef acc, const Unit& u, int wr, int wc, int fr, int fq) const {
    float* base = hid32 + ((size_t)((u.k0 >> 3) * 32 + u.pm) * 256) * 256;
#pragma unroll
    EPI_ROWS {
      const int c = ai * HALF + wr * 64 + m * 16 + fr;
#pragma unroll
      for (int bj = 0; bj < 2; ++bj) {
        f32x4* dp = (f32x4*)(base + (size_t)c * 256 + EPI_COL(bj));
        dp[0] = acc[ai][bj][m][0]; dp[1] = acc[ai][bj][m][1];
      }
    }
  }
};

struct EpiCmpOut {
  const Params& p;
  DI void operator()(AccRef acc, const Unit& u, int wr, int wc, int fr, int fq) const {
    const int kv = u.pm >> 4, bg = u.pm & 15;
    const bool roped = (kv == 0) && (wc == 0);
    u16* dst = (kv ? p.vcmp : p.kcmp) + (size_t)bg * 256 * 64;
#pragma unroll
    for (int ai = 0; ai < 2; ++ai) {
      f32x4 tabx[4][4];
      {
#pragma unroll
        for (int m = 0; m < 4; ++m) {
          const int c = ai * HALF + wr * 64 + m * 16 + fr;
          const f32x4* t4 = (const f32x4*)(p.rope + (size_t)min(16 * c + 31, SEQ - 1) * 8);
          tabx[m][0] = t4[0]; tabx[m][1] = t4[1]; tabx[m][2] = t4[2]; tabx[m][3] = t4[3];
        }
      }
#pragma unroll
      for (int m = 0; m < 4; ++m) {
        const int c = ai * HALF + wr * 64 + m * 16 + fr;
        f32x4 v0 = acc[ai][0][m][0], v1 = acc[ai][0][m][1];
        if (roped) rope8t(v0, v1, tabx[m], fq);
        if (c == 255) { v0 = (f32x4){0.f, 0.f, 0.f, 0.f}; v1 = v0; }
        if (wc < 2) *(u32x4*)(dst + c * 64 + wc * 32 + fq * 8) = pack8(v0, v1);
      }
    }
  }
};

template <int PASS>
struct EpiMerge {
  const Params& p;
  DI void operator()(AccRef acc, const Unit& u, int wr, int wc, int fr, int fq) const {
#pragma unroll
    for (int ai = 0; ai < 2; ++ai) {
      u32x4 gq[4][2], ov[4][2];
#pragma unroll
      for (int m = 0; m < 4; ++m)
#pragma unroll
        for (int bj = 0; bj < 2; ++bj) {
          const int row = EPI_ROW(u), col = u.pn * BM + EPI_COL(bj);
          gq[m][bj] = *(const u32x4*)(p.gm + (size_t)row * 2048 + PASS * 1024 + col);
          if (PASS == 1) ov[m][bj] = *(const u32x4*)(p.mb + (size_t)row * 1024 + col);
        }
#pragma unroll
      for (int m = 0; m < 4; ++m) {
        const int row = EPI_ROW(u);
#pragma unroll
        for (int bj = 0; bj < 2; ++bj) {
          const int col = u.pn * BM + EPI_COL(bj);
          const u32x4 g = gq[m][bj];
          f32x4 v0 = acc[ai][bj][m][0], v1 = acc[ai][bj][m][1];
          v0[0] *= bf_lo(g[0]); v0[1] *= bf_hi(g[0]); v0[2] *= bf_lo(g[1]); v0[3] *= bf_hi(g[1]);
          v1[0] *= bf_lo(g[2]); v1[1] *= bf_hi(g[2]); v1[2] *= bf_lo(g[3]); v1[3] *= bf_hi(g[3]);
          if (PASS == 1) {
            const u32x4 o = ov[m][bj];
            v0[0] += bf_lo(o[0]); v0[1] += bf_hi(o[0]); v0[2] += bf_lo(o[1]); v0[3] += bf_hi(o[1]);
            v1[0] += bf_lo(o[2]); v1[1] += bf_hi(o[2]); v1[2] += bf_lo(o[3]); v1[3] += bf_hi(o[3]);
          }
          *(u32x4*)(p.mb + (size_t)row * 1024 + col) = pack8(v0, v1);
        }
      }
    }
  }
};

template <bool WITH_BF16, bool WITH_F32 = true>
struct EpiResid {
  const float* resid; float* out; u16* outb; float* ssq;
  DI void operator()(AccRef acc, const Unit& u, int wr, int wc, int fr, int fq) const {
#pragma unroll
    for (int ai = 0; ai < 2; ++ai) {
      f32x4 rv[4][2][2];
#pragma unroll
      for (int m = 0; m < 4; ++m)
#pragma unroll
        for (int bj = 0; bj < 2; ++bj) {
          const f32x4* rp = (const f32x4*)(resid + (size_t)EPI_ROW(u) * 1024 + u.pn * BM + EPI_COL(bj));
          rv[m][bj][0] = rp[0]; rv[m][bj][1] = rp[1];
        }
#pragma unroll
      for (int m = 0; m < 4; ++m) {
        const int row = EPI_ROW(u);
        float sq = 0.f;
#pragma unroll
        for (int bj = 0; bj < 2; ++bj) {
          const size_t a = (size_t)row * 1024 + u.pn * BM + EPI_COL(bj);
          const f32x4 v0 = rv[m][bj][0] + acc[ai][bj][m][0], v1 = rv[m][bj][1] + acc[ai][bj][m][1];
          if (WITH_F32) { f32x4* op = (f32x4*)(out + a); op[0] = v0; op[1] = v1; }
          if (WITH_BF16) *(u32x4*)(outb + a) = pack8(v0, v1);
#pragma unroll
          for (int j = 0; j < 4; ++j) sq += v0[j] * v0[j] + v1[j] * v1[j];
        }
        sq += __shfl_xor(sq, 16);
        sq += __shfl_xor(sq, 32);
        if (fq == 0) ssq[(size_t)row * 16 + u.pn * 4 + wc] = sq;
      }
    }
  }
};

struct EpiResidBf {
  u16* xb; float* ssq;
  DI void operator()(AccRef acc, const Unit& u, int wr, int wc, int fr, int fq) const {
#pragma unroll
    for (int ai = 0; ai < 2; ++ai) {
      u32x4 rv[4][2];
#pragma unroll
      for (int m = 0; m < 4; ++m)
#pragma unroll
        for (int bj = 0; bj < 2; ++bj) rv[m][bj] = *(const u32x4*)(xb + (size_t)EPI_ROW(u) * 1024 + u.pn * BM + EPI_COL(bj));
#pragma unroll
      for (int m = 0; m < 4; ++m) {
        const int row = EPI_ROW(u);
        float sq = 0.f;
#pragma unroll
        for (int bj = 0; bj < 2; ++bj) {
          const u32x4 r8 = rv[m][bj];
          f32x4 v0 = acc[ai][bj][m][0], v1 = acc[ai][bj][m][1];
          v0[0] += bf_lo(r8[0]); v0[1] += bf_hi(r8[0]); v0[2] += bf_lo(r8[1]); v0[3] += bf_hi(r8[1]);
          v1[0] += bf_lo(r8[2]); v1[1] += bf_hi(r8[2]); v1[2] += bf_lo(r8[3]); v1[3] += bf_hi(r8[3]);
          *(u32x4*)(xb + (size_t)row * 1024 + u.pn * BM + EPI_COL(bj)) = pack8(v0, v1);
#pragma unroll
          for (int j = 0; j < 4; ++j) sq += v0[j] * v0[j] + v1[j] * v1[j];
        }
        sq += __shfl_xor(sq, 16);
        sq += __shfl_xor(sq, 32);
        if (fq == 0) ssq[(size_t)row * 16 + u.pn * 4 + wc] = sq;
      }
    }
  }
};

struct EpiFinal {
  float* out; const u16* x1b; const float* gfin; float* ssq2; unsigned* cnt;
  DI void operator()(AccRef acc, const Unit& u, int wr, int wc, int fr, int fq) const {
#pragma unroll
    for (int ai = 0; ai < 2; ++ai) {
      u32x4 r8[4][2];
#pragma unroll
      for (int m = 0; m < 4; ++m)
#pragma unroll
        for (int bj = 0; bj < 2; ++bj) r8[m][bj] = *(const u32x4*)(x1b + (size_t)EPI_ROW(u) * 1024 + u.pn * BM + EPI_COL(bj));
#pragma unroll
      for (int m = 0; m < 4; ++m) {
        const int row = EPI_ROW(u);
        float sq = 0.f;
#pragma unroll
        for (int bj = 0; bj < 2; ++bj) {
          const u32x4 r = r8[m][bj];
          acc[ai][bj][m][0] += (f32x4){bf_lo(r[0]), bf_hi(r[0]), bf_lo(r[1]), bf_hi(r[1])};
          acc[ai][bj][m][1] += (f32x4){bf_lo(r[2]), bf_hi(r[2]), bf_lo(r[3]), bf_hi(r[3])};
#pragma unroll
          for (int j = 0; j < 4; ++j) sq += acc[ai][bj][m][0][j] * acc[ai][bj][m][0][j] + acc[ai][bj][m][1][j] * acc[ai][bj][m][1][j];
        }
        sq += __shfl_xor(sq, 16);
        sq += __shfl_xor(sq, 32);
        if (fq == 0) __hip_atomic_store(ssq2 + (size_t)row * 16 + u.pn * 4 + wc, sq, __ATOMIC_RELAXED, __HIP_MEMORY_SCOPE_AGENT);
      }
    }
    asm volatile("s_waitcnt vmcnt(0)" ::: "memory");
    unsigned* c = cnt + (u.pm * 2 + wr) * 16;
    if (fq == 0 && fr == 0) (void)xb_add(c, 1u);
    { unsigned sp = 0; while (xb_ld(c) < 16u) { __builtin_amdgcn_s_sleep(1); if (++sp > (1u << 20)) break; } }
    unsigned long long q0[8], q1[8];
#pragma unroll
    EPI_ROWS {
      unsigned long long* sp = (unsigned long long*)(ssq2 + (size_t)EPI_ROW(u) * 16 + fq * 4);
      q0[ai * 4 + m] = __hip_atomic_load(sp, __ATOMIC_RELAXED, __HIP_MEMORY_SCOPE_AGENT);
      q1[ai * 4 + m] = __hip_atomic_load(sp + 1, __ATOMIC_RELAXED, __HIP_MEMORY_SCOPE_AGENT);
    }
    f32x4 gv[2][2];
#pragma unroll
    for (int bj = 0; bj < 2; ++bj) { const f32x4* gp = (const f32x4*)(gfin + u.pn * BM + EPI_COL(bj)); gv[bj][0] = gp[0]; gv[bj][1] = gp[1]; }
#pragma unroll
    EPI_ROWS {
      const int row = EPI_ROW(u);
      const unsigned long long a0 = q0[ai * 4 + m], a1 = q1[ai * 4 + m];
      float ss = (__uint_as_float((unsigned)a0) + __uint_as_float((unsigned)(a0 >> 32))) + (__uint_as_float((unsigned)a1) + __uint_as_float((unsigned)(a1 >> 32)));
      ss += __shfl_xor(ss, 16);
      ss += __shfl_xor(ss, 32);
      const float rs = rsqrtf(ss * (1.f / DM) + 1e-6f);
#pragma unroll
      for (int bj = 0; bj < 2; ++bj) {
        f32x4* op = (f32x4*)(out + (size_t)row * 1024 + u.pn * BM + EPI_COL(bj));
        __builtin_nontemporal_store(acc[ai][bj][m][0] * rs * gv[bj][0], op);
        __builtin_nontemporal_store(acc[ai][bj][m][1] * rs * gv[bj][1], op + 1);
      }
    }
  }
};

struct EpiFF1 {
  const Params& p;
  DI void operator()(AccRef acc, const Unit& u, int wr, int wc, int fr, int fq) const {
    f32x4 part[8];
#pragma unroll
    EPI_ROWS part[ai * 4 + m] = *(const f32x4*)(p.ssq + (size_t)EPI_ROW(u) * 16 + fq * 4);
    float rs8[8];
#pragma unroll
    for (int r = 0; r < 8; ++r) {
      float ss = (part[r][0] + part[r][1]) + (part[r][2] + part[r][3]);
      ss += __shfl_xor(ss, 16);
      ss += __shfl_xor(ss, 32);
      rs8[r] = rsqrtf(ss * (1.f / DM) + 1e-6f);
    }
#pragma unroll
    EPI_ROWS {
      const int row = EPI_ROW(u);
      const float rs = rs8[ai * 4 + m];
#pragma unroll
      for (int bj = 0; bj < 2; ++bj) {
        f32x4 v0 = acc[ai][bj][m][0] * rs, v1 = acc[ai][bj][m][1] * rs;
#pragma unroll
        for (int j = 0; j < 4; ++j) { const float r0 = fmaxf(v0[j], 0.f), r1 = fmaxf(v1[j], 0.f); v0[j] = r0 * r0; v1[j] = r1 * r1; }
        const int col = u.pn * BM + EPI_COL(bj);
        __builtin_nontemporal_store(pack8(v0, v1), (u32x4*)(p.act + ((size_t)(col >> 6) * T_TOK + row) * 64 + (col & 63)));
      }
    }
  }
};

DI void p0_rows(const Params& p, int item) {
  const int w = threadIdx.x >> 6, lane = threadIdx.x & 63;
  const int row0 = item * 32 + w * 4;
  f32x4 v[4][4];
#pragma unroll
  for (int r = 0; r < 4; ++r) {
    const f32x4* src = (const f32x4*)(p.x + (size_t)(row0 + r) * DM);
#pragma unroll
    for (int i = 0; i < 4; ++i) v[r][i] = __builtin_nontemporal_load(src + lane + 64 * i);
  }
#pragma unroll
  for (int r = 0; r < 4; ++r) {
    float ss = 0.f;
#pragma unroll
    for (int i = 0; i < 4; ++i) ss += v[r][i][0] * v[r][i][0] + v[r][i][1] * v[r][i][1] + v[r][i][2] * v[r][i][2] + v[r][i][3] * v[r][i][3];
#pragma unroll
    for (int o = 32; o; o >>= 1) ss += __shfl_xor(ss, o);
    if (lane == 0) p.rstd0[row0 + r] = rsqrtf(ss * (1.f / DM) + 1e-6f);
    u32x2* dst = (u32x2*)(p.xb + (size_t)(row0 + r) * DM);
#pragma unroll
    for (int i = 0; i < 4; ++i) {
      u32x2 o = {pack_bf2(v[r][i][0], v[r][i][1]), pack_bf2(v[r][i][2], v[r][i][3])};
      dst[lane + 64 * i] = o;
    }
  }
}

constexpr int TJ_WIN = 1024, TJ_WA = 128, TJ_WO = 256, TJ_W1 = 1024, TJ_W2 = 1024, TJ_C1 = 128, TJ_C2 = 16;
constexpr int TJ_TOTAL = TJ_WIN + TJ_WA + TJ_WO + TJ_W1 + TJ_W2 + 2 * TJ_C1 + 2 * TJ_C2;

constexpr int TJ_EARLY = TJ_WIN + 2 * TJ_C1 + 2 * TJ_C2;
DI void p0_transpose(const Params& p, int item, char* smem, int base) {
  const int half = threadIdx.x >> 8, tid = threadIdx.x & 255;
  int idx = item * 2 + half + base;
  const float* src; u16* dst; const float* scale = nullptr; int K, N, kind = 0;
  if (idx < TJ_WIN) { src = p.w_in; dst = p.w_in_t; scale = p.norm_mix; K = 1024; N = 3864; kind = 1; }
  else if ((idx -= TJ_WIN) < TJ_C1) { src = p.ck_w1; dst = p.cw1_t; K = 2048; N = 256; }
  else if ((idx -= TJ_C1) < TJ_C1) { src = p.cv_w1; dst = p.cw1_t + 256 * 2048; K = 2048; N = 256; }
  else if ((idx -= TJ_C1) < TJ_C2) { src = p.ck_w2; dst = p.cw2_t; K = 256; N = 64; }
  else if ((idx -= TJ_C2) < TJ_C2) { src = p.cv_w2; dst = p.cw2_t + 256 * 256; K = 256; N = 64; }
  else if ((idx -= TJ_C2) < TJ_WA) { src = p.w_ba; dst = p.wa_t; K = 512; N = 1024; }
  else if ((idx -= TJ_WA) < TJ_WO) { src = p.w_out; dst = p.wo_t; K = 1024; N = 1024; }
  else if ((idx -= TJ_WO) < TJ_W1) { src = p.w_ff1; dst = p.w1_t; scale = p.norm_mlp; K = 1024; N = 4096; }
  else { idx -= TJ_W1; src = p.w_ff2; dst = p.w2_t; K = 4096; N = 1024; kind = 2; }
  const int nk = K >> 6;
  const int k0 = (idx % nk) * 64, n0 = (idx / nk) * 64;
  float* tile = (float*)(smem + half * 16640);
  __syncthreads();
#pragma unroll
  for (int i = 0; i < 4; ++i) {
    const int kk = (tid >> 4) + 16 * i, nn = (tid & 15) * 4;
    const int nd = n0 + nn;
    int sc;
    if (kind == 1) sc = nd < 1280 ? nd : (nd < 3840 ? nd + 24 : (nd < 3864 ? nd - 2560 : -1));
    else sc = nd < N ? nd : -1;
    float4 v = make_float4(0.f, 0.f, 0.f, 0.f);
    if (sc >= 0) v = *(const float4*)(src + (size_t)(k0 + kk) * N + sc);
    if (scale) { float s = scale[k0 + kk]; v.x *= s; v.y *= s; v.z *= s; v.w *= s; }
    tile[kk * 65 + nn + 0] = v.x; tile[kk * 65 + nn + 1] = v.y; tile[kk * 65 + nn + 2] = v.z; tile[kk * 65 + nn + 3] = v.w;
  }
  __syncthreads();
  {
    const int n = tid >> 2, kq = (tid & 3) * 16;
    unsigned o[8];
#pragma unroll
    for (int j = 0; j < 8; ++j) o[j] = pack_bf2(tile[(kq + 2 * j) * 65 + n], tile[(kq + 2 * j + 1) * 65 + n]);
    u32x4* d = (kind == 2) ? (u32x4*)(dst + ((size_t)(k0 >> 6) * 1024 + (n0 + n)) * 64 + kq)
                           : (u32x4*)(dst + (size_t)(n0 + n) * K + k0 + kq);
    u32x4 o0 = {o[0], o[1], o[2], o[3]}, o1 = {o[4], o[5], o[6], o[7]};
    d[0] = o0; d[1] = o1;
  }
}

DI void p0_weff(const Params& p, int item, char* smem) {
  const int g = item >> 4, n0 = (item & 15) * 64, tid = threadIdx.x;
  float* pw = (float*)smem;
  float* ws = (float*)(smem + 66048);
  __syncthreads();
  for (int e = tid; e < 128 * 128; e += NTHR) { const int c = e >> 7, d = e & 127; pw[c * 129 + d] = p.pool_w[(size_t)g * 16384 + e] * p.pool_scale[g * 128 + d]; }
  for (int e = tid; e < 128 * 64; e += NTHR) { const int d = e >> 6, n = e & 63; ws[e] = p.w_bp[(size_t)(g * 128 + d) * 1024 + n0 + n]; }
  __syncthreads();
  const int c = tid & 127, nq = (tid >> 7) * 16;
  float a[16];
#pragma unroll
  for (int j = 0; j < 16; ++j) a[j] = 0.f;
  for (int d = 0; d < 128; ++d) {
    const float w = pw[c * 129 + d];
#pragma unroll
    for (int j = 0; j < 16; ++j) a[j] += w * ws[d * 64 + nq + j];
  }
#pragma unroll
  for (int j = 0; j < 16; ++j) p.wbe_t[(size_t)(n0 + nq + j) * 512 + g * 128 + c] = (u16)(pack_bf2(a[j], 0.f) & 0xffffu);
}

DI void p0_cbias(const Params& p, int idx, char* smem) {
  const int kv = idx >> 3, nc = idx & 7, tid = threadIdx.x, n = tid & 31, part = tid >> 5;
  const float* pe = kv ? p.pe_v : p.pe_k;
  const float* w1 = kv ? p.cv_w1 : p.ck_w1;
  float s = 0.f;
  for (int k = part * 128; k < part * 128 + 128; ++k) s += pe[k] * w1[(size_t)k * 256 + nc * 32 + n];
  float* red = (float*)smem;
  __syncthreads();
  red[part * 32 + n] = s;
  __syncthreads();
  if (tid < 32) {
    float t = 0.f;
#pragma unroll
    for (int j = 0; j < 16; ++j) t += red[j * 32 + tid];
    p.cbias[kv * 256 + nc * 32 + tid] = t;
  }
}

DI void p0_rope(const Params& p, int idx) {
  const int e = idx * NTHR + threadIdx.x;
  const int pos = e >> 3, i = e & 7;
  const float inv = powf(500000.0f, -(float)(2 * i) / 16.0f);
  const float ang = (float)pos * inv;
  float sn, cs;
  sincosf(ang, &sn, &cs);
  p.rope[e] = make_float2(cs, sn);
}

DI void p2a_pool_item(const Params& p, int item) {
  const int idx = item * NTHR + threadIdx.x;
  const int t = idx >> 6, ch = (idx & 63) * 8;
  const int grp = ch >> 7, wlen = 2 << grp, s = t & (SEQ - 1);
  const int cnt = min(s + 1, wlen);
  float a[8];
#pragma unroll
  for (int j = 0; j < 8; ++j) a[j] = 0.f;
  const u16* base = p.ub + (size_t)t * 512 + ch;
  u32x4 v[16];
#pragma unroll
  for (int k = 0; k < 16; ++k) { v[k] = (u32x4){0u, 0u, 0u, 0u}; if (k < cnt) v[k] = *(const u32x4*)(base - (size_t)k * 512); }
  const u32x4 cur = v[0];
#pragma unroll
  for (int k = 0; k < 16; ++k) {
#pragma unroll
    for (int j = 0; j < 4; ++j) { a[2 * j] += bf_lo(v[k][j]); a[2 * j + 1] += bf_hi(v[k][j]); }
  }
  const float ic = 1.f / (float)cnt;
  u32x4 o;
#pragma unroll
  for (int j = 0; j < 4; ++j) o[j] = pack_bf2(a[2 * j] * ic - bf_lo(cur[j]), a[2 * j + 1] * ic - bf_hi(cur[j]));
  *(u32x4*)(p.pooled + (size_t)t * 512 + ch) = o;
}

constexpr int AT_P = 65536, AT_S = 98304, AT_M = 131072;
template <int MODE>
DI void attn_tiles(const u16* __restrict__ Kg, const u16* __restrict__ Vg, int j0, int j1, char* smem,
                   const bf16x8 (&qf)[4], float& m, float& l, f32x16 (&O)[2], int lo, int hi, int lo_max, int hi_min,
                   unsigned mlo, unsigned mhi, float inv_l, int tok_l, int tid) {
  const int lane = tid & 63, l31 = lane & 31, h = lane >> 5;
  const int lk = tid >> 3, lc = tid & 7;
  const int kwr = lk * 128 + ((lc ^ ((lk >> 1) & 7)) << 4);
  const int vwr = 16384 + (lc >> 2) * 4096 + lk * 64 + (lc & 3) * 16;
  const int f = (l31 >> 1) & 7;
  const int krd = l31 * 128;
  int kx[4];
#pragma unroll
  for (int ks = 0; ks < 4; ++ks) kx[ks] = ((2 * ks + h) ^ f) << 4;
  const lds_cptr vrd = (lds_cptr)smem + 16384 + ((lane >> 4) & 1) * 32 + (lane & 3) * 8 + (4 * h + ((lane & 15) >> 2)) * 64;
  const int goff = lk * 64 + lc * 8;
  u32x4 rk, rv;
  rk = *(const u32x4*)(Kg + (size_t)j0 * 4096 + goff);
  if (MODE != 0) rv = *(const u32x4*)(Vg + (size_t)j0 * 4096 + goff);
  for (int j = j0; j <= j1; ++j) {
    const int bo = ((j - j0) & 1) * 8192;
    *(u32x4*)(smem + bo + kwr) = rk;
    if (MODE != 0) *(u32x4*)(smem + bo + vwr) = rv;
    __syncthreads();
    if (j < j1) {
      rk = *(const u32x4*)(Kg + (size_t)(j + 1) * 4096 + goff);
      if (MODE != 0) rv = *(const u32x4*)(Vg + (size_t)(j + 1) * 4096 + goff);
    }
    bool bit = true;
    if (MODE == 2) {
      bit = ((j < 32 ? (mlo >> j) : (mhi >> (j - 32))) & 1u) != 0;
      if (__ballot(bit) == 0ull) continue;
    }
    f32x16 s0 = zero16(), s1 = zero16();
#pragma unroll
    for (int ks = 0; ks < 4; ++ks) {
      bf16x8 a0 = *(const bf16x8*)(smem + bo + krd + kx[ks]);
      bf16x8 a1 = *(const bf16x8*)(smem + bo + krd + 4096 + kx[ks]);
      s0 = mfma32(a0, qf[ks], s0);
      s1 = mfma32(a1, qf[ks], s1);
    }
    const bool need_mask = (64 * j < lo_max) || (64 * j + 63 > hi_min);
    const int rlo = lo - 64 * j - 4 * h, span = hi - lo;
    if (need_mask) {
#pragma unroll
      for (int i = 0; i < 16; ++i) {
        const int c0 = 8 * (i >> 2) + (i & 3);
        if ((unsigned)(c0 - rlo) > (unsigned)span || span < 0) s0[i] = NEGF;
        if ((unsigned)(c0 + 32 - rlo) > (unsigned)span || span < 0) s1[i] = NEGF;
      }
    }
    float msub;
    if (MODE == 1) {
      msub = m;
    } else {
      float mx = s0[0];
#pragma unroll
      for (int i = 1; i < 16; ++i) mx = fmaxf(mx, s0[i]);
#pragma unroll
      for (int i = 0; i < 16; ++i) mx = fmaxf(mx, s1[i]);
      mx = fmaxf(mx, __shfl_xor(mx, 32));
      if (MODE == 2) mx = bit ? mx : NEGF;
      const float mn = fmaxf(m, mx);
      const float alpha = __builtin_amdgcn_exp2f(m - mn);
      m = mn;
      l *= alpha;
      if (MODE != 0) {
        if (__ballot(alpha != 1.f) != 0ull) {
#pragma unroll
          for (int i = 0; i < 16; ++i) { O[0][i] *= alpha; O[1][i] *= alpha; }
        }
      }
      msub = (MODE == 2 && !bit) ? 1e30f : mn;
    }
    msub = fmaxf(msub, -1e29f);
    float rs = 0.f;
#pragma unroll
    for (int i = 0; i < 16; ++i) {
      float p0 = __builtin_amdgcn_exp2f(s0[i] - msub), p1 = __builtin_amdgcn_exp2f(s1[i] - msub);
      if (MODE == 1) { p0 *= inv_l; p1 *= inv_l; }
      s0[i] = p0; s1[i] = p1;
      rs += p0 + p1;
    }
    l += rs;
    if (MODE == 0) continue;
    if (MODE == 1) {
      float* ps = (float*)(smem + AT_P) + tok_l * 256 + 64 * j + 4 * h;
#pragma unroll
      for (int gq = 0; gq < 4; ++gq) {
        float4 a, b;
        float t;
        t = s0[4 * gq + 0]; t += __shfl_xor(t, 1); t += __shfl_xor(t, 2); a.x = t;
        t = s0[4 * gq + 1]; t += __shfl_xor(t, 1); t += __shfl_xor(t, 2); a.y = t;
        t = s0[4 * gq + 2]; t += __shfl_xor(t, 1); t += __shfl_xor(t, 2); a.z = t;
        t = s0[4 * gq + 3]; t += __shfl_xor(t, 1); t += __shfl_xor(t, 2); a.w = t;
        t = s1[4 * gq + 0]; t += __shfl_xor(t, 1); t += __shfl_xor(t, 2); b.x = t;
        t = s1[4 * gq + 1]; t += __shfl_xor(t, 1); t += __shfl_xor(t, 2); b.y = t;
        t = s1[4 * gq + 2]; t += __shfl_xor(t, 1); t += __shfl_xor(t, 2); b.z = t;
        t = s1[4 * gq + 3]; t += __shfl_xor(t, 1); t += __shfl_xor(t, 2); b.w = t;
        if ((l31 & 3) == 0) { *(float4*)(ps + 8 * gq) = a; *(float4*)(ps + 32 + 8 * gq) = b; }
      }
    }
#pragma unroll
    for (int s4 = 0; s4 < 4; ++s4) {
      u32x4 pk;
      if (s4 < 2) {
#pragma unroll
        for (int jj = 0; jj < 4; ++jj) pk[jj] = pack_bf2(s0[8 * (s4 & 1) + 2 * jj], s0[8 * (s4 & 1) + 2 * jj + 1]);
      } else {
#pragma unroll
        for (int jj = 0; jj < 4; ++jj) pk[jj] = pack_bf2(s1[8 * (s4 & 1) + 2 * jj], s1[8 * (s4 & 1) + 2 * jj + 1]);
      }
      const bf16x8 pb = __builtin_bit_cast(bf16x8, pk);
#pragma unroll
      for (int dt = 0; dt < 2; ++dt) {
        s16x4 vlo = vtr(vrd + bo + dt * 4096 + s4 * 1024);
        s16x4 vhi = vtr(vrd + bo + dt * 4096 + s4 * 1024 + 512);
        bf16x8 vf = __builtin_shufflevector(vlo, vhi, 0, 1, 2, 3, 4, 5, 6, 7);
        O[dt] = mfma32(vf, pb, O[dt]);
      }
    }
  }
  __syncthreads();
}

template <int MODE>
DI void attn_tiles_pipe(const u16* __restrict__ Kg, const u16* __restrict__ Vg, int j0, int j1, char* smem,
                        const bf16x8 (&qf)[4], float& m, float& l, f32x16 (&O)[2], int lo, int hi, int lo_max, int hi_min,
                        unsigned mlo, unsigned mhi, int tid) {
  const int lane = tid & 63, l31 = lane & 31, h = lane >> 5;
  const int lk = tid >> 3, lc = tid & 7;
  const int kwr = lk * 128 + ((lc ^ ((lk >> 1) & 7)) << 4);
  const int vwr = 16384 + (lc >> 2) * 4096 + lk * 64 + (lc & 3) * 16;
  const int f = (l31 >> 1) & 7;
  const int krd = l31 * 128;
  int kx[4];
#pragma unroll
  for (int ks = 0; ks < 4; ++ks) kx[ks] = ((2 * ks + h) ^ f) << 4;
  const lds_cptr vrd = (lds_cptr)smem + 16384 + ((lane >> 4) & 1) * 32 + (lane & 3) * 8 + (4 * h + ((lane & 15) >> 2)) * 64;
  const int goff = lk * 64 + lc * 8;
  u32x4 rk, rv;
  auto qk_tile = [&](int bufoff, f32x16& d0, f32x16& d1) __attribute__((always_inline)) {
    bf16x8 ka[4], kb[4];
#pragma unroll
    for (int ks = 0; ks < 4; ++ks) { ka[ks] = *(const bf16x8*)(smem + bufoff + krd + kx[ks]); kb[ks] = *(const bf16x8*)(smem + bufoff + krd + 4096 + kx[ks]); }
    d0 = mfma32(ka[0], qf[0], zero16()); d1 = mfma32(kb[0], qf[0], zero16());
#pragma unroll
    for (int ks = 1; ks < 4; ++ks) { d0 = mfma32(ka[ks], qf[ks], d0); d1 = mfma32(kb[ks], qf[ks], d1); }
  };
  auto active = [&](int j) __attribute__((always_inline)) -> bool {
    if (MODE != 2) return true;
    const bool b = ((j < 32 ? (mlo >> j) : (mhi >> (j - 32))) & 1u) != 0;
    return __ballot(b) != 0ull;
  };
  auto step = [&](int j, bool act_c, bool& act_n, f32x16& c0, f32x16& c1, f32x16& n0, f32x16& n1) __attribute__((always_inline)) {
    const int par = (j - j0) & 1;
    const int bo = par * 8192, bn = (par ^ 1) * 8192;
    if (j < j1) *(u32x4*)(smem + bn + kwr) = rk;
    *(u32x4*)(smem + bo + vwr) = rv;
    __syncthreads();
    if (j + 2 <= j1) rk = *(const u32x4*)(Kg + (size_t)(j + 2) * 4096 + goff);
    if (j + 1 <= j1) rv = *(const u32x4*)(Vg + (size_t)(j + 1) * 4096 + goff);
    act_n = false;
    if (j < j1) { act_n = active(j + 1); if (act_n) qk_tile(bn, n0, n1); }
    if (!act_c) return;
    bool bit = true;
    if (MODE == 2) bit = ((j < 32 ? (mlo >> j) : (mhi >> (j - 32))) & 1u) != 0;
    const bool need_mask = (64 * j < lo_max) || (64 * j + 63 > hi_min);
    if (need_mask) {
      const int rlo = lo - 64 * j - 4 * h, span = hi - lo;
#pragma unroll
      for (int i = 0; i < 16; ++i) {
        const int cc = 8 * (i >> 2) + (i & 3);
        if ((unsigned)(cc - rlo) > (unsigned)span || span < 0) c0[i] = NEGF;
        if ((unsigned)(cc + 32 - rlo) > (unsigned)span || span < 0) c1[i] = NEGF;
      }
    }
    float mx = c0[0];
#pragma unroll
    for (int i = 1; i < 16; ++i) mx = fmaxf(mx, c0[i]);
#pragma unroll
    for (int i = 0; i < 16; ++i) mx = fmaxf(mx, c1[i]);
    mx = fmaxf(mx, __shfl_xor(mx, 32));
    if (MODE == 2) mx = bit ? mx : NEGF;
    const float mn = fmaxf(m, mx);
    const float alpha = __builtin_amdgcn_exp2f(m - mn);
    m = mn;
    l *= alpha;
    if (__ballot(alpha != 1.f) != 0ull) {
#pragma unroll
      for (int i = 0; i < 16; ++i) { O[0][i] *= alpha; O[1][i] *= alpha; }
    }
    const float msub = (MODE == 2 && !bit) ? 1e30f : fmaxf(mn, -1e29f);
    bf16x8 vf[4][2];
#pragma unroll
    for (int s4 = 0; s4 < 4; ++s4)
#pragma unroll
      for (int dt = 0; dt < 2; ++dt) {
        s16x4 vlo = vtr(vrd + bo + dt * 4096 + s4 * 1024);
        s16x4 vhi = vtr(vrd + bo + dt * 4096 + s4 * 1024 + 512);
        vf[s4][dt] = __builtin_shufflevector(vlo, vhi, 0, 1, 2, 3, 4, 5, 6, 7);
      }
    float rs = 0.f;
#pragma unroll
    for (int i = 0; i < 16; ++i) {
      const float p0 = __builtin_amdgcn_exp2f(c0[i] - msub), p1 = __builtin_amdgcn_exp2f(c1[i] - msub);
      c0[i] = p0; c1[i] = p1;
      rs += p0 + p1;
    }
    l += rs;
#pragma unroll
    for (int s4 = 0; s4 < 4; ++s4) {
      u32x4 pk;
      if (s4 < 2) {
#pragma unroll
        for (int jj = 0; jj < 4; ++jj) pk[jj] = pack_bf2(c0[8 * (s4 & 1) + 2 * jj], c0[8 * (s4 & 1) + 2 * jj + 1]);
      } else {
#pragma unroll
        for (int jj = 0; jj < 4; ++jj) pk[jj] = pack_bf2(c1[8 * (s4 & 1) + 2 * jj], c1[8 * (s4 & 1) + 2 * jj + 1]);
      }
      const bf16x8 pb = __builtin_bit_cast(bf16x8, pk);
      O[0] = mfma32(vf[s4][0], pb, O[0]);
      O[1] = mfma32(vf[s4][1], pb, O[1]);
    }
  };
  rk = *(const u32x4*)(Kg + (size_t)j0 * 4096 + goff);
  rv = *(const u32x4*)(Vg + (size_t)j0 * 4096 + goff);
  *(u32x4*)(smem + kwr) = rk;
  if (j0 < j1) rk = *(const u32x4*)(Kg + (size_t)(j0 + 1) * 4096 + goff);
  __syncthreads();
  f32x16 a0, a1, b0, b1;
  bool actA = true, actB = false;
  qk_tile(0, a0, a1);
  for (int j = j0; j <= j1; j += 2) {
    step(j, actA, actB, a0, a1, b0, b1);
    if (j + 1 <= j1) step(j + 1, actB, actA, b0, b1, a0, a1);
  }
  __syncthreads();
}

constexpr int RING = 6;
DI void glds16(const u16* g, char* lds) {
  __builtin_amdgcn_global_load_lds((const unsigned*)g, (LAS unsigned*)lds, 16, 0, 0);
}
template <int MODE>
DI void attn_tiles_ring(const u16* __restrict__ Kg, const u16* __restrict__ Vg, int j0, int j1, char* smem,
                        const bf16x8 (&qf)[4], float& m, float& l, f32x16 (&O)[2], int lo, int hi, int lo_max, int hi_min,
                        unsigned mlo, unsigned mhi, int tid) {
  const int lane = tid & 63, l31 = lane & 31, h = lane >> 5;
  const int f = (l31 >> 1) & 7;
  const int krd = l31 * 128;
  int kx[4];
#pragma unroll
  for (int ks = 0; ks < 4; ++ks) kx[ks] = ((2 * ks + h) ^ f) << 4;
  const int vrdo = 8192 + ((lane >> 4) & 1) * 32 + (lane & 3) * 8 + (4 * h + ((lane & 15) >> 2)) * 64;
  const lds_cptr lbase = (lds_cptr)smem;
  const int ksrc = (tid >> 3) * 64 + (((tid & 7) ^ (((tid >> 3) >> 1) & 7)) << 3);
  const int vsrc = ((tid >> 2) & 63) * 64 + (((tid >> 8) * 4 + (tid & 3)) << 3);
  const int dma = tid * 16;
  auto issue = [&](int t, int st) __attribute__((always_inline)) {
    const int tc = t < j1 ? t : j1;
    glds16(Kg + (size_t)tc * 4096 + ksrc, smem + st * 16384 + dma);
    glds16(Vg + (size_t)tc * 4096 + vsrc, smem + st * 16384 + 8192 + dma);
  };
  auto qk_tile = [&](int st, f32x16& d0, f32x16& d1) __attribute__((always_inline)) {
    const char* kb_ = smem + st * 16384;
    bf16x8 ka[4], kb[4];
#pragma unroll
    for (int ks = 0; ks < 4; ++ks) { ka[ks] = *(const bf16x8*)(kb_ + krd + kx[ks]); kb[ks] = *(const bf16x8*)(kb_ + krd + 4096 + kx[ks]); }
    __builtin_amdgcn_s_setprio(1);
    d0 = mfma32(ka[0], qf[0], zero16()); d1 = mfma32(kb[0], qf[0], zero16());
#pragma unroll
    for (int ks = 1; ks < 4; ++ks) { d0 = mfma32(ka[ks], qf[ks], d0); d1 = mfma32(kb[ks], qf[ks], d1); }
    __builtin_amdgcn_s_setprio(0);
  };
  auto active = [&](int j) __attribute__((always_inline)) -> bool {
    if (MODE != 2) return true;
    const bool b = ((j < 32 ? (mlo >> j) : (mhi >> (j - 32))) & 1u) != 0;
    return __ballot(b) != 0ull;
  };
  int st_cur = 0, st_iss = 5;
  auto step = [&](int j, bool act_c, bool& act_n, f32x16& c0, f32x16& c1, f32x16& n0, f32x16& n1) __attribute__((always_inline)) {
    asm volatile("s_waitcnt vmcnt(6)" ::: "memory");
    __builtin_amdgcn_s_barrier();
    issue(j + 5, st_iss);
    const int st_nxt = (st_cur == RING - 1) ? 0 : st_cur + 1;
    act_n = false;
    if (j < j1) { act_n = active(j + 1); if (act_n) qk_tile(st_nxt, n0, n1); }
    if (act_c) {
      bool bit = true;
      if (MODE == 2) bit = ((j < 32 ? (mlo >> j) : (mhi >> (j - 32))) & 1u) != 0;
      const bool need_mask = (64 * j < lo_max) || (64 * j + 63 > hi_min);
      if (need_mask) {
        const int rlo = lo - 64 * j - 4 * h, span = hi - lo;
#pragma unroll
        for (int i = 0; i < 16; ++i) {
          const int cc = 8 * (i >> 2) + (i & 3);
          if ((unsigned)(cc - rlo) > (unsigned)span || span < 0) c0[i] = NEGF;
          if ((unsigned)(cc + 32 - rlo) > (unsigned)span || span < 0) c1[i] = NEGF;
        }
      }
      float mx = c0[0];
#pragma unroll
      for (int i = 1; i < 16; ++i) mx = fmaxf(mx, c0[i]);
#pragma unroll
      for (int i = 0; i < 16; ++i) mx = fmaxf(mx, c1[i]);
      mx = fmaxf(mx, __shfl_xor(mx, 32));
      if (MODE == 2) mx = bit ? mx : NEGF;
      const float mn = fmaxf(m, mx);
      const float alpha = __builtin_amdgcn_exp2f(m - mn);
      m = mn;
      l *= alpha;
      if (__ballot(alpha != 1.f) != 0ull) {
#pragma unroll
        for (int i = 0; i < 16; ++i) { O[0][i] *= alpha; O[1][i] *= alpha; }
      }
      const float msub = (MODE == 2 && !bit) ? 1e30f : fmaxf(mn, -1e29f);
      const lds_cptr vb = lbase + st_cur * 16384 + vrdo;
      bf16x8 vf[4][2];
#pragma unroll
      for (int s4 = 0; s4 < 4; ++s4)
#pragma unroll
        for (int dt = 0; dt < 2; ++dt) {
          s16x4 vlo = vtr(vb + dt * 4096 + s4 * 1024);
          s16x4 vhi = vtr(vb + dt * 4096 + s4 * 1024 + 512);
          vf[s4][dt] = __builtin_shufflevector(vlo, vhi, 0, 1, 2, 3, 4, 5, 6, 7);
        }
      float rs = 0.f;
#pragma unroll
      for (int i = 0; i < 16; ++i) {
        const float p0 = __builtin_amdgcn_exp2f(c0[i] - msub), p1 = __builtin_amdgcn_exp2f(c1[i] - msub);
        c0[i] = p0; c1[i] = p1;
        rs += p0 + p1;
      }
      l += rs;
#pragma unroll
      for (int s4 = 0; s4 < 4; ++s4) {
        u32x4 pk;
        if (s4 < 2) {
#pragma unroll
          for (int jj = 0; jj < 4; ++jj) pk[jj] = pack_bf2(c0[8 * (s4 & 1) + 2 * jj], c0[8 * (s4 & 1) + 2 * jj + 1]);
        } else {
#pragma unroll
          for (int jj = 0; jj < 4; ++jj) pk[jj] = pack_bf2(c1[8 * (s4 & 1) + 2 * jj], c1[8 * (s4 & 1) + 2 * jj + 1]);
        }
        const bf16x8 pb = __builtin_bit_cast(bf16x8, pk);
        __builtin_amdgcn_s_setprio(1);
        O[0] = mfma32(vf[s4][0], pb, O[0]);
        O[1] = mfma32(vf[s4][1], pb, O[1]);
        __builtin_amdgcn_s_setprio(0);
      }
    }
    st_cur = st_nxt;
    st_iss = (st_iss == RING - 1) ? 0 : st_iss + 1;
  };
#pragma unroll
  for (int i = 0; i < 5; ++i) issue(j0 + i, i);
  asm volatile("s_waitcnt vmcnt(8)" ::: "memory");
  __builtin_amdgcn_s_barrier();
  f32x16 a0, a1, b0, b1;
  bool actA = true, actB = false;
  qk_tile(0, a0, a1);
  for (int j = j0; j <= j1; j += 2) {
    step(j, actA, actB, a0, a1, b0, b1);
    if (j + 1 <= j1) step(j + 1, actB, actA, b0, b1, a0, a1);
  }
  asm volatile("s_waitcnt vmcnt(0)" ::: "memory");
  __syncthreads();
}

DI void attn_cmp(const u16* __restrict__ Kc, const u16* __restrict__ Vc, int nct, char* smem, const bf16x8 (&qf)[4],
                 f32x16 (&O)[2], int hi, int hi_min, int tok_l, int tid) {
  const int lane = tid & 63, l31 = lane & 31, h = lane >> 5;
  const int f = (l31 >> 1) & 7;
  const int krd = l31 * 128;
  int kx[4];
#pragma unroll
  for (int ks = 0; ks < 4; ++ks) kx[ks] = ((2 * ks + h) ^ f) << 4;
  const int vrdo = 8192 + ((lane >> 4) & 1) * 32 + (lane & 3) * 8 + (4 * h + ((lane & 15) >> 2)) * 64;
  const lds_cptr lbase = (lds_cptr)smem;
  const int ksrc = (tid >> 3) * 64 + (((tid & 7) ^ (((tid >> 3) >> 1) & 7)) << 3);
  const int vsrc = ((tid >> 2) & 63) * 64 + (((tid >> 8) * 4 + (tid & 3)) << 3);
#pragma unroll
  for (int t = 0; t < 4; ++t) {
    const int tc = t < nct ? t : nct - 1;
    glds16(Kc + (size_t)tc * 4096 + ksrc, smem + t * 16384 + tid * 16);
    glds16(Vc + (size_t)tc * 4096 + vsrc, smem + t * 16384 + 8192 + tid * 16);
  }
  asm volatile("s_waitcnt vmcnt(0)" ::: "memory");
  __syncthreads();
  f32x16 S[4][2];
  float mx = NEGF;
#pragma unroll
  for (int t = 0; t < 4; ++t) {
    if (t < nct) {
      const char* kb_ = smem + t * 16384;
      bf16x8 ka[4], kb[4];
#pragma unroll
      for (int ks = 0; ks < 4; ++ks) { ka[ks] = *(const bf16x8*)(kb_ + krd + kx[ks]); kb[ks] = *(const bf16x8*)(kb_ + krd + 4096 + kx[ks]); }
      S[t][0] = mfma32(ka[0], qf[0], zero16()); S[t][1] = mfma32(kb[0], qf[0], zero16());
#pragma unroll
      for (int ks = 1; ks < 4; ++ks) { S[t][0] = mfma32(ka[ks], qf[ks], S[t][0]); S[t][1] = mfma32(kb[ks], qf[ks], S[t][1]); }
      if (64 * t + 63 > hi_min) {
        const int rhi = hi - 64 * t - 4 * h;
#pragma unroll
        for (int i = 0; i < 16; ++i) {
          const int cc = 8 * (i >> 2) + (i & 3);
          if (cc > rhi) S[t][0][i] = NEGF;
          if (cc + 32 > rhi) S[t][1][i] = NEGF;
        }
      }
#pragma unroll
      for (int i = 0; i < 16; ++i) mx = fmaxf(mx, fmaxf(S[t][0][i], S[t][1][i]));
    }
  }
  mx = fmaxf(mx, __shfl_xor(mx, 32));
  const float msub = fmaxf(mx, -1e29f);
  float ls = 0.f;
#pragma unroll
  for (int t = 0; t < 4; ++t)
    if (t < nct) {
#pragma unroll
      for (int i = 0; i < 16; ++i) {
        S[t][0][i] = __builtin_amdgcn_exp2f(S[t][0][i] - msub); S[t][1][i] = __builtin_amdgcn_exp2f(S[t][1][i] - msub);
        ls += S[t][0][i] + S[t][1][i];
      }
    }
  ls += __shfl_xor(ls, 32);
  const float inv_l = 1.f / fmaxf(ls, 1e-30f);
  O[0] = zero16(); O[1] = zero16();
#pragma unroll
  for (int t = 0; t < 4; ++t)
    if (t < nct) {
      f32x16& s0 = S[t][0];
      f32x16& s1 = S[t][1];
#pragma unroll
      for (int i = 0; i < 16; ++i) { s0[i] *= inv_l; s1[i] *= inv_l; }
      float* ps = (float*)(smem + AT_P) + tok_l * 256 + 64 * t + 4 * h;
#pragma unroll
      for (int gq = 0; gq < 4; ++gq) {
        float4 a, b;
        float u;
        u = s0[4 * gq + 0]; u += __shfl_xor(u, 1); u += __shfl_xor(u, 2); a.x = u;
        u = s0[4 * gq + 1]; u += __shfl_xor(u, 1); u += __shfl_xor(u, 2); a.y = u;
        u = s0[4 * gq + 2]; u += __shfl_xor(u, 1); u += __shfl_xor(u, 2); a.z = u;
        u = s0[4 * gq + 3]; u += __shfl_xor(u, 1); u += __shfl_xor(u, 2); a.w = u;
        u = s1[4 * gq + 0]; u += __shfl_xor(u, 1); u += __shfl_xor(u, 2); b.x = u;
        u = s1[4 * gq + 1]; u += __shfl_xor(u, 1); u += __shfl_xor(u, 2); b.y = u;
        u = s1[4 * gq + 2]; u += __shfl_xor(u, 1); u += __shfl_xor(u, 2); b.z = u;
        u = s1[4 * gq + 3]; u += __shfl_xor(u, 1); u += __shfl_xor(u, 2); b.w = u;
        if ((l31 & 3) == 0) { *(float4*)(ps + 8 * gq) = a; *(float4*)(ps + 32 + 8 * gq) = b; }
      }
      const lds_cptr vb = lbase + t * 16384 + vrdo;
#pragma unroll
      for (int s4 = 0; s4 < 4; ++s4) {
        u32x4 pk;
        if (s4 < 2) {
#pragma unroll
          for (int jj = 0; jj < 4; ++jj) pk[jj] = pack_bf2(s0[8 * (s4 & 1) + 2 * jj], s0[8 * (s4 & 1) + 2 * jj + 1]);
        } else {
#pragma unroll
          for (int jj = 0; jj < 4; ++jj) pk[jj] = pack_bf2(s1[8 * (s4 & 1) + 2 * jj], s1[8 * (s4 & 1) + 2 * jj + 1]);
        }
        const bf16x8 pb = __builtin_bit_cast(bf16x8, pk);
#pragma unroll
        for (int dt = 0; dt < 2; ++dt) {
          s16x4 vlo = vtr(vb + dt * 4096 + s4 * 1024);
          s16x4 vhi = vtr(vb + dt * 4096 + s4 * 1024 + 512);
          bf16x8 vf = __builtin_shufflevector(vlo, vhi, 0, 1, 2, 3, 4, 5, 6, 7);
          O[dt] = mfma32(vf, pb, O[dt]);
        }
      }
    }
  __syncthreads();
}

DI void attn_item(const Params& p, int bg, int qt, char* smem) {
  const int tid = opaque_tid(), lane = tid & 63, w = tid >> 6, l31 = lane & 31, h = lane >> 5;
  const int b = bg >> 1, g = bg & 1;
  const int t0 = qt * 64;
  const int tok_l = w * 8 + (l31 >> 2);
  const int tpos = t0 + tok_l;
  const int r = l31 & 3;
  const size_t tglob = (size_t)b * SEQ + tpos;
  bf16x8 qf[4];
  {
    const u16* qp = p.qb + tglob * 512 + (g * 4 + r) * 64 + h * 8;
#pragma unroll
    for (int ks = 0; ks < 4; ++ks) qf[ks] = *(const bf16x8*)(qp + ks * 16);
  }
  const float g0 = p.gate[tglob * 24 + 0 + g * 4 + r];
  const float g1 = p.gate[tglob * 24 + 8 + g * 4 + r];
  const float g2 = p.gate[tglob * 24 + 16 + g * 4 + r];
  const int cur = t0 >> 6;
  f32x16 O[2];
  float m, l;
  unsigned* stash = (unsigned*)(smem + AT_S) + w * 1024 + lane;
  {
    const u16* Kc = p.kcmp + (size_t)bg * 256 * 64;
    const u16* Vc = p.vcmp + (size_t)bg * 256 * 64;
    const int nct = ((t0 + 32) >> 10) + 1;
    const int hi = (tpos - 31) >> 4;
    const int hi_min = (t0 - 31) >> 4;
    attn_cmp(Kc, Vc, nct, smem, qf, O, hi, hi_min, tok_l, tid);
    const float* Ps = (const float*)(smem + AT_P);
    unsigned long long* Ms = (unsigned long long*)(smem + AT_M);
    const int ncv = nct * 64;
    for (int tl = 0; tl < 8; ++tl) {
      const int tokl = w * 8 + tl;
      const int j = lane;
      const float* pr = Ps + tokl * 256;
      float imp = 0.f;
      if (4 * j < ncv) {
        float4 v = *(const float4*)(pr + 4 * j);
        imp = 2.f * (v.x + v.y + v.z) + v.w;
        if (j > 0) imp += pr[4 * j - 1];
      }
      unsigned key = ((__float_as_uint(imp) & ~63u) | (unsigned)(63 - j)) + 64u;
      if (j > cur) key = (unsigned)(63 - j);
      if (j == 0 || j == cur || j == cur - 1) key = 0xFFFFFF00u | (unsigned)(63 - j);
      unsigned* kl = (unsigned*)(smem + w * 256);
      kl[lane] = key;
      int cnt = 0;
#pragma unroll
      for (int k4 = 0; k4 < 16; ++k4) {
        const u32x4 q = *(const u32x4*)(kl + 4 * k4);
        cnt += (q[0] > key) + (q[1] > key) + (q[2] > key) + (q[3] > key);
      }
      unsigned long long bal = __ballot(cnt < 16);
      if (lane == 0) Ms[tokl] = bal;
    }
  }
  __syncthreads();
  unsigned mlo, mhi;
  {
    const unsigned* Mw = (const unsigned*)(smem + AT_M);
    mlo = Mw[tok_l * 2]; mhi = Mw[tok_l * 2 + 1];
  }
#pragma unroll
  for (int i = 0; i < 8; ++i) { stash[i * 64] = pack_bf2(g0 * O[0][2 * i], g0 * O[0][2 * i + 1]); stash[(8 + i) * 64] = pack_bf2(g0 * O[1][2 * i], g0 * O[1][2 * i + 1]); }
  {
    m = NEGF; l = 0.f;
    O[0] = zero16(); O[1] = zero16();
    attn_tiles_ring<2>(p.kvb + (size_t)(2 * 16 + bg) * SEQ * 64, p.kvb + (size_t)(3 * 16 + bg) * SEQ * 64, 0, cur, smem, qf, m, l, O,
                  0, tpos, 0, t0, mlo, mhi, tid);
    const float lt = l + __shfl_xor(l, 32);
    const float sc = g1 / fmaxf(lt, 1e-30f);
#pragma unroll
    for (int i = 0; i < 8; ++i) {
      const unsigned u0 = stash[i * 64], u1 = stash[(8 + i) * 64];
      stash[i * 64] = pack_bf2(bf_lo(u0) + sc * O[0][2 * i], bf_hi(u0) + sc * O[0][2 * i + 1]);
      stash[(8 + i) * 64] = pack_bf2(bf_lo(u1) + sc * O[1][2 * i], bf_hi(u1) + sc * O[1][2 * i + 1]);
    }
  }
  {
    m = NEGF; l = 0.f;
    O[0] = zero16(); O[1] = zero16();
    const int jlo = max(t0 - 511, 0) >> 6;
    attn_tiles_ring<3>(p.kvb + (size_t)(4 * 16 + bg) * SEQ * 64, p.kvb + (size_t)(5 * 16 + bg) * SEQ * 64, jlo, cur, smem, qf, m, l, O,
                  tpos - 511, tpos, t0 + 63 - 511, t0, 0u, 0u, tid);
    const float lt = l + __shfl_xor(l, 32);
    const float sc = g2 / fmaxf(lt, 1e-30f);
#pragma unroll
    for (int i = 0; i < 8; ++i) {
      const unsigned u0 = stash[i * 64], u1 = stash[(8 + i) * 64];
      O[0][2 * i] = bf_lo(u0) + sc * O[0][2 * i]; O[0][2 * i + 1] = bf_hi(u0) + sc * O[0][2 * i + 1];
      O[1][2 * i] = bf_lo(u1) + sc * O[1][2 * i]; O[1][2 * i + 1] = bf_hi(u1) + sc * O[1][2 * i + 1];
    }
  }
  u16* op = p.ob + tglob * 512 + (g * 4 + r) * 64 + 4 * h;
#pragma unroll
  for (int dt = 0; dt < 2; ++dt)
#pragma unroll
    for (int gq = 0; gq < 4; ++gq) {
      u32x2 o = {pack_bf2(O[dt][4 * gq], O[dt][4 * gq + 1]), pack_bf2(O[dt][4 * gq + 2], O[dt][4 * gq + 3])};
      *(u32x2*)(op + dt * 32 + 8 * gq) = o;
    }
}

DI void p10_rows(const Params& p, int item) {
  const int w = threadIdx.x >> 6, lane = threadIdx.x & 63;
  const int row = item * 8 + w;
  float s = (lane < 16) ? p.ssq2[(size_t)row * 16 + lane] : 0.f;
#pragma unroll
  for (int o = 8; o; o >>= 1) s += __shfl_xor(s, o);
  s = __shfl(s, 0);
  const float rs = rsqrtf(s * (1.f / DM) + 1e-6f);
  float4* o4 = (float4*)(p.out + (size_t)row * DM);
  const float4* g4 = (const float4*)p.norm_final;
#pragma unroll
  for (int i = 0; i < 4; ++i) {
    float4 v = o4[lane + 64 * i], g = g4[lane + 64 * i];
    v.x *= rs * g.x; v.y *= rs * g.y; v.z *= rs * g.z; v.w *= rs * g.w;
    o4[lane + 64 * i] = v;
  }
}


#define XB_TMO      128
#define XB_XCNT(j)  (256  + 64 * (j))
#define XB_XSUB(j)  (1280 + 64 * (j))
#define XB_XGEN(j)  (2304 + 64 * (j))
#define XB_TOP      3328
#define XB_TOPGEN   3392
#define XCD_BAR_WORDS 3456
#define XB_SPIN_CAP (1u << 18)
DI unsigned xb_xcc_id() { return (unsigned)__builtin_amdgcn_s_getreg((3 << 11) | 20) & 0xFu; }
#define XB_SPIN(cond, bar) do { unsigned _sp = 0; while (cond) { __builtin_amdgcn_s_sleep(1); \
    if ((++_sp & 255u) == 0u) { if (xb_ld(&(bar)[XB_TMO])) break; if (_sp > XB_SPIN_CAP) { atomicAdd(&(bar)[XB_TMO], 1u); break; } } } } while (0)
struct XcdBarrier { unsigned* bar; unsigned x; volatile LAS unsigned* st; };
DI XcdBarrier xcd_barrier_post(unsigned* bar, volatile LAS unsigned* st) {
  XcdBarrier b; b.bar = bar; b.x = xb_xcc_id(); b.st = st;
  if (threadIdx.x == 0) (void)xb_add(&bar[XB_XCNT(b.x)], 1u);
  return b;
}
DI void xcd_barrier_complete(unsigned* bar, unsigned x, unsigned& nloc, unsigned& nx) {
  const unsigned G = gridDim.x * gridDim.y * gridDim.z;
  unsigned sum, cnt, mine, sp = 0u;
  for (;;) {
    sum = 0u; cnt = 0u; mine = 0u;
#pragma unroll
    for (unsigned j = 0; j < 16; ++j) { const unsigned c = xb_ld(&bar[XB_XCNT(j)]); sum += c; cnt += (c > 0u) ? 1u : 0u; mine = (j == x) ? c : mine; }
    if (sum == G) break;
    __builtin_amdgcn_s_sleep(1);
    if ((++sp & 255u) == 0u) { if (xb_ld(&bar[XB_TMO])) break; if (sp > XB_SPIN_CAP) { atomicAdd(&bar[XB_TMO], 1u); break; } }
  }
  nloc = mine > 0u ? mine : 1u; nx = cnt > 0u ? cnt : 1u;
}
DI void xcd_barrier(const XcdBarrier& b) {
  asm volatile("s_waitcnt vmcnt(0)" ::: "memory");
  __syncthreads();
  if (threadIdx.x == 0) {
    unsigned* bar = b.bar;
    __builtin_amdgcn_s_waitcnt(0);
    unsigned nloc = b.st[0], nx = b.st[1];
    if (nloc == 0u) { xcd_barrier_complete(bar, b.x, nloc, nx); b.st[0] = nloc; b.st[1] = nx; }
    const unsigned old = xb_add(&bar[XB_XSUB(b.x)], 1u);
    const unsigned gen = old / nloc;
    if (old + 1u == (gen + 1u) * nloc) {
      __builtin_amdgcn_fence(__ATOMIC_RELEASE, "agent");
      asm volatile("s_waitcnt vmcnt(0)" ::: "memory");
      const unsigned og = xb_add(&bar[XB_TOP], 1u);
      const unsigned tg = og / nx;
      if (og + 1u == (tg + 1u) * nx) xb_add(&bar[XB_TOPGEN], 1u);
      else XB_SPIN(xb_ld(&bar[XB_TOPGEN]) == tg, bar);
      __builtin_amdgcn_fence(__ATOMIC_ACQUIRE, "agent");
      xb_add(&bar[XB_XGEN(b.x)], 1u);
      asm volatile("s_waitcnt vmcnt(0)" ::: "memory");
    } else {
      XB_SPIN(xb_ld(&bar[XB_XGEN(b.x)]) == gen, bar);
      __builtin_amdgcn_fence(__ATOMIC_ACQUIRE, "agent");
      asm volatile("s_waitcnt vmcnt(0)" ::: "memory");
    }
  }
  __syncthreads();
}

__global__ void __launch_bounds__(NTHR, 2) nsa_pool_block_fwd(Params p) {
  extern __shared__ __attribute__((aligned(16))) unsigned char shm[];
  char* smem = (char*)shm;
  LAS unsigned char* lds = (LAS unsigned char*)shm;
  cg::grid_group grid = cg::this_grid();
  const int G = gridDim.x;
  const int bid = blockIdx.x;
  const int L = (G % 8 == 0) ? (bid % 8) * (G / 8) + bid / 8 : bid;
  volatile LAS unsigned* xst = (volatile LAS unsigned*)(lds + 133120);
  if (threadIdx.x < 4) xst[threadIdx.x] = 0u;
  __syncthreads();
  const XcdBarrier xb = xcd_barrier_post(p.bar, xst);

  if (PH_MASK & 1)
  {
    constexpr int N0 = 1024, N1 = N0 + TJ_EARLY / 2, N2 = N1 + 64, N3 = N2 + 16, N4 = N3 + 64;
    for (int rep = 0; rep < ((REP_MASK & 1) ? 2 : 1); ++rep)
    for (int it = N4 - 1 - bid; it >= 0; it -= G) {
      if (it < N0) p0_rows(p, it);
      else if (it < N1) p0_transpose(p, it - N0, smem, 0);
      else if (it < N2) p0_weff(p, it - N1, smem);
      else if (it < N3) p0_cbias(p, it - N2, smem);
      else p0_rope(p, it - N3);
    }
  }
  if (p.bar == nullptr) grid.sync();
  xcd_barrier(xb);
  if (PH_MASK & 2) {
    Sched S{0, G, bid};
    EpiProj E{p};
    for (int rep = 0; rep < ((REP_MASK & 2) ? 2 : 1); ++rep)
    gemm_phase(lds, Gemm{p.xb, p.w_in_t, DM, DM, DM, 128, 128}, S, E);
  }
  xcd_barrier(xb);
  if (PH_MASK & 4) for (int rep = 0; rep < ((REP_MASK & 4) ? 2 : 1); ++rep)
  {
    Sched S{2, G, bid};
    EpiCmpHid E{(float*)p.mb};
    gemm_phase(lds, Gemm{p.kvb, p.cw1_t, 1024, 2048, 512, 128, 128}, S, E);
    for (int it = bid; it < 4096; it += G) p2a_pool_item(p, it);
  }
  xcd_barrier(xb);
  if (PH_MASK & 8) {
    Sched S{3, G, bid};
    EpiCmpOut E{p};
    for (int i = 0;; ++i) {
      Unit u;
      if (!S.next(i, u)) break;
      const float* h32 = (const float*)p.mb;
      const float* bias = p.cbias + u.pn * 256;
      for (int e0 = threadIdx.x; e0 < 8192; e0 += 4 * NTHR) {
        f32x4 pv[4][4][2];
#pragma unroll
        for (int q = 0; q < 4; ++q) {
          const int e = e0 + q * NTHR, c = e >> 5, n8 = (e & 31) * 8;
#pragma unroll
          for (int ks = 0; ks < 4; ++ks) {
            const f32x4* sp = (const f32x4*)(h32 + ((size_t)((ks * 32 + u.pm) * 256 + c)) * 256 + n8);
            pv[q][ks][0] = sp[0]; pv[q][ks][1] = sp[1];
          }
        }
#pragma unroll
        for (int q = 0; q < 4; ++q) {
          const int e = e0 + q * NTHR, c = e >> 5, n8 = (e & 31) * 8;
          f32x4 v0 = *(const f32x4*)(bias + n8), v1 = *(const f32x4*)(bias + n8 + 4);
#pragma unroll
          for (int ks = 0; ks < 4; ++ks) { v0 += pv[q][ks][0]; v1 += pv[q][ks][1]; }
#pragma unroll
          for (int j = 0; j < 4; ++j) { v0[j] = gelu_tanh(v0[j]); v1[j] = gelu_tanh(v1[j]); }
          *(u32x4*)(p.hid + ((size_t)u.pm * 256 + c) * 256 + n8) = pack8(v0, v1);
        }
      }
    }
    asm volatile("s_waitcnt vmcnt(0)" ::: "memory");
    __syncthreads();
    gemm_phase(lds, Gemm{p.hid, p.cw2_t, 256, 256, 256, 128, 128}, S, E);
    { Unit u0; const bool has_unit = S.next(0, u0);
      if (G >= 256) {
        if (!has_unit) {
          const int rank = bid - (bid >> 3) - (((bid & 7) > ((bid >> 3) & 7)) ? 1 : 0);
          for (int it = rank; it < (TJ_TOTAL - TJ_EARLY) / 2; it += G - 32) p0_transpose(p, it, smem, TJ_EARLY);
        }
      } else {
        __syncthreads();
        for (int it = bid; it < (TJ_TOTAL - TJ_EARLY) / 2; it += G) p0_transpose(p, it, smem, TJ_EARLY);
      }
    }
  }
  xcd_barrier(xb);
  if (ATTN_PRIO) { if (threadIdx.x >= 256) __builtin_amdgcn_s_setprio(2); }
  if (PH_MASK & 16) for (int rep = 0; rep < ((REP_MASK & 16) ? 2 : 1); ++rep)
  if (G == 256) {
    const int x = bid & 7, j = bid >> 3;
    for (int rd = 0; rd < 4; ++rd) {
      const int idx = rd * 32 + ((rd & 1) ? (31 - j) : j);
      attn_item(p, 2 * x + (idx & 1), 63 - (idx >> 1), smem);
    }
  } else
  for (int rd = 0; rd * G < 1024; ++rd) {
    const int i = rd * G + ((rd & 1) ? (G - 1 - L) : L);
    if (i < 1024) attn_item(p, i & 15, 63 - (i >> 4), smem);
  }
  xcd_barrier(xb);
  if (ATTN_PRIO) __builtin_amdgcn_s_setprio(0);
  if (PH_MASK & 32) {
    Sched S{1, G, bid};
    EpiMerge<0> E0{p};
    EpiMerge<1> E1{p};
    for (int rep = 0; rep < ((REP_MASK & 32) ? 2 : 1); ++rep) {
    gemm_phase(lds, Gemm{p.ob, p.wa_t, 512, 512, 512, 128, 128}, S, E0);
    gemm_phase(lds, Gemm{p.pooled, p.wbe_t, 512, 512, 512, 128, 128}, S, E1);
    }
  }
  xcd_barrier(xb);
  if (PH_MASK & 64) {
    Sched S{1, G, bid};
    EpiResidBf E{p.xb, p.ssq};
    for (int rep = 0; rep < ((REP_MASK & 64) ? 2 : 1); ++rep)
    gemm_phase(lds, Gemm{p.mb, p.wo_t, DM, DM, DM, 128, 128}, S, E);
  }
  xcd_barrier(xb);
  if (PH_MASK & 128) {
    Sched S{0, G, bid};
    EpiFF1 E{p};
    for (int rep = 0; rep < ((REP_MASK & 128) ? 2 : 1); ++rep)
    gemm_phase(lds, Gemm{p.xb, p.w1_t, DM, DM, DM, 128, 128}, S, E);
  }
  xcd_barrier(xb);
#if FUSE_FINAL
  if (PH_MASK & 256) {
    Sched S{1, G, bid};
    EpiFinal E{p.out, p.xb, p.norm_final, p.ssq2, p.bar + XCD_BAR_WORDS};
    gemm_phase(lds, Gemm{p.act, p.w2_t, 64, 64, 4096, (size_t)T_TOK * 128, (size_t)1024 * 128}, S, E);
  }
#else
  if (PH_MASK & 256) {
    Sched S{1, G, bid};
    EpiResid<false> E{p.out, p.out, nullptr, p.ssq2};
    gemm_phase(lds, Gemm{p.act, p.w2_t, 64, 64, 4096, (size_t)T_TOK * 128, (size_t)1024 * 128}, S, E);
  }
  xcd_barrier(xb);
  for (int it = bid; it < 4096; it += G) p10_rows(p, it);
#endif
}

extern "C" void kernel_launch(void* const* d_in, const int* in_sizes, int n_in, void* d_out, int out_size, void* d_ws,
                              size_t ws_size, hipStream_t stream) {
  (void)in_sizes; (void)n_in; (void)out_size; (void)ws_size;
  static int grid_blocks = 0;
  if (!grid_blocks) {
    int dev = 0, cus = 0, per_cu = 0;
    (void)hipGetDevice(&dev);
    (void)hipDeviceGetAttribute(&cus, hipDeviceAttributeMultiprocessorCount, dev);
    (void)hipFuncSetAttribute((const void*)nsa_pool_block_fwd, hipFuncAttributeMaxDynamicSharedMemorySize, LDS_BYTES);
    (void)hipOccupancyMaxActiveBlocksPerMultiprocessor(&per_cu, nsa_pool_block_fwd, NTHR, LDS_BYTES);
    if (per_cu > 1) per_cu = 1;
    if (per_cu < 1) per_cu = 1;
    grid_blocks = cus * per_cu;
  }
  Params p{};
  const float* const* in = (const float* const*)d_in;
  p.x = in[0]; p.norm_mix = in[1]; p.w_in = in[2]; p.pe_k = in[3]; p.pe_v = in[4]; p.ck_w1 = in[5]; p.ck_w2 = in[6];
  p.cv_w1 = in[7]; p.cv_w2 = in[8]; p.w_ba = in[9]; p.pool_w = in[10]; p.pool_scale = in[11]; p.w_bp = in[12];
  p.w_out = in[13]; p.norm_mlp = in[14]; p.w_ff1 = in[15]; p.w_ff2 = in[16]; p.norm_final = in[17];
  p.out = (float*)d_out;
  char* ws = (char*)d_ws;
  size_t off = 0;
  auto take = [&](size_t bytes) { char* r = ws + off; off += (bytes + 255) & ~(size_t)255; return r; };
  const size_t T = T_TOK;
  p.xb = (u16*)take(T * 1024 * 2);
  p.w_in_t = (u16*)take((size_t)NPROJ * 1024 * 2);
  p.wa_t = (u16*)take(1024 * 512 * 2);
  p.wbe_t = (u16*)take(1024 * 512 * 2);
  p.wo_t = (u16*)take(1024 * 1024 * 2);
  p.w1_t = (u16*)take((size_t)4096 * 1024 * 2);
  p.w2_t = (u16*)take((size_t)4096 * 1024 * 2);
  p.cw1_t = (u16*)take(2 * 256 * 2048 * 2);
  p.cw2_t = (u16*)take(2 * 256 * 256 * 2);
  p.rstd0 = (float*)take(T * 4);
  p.cbias = (float*)take(512 * 4);
  p.rope = (float2*)take((size_t)SEQ * 8 * 8);
  p.ssq = (float*)take(T * 16 * 4);
  p.ssq2 = (float*)take(T * 16 * 4);
  p.mb = (u16*)take(T * 1024 * 2);
  char* regionD = ws + off;
  p.qb = (u16*)take(T * 512 * 2);
  p.kvb = (u16*)take((size_t)6 * 16 * SEQ * 64 * 2);
  p.gate = (float*)take(T * 24 * 4);
  p.ub = (u16*)take(T * 512 * 2);
  p.gm = (u16*)take(T * 2048 * 2);
  p.hid = (u16*)take((size_t)2 * 16 * 256 * 256 * 2);
  p.kcmp = (u16*)take(16 * 256 * 64 * 2);
  p.vcmp = (u16*)take(16 * 256 * 64 * 2);
  p.pooled = (u16*)take(T * 512 * 2);
  p.ob = (u16*)take(T * 512 * 2);
  p.bar = (unsigned*)take((XCD_BAR_WORDS + 4096) * 4);
  p.act = (u16*)regionD;
  (void)hipMemsetAsync(p.bar, 0, (XCD_BAR_WORDS + 4096) * 4, stream);
  void* args[] = {&p};
  hipError_t e = hipLaunchCooperativeKernel((void*)nsa_pool_block_fwd, dim3(grid_blocks), dim3(NTHR), args, LDS_BYTES, stream);
  if (e != hipSuccess) fprintf(stderr, "cooperative launch failed: %s (grid %d)\n", hipGetErrorString(e), grid_blocks);
}
```
